# Optimizing an MI355X kernel written in HIP

```python
import math
import jax
import jax.numpy as jnp
from jax import lax
import numpy as np

D_MODEL = 2048
BATCH = 4
SEQ = 4096
DEPTH = 2

CTX_LEN = 256
GRID_W = 64
NORM_EPS = 1e-6

A_HEADS = 8
A_DK = 128
A_DV = 128
A_DIM = A_HEADS * A_DK
A_CHUNK = 64

B_HEADS = 16
B_N = 64
B_DIM = B_HEADS * B_N
B_W_LORA = 64
B_A_LORA = 64
B_G_LORA = 160
B_GN_EPS = 64e-5
B_DECAY_SCALE = math.exp(-0.5)

C_HEADS = 8
C_DK = 128
C_DV = 256
C_QK = C_HEADS * C_DK
C_V = C_HEADS * C_DV
C_CHUNK = 64
C_GATE_CAP = 15.0

FFN_HIDDEN = -(-8 * D_MODEL // (3 * 256)) * 256

CONV_CH = 3 * A_DIM + 3 * B_DIM
AB_Z0 = CONV_CH
AB_GATE0 = AB_Z0 + A_DIM
AB_WD0 = AB_GATE0 + 4 * A_HEADS
AB_AD0 = AB_WD0 + 2 * B_W_LORA
AB_GD0 = AB_AD0 + 2 * B_A_LORA
AB_IN = AB_GD0 + B_G_LORA
AB_MIX = A_DIM + B_DIM

C_O0 = 2 * C_QK + C_V
C_GATE0 = C_O0 + C_V
C_IN = C_GATE0 + 4 * C_HEADS

kernel_name = 'bidir_gdn_rwkv7_mlstm_dit_block'


def rms_norm(x, w, eps=NORM_EPS):
    xf = x.astype(jnp.float32)
    y = xf * lax.rsqrt(jnp.mean(xf * xf, axis=-1, keepdims=True) + eps)
    return (y * w.astype(jnp.float32)).astype(x.dtype)


def modulate(x, w, shift, scale):
    return rms_norm(x, w) * (1 + scale) + shift


def l2norm(t):
    return t * lax.rsqrt(jnp.sum(t * t, axis=-1, keepdims=True) + 1e-6)


def softcap(t, cap):
    return cap * jnp.tanh(t / cap)


def split_heads(t, n_heads):
    b, l, _ = t.shape
    return t.reshape(b, l, n_heads, -1).transpose(0, 2, 1, 3)


def merge_heads(t):
    b, h, l, d = t.shape
    return t.transpose(0, 2, 1, 3).reshape(b, l, h * d)


def to_chunks(t, size):
    b, h, l = t.shape[:3]
    return jnp.moveaxis(t.reshape(b, h, l // size, size, *t.shape[3:]), 2, 0)


def from_chunks(t):
    t = jnp.moveaxis(t, 0, 2)
    b, h, n, size = t.shape[:4]
    return t.reshape(b, h, n * size, *t.shape[4:])


def grid_dwconv3x3(t, w, rows):
    b, l, ch = t.shape
    cols = l // rows
    g = jnp.pad(t.reshape(b, rows, cols, ch), ((0, 0), (1, 1), (1, 1), (0, 0)))
    out = sum(g[:, dr:dr + rows, dc:dc + cols] * w[dr, dc] for dr in range(3) for dc in range(3))
    return out.reshape(b, l, ch)


def swiglu(h, w1, w3, w2):
    return jnp.einsum('blf,fd->bld', jax.nn.silu(h @ w1) * (h @ w3), w2)


def gdn_run(inputs, s0, with_out):
    q, k, v, g, beta = inputs
    dv = v.shape[-1]
    kc, vc, bc = to_chunks(k, A_CHUNK), to_chunks(v, A_CHUNK), to_chunks(beta, A_CHUNK)
    gc = jnp.cumsum(to_chunks(g, A_CHUNK), axis=-1)
    idx = jnp.arange(A_CHUNK)
    causal = idx[:, None] >= idx[None, :]
    decay = jnp.exp(jnp.where(causal, gc[..., :, None] - gc[..., None, :], -jnp.inf))
    kb = kc * bc[..., None]
    m = jnp.where(idx[:, None] > idx[None, :], jnp.einsum('nbhid,nbhjd->nbhij', kb, kc) * decay, 0.0)
    rhs = jnp.concatenate([vc * bc[..., None], kb * jnp.exp(gc)[..., None]], axis=-1)
    uw = lax.linalg.triangular_solve(m, rhs, left_side=True, lower=True, unit_diagonal=True)
    xs = (kc, gc, uw[..., :dv], uw[..., dv:])
    if with_out:
        qc = to_chunks(q, A_CHUNK)
        xs = xs + (qc * jnp.exp(gc)[..., None], jnp.einsum('nbhid,nbhjd->nbhij', qc, kc) * decay)

    def step(s, xc):
        k_c, g_c, u_c, w_c = xc[:4]
        v_new = u_c - jnp.einsum('bhcd,bhde->bhce', w_c, s)
        g_last = g_c[..., -1]
        s_next = s * jnp.exp(g_last)[..., None, None] + jnp.einsum(
            'bhcd,bhce->bhde', k_c * jnp.exp(g_last[..., None] - g_c)[..., None], v_new)
        if with_out:
            qg_c, qk_c = xc[4:]
            o = jnp.einsum('bhcd,bhde->bhce', qg_c, s) + jnp.einsum('bhij,bhje->bhie', qk_c, v_new)
            return s_next, o
        return s_next, None

    s_fin, o = lax.scan(step, s0, xs)
    return s_fin, (from_chunks(o) if with_out else None)


def rwkv7_run(inputs, s0, with_out):
    r, w, kk, kka, v, kt = inputs
    seq_major = lambda t: jnp.moveaxis(t, 2, 0)
    xs = tuple(seq_major(t) for t in (w, kk, kka, v, kt))
    if with_out:
        xs = xs + (seq_major(r),)

    def step(s, xt):
        w_t, kk_t, kka_t, v_t, k_t = xt[:5]
        s_kk = jnp.einsum('bhvk,bhk->bhv', s, kk_t)
        s = s * w_t[..., None, :] - s_kk[..., :, None] * kka_t[..., None, :] + v_t[..., :, None] * k_t[..., None, :]
        if with_out:
            return s, jnp.einsum('bhvk,bhk->bhv', s, xt[5])
        return s, None

    s_fin, y = lax.scan(step, s0, xs)
    return s_fin, (jnp.moveaxis(y, 0, 2) if with_out else None)


def mlstm_run(inputs, state0, with_out):
    q, k, v, ig, logf = inputs
    kc, vc, igc = to_chunks(k, C_CHUNK), to_chunks(v, C_CHUNK), to_chunks(ig, C_CHUNK)
    b = jnp.cumsum(to_chunks(logf, C_CHUNK), axis=-1)
    w_end = b[..., -1:] - b + igc
    xs = (kc, vc, b, w_end)
    if with_out:
        qc = to_chunks(q, C_CHUNK)
        idx = jnp.arange(C_CHUNK)
        causal = idx[:, None] >= idx[None, :]
        dmat = jnp.where(causal, b[..., :, None] - b[..., None, :] + igc[..., None, :], -jnp.inf)
        xs = xs + (qc, dmat, jnp.max(dmat, axis=-1), jnp.einsum('nbhid,nbhjd->nbhij', qc, kc))

    def step(carry, xc):
        c_st, n_st, m_st = carry
        k_c, v_c, b_c, w_c = xc[:4]
        b_last = b_c[..., -1]
        m_new = jnp.maximum(b_last + m_st, jnp.max(w_c, axis=-1))
        scale = jnp.exp(b_last + m_st - m_new)
        kw = k_c * jnp.exp(w_c - m_new[..., None])[..., None]
        c_next = c_st * scale[..., None, None] + jnp.einsum('bhcd,bhce->bhde', kw, v_c)
        n_next = n_st * scale[..., None] + jnp.sum(kw, axis=-2)
        if with_out:
            q_c, d_c, dmax_c, qk_c = xc[4:]
            m_row = jnp.maximum(b_c + m_st[..., None], dmax_c)
            inter = jnp.exp(b_c + m_st[..., None] - m_row)
            s = qk_c * jnp.exp(d_c - m_row[..., None])
            num = jnp.einsum('bhij,bhje->bhie', s, v_c) + inter[..., None] * jnp.einsum('bhid,bhde->bhie', q_c, c_st)
            den = jnp.sum(s, axis=-1) + inter * jnp.einsum('bhid,bhd->bhi', q_c, n_st)
            h = num / jnp.maximum(jnp.abs(den), jnp.exp(-m_row))[..., None]
            return (c_next, n_next, m_new), h
        return (c_next, n_next, m_new), None

    s_fin, h = lax.scan(step, state0, xs)
    return s_fin, (from_chunks(h) if with_out else None)


def flip_seq(ts):
    return tuple(jnp.flip(t, axis=2) for t in ts)


def scan_two_streams(run, ctx_in, lat_in, state0, ctx_out):
    s_ctx, y_ctx = run(ctx_in, state0, ctx_out)
    _, y_lat = run(lat_in, s_ctx, True)
    return y_ctx, y_lat


def bidirectional(run, ctx_fwd, lat_fwd, ctx_bwd, lat_bwd, state0, ctx_out):
    yc_f, yl_f = scan_two_streams(run, ctx_fwd, lat_fwd, state0, ctx_out)
    yc_b, yl_b = scan_two_streams(run, flip_seq(ctx_bwd), flip_seq(lat_bwd), state0, ctx_out)
    y_lat = yl_f + jnp.flip(yl_b, axis=2)
    y_ctx = (yc_f + jnp.flip(yc_b, axis=2)) if ctx_out else None
    return y_ctx, y_lat


def ab_features(h, rows, w_in, conv_w, a_log, dt_bias, w0, w_up, a0, a_up, g_up, k_k, k_a):
    b, l, _ = h.shape
    p = jnp.einsum('bld,dp->blp', h, w_in).astype(jnp.float32)
    cv = grid_dwconv3x3(p[..., :CONV_CH], conv_w, rows)
    qa, ka, va = jnp.split(jax.nn.silu(cv[..., :3 * A_DIM]), 3, axis=-1)
    qa = l2norm(split_heads(qa, A_HEADS)) * A_DK ** -0.5
    ka = l2norm(split_heads(ka, A_HEADS))
    va = split_heads(va, A_HEADS)
    z = p[..., AB_Z0:AB_GATE0]
    gl = p[..., AB_GATE0:AB_WD0].reshape(b, l, 2, 2, A_HEADS).transpose(2, 3, 0, 4, 1)
    log_alpha = -jnp.exp(a_log)[:, None, :, None] * jax.nn.softplus(gl[0] + dt_bias[:, None, :, None])
    beta = jax.nn.sigmoid(gl[1])
    gdn_f = (qa, ka, va, log_alpha[0], beta[0])
    gdn_b = (qa, ka, va, log_alpha[1], beta[1])
    r, kb, vb = jnp.split(cv[..., 3 * A_DIM:], 3, axis=-1)
    wd = p[..., AB_WD0:AB_AD0].reshape(b, l, 2, B_W_LORA)
    ad = p[..., AB_AD0:AB_GD0].reshape(b, l, 2, B_A_LORA)
    log_w = -B_DECAY_SCALE * jax.nn.sigmoid(w0 + jnp.einsum('bldr,drc->bldc', jnp.tanh(wd), w_up))
    a = jax.nn.sigmoid(a0 + jnp.einsum('bldr,drc->bldc', ad, a_up))
    g_out = jnp.einsum('blr,rc->blc', jax.nn.sigmoid(p[..., AB_GD0:AB_IN]), g_up)
    kk = l2norm(split_heads(kb * k_k, B_HEADS))
    kt = kb[:, :, None] * (1 + (a - 1) * k_a)
    rh, vh = split_heads(r, B_HEADS), split_heads(vb, B_HEADS)

    def direction(d):
        kka = kk * split_heads(a[:, :, d], B_HEADS)
        return (rh, split_heads(jnp.exp(log_w[:, :, d]), B_HEADS), kk, kka, vh, split_heads(kt[:, :, d], B_HEADS))

    post = (z, rh, split_heads(kt[:, :, 0] + kt[:, :, 1], B_HEADS), vh, g_out)
    return gdn_f, gdn_b, direction(0), direction(1), post


def ab_output(o_a, y_b, post, gdn_norm_w, r_k, ln_w, ln_b, w_out, dtype):
    z, rh, kt_sum, vh, g_out = post
    ya = merge_heads(rms_norm(o_a, gdn_norm_w)) * jax.nn.silu(z)
    mu = jnp.mean(y_b, axis=-1, keepdims=True)
    var = jnp.mean(jnp.square(y_b - mu), axis=-1, keepdims=True)
    yb = (y_b - mu) * lax.rsqrt(var + B_GN_EPS)
    bonus = jnp.sum(rh * kt_sum * r_k[:, None, :], axis=-1, keepdims=True) * vh
    yb = (merge_heads(yb) * ln_w + ln_b + merge_heads(bonus)) * g_out
    return jnp.einsum('blc,cd->bld', jnp.concatenate([ya, yb], axis=-1), w_out).astype(dtype)


def ab_mixer(h_c, h_l, rows, ctx_out, w_in, conv_w, a_log, dt_bias, gdn_norm_w, w0, w_up, a0, a_up, g_up,
             k_k, k_a, r_k, ln_w, ln_b, w_out):
    gc_f, gc_b, rc_f, rc_b, post_c = ab_features(h_c, 1, w_in, conv_w, a_log, dt_bias, w0, w_up, a0, a_up, g_up, k_k, k_a)
    gl_f, gl_b, rl_f, rl_b, post_l = ab_features(h_l, rows, w_in, conv_w, a_log, dt_bias, w0, w_up, a0, a_up, g_up, k_k, k_a)
    bsz = h_l.shape[0]
    s0_a = jnp.zeros((bsz, A_HEADS, A_DK, A_DV), jnp.float32)
    s0_b = jnp.zeros((bsz, B_HEADS, B_N, B_N), jnp.float32)
    oa_c, oa_l = bidirectional(gdn_run, gc_f, gl_f, gc_b, gl_b, s0_a, ctx_out)
    yb_c, yb_l = bidirectional(rwkv7_run, rc_f, rl_f, rc_b, rl_b, s0_b, ctx_out)
    out_l = ab_output(oa_l, yb_l, post_l, gdn_norm_w, r_k, ln_w, ln_b, w_out, h_l.dtype)
    out_c = ab_output(oa_c, yb_c, post_c, gdn_norm_w, r_k, ln_w, ln_b, w_out, h_c.dtype) if ctx_out else None
    return out_c, out_l


def mlstm_features(h, w_in, i_bias, f_bias):
    b, l, _ = h.shape
    p = jnp.einsum('bld,dp->blp', h, w_in).astype(jnp.float32)
    q = split_heads(p[..., :C_QK], C_HEADS) * C_DK ** -0.5
    k = split_heads(p[..., C_QK:2 * C_QK], C_HEADS)
    v = split_heads(p[..., 2 * C_QK:C_O0], C_HEADS)
    o = p[..., C_O0:C_GATE0]
    gl = p[..., C_GATE0:].reshape(b, l, 2, 2, C_HEADS).transpose(2, 3, 0, 4, 1)
    ig = softcap(gl[0] + i_bias[:, None, :, None], C_GATE_CAP)
    logf = jax.nn.log_sigmoid(softcap(gl[1] + f_bias[:, None, :, None], C_GATE_CAP))
    return (q, k, v, ig[0], logf[0]), (q, k, v, ig[1], logf[1]), o


def mlstm_output(hh, o, norm_w, w_out, dtype):
    y = merge_heads(rms_norm(hh, norm_w.reshape(C_HEADS, 1, C_DV))) * jax.nn.sigmoid(o)
    return jnp.einsum('blc,cd->bld', y, w_out).astype(dtype)


def mlstm_mixer(h_c, h_l, ctx_out, w_in, i_bias, f_bias, norm_w, w_out):
    c_f, c_b, o_c = mlstm_features(h_c, w_in, i_bias, f_bias)
    l_f, l_b, o_l = mlstm_features(h_l, w_in, i_bias, f_bias)
    bsz = h_l.shape[0]
    s0 = (jnp.zeros((bsz, C_HEADS, C_DK, C_DV), jnp.float32),
          jnp.zeros((bsz, C_HEADS, C_DK), jnp.float32),
          jnp.zeros((bsz, C_HEADS), jnp.float32))
    hc, hl = bidirectional(mlstm_run, c_f, l_f, c_b, l_b, s0, ctx_out)
    out_l = mlstm_output(hl, o_l, norm_w, w_out, h_l.dtype)
    out_c = mlstm_output(hc, o_c, norm_w, w_out, h_c.dtype) if ctx_out else None
    return out_c, out_l


def setup_inputs(seed: int = 0) -> dict:
    key = jax.random.key(seed)
    keys = iter(jax.random.split(key, 48))

    def nrm(shape, scale):
        return scale * jax.random.normal(next(keys), shape, jnp.float32)

    def unif(shape, lo, hi):
        return jax.random.uniform(next(keys), shape, jnp.float32, lo, hi)

    ne, no = (DEPTH + 1) // 2, DEPTH // 2
    d = D_MODEL
    dt = jnp.exp(unif((ne, 2, A_HEADS), math.log(1e-3), math.log(1e-1)))
    return {
        'x': nrm((BATCH, SEQ, d), 1.0),
        'c': nrm((BATCH, d), 1.0),
        'ctx': nrm((BATCH, CTX_LEN, d), 1.0),
        'c_ctx': nrm((d,), 1.0),
        'ada_w': nrm((DEPTH, d, 6 * d), 0.5 * d ** -0.5),
        'ada_b': nrm((DEPTH, 6 * d), 0.02),
        'norm_w': 1.0 + nrm((DEPTH, 2, d), 0.02),
        'ab_w_in': nrm((ne, d, AB_IN), d ** -0.5),
        'ab_conv_w': nrm((ne, 3, 3, CONV_CH), 1.0 / 3.0),
        'gdn_a_log': jnp.log(unif((ne, 2, A_HEADS), 1.0, 16.0)),
        'gdn_dt_bias': dt + jnp.log(-jnp.expm1(-dt)),
        'gdn_norm_w': 1.0 + nrm((ne, A_DV), 0.02),
        'rw_w0': unif((ne, 2, B_DIM), -3.0, 3.0),
        'rw_w_up': nrm((ne, 2, B_W_LORA, B_DIM), 0.5 * B_W_LORA ** -0.5),
        'rw_a0': nrm((ne, 2, B_DIM), 0.1),
        'rw_a_up': nrm((ne, 2, B_A_LORA, B_DIM), 0.5 * B_A_LORA ** -0.5),
        'rw_g_up': nrm((ne, B_G_LORA, B_DIM), B_G_LORA ** -0.5),
        'rw_k_k': 0.85 + nrm((ne, B_DIM), 0.02),
        'rw_k_a': 1.0 + nrm((ne, B_DIM), 0.02),
        'rw_r_k': nrm((ne, B_HEADS, B_N), 0.1),
        'rw_ln_w': 1.0 + nrm((ne, B_DIM), 0.02),
        'rw_ln_b': nrm((ne, B_DIM), 0.02),
        'ab_w_out': nrm((ne, AB_MIX, d), AB_MIX ** -0.5),
        'ml_w_in': nrm((no, d, C_IN), d ** -0.5),
        'ml_i_bias': nrm((no, 2, C_HEADS), 0.1),
        'ml_f_bias': jnp.linspace(3.0, 6.0, C_HEADS) + nrm((no, 2, C_HEADS), 0.1),
        'ml_norm_w': 1.0 + nrm((no, C_V), 0.02),
        'ml_w_out': nrm((no, C_V, d), C_V ** -0.5),
        'ffn_w1': nrm((DEPTH, d, FFN_HIDDEN), d ** -0.5),
        'ffn_w3': nrm((DEPTH, d, FFN_HIDDEN), d ** -0.5),
        'ffn_w2': nrm((DEPTH, FFN_HIDDEN, d), FFN_HIDDEN ** -0.5),
        'final_norm_w': 1.0 + nrm((d,), 0.02),
    }


def reference(x, c, ctx, c_ctx, ada_w, ada_b, norm_w, ab_w_in, ab_conv_w, gdn_a_log, gdn_dt_bias, gdn_norm_w,
              rw_w0, rw_w_up, rw_a0, rw_a_up, rw_g_up, rw_k_k, rw_k_a, rw_r_k, rw_ln_w, rw_ln_b, ab_w_out,
              ml_w_in, ml_i_bias, ml_f_bias, ml_norm_w, ml_w_out, ffn_w1, ffn_w3, ffn_w2, final_norm_w):
    rows = x.shape[1] // GRID_W
    cond_l = jax.nn.silu(c)[:, None, :]
    cond_c = jax.nn.silu(c_ctx)[None, None, :]
    xc = ctx
    for i in range(DEPTH):
        ctx_out = i < DEPTH - 1
        j = i // 2
        ml = jnp.split(jnp.einsum('bsd,de->bse', cond_l, ada_w[i]) + ada_b[i], 6, axis=-1)
        mc = jnp.split(jnp.einsum('bsd,de->bse', cond_c, ada_w[i]) + ada_b[i], 6, axis=-1)
        h_l = modulate(x, norm_w[i, 0], ml[0], ml[1])
        h_c = modulate(xc, norm_w[i, 0], mc[0], mc[1])
        if i % 2 == 0:
            o_c, o_l = ab_mixer(h_c, h_l, rows, ctx_out, ab_w_in[j], ab_conv_w[j], gdn_a_log[j], gdn_dt_bias[j],
                                gdn_norm_w[j], rw_w0[j], rw_w_up[j], rw_a0[j], rw_a_up[j], rw_g_up[j], rw_k_k[j],
                                rw_k_a[j], rw_r_k[j], rw_ln_w[j], rw_ln_b[j], ab_w_out[j])
        else:
            o_c, o_l = mlstm_mixer(h_c, h_l, ctx_out, ml_w_in[j], ml_i_bias[j], ml_f_bias[j], ml_norm_w[j], ml_w_out[j])
        x = x + ml[2] * o_l
        x = x + ml[5] * swiglu(modulate(x, norm_w[i, 1], ml[3], ml[4]), ffn_w1[i], ffn_w3[i], ffn_w2[i])
        if ctx_out:
            xc = xc + mc[2] * o_c
            xc = xc + mc[5] * swiglu(modulate(xc, norm_w[i, 1], mc[3], mc[4]), ffn_w1[i], ffn_w3[i], ffn_w2[i])
    return rms_norm(x, final_norm_w)
```

```cpp
#include <hip/hip_runtime.h>
#include <cstdio>
#include <cstdint>
#define LAS __attribute__((address_space(3)))
#define GAS __attribute__((address_space(1)))
#define XB_TMO      128
#define XB_XCNT(j)  (256  + 64 * (j))
#define XB_XSUB(j)  (1280 + 64 * (j))
#define XB_XGEN(j)  (2304 + 64 * (j))
#define XB_TOP      3328
#define XB_TOPGEN   3392
#define XCD_BAR_WORDS 3456
#define XB_SPIN_CAP (1u << 20)

__device__ __forceinline__ unsigned xb_ld(unsigned* p)              { return __hip_atomic_load(p, __ATOMIC_RELAXED, __HIP_MEMORY_SCOPE_AGENT); }
__device__ __forceinline__ unsigned xb_add(unsigned* p, unsigned v) { return __hip_atomic_fetch_add(p, v, __ATOMIC_RELAXED, __HIP_MEMORY_SCOPE_AGENT); }
__device__ __forceinline__ unsigned xb_xcc_id() { return (unsigned)__builtin_amdgcn_s_getreg((3 << 11) | 20) & 0xFu; }
#define XB_SPIN(cond, bar) do { unsigned _sp = 0; while (cond) { __builtin_amdgcn_s_sleep(1); \
    if ((++_sp & 255u) == 0u) { if (xb_ld(&(bar)[XB_TMO])) break; if (_sp > XB_SPIN_CAP) { atomicAdd(&(bar)[XB_TMO], 1u); break; } } } } while (0)

struct XcdBarrier {
    unsigned* bar; unsigned x;
    volatile LAS unsigned* st;
};

__device__ __forceinline__ XcdBarrier xcd_barrier_post(unsigned* bar, volatile LAS unsigned* st) {
    XcdBarrier b; b.bar = bar; b.x = xb_xcc_id(); b.st = st;
    if (threadIdx.x == 0) (void)xb_add(&bar[XB_XCNT(b.x)], 1u);
    return b;
}
__device__ __forceinline__ void xcd_barrier_complete(unsigned* bar, unsigned x, unsigned& nloc, unsigned& nx) {
    const unsigned G = gridDim.x * gridDim.y * gridDim.z;
    unsigned sum, cnt, mine, sp = 0u;
    for (;;) {
        sum = 0u; cnt = 0u; mine = 0u;
#pragma unroll
        for (unsigned j = 0; j < 16; ++j) { const unsigned c = xb_ld(&bar[XB_XCNT(j)]); sum += c; cnt += (c > 0u) ? 1u : 0u; mine = (j == x) ? c : mine; }
        if (sum == G) break;
        __builtin_amdgcn_s_sleep(1);
        if ((++sp & 255u) == 0u) { if (xb_ld(&bar[XB_TMO])) break; if (sp > XB_SPIN_CAP) { atomicAdd(&bar[XB_TMO], 1u); break; } }
    }
    nloc = mine > 0u ? mine : 1u; nx = cnt > 0u ? cnt : 1u;
}

__device__ __forceinline__ void xcd_barrier(const XcdBarrier& b) {
    asm volatile("s_waitcnt vmcnt(0)" ::: "memory");
    __syncthreads();
    if (threadIdx.x == 0) {
        unsigned* bar = b.bar;
        __builtin_amdgcn_s_waitcnt(0);
        unsigned nloc = b.st[0], nx = b.st[1];
        if (nloc == 0u) { xcd_barrier_complete(bar, b.x, nloc, nx); b.st[0] = nloc; b.st[1] = nx; }
        const unsigned old = xb_add(&bar[XB_XSUB(b.x)], 1u);
        const unsigned gen = old / nloc;
        if (old + 1u == (gen + 1u) * nloc) {
            __builtin_amdgcn_fence(__ATOMIC_RELEASE, "agent");
            asm volatile("s_waitcnt vmcnt(0)" ::: "memory");
            const unsigned og = xb_add(&bar[XB_TOP], 1u);
            const unsigned tg = og / nx;
            if (og + 1u == (tg + 1u) * nx) xb_add(&bar[XB_TOPGEN], 1u);
            else XB_SPIN(xb_ld(&bar[XB_TOPGEN]) == tg, bar);
            __builtin_amdgcn_fence(__ATOMIC_ACQUIRE, "agent");
            xb_add(&bar[XB_XGEN(b.x)], 1u);
            asm volatile("s_waitcnt vmcnt(0)" ::: "memory");
        } else {
            XB_SPIN(xb_ld(&bar[XB_XGEN(b.x)]) == gen, bar);
            __builtin_amdgcn_fence(__ATOMIC_ACQUIRE, "agent");
            asm volatile("s_waitcnt vmcnt(0)" ::: "memory");
        }
    }
    __syncthreads();
}
#include <hip/hip_runtime.h>
namespace pg8 {
#define PG8_LAS __attribute__((address_space(3)))
typedef unsigned short bf16_t;
typedef short bf16x8 __attribute__((ext_vector_type(8)));
typedef float f32x4 __attribute__((ext_vector_type(4)));
typedef unsigned u32x4 __attribute__((ext_vector_type(4)));
constexpr int BM = 256, BK = 64, HALF = 128, HTB = HALF * BK * 2  , STAGE_BYTES = 8 * HTB, NXCD = 8, WGM = 8;

__host__ __device__ __forceinline__ int lds_byte(int r, int c) { const int st = (r >> 4) * 2 + (c >> 5), rr = r & 15, cc = c & 31, ob = rr * 64 + cc * 2; return st * 1024 + (ob ^ (((ob >> 9) & 1) << 5)); }
__host__ __device__ __forceinline__ void stage_rc(int b, int& R, int& C) { const int st = b / 1024, sb = b % 1024, swz = sb ^ (((sb >> 9) & 1) << 5); R = (st >> 1) * 16 + swz / 64; C = (st & 1) * 32 + (swz % 64) / 2; }
__host__ __device__ __forceinline__ int perm32(int rho) { const int n = rho >> 4, i = rho & 15; return 8 * (i >> 2) + 4 * n + (i & 3); }

struct Unit { int pm, pn; };
struct Gemm { const bf16_t* A; const bf16_t* Bt; int M, N, K; };

struct StaticOrder {
    int nM, nN, nwg, G, c;
    __host__ __device__ void init(int M, int N, int G_, int c_) { nM = M / BM; nN = N / BM; nwg = nM * nN; G = G_; c = c_; }
    __host__ __device__ bool next(int i, Unit& u) const {
        const long L = (long)i * G + c; if (L >= nwg) return false;
        int wgid = (int)L; { const int q = nwg / NXCD, r = nwg % NXCD, xcd = wgid % NXCD, off = wgid / NXCD; wgid = (xcd < r ? xcd * (q + 1) : r * (q + 1) + (xcd - r) * q) + off; }
        const int nig = WGM * nN, gid = wgid / nig, fm = gid * WGM, gsz = (nM - fm) < WGM ? (nM - fm) : WGM;
        u.pm = fm + ((wgid % nig) % gsz); u.pn = (wgid % nig) / gsz; return true;
    }
    __device__ __forceinline__ void a_ready(const Unit&) const {}
    __device__ __forceinline__ void done(const Unit&) const {}
};
template <class Epi, class Sched>
__device__ __forceinline__ void gemm_phase(PG8_LAS unsigned char* lds, const Gemm g, const Sched& S, const Epi& E) {
    const int tid = threadIdx.x, wid = __builtin_amdgcn_readfirstlane(tid >> 6), lane = tid & 63, wr = wid >> 2, wc = wid & 3, fr = lane & 15, fq = lane >> 4;
    const int K = g.K, nt = K / BK;
    unsigned voffA[2], voffB[2];
#pragma unroll
    for (int i = 0; i < 2; ++i) { int R, C; stage_rc(tid * 16 + i * 8192, R, C); const int Rb = Epi::PERM ? ((R & ~31) + perm32(R & 31)) : R;
        voffA[i] = (unsigned)(R * K + C) * 2u; voffB[i] = (unsigned)(Rb * K + C) * 2u; }
    const size_t kstep = (size_t)(BK * 2);
    const size_t hstep = (size_t)HALF * K * 2;
    const size_t tstep = 2 * hstep;
    const unsigned ldsw = (unsigned)wid * 1024u;
    const int aoff = lds_byte(wr * 64 + fr, fq * 8), boff = lds_byte(wc * 32 + fr, fq * 8);
#define PG8_SA(b, h) (((b) * 2 + (h)) * HTB)
#define PG8_SB(b, h) ((4 + (b) * 2 + (h)) * HTB)
#define PG8_STAGE(bufoff, gbase, voff) do { _Pragma("unroll") for (int _i = 0; _i < 2; ++_i) \
        __builtin_amdgcn_global_load_lds((const unsigned*)((const char*)(gbase) + (voff)[_i]), (PG8_LAS unsigned*)(lds + (bufoff) + ldsw + _i * 8192), 16, 0, 0); } while (0)
#define PG8_LDA(dst, b, h) do { _Pragma("unroll") for (int m = 0; m < 4; ++m) _Pragma("unroll") for (int k = 0; k < 2; ++k) dst[m][k] = *(const PG8_LAS bf16x8*)(lds + PG8_SA(b, h) + aoff + m * 2048 + k * 1024); } while (0)
#define PG8_LDB(dst, b, h) do { _Pragma("unroll") for (int n = 0; n < 2; ++n) _Pragma("unroll") for (int k = 0; k < 2; ++k) dst[n][k] = *(const PG8_LAS bf16x8*)(lds + PG8_SB(b, h) + boff + n * 2048 + k * 1024); } while (0)
#define PG8_MMA(ai, bj, At, Bt) do { __builtin_amdgcn_s_setprio(1); _Pragma("unroll") for (int m = 0; m < 4; ++m) _Pragma("unroll") for (int n = 0; n < 2; ++n) _Pragma("unroll") for (int k = 0; k < 2; ++k) \
        acc[ai][bj][m][n] = __builtin_amdgcn_mfma_f32_16x16x32_bf16(Bt[n][k], At[m][k], acc[ai][bj][m][n], 0, 0, 0); __builtin_amdgcn_s_setprio(0); } while (0)
#define PG8_WAIT_V(n) asm volatile("s_waitcnt vmcnt(" #n ")" ::: "memory")
#define PG8_WAIT_L(n) asm volatile("s_waitcnt lgkmcnt(" #n ")" ::: "memory")
#define PG8_BAR __builtin_amdgcn_s_barrier()
#define PG8_SCHED __builtin_amdgcn_sched_barrier(0)
    Unit cur, nxt; int ui = 0;
    if (!S.next(0, cur)) return;
    f32x4 acc[2][2][4][2];
#pragma unroll
    for (int a = 0; a < 2; ++a)
#pragma unroll
        for (int b = 0; b < 2; ++b)
#pragma unroll
            for (int m = 0; m < 4; ++m)
#pragma unroll
                for (int n = 0; n < 2; ++n) acc[a][b][m][n] = (f32x4){0.f, 0.f, 0.f, 0.f};
    bf16x8 At[4][2], B0[2][2], B1[2][2];
    const char* cA = (const char*)g.A + (size_t)cur.pm * tstep; const char* cB = (const char*)g.Bt + (size_t)cur.pn * tstep;
    S.a_ready(cur);
    PG8_STAGE(PG8_SB(0, 0), cB, voffB); PG8_STAGE(PG8_SA(0, 0), cA, voffA); PG8_STAGE(PG8_SB(0, 1), cB + hstep, voffB); PG8_STAGE(PG8_SA(0, 1), cA + hstep, voffA);
    if (wr == 1) PG8_BAR;
    PG8_WAIT_V(4); PG8_BAR;
    PG8_STAGE(PG8_SB(1, 0), cB + kstep, voffB); PG8_STAGE(PG8_SA(1, 0), cA + kstep, voffA); PG8_STAGE(PG8_SB(1, 1), cB + hstep + kstep, voffB);
    PG8_WAIT_V(6); PG8_BAR;
    for (;;) {
        const bool has_next = S.next(ui + 1, nxt);
        const char* nA = has_next ? (const char*)g.A + (size_t)nxt.pm * tstep : cA; const char* nB = has_next ? (const char*)g.Bt + (size_t)nxt.pn * tstep : cB;
        for (int t = 0; t < nt; t += 2) {
            const bool last = (t == nt - 2);
            const char* a1 = cA + (size_t)(t + 1) * kstep;
            const char* a2 = last ? nA : cA + (size_t)(t + 2) * kstep; const char* b2 = last ? nB : cB + (size_t)(t + 2) * kstep;
            const char* a3 = a2 + kstep; const char* b3 = b2 + kstep;
            if (last && has_next) S.a_ready(nxt);
            PG8_LDB(B0, 0, 0); PG8_SCHED; PG8_LDA(At, 0, 0); PG8_STAGE(PG8_SA(1, 1), a1 + hstep, voffA);
            PG8_WAIT_L(8); PG8_BAR; PG8_WAIT_L(0); PG8_MMA(0, 0, At, B0); PG8_BAR; PG8_SCHED;
            PG8_LDB(B1, 0, 1); PG8_STAGE(PG8_SB(0, 0), b2, voffB);
            PG8_BAR; PG8_WAIT_L(0); PG8_MMA(0, 1, At, B1); PG8_BAR;
            PG8_LDA(At, 0, 1); PG8_STAGE(PG8_SA(0, 0), a2, voffA);
            PG8_BAR; PG8_WAIT_L(0); PG8_MMA(1, 0, At, B0); PG8_BAR; PG8_SCHED;
            PG8_STAGE(PG8_SB(0, 1), b2 + hstep, voffB);
            PG8_WAIT_V(6); PG8_BAR; PG8_MMA(1, 1, At, B1); PG8_BAR;
            PG8_LDB(B0, 1, 0); PG8_SCHED; PG8_LDA(At, 1, 0); PG8_STAGE(PG8_SA(0, 1), a2 + hstep, voffA);
            PG8_WAIT_L(8); PG8_BAR; PG8_WAIT_L(0); PG8_MMA(0, 0, At, B0); PG8_BAR; PG8_SCHED;
            PG8_LDB(B1, 1, 1); PG8_STAGE(PG8_SB(1, 0), b3, voffB);
            PG8_BAR; PG8_WAIT_L(0); PG8_MMA(0, 1, At, B1); PG8_BAR;
            PG8_LDA(At, 1, 1); PG8_STAGE(PG8_SA(1, 0), a3, voffA);
            PG8_BAR; PG8_WAIT_L(0); PG8_MMA(1, 0, At, B0); PG8_BAR; PG8_SCHED;
            PG8_STAGE(PG8_SB(1, 1), b3 + hstep, voffB);
            PG8_WAIT_V(6); PG8_BAR; PG8_MMA(1, 1, At, B1); PG8_BAR;
        }
        if constexpr (!Epi::AFTER_DRAIN) { E(acc, cur, wr, wc, fr, fq); S.done(cur); }
        if (!has_next) break;
#pragma unroll
        for (int a = 0; a < 2; ++a)
#pragma unroll
            for (int b = 0; b < 2; ++b)
#pragma unroll
                for (int m = 0; m < 4; ++m)
#pragma unroll
                    for (int n = 0; n < 2; ++n) acc[a][b][m][n] = (f32x4){0.f, 0.f, 0.f, 0.f};
        cur = nxt; cA = nA; cB = nB; ++ui;
    }
    PG8_WAIT_V(0);
    if (wr == 0) PG8_BAR;
    PG8_BAR;
    if constexpr (Epi::AFTER_DRAIN) { E.fused(acc, cur, wr, wc, fr, fq, lds, wid, lane); S.done(cur); }
#undef PG8_SA
#undef PG8_SB
#undef PG8_STAGE
#undef PG8_LDA
#undef PG8_LDB
#undef PG8_MMA
#undef PG8_WAIT_V
#undef PG8_WAIT_L
#undef PG8_BAR
#undef PG8_SCHED
}
}

typedef unsigned short bf16_t;
typedef float f32x4 __attribute__((ext_vector_type(4)));
typedef float f32x2 __attribute__((ext_vector_type(2)));
typedef unsigned u32x4 __attribute__((ext_vector_type(4)));
typedef unsigned u32x2 __attribute__((ext_vector_type(2)));

constexpr int D = 2048, NB = 4, SEQ = 4096, CTXL = 256;
constexpr int ML = NB * SEQ;
constexpr int MC = NB * CTXL;
constexpr int MT = ML + MC;
constexpr int AB_IN = 7616, NIN0 = 7680, PW0 = 7168, TW0 = 512;
constexpr int C_INW = 6176, NIN1 = 6400, PW1 = 6144, TW1 = 256;
constexpr int FF = 5632;
constexpr int MODW = 6 * D;
constexpr int NTHREADS = 512, NWAVES = 8;

constexpr size_t MiB = 1u << 20;
constexpr size_t WS_CTL = 0, CTL_BYTES = 16384;
constexpr size_t WS_MOD = 1 * MiB;
constexpr size_t WS_GA = 2 * MiB, WS_GB = 4 * MiB;
constexpr size_t WS_XC = 6 * MiB;
constexpr size_t WS_HY = 14 * MiB;
constexpr size_t WS_TAIL = 82 * MiB;
constexpr size_t WS_WIN = 116 * MiB;
constexpr size_t WS_WOUT = 146 * MiB;
constexpr size_t WS_W13 = 154 * MiB;
constexpr size_t WS_W2 = 198 * MiB;
constexpr size_t WS_P = 220 * MiB;
constexpr size_t WS_F = 458 * MiB;
constexpr size_t FSLOT = (size_t)MT * 1024 * 2;
constexpr size_t WS_END = 696 * MiB;
static_assert(WS_F + 7 * FSLOT <= WS_END, "ws map");
static_assert(WS_HY + (size_t)MT * D * 2 <= WS_TAIL && WS_TAIL + (size_t)MT * TW0 * 4 <= WS_WIN && WS_W2 + (size_t)D * FF * 2 <= WS_P && WS_P + (size_t)MT * PW0 * 2 <= WS_F, "ws map");

constexpr int LDS_BYTES = 147456;
constexpr int LDS_BAR_OFF = LDS_BYTES - 64;

__device__ __forceinline__ float bflo(unsigned u) { return __builtin_bit_cast(float, u << 16); }
__device__ __forceinline__ float bfhi(unsigned u) { return __builtin_bit_cast(float, u & 0xffff0000u); }
__device__ __forceinline__ float bf1(bf16_t h) { return __builtin_bit_cast(float, (unsigned)h << 16); }
__device__ __forceinline__ unsigned f2bf(float f) { unsigned u = __builtin_bit_cast(unsigned, f); return (u + 0x7fffu + ((u >> 16) & 1u)) >> 16; }
__device__ __forceinline__ unsigned pk2(float lo, float hi) { return f2bf(lo) | (f2bf(hi) << 16); }
__device__ __forceinline__ float sigm(float x) { return 1.f / (1.f + expf(-x)); }
__device__ __forceinline__ float sigm_fast(float x) { return 1.f / (1.f + __expf(-x)); }
__device__ __forceinline__ float silu_fast(float x) { return x / (1.f + __expf(-x)); }
__device__ __forceinline__ float softplus_(float x) { return fmaxf(x, 0.f) + log1pf(expf(-fabsf(x))); }
__device__ __forceinline__ float logsigm_(float x) { return fminf(x, 0.f) - log1pf(expf(-fabsf(x))); }
template <int W> __device__ __forceinline__ float grp_sum(float v) {
#pragma unroll
    for (int o = 1; o < W; o <<= 1) v += __shfl_xor(v, o);
    return v;
}
__device__ __forceinline__ void unpack8(const u32x4 u, float (&f)[8]) {
    f[0] = bflo(u.x); f[1] = bfhi(u.x); f[2] = bflo(u.y); f[3] = bfhi(u.y); f[4] = bflo(u.z); f[5] = bfhi(u.z); f[6] = bflo(u.w); f[7] = bfhi(u.w);
}
__device__ __forceinline__ u32x4 pack8(const float (&f)[8]) { u32x4 o; o.x = pk2(f[0], f[1]); o.y = pk2(f[2], f[3]); o.z = pk2(f[4], f[5]); o.w = pk2(f[6], f[7]); return o; }

struct EpiInProj {
    static constexpr bool PERM = true, AFTER_DRAIN = false;
    bf16_t* P; int ldp; int nPt; float* T; int ldt;
    __device__ __forceinline__ void operator()(const pg8::f32x4 (&acc)[2][2][4][2], const pg8::Unit& u, int wr, int wc, int fr, int fq) const {
        const int row0 = u.pm * 256 + wr * 64 + fr;
        if (u.pn < nPt) {
            const int col0 = u.pn * 256 + wc * 32 + 8 * fq;
#pragma unroll
            for (int ai = 0; ai < 2; ++ai)
#pragma unroll
                for (int m = 0; m < 4; ++m) { bf16_t* rowp = P + (size_t)(row0 + ai * 128 + m * 16) * ldp + col0;
#pragma unroll
                    for (int bj = 0; bj < 2; ++bj) { const pg8::f32x4 v0 = acc[ai][bj][m][0], v1 = acc[ai][bj][m][1];
                        u32x4 o; o.x = pk2(v0[0], v0[1]); o.y = pk2(v0[2], v0[3]); o.z = pk2(v1[0], v1[1]); o.w = pk2(v1[2], v1[3]);
                        *(u32x4*)(rowp + bj * 128) = o; } }
        } else {
            const int col0 = (u.pn - nPt) * 256 + wc * 32 + 8 * fq;
#pragma unroll
            for (int ai = 0; ai < 2; ++ai)
#pragma unroll
                for (int m = 0; m < 4; ++m) { float* rowp = T + (size_t)(row0 + ai * 128 + m * 16) * ldt + col0;
#pragma unroll
                    for (int bj = 0; bj < 2; ++bj) { *(pg8::f32x4*)(rowp + bj * 128) = acc[ai][bj][m][0]; *(pg8::f32x4*)(rowp + bj * 128 + 4) = acc[ai][bj][m][1]; } }
        }
    }
};
struct EpiResid {
    static constexpr bool PERM = false, AFTER_DRAIN = false;
    const float* srcL; const float* srcC; float* dstL; float* dstC; const float* gate;
    __device__ __forceinline__ void operator()(const pg8::f32x4 (&acc)[2][2][4][2], const pg8::Unit& u, int wr, int wc, int fr, int fq) const {
        const bool lat = u.pm < 64;
        const int rowl = (lat ? u.pm : u.pm - 64) * 256 + wr * 64 + fr, col0 = u.pn * 256 + wc * 32 + 4 * fq;
        const float* src = lat ? srcL : srcC; float* dst = lat ? dstL : dstC;
        const float* g = gate + (size_t)(lat ? (u.pm >> 4) : 4) * MODW + col0;
        pg8::f32x4 gv[2][2];
#pragma unroll
        for (int bj = 0; bj < 2; ++bj)
#pragma unroll
            for (int n = 0; n < 2; ++n) gv[bj][n] = *(const pg8::f32x4*)(g + bj * 128 + n * 16);
#pragma unroll
        for (int ai = 0; ai < 2; ++ai)
#pragma unroll
            for (int m = 0; m < 4; ++m) { const size_t ro = (size_t)(rowl + ai * 128 + m * 16) * D + col0;
#pragma unroll
                for (int bj = 0; bj < 2; ++bj)
#pragma unroll
                    for (int n = 0; n < 2; ++n) { const pg8::f32x4 s = *(const pg8::f32x4*)(src + ro + bj * 128 + n * 16);
                        *(pg8::f32x4*)(dst + ro + bj * 128 + n * 16) = s + gv[bj][n] * acc[ai][bj][m][n]; } }
    }
};
struct EpiSwiGLU {
    static constexpr bool PERM = true, AFTER_DRAIN = false;
    bf16_t* H; int ldh;
    __device__ __forceinline__ void operator()(const pg8::f32x4 (&acc)[2][2][4][2], const pg8::Unit& u, int wr, int wc, int fr, int fq) const {
        const int row0 = u.pm * 256 + wr * 64 + fr, col0 = u.pn * 128 + wc * 32 + 8 * fq;
#pragma unroll
        for (int ai = 0; ai < 2; ++ai)
#pragma unroll
            for (int m = 0; m < 4; ++m) { float h[8];
#pragma unroll
                for (int n = 0; n < 2; ++n)
#pragma unroll
                    for (int j = 0; j < 4; ++j) h[n * 4 + j] = silu_fast(acc[ai][0][m][n][j]) * acc[ai][1][m][n][j];
                *(u32x4*)(H + (size_t)(row0 + ai * 128 + m * 16) * ldh + col0) = pack8(h); }
    }
};

struct Ctx {
    LAS unsigned char* lds; int tid, lane, wave, G, wg, gw, NGW;
    const float* in[32]; float* out; unsigned char* ws;
};
#define IN_X 0
#define IN_C 1
#define IN_CTX 2
#define IN_CCTX 3
#define IN_ADAW 4
#define IN_ADAB 5
#define IN_NORMW 6
#define IN_ABWIN 7
#define IN_CONVW 8
#define IN_ALOG 9
#define IN_DTB 10
#define IN_GDNNW 11
#define IN_W0 12
#define IN_WUP 13
#define IN_A0 14
#define IN_AUP 15
#define IN_GUP 16
#define IN_KK 17
#define IN_KA 18
#define IN_RK 19
#define IN_LNW 20
#define IN_LNB 21
#define IN_ABWOUT 22
#define IN_MLWIN 23
#define IN_MLIB 24
#define IN_MLFB 25
#define IN_MLNW 26
#define IN_MLWOUT 27
#define IN_W1 28
#define IN_W3 29
#define IN_W2 30
#define IN_FNW 31

__device__ __forceinline__ void transpose_item(const float* W, int K, int N, bf16_t* WT, int out_row0, LAS float* scr, int k0, int n0, int lane) {
#pragma unroll 8
    for (int i = 0; i < 32; ++i) { const int kk = 2 * i + (lane >> 5); scr[kk * 33 + (lane & 31)] = W[(size_t)(k0 + kk) * N + n0 + (lane & 31)]; }
    asm volatile("s_waitcnt lgkmcnt(0)" ::: "memory");
    const int c = lane & 7;
#pragma unroll
    for (int j = 0; j < 4; ++j) { const int n = (lane >> 3) + 8 * j; const LAS float* s = scr + (8 * c) * 33 + n;
        u32x4 o; o.x = pk2(s[0 * 33], s[1 * 33]); o.y = pk2(s[2 * 33], s[3 * 33]); o.z = pk2(s[4 * 33], s[5 * 33]); o.w = pk2(s[6 * 33], s[7 * 33]);
        *(u32x4*)(WT + (size_t)(out_row0 + n) * K + k0 + 8 * c) = o; }
    asm volatile("s_waitcnt lgkmcnt(0)" ::: "memory");
}
__device__ __forceinline__ void transpose_matrix(const Ctx& c, const float* W, int K, int N, bf16_t* WT, int mode, LAS float* scr) {
    const int nblk = N / 32, items = (K / 64) * nblk;
    for (int it = c.gw; it < items; it += c.NGW) {
        const int kb = it / nblk, nb = it % nblk, n0 = nb * 32;
        const int orow = mode == 0 ? n0 : ((n0 >> 7) * 256 + (n0 & 127) + (mode == 2 ? 128 : 0));
        transpose_item(W, K, N, WT, orow, scr, kb * 64, n0, c.lane);
    }
}
__device__ __forceinline__ void zero_rows(const Ctx& c, bf16_t* WT, int K, int r0, int r1) {
    u32x4* p = (u32x4*)(WT + (size_t)r0 * K); const size_t n = (size_t)(r1 - r0) * K / 8;
    for (size_t i = (size_t)c.wg * NTHREADS + c.tid; i < n; i += (size_t)c.G * NTHREADS) p[i] = (u32x4){0u, 0u, 0u, 0u};
}
__device__ __forceinline__ void convert_weights(const Ctx& c, int layer) {
    LAS float* scr = (LAS float*)(c.lds + 65536) + c.wave * (64 * 33);
    bf16_t* Win = (bf16_t*)(c.ws + WS_WIN); bf16_t* Wout = (bf16_t*)(c.ws + WS_WOUT); bf16_t* W13 = (bf16_t*)(c.ws + WS_W13); bf16_t* W2 = (bf16_t*)(c.ws + WS_W2);
    if (layer == 0) { transpose_matrix(c, c.in[IN_ABWIN], D, AB_IN, Win, 0, scr); zero_rows(c, Win, D, AB_IN, NIN0); transpose_matrix(c, c.in[IN_ABWOUT], D, D, Wout, 0, scr); }
    else { transpose_matrix(c, c.in[IN_MLWIN], D, C_INW, Win, 0, scr); zero_rows(c, Win, D, C_INW, NIN1); transpose_matrix(c, c.in[IN_MLWOUT], D, D, Wout, 0, scr); }
    transpose_matrix(c, c.in[IN_W1] + (size_t)layer * D * FF, D, FF, W13, 1, scr);
    transpose_matrix(c, c.in[IN_W3] + (size_t)layer * D * FF, D, FF, W13, 2, scr);
    transpose_matrix(c, c.in[IN_W2] + (size_t)layer * FF * D, FF, D, W2, 0, scr);
}
__device__ __forceinline__ void ada_phase(const Ctx& c) {
    LAS float* sc = (LAS float*)c.lds;
    LAS float* red = sc + 5 * D;
    for (int i = c.tid; i < 5 * D; i += NTHREADS) { const int b = i / D, k = i % D; const float v = b < 4 ? c.in[IN_C][b * D + k] : c.in[IN_CCTX][k]; sc[i] = v / (1.f + expf(-v)); }
    __syncthreads();
    float* MOD = (float*)(c.ws + WS_MOD);
    for (int u = c.wg; u < 2 * (MODW / 64); u += c.G) {
        const int layer = u / (MODW / 64), cb = (u % (MODW / 64)) * 64;
        const float* wp = c.in[IN_ADAW] + (size_t)layer * D * MODW + cb + c.lane;
        float acc[5] = {0.f, 0.f, 0.f, 0.f, 0.f};
        const int k0 = c.wave * 256;
#pragma unroll 16
        for (int k = k0; k < k0 + 256; ++k) { const float w = wp[(size_t)k * MODW];
#pragma unroll
            for (int b = 0; b < 5; ++b) acc[b] += sc[b * D + k] * w; }
#pragma unroll
        for (int b = 0; b < 5; ++b) red[(c.wave * 5 + b) * 64 + c.lane] = acc[b];
        __syncthreads();
        if (c.tid < 320) { const int b = c.tid / 64, l = c.tid % 64; float s = 0.f;
#pragma unroll
            for (int w = 0; w < 8; ++w) s += red[(w * 5 + b) * 64 + l];
            MOD[(size_t)(layer * 5 + b) * MODW + cb + l] = s + c.in[IN_ADAB][layer * MODW + cb + l]; }
        __syncthreads();
    }
}
__device__ __forceinline__ void norm_mod_phase(const Ctx& c, const float* srcL, const float* srcC, const float* nw, const float* modl, int shift_off, int scale_off, int nrows) {
    bf16_t* H = (bf16_t*)(c.ws + WS_HY);
    for (int r = c.gw; r < nrows; r += c.NGW) {
        const float* xr = r < ML ? srcL + (size_t)r * D : srcC + (size_t)(r - ML) * D;
        const float* mr = modl + (size_t)(r < ML ? (r >> 12) : 4) * MODW;
        f32x4 v[8]; float ss = 0.f;
#pragma unroll
        for (int j = 0; j < 8; ++j) { v[j] = ((const f32x4*)xr)[c.lane + 64 * j]; ss += v[j].x * v[j].x + v[j].y * v[j].y + v[j].z * v[j].z + v[j].w * v[j].w; }
        ss = grp_sum<64>(ss);
        const float rstd = 1.f / sqrtf(ss * (1.f / D) + 1e-6f);
#pragma unroll
        for (int j = 0; j < 8; ++j) { const f32x4 w4 = ((const f32x4*)nw)[c.lane + 64 * j], s4 = ((const f32x4*)(mr + scale_off))[c.lane + 64 * j], h4 = ((const f32x4*)(mr + shift_off))[c.lane + 64 * j];
            const f32x4 y = v[j] * rstd * w4 * (s4 + 1.f) + h4;
            u32x2 o; o.x = pk2(y.x, y.y); o.y = pk2(y.z, y.w);
            ((u32x2*)(H + (size_t)r * D))[c.lane + 64 * j] = o; }
    }
}
__device__ __forceinline__ void final_norm_phase(const Ctx& c) {
    const float* nw = c.in[IN_FNW];
    for (int r = c.gw; r < ML; r += c.NGW) {
        f32x4* xr = (f32x4*)(c.out + (size_t)r * D);
        f32x4 v[8]; float ss = 0.f;
#pragma unroll
        for (int j = 0; j < 8; ++j) { v[j] = xr[c.lane + 64 * j]; ss += v[j].x * v[j].x + v[j].y * v[j].y + v[j].z * v[j].z + v[j].w * v[j].w; }
        ss = grp_sum<64>(ss);
        const float rstd = 1.f / sqrtf(ss * (1.f / D) + 1e-6f);
#pragma unroll
        for (int j = 0; j < 8; ++j) xr[c.lane + 64 * j] = v[j] * rstd * ((const f32x4*)nw)[c.lane + 64 * j];
    }
}

__device__ __forceinline__ void ab_feature_phase(const Ctx& c) {
    const bf16_t* P = (const bf16_t*)(c.ws + WS_P); const float* T = (const float*)(c.ws + WS_TAIL);
    bf16_t* F = (bf16_t*)(c.ws + WS_F);
    float* GA = (float*)(c.ws + WS_GA); float* GB = (float*)(c.ws + WS_GB);
    const float* cw = c.in[IN_CONVW];
    const int lane = c.lane;
    for (int it = 0; it * c.NGW < MT; ++it) {
        const int r = it * c.NGW + c.wg * NWAVES + c.wave;
        if (r >= MT) break;
        int nb[9];
        if (r < ML) { const int b = r >> 12, t = r & 4095, gr = t >> 6, gc = t & 63;
#pragma unroll
            for (int dr = 0; dr < 3; ++dr)
#pragma unroll
                for (int dc = 0; dc < 3; ++dc) { const int rr = gr + dr - 1, cc = gc + dc - 1; nb[dr * 3 + dc] = (rr >= 0 && rr < 64 && cc >= 0 && cc < 64) ? (b * 4096 + rr * 64 + cc) : -1; } }
        else { const int q = r - ML, b = q >> 8, t = q & 255;
#pragma unroll
            for (int k = 0; k < 9; ++k) nb[k] = -1;
#pragma unroll
            for (int dc = 0; dc < 3; ++dc) { const int cc = t + dc - 1; nb[3 + dc] = (cc >= 0 && cc < 256) ? (ML + b * 256 + cc) : -1; } }
#pragma unroll 1
        for (int blk = 0; blk < 12; ++blk) {
            const int ch = blk * 512 + lane * 8;
            float cv[8];
#pragma unroll
            for (int j = 0; j < 8; ++j) cv[j] = 0.f;
#pragma unroll
            for (int k = 0; k < 9; ++k) if (nb[k] >= 0) {
                const u32x4 pv = *(const u32x4*)(P + (size_t)nb[k] * PW0 + ch);
                const f32x4 w0 = *(const f32x4*)(cw + k * 6144 + ch), w1 = *(const f32x4*)(cw + k * 6144 + ch + 4);
                float pf[8]; unpack8(pv, pf);
                cv[0] += pf[0] * w0.x; cv[1] += pf[1] * w0.y; cv[2] += pf[2] * w0.z; cv[3] += pf[3] * w0.w;
                cv[4] += pf[4] * w1.x; cv[5] += pf[5] * w1.y; cv[6] += pf[6] * w1.z; cv[7] += pf[7] * w1.w; }
            const int grp = blk >> 1, cl = (blk & 1) * 512 + lane * 8;
            if (grp < 3) {
                float ss = 0.f;
#pragma unroll
                for (int j = 0; j < 8; ++j) { cv[j] = cv[j] / (1.f + __expf(-cv[j])); ss += cv[j] * cv[j]; }
                if (grp < 2) { ss = grp_sum<16>(ss); const float sc = (1.f / sqrtf(ss + 1e-6f)) * (grp == 0 ? 0.08838834764831845f : 1.f);
#pragma unroll
                    for (int j = 0; j < 8; ++j) cv[j] *= sc; }
                *(u32x4*)(F + (size_t)grp * MT * 1024 + (size_t)r * 1024 + cl) = pack8(cv);
            } else if (grp == 3) { *(u32x4*)(F + (size_t)3 * MT * 1024 + (size_t)r * 1024 + cl) = pack8(cv);
            } else if (grp == 5) { *(u32x4*)(F + (size_t)6 * MT * 1024 + (size_t)r * 1024 + cl) = pack8(cv);
            } else {
                *(u32x4*)(F + (size_t)5 * MT * 1024 + (size_t)r * 1024 + cl) = pack8(cv);
                const f32x4 k0 = *(const f32x4*)(c.in[IN_KK] + cl), k1 = *(const f32x4*)(c.in[IN_KK] + cl + 4);
                float t[8] = {cv[0] * k0.x, cv[1] * k0.y, cv[2] * k0.z, cv[3] * k0.w, cv[4] * k1.x, cv[5] * k1.y, cv[6] * k1.z, cv[7] * k1.w};
                float ss = 0.f;
#pragma unroll
                for (int j = 0; j < 8; ++j) ss += t[j] * t[j];
                ss = grp_sum<8>(ss); const float sc = 1.f / sqrtf(ss + 1e-6f);
#pragma unroll
                for (int j = 0; j < 8; ++j) t[j] *= sc;
                *(u32x4*)(F + (size_t)4 * MT * 1024 + (size_t)r * 1024 + cl) = pack8(t);
            }
        }
        if (lane < 16) {
            const float g0 = T[(size_t)r * TW0 + lane], g1 = T[(size_t)r * TW0 + 16 + lane];
            GA[(size_t)r * 16 + lane] = -expf(c.in[IN_ALOG][lane]) * softplus_(g0 + c.in[IN_DTB][lane]);
            GB[(size_t)r * 16 + lane] = sigm(g1);
        }
    }
}
__device__ __forceinline__ void rw_lora_phase(const Ctx& c) {
    bf16_t* P = (bf16_t*)(c.ws + WS_P); const float* T = (const float*)(c.ws + WS_TAIL);
    LAS float* xin = (LAS float*)c.lds;
    const int tid = c.tid;
    for (int tile = c.wg; tile < MT / 16; tile += c.G) {
        const int r0 = tile * 16;
#pragma unroll 1
        for (int pass = 0; pass < 2; ++pass) {
            __syncthreads();
            for (int i = tid; i < 16 * 128; i += NTHREADS) { const int tk = i >> 7, j = i & 127; const float v = T[(size_t)(r0 + tk) * TW0 + 32 + pass * 128 + j]; xin[i] = pass == 0 ? tanhf(v) : v; }
            __syncthreads();
            const float* up = c.in[pass == 0 ? IN_WUP : IN_AUP];
            float acc[16][2][2];
#pragma unroll
            for (int tk = 0; tk < 16; ++tk) { acc[tk][0][0] = acc[tk][0][1] = acc[tk][1][0] = acc[tk][1][1] = 0.f; }
#pragma unroll 2
            for (int rr = 0; rr < 64; ++rr) {
                const float w00 = up[(size_t)rr * 1024 + tid], w01 = up[(size_t)rr * 1024 + tid + 512], w10 = up[(size_t)(64 + rr) * 1024 + tid], w11 = up[(size_t)(64 + rr) * 1024 + tid + 512];
#pragma unroll
                for (int tk = 0; tk < 16; ++tk) { const float x0 = xin[tk * 128 + rr], x1 = xin[tk * 128 + 64 + rr];
                    acc[tk][0][0] += x0 * w00; acc[tk][0][1] += x0 * w01; acc[tk][1][0] += x1 * w10; acc[tk][1][1] += x1 * w11; }
            }
            const float* bias = c.in[pass == 0 ? IN_W0 : IN_A0];
#pragma unroll
            for (int d = 0; d < 2; ++d)
#pragma unroll
                for (int j = 0; j < 2; ++j) { const int ch = tid + 512 * j; const float bz = bias[d * 1024 + ch];
#pragma unroll
                    for (int tk = 0; tk < 16; ++tk) { const float s = sigm(bz + acc[tk][d][j]);
                        P[(size_t)(r0 + tk) * PW0 + (pass * 2 + d) * 1024 + ch] = (bf16_t)f2bf(pass == 0 ? -0.6065306597126334f * s : s); } }
        }
    }
}
__device__ __forceinline__ int chunk_row(int b, int dir, int s) {
    if (s < 4) return ML + b * 256 + (dir == 0 ? s : 3 - s) * 64;
    return b * 4096 + (dir == 0 ? s - 4 : 67 - s) * 64;
}
__device__ __forceinline__ void gdn_scan_phase(const Ctx& c) {
    const bf16_t* F = (const bf16_t*)(c.ws + WS_F); bf16_t* P = (bf16_t*)(c.ws + WS_P);
    const float* GA = (const float*)(c.ws + WS_GA); const float* GB = (const float*)(c.ws + WS_GB);
    const int lane = c.lane, tid = c.tid, slab = lane & 15, cl = c.wave * 4 + (lane >> 4);
    for (int item = c.wg; item < 256; item += c.G) {
        const int chain = item >> 2, cq = item & 3, b = chain >> 4, h = (chain >> 1) & 7, dir = chain & 1;
        float S[8];
#pragma unroll
        for (int i = 0; i < 8; ++i) S[i] = 0.f;
        u32x4 rk[2], rq[2], rv; float rg = 0.f, rb = 0.f;
        auto gload = [&](int s) {
            const int row0 = chunk_row(b, dir, s);
#pragma unroll
            for (int i = 0; i < 2; ++i) { const int pc = tid + i * 512, tk = pc >> 4, o = (pc & 15) * 8;
                rk[i] = *(const u32x4*)(F + (size_t)1 * MT * 1024 + (size_t)(row0 + tk) * 1024 + h * 128 + o);
                rq[i] = *(const u32x4*)(F + (size_t)0 * MT * 1024 + (size_t)(row0 + tk) * 1024 + h * 128 + o); }
            if (tid < 256) { const int tk = tid >> 2, o = (tid & 3) * 8; rv = *(const u32x4*)(F + (size_t)2 * MT * 1024 + (size_t)(row0 + tk) * 1024 + h * 128 + cq * 32 + o); }
            if (tid < 64) { rg = GA[(size_t)(row0 + tid) * 16 + dir * 8 + h]; rb = GB[(size_t)(row0 + tid) * 16 + dir * 8 + h]; }
        };
        auto lstore = [&](int bufi) {
            LAS unsigned char* bp = c.lds + bufi * 40960;
#pragma unroll
            for (int i = 0; i < 2; ++i) { const int pc = tid + i * 512; *(LAS u32x4*)(bp + pc * 16) = rk[i]; *(LAS u32x4*)(bp + 16384 + pc * 16) = rq[i]; }
            if (tid < 256) *(LAS u32x4*)(bp + 32768 + tid * 16) = rv;
            if (tid < 64) { *(LAS float*)(bp + 36864 + tid * 4) = rg; *(LAS float*)(bp + 37120 + tid * 4) = rb; }
        };
        __syncthreads();
        gload(0); lstore(0);
        __syncthreads();
        LAS float* ost = (LAS float*)(c.lds + 81920);
#pragma unroll 1
        for (int s = 0; s < 68; ++s) {
            if (s + 1 < 68) gload(s + 1);
            const LAS unsigned char* bp = c.lds + (s & 1) * 40960;
#pragma unroll 2
            for (int j = 0; j < 64; ++j) {
                const int tl = dir == 0 ? j : 63 - j;
                float kf[8], qf[8];
                unpack8(*(const LAS u32x4*)(bp + tl * 256 + slab * 16), kf);
                unpack8(*(const LAS u32x4*)(bp + 16384 + tl * 256 + slab * 16), qf);
                const float vv = bf1(*(const LAS bf16_t*)(bp + 32768 + tl * 64 + cl * 2));
                const float a = __expf(*(const LAS float*)(bp + 36864 + tl * 4)), bt = *(const LAS float*)(bp + 37120 + tl * 4);
                float dot = 0.f;
#pragma unroll
                for (int i = 0; i < 8; ++i) dot += S[i] * kf[i];
                dot = grp_sum<16>(dot);
                const float dlt = bt * (vv - a * dot);
                float od = 0.f;
#pragma unroll
                for (int i = 0; i < 8; ++i) { S[i] = a * S[i] + kf[i] * dlt; od += S[i] * qf[i]; }
                od = grp_sum<16>(od);
                if (slab == 0) ost[tl * 32 + cl] = od;
            }
            __syncthreads();
            {
                const int row0 = chunk_row(b, dir, s), tk = tid >> 3, o = (tid & 7) * 4;
                const f32x4 v = *(const LAS f32x4*)(ost + tk * 32 + o);
                u32x2 w; w.x = pk2(v.x, v.y); w.y = pk2(v.z, v.w);
                *(u32x2*)(P + (size_t)(row0 + tk) * PW0 + (4 + dir) * 1024 + h * 128 + cq * 32 + o) = w;
            }
            if (s + 1 < 68) lstore((s + 1) & 1);
            __syncthreads();
        }
    }
}
__device__ __forceinline__ void rwkv_scan_phase(const Ctx& c) {
    const bf16_t* F = (const bf16_t*)(c.ws + WS_F); const bf16_t* P = (const bf16_t*)(c.ws + WS_P);
    bf16_t* Y = (bf16_t*)(c.ws + WS_F);
    const int lane = c.lane, tid = c.tid, slab = lane & 15, rl = c.wave * 4 + (lane >> 4);
    for (int item = c.wg; item < 256; item += c.G) {
        const int chain = item >> 1, rh = item & 1, b = chain >> 5, h = (chain >> 1) & 15, dir = chain & 1;
        float S[4] = {0.f, 0.f, 0.f, 0.f};
        const f32x4 ka = *(const f32x4*)(c.in[IN_KA] + h * 64 + slab * 4);
        u32x4 rr[5]; u32x4 rv;
        auto gload = [&](int s) {
            const int row0 = chunk_row(b, dir, s);
            const int tk = tid >> 3, o = (tid & 7) * 8;
            rr[0] = *(const u32x4*)(F + (size_t)3 * MT * 1024 + (size_t)(row0 + tk) * 1024 + h * 64 + o);
            rr[1] = *(const u32x4*)(F + (size_t)4 * MT * 1024 + (size_t)(row0 + tk) * 1024 + h * 64 + o);
            rr[2] = *(const u32x4*)(F + (size_t)5 * MT * 1024 + (size_t)(row0 + tk) * 1024 + h * 64 + o);
            rr[3] = *(const u32x4*)(P + (size_t)(row0 + tk) * PW0 + (0 + dir) * 1024 + h * 64 + o);
            rr[4] = *(const u32x4*)(P + (size_t)(row0 + tk) * PW0 + (2 + dir) * 1024 + h * 64 + o);
            if (tid < 256) { const int t2 = tid >> 2, o2 = (tid & 3) * 8; rv = *(const u32x4*)(F + (size_t)6 * MT * 1024 + (size_t)(row0 + t2) * 1024 + h * 64 + rh * 32 + o2); }
        };
        auto lstore = [&](int bufi) {
            LAS unsigned char* bp = c.lds + bufi * 45056;
#pragma unroll
            for (int q = 0; q < 5; ++q) *(LAS u32x4*)(bp + q * 8192 + tid * 16) = rr[q];
            if (tid < 256) *(LAS u32x4*)(bp + 40960 + tid * 16) = rv;
        };
        __syncthreads();
        gload(0); lstore(0);
        __syncthreads();
        LAS float* yst = (LAS float*)(c.lds + 90112);
#pragma unroll 1
        for (int s = 0; s < 68; ++s) {
            if (s + 1 < 68) gload(s + 1);
            const LAS unsigned char* bp = c.lds + (s & 1) * 45056;
#pragma unroll 2
            for (int j = 0; j < 64; ++j) {
                const int tl = dir == 0 ? j : 63 - j;
                const u32x2 ur = *(const LAS u32x2*)(bp + tl * 128 + slab * 8), ukk = *(const LAS u32x2*)(bp + 8192 + tl * 128 + slab * 8), ukb = *(const LAS u32x2*)(bp + 16384 + tl * 128 + slab * 8),
                            ulw = *(const LAS u32x2*)(bp + 24576 + tl * 128 + slab * 8), ua = *(const LAS u32x2*)(bp + 32768 + tl * 128 + slab * 8);
                const float vv = bf1(*(const LAS bf16_t*)(bp + 40960 + tl * 64 + rl * 2));
                const float rf[4] = {bflo(ur.x), bfhi(ur.x), bflo(ur.y), bfhi(ur.y)}, kkf[4] = {bflo(ukk.x), bfhi(ukk.x), bflo(ukk.y), bfhi(ukk.y)}, kbf[4] = {bflo(ukb.x), bfhi(ukb.x), bflo(ukb.y), bfhi(ukb.y)},
                            lwf[4] = {bflo(ulw.x), bfhi(ulw.x), bflo(ulw.y), bfhi(ulw.y)}, af[4] = {bflo(ua.x), bfhi(ua.x), bflo(ua.y), bfhi(ua.y)};
                float sk = 0.f;
#pragma unroll
                for (int i = 0; i < 4; ++i) sk += S[i] * kkf[i];
                sk = grp_sum<16>(sk);
                float y = 0.f;
#pragma unroll
                for (int i = 0; i < 4; ++i) { const float w = __expf(lwf[i]), kka = kkf[i] * af[i], kt = kbf[i] * (1.f + (af[i] - 1.f) * ka[i]);
                    S[i] = S[i] * w - sk * kka + vv * kt; y += S[i] * rf[i]; }
                y = grp_sum<16>(y);
                if (slab == 0) yst[tl * 32 + rl] = y;
            }
            __syncthreads();
            {   const int row0 = chunk_row(b, dir, s), tk = tid >> 3, o = (tid & 7) * 4;
                const f32x4 v = *(const LAS f32x4*)(yst + tk * 32 + o);
                u32x2 w; w.x = pk2(v.x, v.y); w.y = pk2(v.z, v.w);
                *(u32x2*)(Y + (size_t)dir * MT * 1024 + (size_t)(row0 + tk) * 1024 + h * 64 + rh * 32 + o) = w;
            }
            if (s + 1 < 68) lstore((s + 1) & 1);
            __syncthreads();
        }
    }
}
__device__ __forceinline__ void ab_output_phase(const Ctx& c) {
    const bf16_t* F = (const bf16_t*)(c.ws + WS_F); const bf16_t* P = (const bf16_t*)(c.ws + WS_P); const float* T = (const float*)(c.ws + WS_TAIL);
    bf16_t* Yo = (bf16_t*)(c.ws + WS_HY);
    LAS float* sg = (LAS float*)c.lds;
    const int tid = c.tid, lane = c.lane, wave = c.wave;
    for (int tile = c.wg; tile < MT / 16; tile += c.G) {
        const int r0 = tile * 16;
        __syncthreads();
        for (int i = tid; i < 16 * 160; i += NTHREADS) { const int tk = i / 160, j = i % 160; sg[i] = sigm(T[(size_t)(r0 + tk) * TW0 + 288 + j]); }
        __syncthreads();
        LAS float* gos = (LAS float*)(c.lds + 16384);
        {
            float go[16][2];
#pragma unroll
            for (int tk = 0; tk < 16; ++tk) go[tk][0] = go[tk][1] = 0.f;
            const float* gup = c.in[IN_GUP];
#pragma unroll 2
            for (int rr = 0; rr < 160; ++rr) { const float w0 = gup[(size_t)rr * 1024 + tid], w1 = gup[(size_t)rr * 1024 + tid + 512];
#pragma unroll
                for (int tk = 0; tk < 16; ++tk) { const float x = sg[tk * 160 + rr]; go[tk][0] += x * w0; go[tk][1] += x * w1; } }
#pragma unroll
            for (int tk = 0; tk < 16; ++tk) { gos[tk * 1024 + tid] = go[tk][0]; gos[tk * 1024 + tid + 512] = go[tk][1]; }
        }
#pragma unroll
        for (int j = 0; j < 2; ++j) {
            const int ch = tid + 512 * j;
            const float kaj = c.in[IN_KA][ch], rkj = c.in[IN_RK][ch], lnw = c.in[IN_LNW][ch], lnb = c.in[IN_LNB][ch];
#pragma unroll 4
            for (int tk = 0; tk < 16; ++tk) {
                const size_t row = (size_t)(r0 + tk);
                const float y = bf1(F[(size_t)0 * MT * 1024 + row * 1024 + ch]) + bf1(F[(size_t)1 * MT * 1024 + row * 1024 + ch]);
                const float rv = bf1(F[(size_t)3 * MT * 1024 + row * 1024 + ch]), kb = bf1(F[(size_t)5 * MT * 1024 + row * 1024 + ch]), vb = bf1(F[(size_t)6 * MT * 1024 + row * 1024 + ch]);
                const float a0 = bf1(P[row * PW0 + 2048 + ch]), a1 = bf1(P[row * PW0 + 3072 + ch]);
                const float mu = grp_sum<64>(y) * (1.f / 64.f), dv = y - mu, var = grp_sum<64>(dv * dv) * (1.f / 64.f);
                const float kts = kb * (2.f + (a0 + a1 - 2.f) * kaj);
                const float bonus = grp_sum<64>(rv * kts * rkj) * vb;
                const float o = (dv * (1.f / sqrtf(var + 64e-5f)) * lnw + lnb + bonus) * gos[tk * 1024 + ch];
                Yo[row * D + 1024 + ch] = (bf16_t)f2bf(o);
            }
        }
        {   const int ch = 2 * tid;
            const float nw0 = c.in[IN_GDNNW][ch & 127], nw1 = c.in[IN_GDNNW][(ch & 127) + 1];
#pragma unroll 4
            for (int tk = 0; tk < 16; ++tk) {
                const size_t row = (size_t)(r0 + tk);
                const unsigned uf = *(const unsigned*)(P + row * PW0 + 4096 + ch), ub = *(const unsigned*)(P + row * PW0 + 5120 + ch), uz = *(const unsigned*)(P + row * PW0 + 6144 + ch);
                const float o0 = bflo(uf) + bflo(ub), o1 = bfhi(uf) + bfhi(ub);
                const float ss = grp_sum<64>(o0 * o0 + o1 * o1), rstd = 1.f / sqrtf(ss * (1.f / 128.f) + 1e-6f);
                const float z0 = bflo(uz), z1 = bfhi(uz);
                *(unsigned*)(Yo + row * D + ch) = pk2(o0 * rstd * nw0 * silu_fast(z0), o1 * rstd * nw1 * silu_fast(z1));
            }
        }
    }
}

__device__ __forceinline__ void ml_gate_phase(const Ctx& c) {
    const float* T = (const float*)(c.ws + WS_TAIL); float* GA = (float*)(c.ws + WS_GA); float* GB = (float*)(c.ws + WS_GB);
    for (size_t i = (size_t)c.wg * NTHREADS + c.tid; i < (size_t)MT * 16; i += (size_t)c.G * NTHREADS) {
        const size_t r = i >> 4; const int k = (int)(i & 15);
        const float gi = T[r * TW1 + k] + c.in[IN_MLIB][k], gf = T[r * TW1 + 16 + k] + c.in[IN_MLFB][k];
        GA[i] = 15.f * tanhf(gi * (1.f / 15.f));
        GB[i] = logsigm_(15.f * tanhf(gf * (1.f / 15.f)));
    }
}
__device__ __forceinline__ void mlstm_scan_phase(const Ctx& c) {
    const bf16_t* P = (const bf16_t*)(c.ws + WS_P); bf16_t* Hs = (bf16_t*)(c.ws + WS_F);
    const float* GA = (const float*)(c.ws + WS_GA); const float* GB = (const float*)(c.ws + WS_GB);
    const int lane = c.lane, tid = c.tid, slab = lane & 15, cp = c.wave * 4 + (lane >> 4);
    for (int item = c.wg; item < 256; item += c.G) {
        const int chain = item >> 2, cq = item & 3, b = chain >> 4, h = (chain >> 1) & 7, dir = chain & 1;
        float C[8][2], n[8]; float m = 0.f;
#pragma unroll
        for (int i = 0; i < 8; ++i) { C[i][0] = C[i][1] = 0.f; n[i] = 0.f; }
        u32x4 rk[2], rq[2], rv; float rg = 0.f, rb = 0.f;
        auto gload = [&](int s) {
            const int row0 = chunk_row(b, dir, s);
#pragma unroll
            for (int i = 0; i < 2; ++i) { const int pc = tid + i * 512, tk = pc >> 4, o = (pc & 15) * 8;
                rk[i] = *(const u32x4*)(P + (size_t)(row0 + tk) * PW1 + 1024 + h * 128 + o);
                rq[i] = *(const u32x4*)(P + (size_t)(row0 + tk) * PW1 + h * 128 + o); }
            { const int tk = tid >> 3, o = (tid & 7) * 8; rv = *(const u32x4*)(P + (size_t)(row0 + tk) * PW1 + 2048 + h * 256 + cq * 64 + o); }
            if (tid < 64) { rg = GA[(size_t)(row0 + tid) * 16 + dir * 8 + h]; rb = GB[(size_t)(row0 + tid) * 16 + dir * 8 + h]; }
        };
        auto lstore = [&](int bufi) {
            LAS unsigned char* bp = c.lds + bufi * 41472;
#pragma unroll
            for (int i = 0; i < 2; ++i) { const int pc = tid + i * 512; *(LAS u32x4*)(bp + pc * 16) = rk[i]; *(LAS u32x4*)(bp + 16384 + pc * 16) = rq[i]; }
            *(LAS u32x4*)(bp + 32768 + tid * 16) = rv;
            if (tid < 64) { *(LAS float*)(bp + 40960 + tid * 4) = rg; *(LAS float*)(bp + 41216 + tid * 4) = rb; }
        };
        __syncthreads();
        gload(0); lstore(0);
        __syncthreads();
        LAS float* hst = (LAS float*)(c.lds + 82944);
#pragma unroll 1
        for (int s = 0; s < 68; ++s) {
            if (s + 1 < 68) gload(s + 1);
            const LAS unsigned char* bp = c.lds + (s & 1) * 41472;
#pragma unroll 2
            for (int j = 0; j < 64; ++j) {
                const int tl = dir == 0 ? j : 63 - j;
                float kf[8], qf[8];
                unpack8(*(const LAS u32x4*)(bp + tl * 256 + slab * 16), kf);
                unpack8(*(const LAS u32x4*)(bp + 16384 + tl * 256 + slab * 16), qf);
                const unsigned uv = *(const LAS unsigned*)(bp + 32768 + tl * 128 + cp * 4);
                const float v0 = bflo(uv), v1 = bfhi(uv);
                const float ig = *(const LAS float*)(bp + 40960 + tl * 4), lf = *(const LAS float*)(bp + 41216 + tl * 4);
                const float mn = fmaxf(lf + m, ig), fs = __expf(lf + m - mn), is = __expf(ig - mn);
                m = mn;
                float n0 = 0.f, n1 = 0.f, dn = 0.f;
#pragma unroll
                for (int i = 0; i < 8; ++i) { const float ki = is * kf[i], qi = qf[i] * 0.08838834764831845f;
                    C[i][0] = fs * C[i][0] + ki * v0; C[i][1] = fs * C[i][1] + ki * v1; n[i] = fs * n[i] + ki;
                    n0 += C[i][0] * qi; n1 += C[i][1] * qi; dn += n[i] * qi; }
                n0 = grp_sum<16>(n0); n1 = grp_sum<16>(n1); dn = grp_sum<16>(dn);
                if (slab == 0) { const float dd = 1.f / fmaxf(fabsf(dn), __expf(-mn)); hst[tl * 64 + cp * 2] = n0 * dd; hst[tl * 64 + cp * 2 + 1] = n1 * dd; }
            }
            __syncthreads();
            if (s >= 4) {
                const int row0 = chunk_row(b, dir, s), tk = tid >> 3, o = (tid & 7) * 8;
                float v[8];
#pragma unroll
                for (int i = 0; i < 8; ++i) v[i] = hst[tk * 64 + o + i];
                *(u32x4*)(Hs + (size_t)dir * ML * D + (size_t)(row0 + tk) * D + h * 256 + cq * 64 + o) = pack8(v);
            }
            if (s + 1 < 68) lstore((s + 1) & 1);
            __syncthreads();
        }
    }
}
__device__ __forceinline__ void ml_output_phase(const Ctx& c) {
    const bf16_t* Hs = (const bf16_t*)(c.ws + WS_F); const bf16_t* P = (const bf16_t*)(c.ws + WS_P); bf16_t* Yo = (bf16_t*)(c.ws + WS_HY);
    const float* nw = c.in[IN_MLNW];
    for (int r = c.gw; r < ML; r += c.NGW) {
#pragma unroll
        for (int blk = 0; blk < 4; ++blk) {
            const int ch = blk * 512 + c.lane * 8;
            float a[8], bb[8], o[8];
            unpack8(*(const u32x4*)(Hs + (size_t)r * D + ch), a); unpack8(*(const u32x4*)(Hs + (size_t)ML * D + (size_t)r * D + ch), bb);
            unpack8(*(const u32x4*)(P + (size_t)r * PW1 + 4096 + ch), o);
            float ss = 0.f;
#pragma unroll
            for (int j = 0; j < 8; ++j) { a[j] += bb[j]; ss += a[j] * a[j]; }
            ss = grp_sum<32>(ss); const float rstd = 1.f / sqrtf(ss * (1.f / 256.f) + 1e-6f);
            const f32x4 w0 = *(const f32x4*)(nw + ch), w1 = *(const f32x4*)(nw + ch + 4);
            const float wv[8] = {w0.x, w0.y, w0.z, w0.w, w1.x, w1.y, w1.z, w1.w};
#pragma unroll
            for (int j = 0; j < 8; ++j) a[j] = a[j] * rstd * wv[j] * sigm_fast(o[j]);
            *(u32x4*)(Yo + (size_t)r * D + ch) = pack8(a);
        }
    }
}

struct Args { const float* in[32]; float* out; unsigned char* ws; int ph_lo, ph_hi; };
constexpr int NPHASE = 24;
__global__ void __launch_bounds__(NTHREADS, 2) fwd_kernel(Args args) {
    extern __shared__ __attribute__((aligned(16))) unsigned char lds_raw[];
    Ctx c;
    c.lds = (LAS unsigned char*)lds_raw;
    c.tid = threadIdx.x; c.lane = c.tid & 63; c.wave = __builtin_amdgcn_readfirstlane(c.tid >> 6);
    c.G = gridDim.x; c.wg = blockIdx.x; c.gw = c.wg * NWAVES + c.wave; c.NGW = c.G * NWAVES;
#pragma unroll
    for (int i = 0; i < 32; ++i) c.in[i] = args.in[i];
    c.out = args.out; c.ws = args.ws;
    const int lo = args.ph_lo, hi = args.ph_hi;
    volatile LAS unsigned* bst = (volatile LAS unsigned*)(c.lds + LDS_BAR_OFF);
    if (c.tid < 4) bst[c.tid] = 0u;
    __syncthreads();
    XcdBarrier bar; bar.bar = (unsigned*)(c.ws + WS_CTL); bar.x = 0; bar.st = bst;
    if (hi - lo > 1) bar = xcd_barrier_post((unsigned*)(c.ws + WS_CTL), bst);
#define IN(k) (lo <= (k) && (k) < hi)
#define SEAM(k) do { if (IN(k) && IN((k) + 1)) xcd_barrier(bar); } while (0)
    float* MOD = (float*)(c.ws + WS_MOD);
    float* XC = (float*)(c.ws + WS_XC);
    bf16_t* HY = (bf16_t*)(c.ws + WS_HY); bf16_t* Pb = (bf16_t*)(c.ws + WS_P); float* TL = (float*)(c.ws + WS_TAIL);
    bf16_t* Win = (bf16_t*)(c.ws + WS_WIN); bf16_t* Wout = (bf16_t*)(c.ws + WS_WOUT); bf16_t* W13 = (bf16_t*)(c.ws + WS_W13); bf16_t* W2 = (bf16_t*)(c.ws + WS_W2);
    const float* X = c.in[IN_X]; const float* CX = c.in[IN_CTX];

    if (IN(0)) { ada_phase(c); __syncthreads(); convert_weights(c, 0); }
    SEAM(0);
    if (IN(1)) norm_mod_phase(c, X, CX, c.in[IN_NORMW], MOD, 0, D, MT);
    SEAM(1);
    if (IN(2)) { pg8::Gemm g{HY, Win, MT, NIN0, D}; pg8::StaticOrder S; S.init(MT, NIN0, c.G, c.wg); EpiInProj E{Pb, PW0, PW0 / 256, TL, TW0};
        pg8::gemm_phase<EpiInProj, pg8::StaticOrder>(c.lds, g, S, E); }
    SEAM(2);
    if (IN(3)) ab_feature_phase(c);
    SEAM(3);
    if (IN(4)) rw_lora_phase(c);
    SEAM(4);
    if (IN(5)) gdn_scan_phase(c);
    SEAM(5);
    if (IN(6)) rwkv_scan_phase(c);
    SEAM(6);
    if (IN(7)) ab_output_phase(c);
    SEAM(7);
    if (IN(8)) { pg8::Gemm g{HY, Wout, MT, D, D}; pg8::StaticOrder S; S.init(MT, D, c.G, c.wg); EpiResid E{X, CX, c.out, XC, MOD + 2 * D};
        pg8::gemm_phase<EpiResid, pg8::StaticOrder>(c.lds, g, S, E); }
    SEAM(8);
    if (IN(9)) norm_mod_phase(c, c.out, XC, c.in[IN_NORMW] + D, MOD, 3 * D, 4 * D, MT);
    SEAM(9);
    if (IN(10)) { pg8::Gemm g{HY, W13, MT, 2 * FF, D}; pg8::StaticOrder S; S.init(MT, 2 * FF, c.G, c.wg); EpiSwiGLU E{Pb, FF};
        pg8::gemm_phase<EpiSwiGLU, pg8::StaticOrder>(c.lds, g, S, E); }
    SEAM(10);
    if (IN(11)) { pg8::Gemm g{Pb, W2, MT, D, FF}; pg8::StaticOrder S; S.init(MT, D, c.G, c.wg); EpiResid E{c.out, XC, c.out, XC, MOD + 5 * D};
        pg8::gemm_phase<EpiResid, pg8::StaticOrder>(c.lds, g, S, E); }
    SEAM(11);
    if (IN(12)) { convert_weights(c, 1); norm_mod_phase(c, c.out, XC, c.in[IN_NORMW] + 2 * D, MOD + 5 * MODW, 0, D, MT); }
    SEAM(12);
    if (IN(13)) { pg8::Gemm g{HY, Win, MT, NIN1, D}; pg8::StaticOrder S; S.init(MT, NIN1, c.G, c.wg); EpiInProj E{Pb, PW1, PW1 / 256, TL, TW1};
        pg8::gemm_phase<EpiInProj, pg8::StaticOrder>(c.lds, g, S, E); }
    SEAM(13);
    if (IN(14)) ml_gate_phase(c);
    SEAM(14);
    if (IN(15)) mlstm_scan_phase(c);
    SEAM(15);
    if (IN(16)) ml_output_phase(c);
    SEAM(16);
    if (IN(17)) { pg8::Gemm g{HY, Wout, ML, D, D}; pg8::StaticOrder S; S.init(ML, D, c.G, c.wg); EpiResid E{c.out, XC, c.out, XC, MOD + 5 * MODW + 2 * D};
        pg8::gemm_phase<EpiResid, pg8::StaticOrder>(c.lds, g, S, E); }
    SEAM(17);
    if (IN(18)) norm_mod_phase(c, c.out, XC, c.in[IN_NORMW] + 3 * D, MOD + 5 * MODW, 3 * D, 4 * D, ML);
    SEAM(18);
    if (IN(19)) { pg8::Gemm g{HY, W13, ML, 2 * FF, D}; pg8::StaticOrder S; S.init(ML, 2 * FF, c.G, c.wg); EpiSwiGLU E{Pb, FF};
        pg8::gemm_phase<EpiSwiGLU, pg8::StaticOrder>(c.lds, g, S, E); }
    SEAM(19);
    if (IN(20)) { pg8::Gemm g{Pb, W2, ML, D, FF}; pg8::StaticOrder S; S.init(ML, D, c.G, c.wg); EpiResid E{c.out, XC, c.out, XC, MOD + 5 * MODW + 5 * D};
        pg8::gemm_phase<EpiResid, pg8::StaticOrder>(c.lds, g, S, E); }
    SEAM(20);
    if (IN(21)) final_norm_phase(c);
#undef IN
#undef SEAM
}

#ifndef N_LAUNCH_MODE
#define N_LAUNCH_MODE 1
#endif
extern "C" void kernel_launch(void* const* d_in, const int* in_sizes, int n_in, void* d_out, int out_size, void* d_ws, size_t ws_size, hipStream_t stream) {
    static int grid = 0;
    if (grid == 0) {
        if (n_in != 32 || out_size != ML * D || ws_size < WS_END) { fprintf(stderr, "kernel_launch: unexpected problem (n_in %d out %d ws %zu)\n", n_in, out_size, ws_size); grid = -1; return; }
        int dev = 0, cus = 0;
        if (hipGetDevice(&dev) != hipSuccess || hipDeviceGetAttribute(&cus, hipDeviceAttributeMultiprocessorCount, dev) != hipSuccess) { grid = -1; return; }
        if (hipFuncSetAttribute((const void*)fwd_kernel, hipFuncAttributeMaxDynamicSharedMemorySize, LDS_BYTES) != hipSuccess) { grid = -1; return; }
        int per_cu = 0;
        if (hipOccupancyMaxActiveBlocksPerMultiprocessor(&per_cu, (const void*)fwd_kernel, NTHREADS, LDS_BYTES) != hipSuccess || per_cu < 1) { fprintf(stderr, "kernel_launch: occupancy query says %d\n", per_cu); }
        (void)hipGetLastError();
        grid = cus;
    }
    if (grid < 0) return;
    (void)hipMemsetAsync((char*)d_ws + WS_CTL, 0, CTL_BYTES, stream);
    Args a{};
    for (int i = 0; i < 32; ++i) a.in[i] = (const float*)d_in[i];
    a.out = (float*)d_out; a.ws = (unsigned char*)d_ws;
#if N_LAUNCH_MODE == 1
    a.ph_lo = 0; a.ph_hi = NPHASE;
    hipLaunchKernelGGL(fwd_kernel, dim3(grid), dim3(NTHREADS), LDS_BYTES, stream, a);
#else
    for (int p = 0; p < 22; ++p) { a.ph_lo = p; a.ph_hi = p + 1; hipLaunchKernelGGL(fwd_kernel, dim3(grid), dim3(NTHREADS), LDS_BYTES, stream, a); }
#endif
}
```

```cpp
#include <hip/hip_runtime.h>
#include <cstdio>
#include <cstdint>
#define LAS __attribute__((address_space(3)))
#define GAS __attribute__((address_space(1)))
#define XB_TMO      128
#define XB_XCNT(j)  (256  + 64 * (j))
#define XB_XSUB(j)  (1280 + 64 * (j))
#define XB_XGEN(j)  (2304 + 64 * (j))
#define XB_TOP      3328
#define XB_TOPGEN   3392
#define XCD_BAR_WORDS 3456
#define XB_SPIN_CAP (1u << 20)

__device__ __forceinline__ unsigned xb_ld(unsigned* p)              { return __hip_atomic_load(p, __ATOMIC_RELAXED, __HIP_MEMORY_SCOPE_AGENT); }
__device__ __forceinline__ unsigned xb_add(unsigned* p, unsigned v) { return __hip_atomic_fetch_add(p, v, __ATOMIC_RELAXED, __HIP_MEMORY_SCOPE_AGENT); }
__device__ __forceinline__ unsigned xb_xcc_id() { return (unsigned)__builtin_amdgcn_s_getreg((3 << 11) | 20) & 0xFu; }
#define XB_SPIN(cond, bar) do { unsigned _sp = 0; while (cond) { __builtin_amdgcn_s_sleep(1); \
    if ((++_sp & 255u) == 0u) { if (xb_ld(&(bar)[XB_TMO])) break; if (_sp > XB_SPIN_CAP) { atomicAdd(&(bar)[XB_TMO], 1u); break; } } } } while (0)

struct XcdBarrier {
    unsigned* bar; unsigned x;
    volatile LAS unsigned* st;
};

__device__ __forceinline__ XcdBarrier xcd_barrier_post(unsigned* bar, volatile LAS unsigned* st) {
    XcdBarrier b; b.bar = bar; b.x = xb_xcc_id(); b.st = st;
    if (threadIdx.x == 0) (void)xb_add(&bar[XB_XCNT(b.x)], 1u);
    return b;
}
__device__ __forceinline__ void xcd_barrier_complete(unsigned* bar, unsigned x, unsigned& nloc, unsigned& nx) {
    const unsigned G = gridDim.x * gridDim.y * gridDim.z;
    unsigned sum, cnt, mine, sp = 0u;
    for (;;) {
        sum = 0u; cnt = 0u; mine = 0u;
#pragma unroll
        for (unsigned j = 0; j < 16; ++j) { const unsigned c = xb_ld(&bar[XB_XCNT(j)]); sum += c; cnt += (c > 0u) ? 1u : 0u; mine = (j == x) ? c : mine; }
        if (sum == G) break;
        __builtin_amdgcn_s_sleep(1);
        if ((++sp & 255u) == 0u) { if (xb_ld(&bar[XB_TMO])) break; if (sp > XB_SPIN_CAP) { atomicAdd(&bar[XB_TMO], 1u); break; } }
    }
    nloc = mine > 0u ? mine : 1u; nx = cnt > 0u ? cnt : 1u;
}

__device__ __forceinline__ void xcd_barrier(const XcdBarrier& b) {
    asm volatile("s_waitcnt vmcnt(0)" ::: "memory");
    __syncthreads();
    if (threadIdx.x == 0) {
        unsigned* bar = b.bar;
        __builtin_amdgcn_s_waitcnt(0);
        unsigned nloc = b.st[0], nx = b.st[1];
        if (nloc == 0u) { xcd_barrier_complete(bar, b.x, nloc, nx); b.st[0] = nloc; b.st[1] = nx; }
        const unsigned old = xb_add(&bar[XB_XSUB(b.x)], 1u);
        const unsigned gen = old / nloc;
        if (old + 1u == (gen + 1u) * nloc) {
            __builtin_amdgcn_fence(__ATOMIC_RELEASE, "agent");
            asm volatile("s_waitcnt vmcnt(0)" ::: "memory");
            const unsigned og = xb_add(&bar[XB_TOP], 1u);
            const unsigned tg = og / nx;
            if (og + 1u == (tg + 1u) * nx) xb_add(&bar[XB_TOPGEN], 1u);
            else XB_SPIN(xb_ld(&bar[XB_TOPGEN]) == tg, bar);
            __builtin_amdgcn_fence(__ATOMIC_ACQUIRE, "agent");
            xb_add(&bar[XB_XGEN(b.x)], 1u);
            asm volatile("s_waitcnt vmcnt(0)" ::: "memory");
        } else {
            XB_SPIN(xb_ld(&bar[XB_XGEN(b.x)]) == gen, bar);
            __builtin_amdgcn_fence(__ATOMIC_ACQUIRE, "agent");
            asm volatile("s_waitcnt vmcnt(0)" ::: "memory");
        }
    }
    __syncthreads();
}
#include <hip/hip_runtime.h>
namespace pg8 {
#define PG8_LAS __attribute__((address_space(3)))
typedef unsigned short bf16_t;
typedef short bf16x8 __attribute__((ext_vector_type(8)));
typedef float f32x4 __attribute__((ext_vector_type(4)));
typedef unsigned u32x4 __attribute__((ext_vector_type(4)));
constexpr int BM = 256, BK = 64, HALF = 128, HTB = HALF * BK * 2  , STAGE_BYTES = 8 * HTB, NXCD = 8, WGM = 8;

__host__ __device__ __forceinline__ int lds_byte(int r, int c) { const int st = (r >> 4) * 2 + (c >> 5), rr = r & 15, cc = c & 31, ob = rr * 64 + cc * 2; return st * 1024 + (ob ^ (((ob >> 9) & 1) << 5)); }
__host__ __device__ __forceinline__ void stage_rc(int b, int& R, int& C) { const int st = b / 1024, sb = b % 1024, swz = sb ^ (((sb >> 9) & 1) << 5); R = (st >> 1) * 16 + swz / 64; C = (st & 1) * 32 + (swz % 64) / 2; }
__host__ __device__ __forceinline__ int perm32(int rho) { const int n = rho >> 4, i = rho & 15; return 8 * (i >> 2) + 4 * n + (i & 3); }

struct Unit { int pm, pn; };
struct Gemm { const bf16_t* A; const bf16_t* Bt; int M, N, K; };

struct StaticOrder {
    int nM, nN, nwg, G, c;
    __host__ __device__ void init(int M, int N, int G_, int c_) { nM = M / BM; nN = N / BM; nwg = nM * nN; G = G_; c = c_; }
    __host__ __device__ bool next(int i, Unit& u) const {
        const long L = (long)i * G + c; if (L >= nwg) return false;
        int wgid = (int)L; { const int q = nwg / NXCD, r = nwg % NXCD, xcd = wgid % NXCD, off = wgid / NXCD; wgid = (xcd < r ? xcd * (q + 1) : r * (q + 1) + (xcd - r) * q) + off; }
        const int nig = WGM * nN, gid = wgid / nig, fm = gid * WGM, gsz = (nM - fm) < WGM ? (nM - fm) : WGM;
        u.pm = fm + ((wgid % nig) % gsz); u.pn = (wgid % nig) / gsz; return true;
    }
    __device__ __forceinline__ void a_ready(const Unit&) const {}
    __device__ __forceinline__ void done(const Unit&) const {}
};
template <class Epi, class Sched>
__device__ __forceinline__ void gemm_phase(PG8_LAS unsigned char* lds, const Gemm g, const Sched& S, const Epi& E) {
    const int tid = threadIdx.x, wid = __builtin_amdgcn_readfirstlane(tid >> 6), lane = tid & 63, wr = wid >> 2, wc = wid & 3, fr = lane & 15, fq = lane >> 4;
    const int K = g.K, nt = K / BK;
    unsigned voffA[2], voffB[2];
#pragma unroll
    for (int i = 0; i < 2; ++i) { int R, C; stage_rc(tid * 16 + i * 8192, R, C); const int Rb = Epi::PERM ? ((R & ~31) + perm32(R & 31)) : R;
        voffA[i] = (unsigned)(R * K + C) * 2u; voffB[i] = (unsigned)(Rb * K + C) * 2u; }
    const size_t kstep = (size_t)(BK * 2);
    const size_t hstep = (size_t)HALF * K * 2;
    const size_t tstep = 2 * hstep;
    const unsigned ldsw = (unsigned)wid * 1024u;
    const int aoff = lds_byte(wr * 64 + fr, fq * 8), boff = lds_byte(wc * 32 + fr, fq * 8);
#define PG8_SA(b, h) (((b) * 2 + (h)) * HTB)
#define PG8_SB(b, h) ((4 + (b) * 2 + (h)) * HTB)
#define PG8_STAGE(bufoff, gbase, voff) do { _Pragma("unroll") for (int _i = 0; _i < 2; ++_i) \
        __builtin_amdgcn_global_load_lds((const unsigned*)((const char*)(gbase) + (voff)[_i]), (PG8_LAS unsigned*)(lds + (bufoff) + ldsw + _i * 8192), 16, 0, 0); } while (0)
#define PG8_LDA(dst, b, h) do { _Pragma("unroll") for (int m = 0; m < 4; ++m) _Pragma("unroll") for (int k = 0; k < 2; ++k) dst[m][k] = *(const PG8_LAS bf16x8*)(lds + PG8_SA(b, h) + aoff + m * 2048 + k * 1024); } while (0)
#define PG8_LDB(dst, b, h) do { _Pragma("unroll") for (int n = 0; n < 2; ++n) _Pragma("unroll") for (int k = 0; k < 2; ++k) dst[n][k] = *(const PG8_LAS bf16x8*)(lds + PG8_SB(b, h) + boff + n * 2048 + k * 1024); } while (0)
#define PG8_MMA(ai, bj, At, Bt) do { __builtin_amdgcn_s_setprio(1); _Pragma("unroll") for (int m = 0; m < 4; ++m) _Pragma("unroll") for (int n = 0; n < 2; ++n) _Pragma("unroll") for (int k = 0; k < 2; ++k) \
        acc[ai][bj][m][n] = __builtin_amdgcn_mfma_f32_16x16x32_bf16(Bt[n][k], At[m][k], acc[ai][bj][m][n], 0, 0, 0); __builtin_amdgcn_s_setprio(0); } while (0)
#define PG8_WAIT_V(n) asm volatile("s_waitcnt vmcnt(" #n ")" ::: "memory")
#define PG8_WAIT_L(n) asm volatile("s_waitcnt lgkmcnt(" #n ")" ::: "memory")
#define PG8_BAR __builtin_amdgcn_s_barrier()
#define PG8_SCHED __builtin_amdgcn_sched_barrier(0)
    Unit cur, nxt; int ui = 0;
    if (!S.next(0, cur)) return;
    f32x4 acc[2][2][4][2];
#pragma unroll
    for (int a = 0; a < 2; ++a)
#pragma unroll
        for (int b = 0; b < 2; ++b)
#pragma unroll
            for (int m = 0; m < 4; ++m)
#pragma unroll
                for (int n = 0; n < 2; ++n) acc[a][b][m][n] = (f32x4){0.f, 0.f, 0.f, 0.f};
    bf16x8 At[4][2], B0[2][2], B1[2][2];
    const char* cA = (const char*)g.A + (size_t)cur.pm * tstep; const char* cB = (const char*)g.Bt + (size_t)cur.pn * tstep;
    S.a_ready(cur);
    PG8_STAGE(PG8_SB(0, 0), cB, voffB); PG8_STAGE(PG8_SA(0, 0), cA, voffA); PG8_STAGE(PG8_SB(0, 1), cB + hstep, voffB); PG8_STAGE(PG8_SA(0, 1), cA + hstep, voffA);
    if (wr == 1) PG8_BAR;
    PG8_WAIT_V(4); PG8_BAR;
    PG8_STAGE(PG8_SB(1, 0), cB + kstep, voffB); PG8_STAGE(PG8_SA(1, 0), cA + kstep, voffA); PG8_STAGE(PG8_SB(1, 1), cB + hstep + kstep, voffB);
    PG8_WAIT_V(6); PG8_BAR;
    for (;;) {
        const bool has_next = S.next(ui + 1, nxt);
        const char* nA = has_next ? (const char*)g.A + (size_t)nxt.pm * tstep : cA; const char* nB = has_next ? (const char*)g.Bt + (size_t)nxt.pn * tstep : cB;
        for (int t = 0; t < nt; t += 2) {
            const bool last = (t == nt - 2);
            const char* a1 = cA + (size_t)(t + 1) * kstep;
            const char* a2 = last ? nA : cA + (size_t)(t + 2) * kstep; const char* b2 = last ? nB : cB + (size_t)(t + 2) * kstep;
            const char* a3 = a2 + kstep; const char* b3 = b2 + kstep;
            if (last && has_next) S.a_ready(nxt);
            PG8_LDB(B0, 0, 0); PG8_SCHED; PG8_LDA(At, 0, 0); PG8_STAGE(PG8_SA(1, 1), a1 + hstep, voffA);
            PG8_WAIT_L(8); PG8_BAR; PG8_WAIT_L(0); PG8_MMA(0, 0, At, B0); PG8_BAR; PG8_SCHED;
            PG8_LDB(B1, 0, 1); PG8_STAGE(PG8_SB(0, 0), b2, voffB);
            PG8_BAR; PG8_WAIT_L(0); PG8_MMA(0, 1, At, B1); PG8_BAR;
            PG8_LDA(At, 0, 1); PG8_STAGE(PG8_SA(0, 0), a2, voffA);
            PG8_BAR; PG8_WAIT_L(0); PG8_MMA(1, 0, At, B0); PG8_BAR; PG8_SCHED;
            PG8_STAGE(PG8_SB(0, 1), b2 + hstep, voffB);
            PG8_WAIT_V(6); PG8_BAR; PG8_MMA(1, 1, At, B1); PG8_BAR;
            PG8_LDB(B0, 1, 0); PG8_SCHED; PG8_LDA(At, 1, 0); PG8_STAGE(PG8_SA(0, 1), a2 + hstep, voffA);
            PG8_WAIT_L(8); PG8_BAR; PG8_WAIT_L(0); PG8_MMA(0, 0, At, B0); PG8_BAR; PG8_SCHED;
            PG8_LDB(B1, 1, 1); PG8_STAGE(PG8_SB(1, 0), b3, voffB);
            PG8_BAR; PG8_WAIT_L(0); PG8_MMA(0, 1, At, B1); PG8_BAR;
            PG8_LDA(At, 1, 1); PG8_STAGE(PG8_SA(1, 0), a3, voffA);
            PG8_BAR; PG8_WAIT_L(0); PG8_MMA(1, 0, At, B0); PG8_BAR; PG8_SCHED;
            PG8_STAGE(PG8_SB(1, 1), b3 + hstep, voffB);
            PG8_WAIT_V(6); PG8_BAR; PG8_MMA(1, 1, At, B1); PG8_BAR;
        }
        if constexpr (!Epi::AFTER_DRAIN) { E(acc, cur, wr, wc, fr, fq); S.done(cur); }
        if (!has_next) break;
#pragma unroll
        for (int a = 0; a < 2; ++a)
#pragma unroll
            for (int b = 0; b < 2; ++b)
#pragma unroll
                for (int m = 0; m < 4; ++m)
#pragma unroll
                    for (int n = 0; n < 2; ++n) acc[a][b][m][n] = (f32x4){0.f, 0.f, 0.f, 0.f};
        cur = nxt; cA = nA; cB = nB; ++ui;
    }
    PG8_WAIT_V(0);
    if (wr == 0) PG8_BAR;
    PG8_BAR;
    if constexpr (Epi::AFTER_DRAIN) { E.fused(acc, cur, wr, wc, fr, fq, lds, wid, lane); S.done(cur); }
#undef PG8_SA
#undef PG8_SB
#undef PG8_STAGE
#undef PG8_LDA
#undef PG8_LDB
#undef PG8_MMA
#undef PG8_WAIT_V
#undef PG8_WAIT_L
#undef PG8_BAR
#undef PG8_SCHED
}
}

typedef unsigned short bf16_t;
typedef float f32x4 __attribute__((ext_vector_type(4)));
typedef float f32x2 __attribute__((ext_vector_type(2)));
typedef unsigned u32x4 __attribute__((ext_vector_type(4)));
typedef unsigned u32x2 __attribute__((ext_vector_type(2)));

constexpr int D = 2048, NB = 4, SEQ = 4096, CTXL = 256;
constexpr int ML = NB * SEQ;
constexpr int MC = NB * CTXL;
constexpr int MT = ML + MC;
constexpr int AB_IN = 7616, NIN0 = 7680, PW0 = 7168, TW0 = 512;
constexpr int C_INW = 6176, NIN1 = 6400, PW1 = 6144, TW1 = 256;
constexpr int FF = 5632;
constexpr int MODW = 6 * D;
constexpr int NTHREADS = 512, NWAVES = 8;

constexpr size_t MiB = 1u << 20;
constexpr size_t WS_CTL = 0, CTL_BYTES = 16384;
constexpr size_t WS_MOD = 1 * MiB;
constexpr size_t WS_GA = 2 * MiB, WS_GB = 4 * MiB;
constexpr size_t WS_XC = 6 * MiB;
constexpr size_t WS_HY = 14 * MiB;
constexpr size_t WS_TAIL = 82 * MiB;
constexpr size_t WS_WIN = 116 * MiB;
constexpr size_t WS_WOUT = 146 * MiB;
constexpr size_t WS_W13 = 154 * MiB;
constexpr size_t WS_W2 = 198 * MiB;
constexpr size_t WS_P = 220 * MiB;
constexpr size_t WS_F = 458 * MiB;
constexpr size_t FSLOT = (size_t)MT * 1024 * 2;
constexpr size_t WS_END = 696 * MiB;
static_assert(WS_F + 7 * FSLOT <= WS_END, "ws map");
static_assert(WS_HY + (size_t)MT * D * 2 <= WS_TAIL && WS_TAIL + (size_t)MT * TW0 * 4 <= WS_WIN && WS_W2 + (size_t)D * FF * 2 <= WS_P && WS_P + (size_t)MT * PW0 * 2 <= WS_F, "ws map");

constexpr int LDS_BYTES = 147456;
constexpr int LDS_BAR_OFF = LDS_BYTES - 64;

__device__ __forceinline__ float bflo(unsigned u) { return __builtin_bit_cast(float, u << 16); }
__device__ __forceinline__ float bfhi(unsigned u) { return __builtin_bit_cast(float, u & 0xffff0000u); }
__device__ __forceinline__ float bf1(bf16_t h) { return __builtin_bit_cast(float, (unsigned)h << 16); }
__device__ __forceinline__ unsigned f2bf(float f) { unsigned u = __builtin_bit_cast(unsigned, f); return (u + 0x7fffu + ((u >> 16) & 1u)) >> 16; }
__device__ __forceinline__ unsigned pk2(float lo, float hi) { return f2bf(lo) | (f2bf(hi) << 16); }
__device__ __forceinline__ float sigm(float x) { return 1.f / (1.f + expf(-x)); }
__device__ __forceinline__ float sigm_fast(float x) { return 1.f / (1.f + __expf(-x)); }
__device__ __forceinline__ float silu_fast(float x) { return x / (1.f + __expf(-x)); }
__device__ __forceinline__ float softplus_(float x) { return fmaxf(x, 0.f) + log1pf(expf(-fabsf(x))); }
__device__ __forceinline__ float logsigm_(float x) { return fminf(x, 0.f) - log1pf(expf(-fabsf(x))); }
template <int W> __device__ __forceinline__ float grp_sum(float v) {
#pragma unroll
    for (int o = 1; o < W; o <<= 1) v += __shfl_xor(v, o);
    return v;
}
__device__ __forceinline__ void unpack8(const u32x4 u, float (&f)[8]) {
    f[0] = bflo(u.x); f[1] = bfhi(u.x); f[2] = bflo(u.y); f[3] = bfhi(u.y); f[4] = bflo(u.z); f[5] = bfhi(u.z); f[6] = bflo(u.w); f[7] = bfhi(u.w);
}
__device__ __forceinline__ u32x4 pack8(const float (&f)[8]) { u32x4 o; o.x = pk2(f[0], f[1]); o.y = pk2(f[2], f[3]); o.z = pk2(f[4], f[5]); o.w = pk2(f[6], f[7]); return o; }

struct EpiInProj {
    static constexpr bool PERM = true, AFTER_DRAIN = false;
    bf16_t* P; int ldp; int nPt; float* T; int ldt;
    __device__ __forceinline__ void operator()(const pg8::f32x4 (&acc)[2][2][4][2], const pg8::Unit& u, int wr, int wc, int fr, int fq) const {
        const int row0 = u.pm * 256 + wr * 64 + fr;
        if (u.pn < nPt) {
            const int col0 = u.pn * 256 + wc * 32 + 8 * fq;
#pragma unroll
            for (int ai = 0; ai < 2; ++ai)
#pragma unroll
                for (int m = 0; m < 4; ++m) { bf16_t* rowp = P + (size_t)(row0 + ai * 128 + m * 16) * ldp + col0;
#pragma unroll
                    for (int bj = 0; bj < 2; ++bj) { const pg8::f32x4 v0 = acc[ai][bj][m][0], v1 = acc[ai][bj][m][1];
                        u32x4 o; o.x = pk2(v0[0], v0[1]); o.y = pk2(v0[2], v0[3]); o.z = pk2(v1[0], v1[1]); o.w = pk2(v1[2], v1[3]);
                        *(u32x4*)(rowp + bj * 128) = o; } }
        } else {
            const int col0 = (u.pn - nPt) * 256 + wc * 32 + 8 * fq;
#pragma unroll
            for (int ai = 0; ai < 2; ++ai)
#pragma unroll
                for (int m = 0; m < 4; ++m) { float* rowp = T + (size_t)(row0 + ai * 128 + m * 16) * ldt + col0;
#pragma unroll
                    for (int bj = 0; bj < 2; ++bj) { *(pg8::f32x4*)(rowp + bj * 128) = acc[ai][bj][m][0]; *(pg8::f32x4*)(rowp + bj * 128 + 4) = acc[ai][bj][m][1]; } }
        }
    }
};
struct EpiResid {
    static constexpr bool PERM = false, AFTER_DRAIN = false;
    const float* srcL; const float* srcC; float* dstL; float* dstC; const float* gate;
    __device__ __forceinline__ void operator()(const pg8::f32x4 (&acc)[2][2][4][2], const pg8::Unit& u, int wr, int wc, int fr, int fq) const {
        const bool lat = u.pm < 64;
        const int rowl = (lat ? u.pm : u.pm - 64) * 256 + wr * 64 + fr, col0 = u.pn * 256 + wc * 32 + 4 * fq;
        const float* src = lat ? srcL : srcC; float* dst = lat ? dstL : dstC;
        const float* g = gate + (size_t)(lat ? (u.pm >> 4) : 4) * MODW + col0;
        pg8::f32x4 gv[2][2];
#pragma unroll
        for (int bj = 0; bj < 2; ++bj)
#pragma unroll
            for (int n = 0; n < 2; ++n) gv[bj][n] = *(const pg8::f32x4*)(g + bj * 128 + n * 16);
#pragma unroll
        for (int ai = 0; ai < 2; ++ai)
#pragma unroll
            for (int m = 0; m < 4; ++m) { const size_t ro = (size_t)(rowl + ai * 128 + m * 16) * D + col0;
#pragma unroll
                for (int bj = 0; bj < 2; ++bj)
#pragma unroll
                    for (int n = 0; n < 2; ++n) { const pg8::f32x4 s = *(const pg8::f32x4*)(src + ro + bj * 128 + n * 16);
                        *(pg8::f32x4*)(dst + ro + bj * 128 + n * 16) = s + gv[bj][n] * acc[ai][bj][m][n]; } }
    }
};
struct EpiSwiGLU {
    static constexpr bool PERM = true, AFTER_DRAIN = false;
    bf16_t* H; int ldh;
    __device__ __forceinline__ void operator()(const pg8::f32x4 (&acc)[2][2][4][2], const pg8::Unit& u, int wr, int wc, int fr, int fq) const {
        const int row0 = u.pm * 256 + wr * 64 + fr, col0 = u.pn * 128 + wc * 32 + 8 * fq;
#pragma unroll
        for (int ai = 0; ai < 2; ++ai)
#pragma unroll
            for (int m = 0; m < 4; ++m) { float h[8];
#pragma unroll
                for (int n = 0; n < 2; ++n)
#pragma unroll
                    for (int j = 0; j < 4; ++j) h[n * 4 + j] = silu_fast(acc[ai][0][m][n][j]) * acc[ai][1][m][n][j];
                *(u32x4*)(H + (size_t)(row0 + ai * 128 + m * 16) * ldh + col0) = pack8(h); }
    }
};

struct Ctx {
    LAS unsigned char* lds; int tid, lane, wave, G, wg, gw, NGW;
    const float* in[32]; float* out; unsigned char* ws;
};
#define IN_X 0
#define IN_C 1
#define IN_CTX 2
#define IN_CCTX 3
#define IN_ADAW 4
#define IN_ADAB 5
#define IN_NORMW 6
#define IN_ABWIN 7
#define IN_CONVW 8
#define IN_ALOG 9
#define IN_DTB 10
#define IN_GDNNW 11
#define IN_W0 12
#define IN_WUP 13
#define IN_A0 14
#define IN_AUP 15
#define IN_GUP 16
#define IN_KK 17
#define IN_KA 18
#define IN_RK 19
#define IN_LNW 20
#define IN_LNB 21
#define IN_ABWOUT 22
#define IN_MLWIN 23
#define IN_MLIB 24
#define IN_MLFB 25
#define IN_MLNW 26
#define IN_MLWOUT 27
#define IN_W1 28
#define IN_W3 29
#define IN_W2 30
#define IN_FNW 31

__device__ __forceinline__ void transpose_item(const float* W, int K, int N, bf16_t* WT, int out_row0, LAS float* scr, int k0, int n0, int lane) {
#pragma unroll 8
    for (int i = 0; i < 32; ++i) { const int kk = 2 * i + (lane >> 5); scr[kk * 33 + (lane & 31)] = W[(size_t)(k0 + kk) * N + n0 + (lane & 31)]; }
    asm volatile("s_waitcnt lgkmcnt(0)" ::: "memory");
    const int c = lane & 7;
#pragma unroll
    for (int j = 0; j < 4; ++j) { const int n = (lane >> 3) + 8 * j; const LAS float* s = scr + (8 * c) * 33 + n;
        u32x4 o; o.x = pk2(s[0 * 33], s[1 * 33]); o.y = pk2(s[2 * 33], s[3 * 33]); o.z = pk2(s[4 * 33], s[5 * 33]); o.w = pk2(s[6 * 33], s[7 * 33]);
        *(u32x4*)(WT + (size_t)(out_row0 + n) * K + k0 + 8 * c) = o; }
    asm volatile("s_waitcnt lgkmcnt(0)" ::: "memory");
}
__device__ __forceinline__ void transpose_matrix(const Ctx& c, const float* W, int K, int N, bf16_t* WT, int mode, LAS float* scr) {
    const int nblk = N / 32, items = (K / 64) * nblk;
    for (int it = c.gw; it < items; it += c.NGW) {
        const int kb = it / nblk, nb = it % nblk, n0 = nb * 32;
        const int orow = mode == 0 ? n0 : ((n0 >> 7) * 256 + (n0 & 127) + (mode == 2 ? 128 : 0));
        transpose_item(W, K, N, WT, orow, scr, kb * 64, n0, c.lane);
    }
}
__device__ __forceinline__ void zero_rows(const Ctx& c, bf16_t* WT, int K, int r0, int r1) {
    u32x4* p = (u32x4*)(WT + (size_t)r0 * K); const size_t n = (size_t)(r1 - r0) * K / 8;
    for (size_t i = (size_t)c.wg * NTHREADS + c.tid; i < n; i += (size_t)c.G * NTHREADS) p[i] = (u32x4){0u, 0u, 0u, 0u};
}
__device__ __forceinline__ void convert_weights(const Ctx& c, int layer) {
    LAS float* scr = (LAS float*)(c.lds + 65536) + c.wave * (64 * 33);
    bf16_t* Win = (bf16_t*)(c.ws + WS_WIN); bf16_t* Wout = (bf16_t*)(c.ws + WS_WOUT); bf16_t* W13 = (bf16_t*)(c.ws + WS_W13); bf16_t* W2 = (bf16_t*)(c.ws + WS_W2);
    if (layer == 0) { transpose_matrix(c, c.in[IN_ABWIN], D, AB_IN, Win, 0, scr); zero_rows(c, Win, D, AB_IN, NIN0); transpose_matrix(c, c.in[IN_ABWOUT], D, D, Wout, 0, scr); }
    else { transpose_matrix(c, c.in[IN_MLWIN], D, C_INW, Win, 0, scr); zero_rows(c, Win, D, C_INW, NIN1); transpose_matrix(c, c.in[IN_MLWOUT], D, D, Wout, 0, scr); }
    transpose_matrix(c, c.in[IN_W1] + (size_t)layer * D * FF, D, FF, W13, 1, scr);
    transpose_matrix(c, c.in[IN_W3] + (size_t)layer * D * FF, D, FF, W13, 2, scr);
    transpose_matrix(c, c.in[IN_W2] + (size_t)layer * FF * D, FF, D, W2, 0, scr);
}
__device__ __forceinline__ void ada_phase(const Ctx& c) {
    LAS float* sc = (LAS float*)c.lds;
    LAS float* red = sc + 5 * D;
    for (int i = c.tid; i < 5 * D; i += NTHREADS) { const int b = i / D, k = i % D; const float v = b < 4 ? c.in[IN_C][b * D + k] : c.in[IN_CCTX][k]; sc[i] = v / (1.f + expf(-v)); }
    __syncthreads();
    float* MOD = (float*)(c.ws + WS_MOD);
    for (int u = c.wg; u < 2 * (MODW / 64); u += c.G) {
        const int layer = u / (MODW / 64), cb = (u % (MODW / 64)) * 64;
        const float* wp = c.in[IN_ADAW] + (size_t)layer * D * MODW + cb + c.lane;
        float acc[5] = {0.f, 0.f, 0.f, 0.f, 0.f};
        const int k0 = c.wave * 256;
#pragma unroll 16
        for (int k = k0; k < k0 + 256; ++k) { const float w = wp[(size_t)k * MODW];
#pragma unroll
            for (int b = 0; b < 5; ++b) acc[b] += sc[b * D + k] * w; }
#pragma unroll
        for (int b = 0; b < 5; ++b) red[(c.wave * 5 + b) * 64 + c.lane] = acc[b];
        __syncthreads();
        if (c.tid < 320) { const int b = c.tid / 64, l = c.tid % 64; float s = 0.f;
#pragma unroll
            for (int w = 0; w < 8; ++w) s += red[(w * 5 + b) * 64 + l];
            MOD[(size_t)(layer * 5 + b) * MODW + cb + l] = s + c.in[IN_ADAB][layer * MODW + cb + l]; }
        __syncthreads();
    }
}
__device__ __forceinline__ void norm_mod_phase(const Ctx& c, const float* srcL, const float* srcC, const float* nw, const float* modl, int shift_off, int scale_off, int nrows) {
    bf16_t* H = (bf16_t*)(c.ws + WS_HY);
    for (int r = c.gw; r < nrows; r += c.NGW) {
        const float* xr = r < ML ? srcL + (size_t)r * D : srcC + (size_t)(r - ML) * D;
        const float* mr = modl + (size_t)(r < ML ? (r >> 12) : 4) * MODW;
        f32x4 v[8]; float ss = 0.f;
#pragma unroll
        for (int j = 0; j < 8; ++j) { v[j] = ((const f32x4*)xr)[c.lane + 64 * j]; ss += v[j].x * v[j].x + v[j].y * v[j].y + v[j].z * v[j].z + v[j].w * v[j].w; }
        ss = grp_sum<64>(ss);
        const float rstd = 1.f / sqrtf(ss * (1.f / D) + 1e-6f);
#pragma unroll
        for (int j = 0; j < 8; ++j) { const f32x4 w4 = ((const f32x4*)nw)[c.lane + 64 * j], s4 = ((const f32x4*)(mr + scale_off))[c.lane + 64 * j], h4 = ((const f32x4*)(mr + shift_off))[c.lane + 64 * j];
            const f32x4 y = v[j] * rstd * w4 * (s4 + 1.f) + h4;
            u32x2 o; o.x = pk2(y.x, y.y); o.y = pk2(y.z, y.w);
            ((u32x2*)(H + (size_t)r * D))[c.lane + 64 * j] = o; }
    }
}
__device__ __forceinline__ void final_norm_phase(const Ctx& c) {
    const float* nw = c.in[IN_FNW];
    for (int r = c.gw; r < ML; r += c.NGW) {
        f32x4* xr = (f32x4*)(c.out + (size_t)r * D);
        f32x4 v[8]; float ss = 0.f;
#pragma unroll
        for (int j = 0; j < 8; ++j) { v[j] = xr[c.lane + 64 * j]; ss += v[j].x * v[j].x + v[j].y * v[j].y + v[j].z * v[j].z + v[j].w * v[j].w; }
        ss = grp_sum<64>(ss);
        const float rstd = 1.f / sqrtf(ss * (1.f / D) + 1e-6f);
#pragma unroll
        for (int j = 0; j < 8; ++j) xr[c.lane + 64 * j] = v[j] * rstd * ((const f32x4*)nw)[c.lane + 64 * j];
    }
}

__device__ __forceinline__ void ab_feature_phase(const Ctx& c) {
    const bf16_t* P = (const bf16_t*)(c.ws + WS_P); const float* T = (const float*)(c.ws + WS_TAIL);
    bf16_t* F = (bf16_t*)(c.ws + WS_F);
    float* GA = (float*)(c.ws + WS_GA); float* GB = (float*)(c.ws + WS_GB);
    const float* cw = c.in[IN_CONVW];
    const int lane = c.lane;
    for (int it = 0; it * c.NGW < MT; ++it) {
        const int r = it * c.NGW + c.wg * NWAVES + c.wave;
        if (r >= MT) break;
        int nb[9];
        if (r < ML) { const int b = r >> 12, t = r & 4095, gr = t >> 6, gc = t & 63;
#pragma unroll
            for (int dr = 0; dr < 3; ++dr)
#pragma unroll
                for (int dc = 0; dc < 3; ++dc) { const int rr = gr + dr - 1, cc = gc + dc - 1; nb[dr * 3 + dc] = (rr >= 0 && rr < 64 && cc >= 0 && cc < 64) ? (b * 4096 + rr * 64 + cc) : -1; } }
        else { const int q = r - ML, b = q >> 8, t = q & 255;
#pragma unroll
            for (int k = 0; k < 9; ++k) nb[k] = -1;
#pragma unroll
            for (int dc = 0; dc < 3; ++dc) { const int cc = t + dc - 1; nb[3 + dc] = (cc >= 0 && cc < 256) ? (ML + b * 256 + cc) : -1; } }
#pragma unroll 1
        for (int blk = 0; blk < 12; ++blk) {
            const int ch = blk * 512 + lane * 8;
            float cv[8];
#pragma unroll
            for (int j = 0; j < 8; ++j) cv[j] = 0.f;
#pragma unroll
            for (int k = 0; k < 9; ++k) if (nb[k] >= 0) {
                const u32x4 pv = *(const u32x4*)(P + (size_t)nb[k] * PW0 + ch);
                const f32x4 w0 = *(const f32x4*)(cw + k * 6144 + ch), w1 = *(const f32x4*)(cw + k * 6144 + ch + 4);
                float pf[8]; unpack8(pv, pf);
                cv[0] += pf[0] * w0.x; cv[1] += pf[1] * w0.y; cv[2] += pf[2] * w0.z; cv[3] += pf[3] * w0.w;
                cv[4] += pf[4] * w1.x; cv[5] += pf[5] * w1.y; cv[6] += pf[6] * w1.z; cv[7] += pf[7] * w1.w; }
            const int grp = blk >> 1, cl = (blk & 1) * 512 + lane * 8;
            if (grp < 3) {
                float ss = 0.f;
#pragma unroll
                for (int j = 0; j < 8; ++j) { cv[j] = cv[j] / (1.f + __expf(-cv[j])); ss += cv[j] * cv[j]; }
                if (grp < 2) { ss = grp_sum<16>(ss); const float sc = (1.f / sqrtf(ss + 1e-6f)) * (grp == 0 ? 0.08838834764831845f : 1.f);
#pragma unroll
                    for (int j = 0; j < 8; ++j) cv[j] *= sc; }
                *(u32x4*)(F + (size_t)grp * MT * 1024 + (size_t)r * 1024 + cl) = pack8(cv);
            } else if (grp == 3) { *(u32x4*)(F + (size_t)3 * MT * 1024 + (size_t)r * 1024 + cl) = pack8(cv);
            } else if (grp == 5) { *(u32x4*)(F + (size_t)6 * MT * 1024 + (size_t)r * 1024 + cl) = pack8(cv);
            } else {
                *(u32x4*)(F + (size_t)5 * MT * 1024 + (size_t)r * 1024 + cl) = pack8(cv);
                const f32x4 k0 = *(const f32x4*)(c.in[IN_KK] + cl), k1 = *(const f32x4*)(c.in[IN_KK] + cl + 4);
                float t[8] = {cv[0] * k0.x, cv[1] * k0.y, cv[2] * k0.z, cv[3] * k0.w, cv[4] * k1.x, cv[5] * k1.y, cv[6] * k1.z, cv[7] * k1.w};
                float ss = 0.f;
#pragma unroll
                for (int j = 0; j < 8; ++j) ss += t[j] * t[j];
                ss = grp_sum<8>(ss); const float sc = 1.f / sqrtf(ss + 1e-6f);
#pragma unroll
                for (int j = 0; j < 8; ++j) t[j] *= sc;
                *(u32x4*)(F + (size_t)4 * MT * 1024 + (size_t)r * 1024 + cl) = pack8(t);
            }
        }
        if (lane < 16) {
            const float g0 = T[(size_t)r * TW0 + lane], g1 = T[(size_t)r * TW0 + 16 + lane];
            GA[(size_t)r * 16 + lane] = -expf(c.in[IN_ALOG][lane]) * softplus_(g0 + c.in[IN_DTB][lane]);
            GB[(size_t)r * 16 + lane] = sigm(g1);
        }
    }
}
__device__ __forceinline__ void rw_lora_phase(const Ctx& c) {
    bf16_t* P = (bf16_t*)(c.ws + WS_P); const float* T = (const float*)(c.ws + WS_TAIL);
    LAS float* xin = (LAS float*)c.lds;
    const int tid = c.tid;
    for (int tile = c.wg; tile < MT / 16; tile += c.G) {
        const int r0 = tile * 16;
#pragma unroll 1
        for (int pass = 0; pass < 2; ++pass) {
            __syncthreads();
            for (int i = tid; i < 16 * 128; i += NTHREADS) { const int tk = i >> 7, j = i & 127; const float v = T[(size_t)(r0 + tk) * TW0 + 32 + pass * 128 + j]; xin[i] = pass == 0 ? tanhf(v) : v; }
            __syncthreads();
            const float* up = c.in[pass == 0 ? IN_WUP : IN_AUP];
            float acc[16][2][2];
#pragma unroll
            for (int tk = 0; tk < 16; ++tk) { acc[tk][0][0] = acc[tk][0][1] = acc[tk][1][0] = acc[tk][1][1] = 0.f; }
#pragma unroll 2
            for (int rr = 0; rr < 64; ++rr) {
                const float w00 = up[(size_t)rr * 1024 + tid], w01 = up[(size_t)rr * 1024 + tid + 512], w10 = up[(size_t)(64 + rr) * 1024 + tid], w11 = up[(size_t)(64 + rr) * 1024 + tid + 512];
#pragma unroll
                for (int tk = 0; tk < 16; ++tk) { const float x0 = xin[tk * 128 + rr], x1 = xin[tk * 128 + 64 + rr];
                    acc[tk][0][0] += x0 * w00; acc[tk][0][1] += x0 * w01; acc[tk][1][0] += x1 * w10; acc[tk][1][1] += x1 * w11; }
            }
            const float* bias = c.in[pass == 0 ? IN_W0 : IN_A0];
#pragma unroll
            for (int d = 0; d < 2; ++d)
#pragma unroll
                for (int j = 0; j < 2; ++j) { const int ch = tid + 512 * j; const float bz = bias[d * 1024 + ch];
#pragma unroll
                    for (int tk = 0; tk < 16; ++tk) { const float s = sigm(bz + acc[tk][d][j]);
                        P[(size_t)(r0 + tk) * PW0 + (pass * 2 + d) * 1024 + ch] = (bf16_t)f2bf(pass == 0 ? -0.6065306597126334f * s : s); } }
        }
    }
}
__device__ __forceinline__ int chunk_row(int b, int dir, int s) {
    if (s < 4) return ML + b * 256 + (dir == 0 ? s : 3 - s) * 64;
    return b * 4096 + (dir == 0 ? s - 4 : 67 - s) * 64;
}
__device__ __forceinline__ void gdn_scan_phase(const Ctx& c) {
    const bf16_t* F = (const bf16_t*)(c.ws + WS_F); bf16_t* P = (bf16_t*)(c.ws + WS_P);
    const float* GA = (const float*)(c.ws + WS_GA); const float* GB = (const float*)(c.ws + WS_GB);
    const int lane = c.lane, tid = c.tid, slab = lane & 15, cl = c.wave * 4 + (lane >> 4);
    for (int item = c.wg; item < 256; item += c.G) {
        const int chain = item >> 2, cq = item & 3, b = chain >> 4, h = (chain >> 1) & 7, dir = chain & 1;
        float S[8];
#pragma unroll
        for (int i = 0; i < 8; ++i) S[i] = 0.f;
        u32x4 rk[2], rq[2], rv; float rg = 0.f, rb = 0.f;
        auto gload = [&](int s) {
            const int row0 = chunk_row(b, dir, s);
#pragma unroll
            for (int i = 0; i < 2; ++i) { const int pc = tid + i * 512, tk = pc >> 4, o = (pc & 15) * 8;
                rk[i] = *(const u32x4*)(F + (size_t)1 * MT * 1024 + (size_t)(row0 + tk) * 1024 + h * 128 + o);
                rq[i] = *(const u32x4*)(F + (size_t)0 * MT * 1024 + (size_t)(row0 + tk) * 1024 + h * 128 + o); }
            if (tid < 256) { const int tk = tid >> 2, o = (tid & 3) * 8; rv = *(const u32x4*)(F + (size_t)2 * MT * 1024 + (size_t)(row0 + tk) * 1024 + h * 128 + cq * 32 + o); }
            if (tid < 64) { rg = GA[(size_t)(row0 + tid) * 16 + dir * 8 + h]; rb = GB[(size_t)(row0 + tid) * 16 + dir * 8 + h]; }
        };
        auto lstore = [&](int bufi) {
            LAS unsigned char* bp = c.lds + bufi * 40960;
#pragma unroll
            for (int i = 0; i < 2; ++i) { const int pc = tid + i * 512; *(LAS u32x4*)(bp + pc * 16) = rk[i]; *(LAS u32x4*)(bp + 16384 + pc * 16) = rq[i]; }
            if (tid < 256) *(LAS u32x4*)(bp + 32768 + tid * 16) = rv;
            if (tid < 64) { *(LAS float*)(bp + 36864 + tid * 4) = rg; *(LAS float*)(bp + 37120 + tid * 4) = rb; }
        };
        __syncthreads();
        gload(0); lstore(0);
        __syncthreads();
        LAS float* ost = (LAS float*)(c.lds + 81920);
#pragma unroll 1
        for (int s = 0; s < 68; ++s) {
            if (s + 1 < 68) gload(s + 1);
            const LAS unsigned char* bp = c.lds + (s & 1) * 40960;
#pragma unroll 2
            for (int j = 0; j < 64; ++j) {
                const int tl = dir == 0 ? j : 63 - j;
                float kf[8], qf[8];
                unpack8(*(const LAS u32x4*)(bp + tl * 256 + slab * 16), kf);
                unpack8(*(const LAS u32x4*)(bp + 16384 + tl * 256 + slab * 16), qf);
                const float vv = bf1(*(const LAS bf16_t*)(bp + 32768 + tl * 64 + cl * 2));
                const float a = __expf(*(const LAS float*)(bp + 36864 + tl * 4)), bt = *(const LAS float*)(bp + 37120 + tl * 4);
                float dot = 0.f;
#pragma unroll
                for (int i = 0; i < 8; ++i) dot += S[i] * kf[i];
                dot = grp_sum<16>(dot);
                const float dlt = bt * (vv - a * dot);
                float od = 0.f;
#pragma unroll
                for (int i = 0; i < 8; ++i) { S[i] = a * S[i] + kf[i] * dlt; od += S[i] * qf[i]; }
                od = grp_sum<16>(od);
                if (slab == 0) ost[tl * 32 + cl] = od;
            }
            __syncthreads();
            {
                const int row0 = chunk_row(b, dir, s), tk = tid >> 3, o = (tid & 7) * 4;
                const f32x4 v = *(const LAS f32x4*)(ost + tk * 32 + o);
                u32x2 w; w.x = pk2(v.x, v.y); w.y = pk2(v.z, v.w);
                *(u32x2*)(P + (size_t)(row0 + tk) * PW0 + (4 + dir) * 1024 + h * 128 + cq * 32 + o) = w;
            }
            if (s + 1 < 68) lstore((s + 1) & 1);
            __syncthreads();
        }
    }
}
__device__ __forceinline__ void rwkv_scan_phase(const Ctx& c) {
    const bf16_t* F = (const bf16_t*)(c.ws + WS_F); const bf16_t* P = (const bf16_t*)(c.ws + WS_P);
    bf16_t* Y = (bf16_t*)(c.ws + WS_F);
    const int lane = c.lane, tid = c.tid, slab = lane & 15, rl = c.wave * 4 + (lane >> 4);
    for (int item = c.wg; item < 256; item += c.G) {
        const int chain = item >> 1, rh = item & 1, b = chain >> 5, h = (chain >> 1) & 15, dir = chain & 1;
        float S[4] = {0.f, 0.f, 0.f, 0.f};
        const f32x4 ka = *(const f32x4*)(c.in[IN_KA] + h * 64 + slab * 4);
        u32x4 rr[5]; u32x4 rv;
        auto gload = [&](int s) {
            const int row0 = chunk_row(b, dir, s);
            const int tk = tid >> 3, o = (tid & 7) * 8;
            rr[0] = *(const u32x4*)(F + (size_t)3 * MT * 1024 + (size_t)(row0 + tk) * 1024 + h * 64 + o);
            rr[1] = *(const u32x4*)(F + (size_t)4 * MT * 1024 + (size_t)(row0 + tk) * 1024 + h * 64 + o);
            rr[2] = *(const u32x4*)(F + (size_t)5 * MT * 1024 + (size_t)(row0 + tk) * 1024 + h * 64 + o);
            rr[3] = *(const u32x4*)(P + (size_t)(row0 + tk) * PW0 + (0 + dir) * 1024 + h * 64 + o);
            rr[4] = *(const u32x4*)(P + (size_t)(row0 + tk) * PW0 + (2 + dir) * 1024 + h * 64 + o);
            if (tid < 256) { const int t2 = tid >> 2, o2 = (tid & 3) * 8; rv = *(const u32x4*)(F + (size_t)6 * MT * 1024 + (size_t)(row0 + t2) * 1024 + h * 64 + rh * 32 + o2); }
        };
        auto lstore = [&](int bufi) {
            LAS unsigned char* bp = c.lds + bufi * 45056;
#pragma unroll
            for (int q = 0; q < 5; ++q) *(LAS u32x4*)(bp + q * 8192 + tid * 16) = rr[q];
            if (tid < 256) *(LAS u32x4*)(bp + 40960 + tid * 16) = rv;
        };
        __syncthreads();
        gload(0); lstore(0);
        __syncthreads();
        LAS float* yst = (LAS float*)(c.lds + 90112);
#pragma unroll 1
        for (int s = 0; s < 68; ++s) {
            if (s + 1 < 68) gload(s + 1);
            const LAS unsigned char* bp = c.lds + (s & 1) * 45056;
#pragma unroll 2
            for (int j = 0; j < 64; ++j) {
                const int tl = dir == 0 ? j : 63 - j;
                const u32x2 ur = *(const LAS u32x2*)(bp + tl * 128 + slab * 8), ukk = *(const LAS u32x2*)(bp + 8192 + tl * 128 + slab * 8), ukb = *(const LAS u32x2*)(bp + 16384 + tl * 128 + slab * 8),
                            ulw = *(const LAS u32x2*)(bp + 24576 + tl * 128 + slab * 8), ua = *(const LAS u32x2*)(bp + 32768 + tl * 128 + slab * 8);
                const float vv = bf1(*(const LAS bf16_t*)(bp + 40960 + tl * 64 + rl * 2));
                const float rf[4] = {bflo(ur.x), bfhi(ur.x), bflo(ur.y), bfhi(ur.y)}, kkf[4] = {bflo(ukk.x), bfhi(ukk.x), bflo(ukk.y), bfhi(ukk.y)}, kbf[4] = {bflo(ukb.x), bfhi(ukb.x), bflo(ukb.y), bfhi(ukb.y)},
                            lwf[4] = {bflo(ulw.x), bfhi(ulw.x), bflo(ulw.y), bfhi(ulw.y)}, af[4] = {bflo(ua.x), bfhi(ua.x), bflo(ua.y), bfhi(ua.y)};
                float sk = 0.f;
#pragma unroll
                for (int i = 0; i < 4; ++i) sk += S[i] * kkf[i];
                sk = grp_sum<16>(sk);
                float y = 0.f;
#pragma unroll
                for (int i = 0; i < 4; ++i) { const float w = __expf(lwf[i]), kka = kkf[i] * af[i], kt = kbf[i] * (1.f + (af[i] - 1.f) * ka[i]);
                    S[i] = S[i] * w - sk * kka + vv * kt; y += S[i] * rf[i]; }
                y = grp_sum<16>(y);
                if (slab == 0) yst[tl * 32 + rl] = y;
            }
            __syncthreads();
            {   const int row0 = chunk_row(b, dir, s), tk = tid >> 3, o = (tid & 7) * 4;
                const f32x4 v = *(const LAS f32x4*)(yst + tk * 32 + o);
                u32x2 w; w.x = pk2(v.x, v.y); w.y = pk2(v.z, v.w);
                *(u32x2*)(Y + (size_t)dir * MT * 1024 + (size_t)(row0 + tk) * 1024 + h * 64 + rh * 32 + o) = w;
            }
            if (s + 1 < 68) lstore((s + 1) & 1);
            __syncthreads();
        }
    }
}
__device__ __forceinline__ void ab_output_phase(const Ctx& c) {
    const bf16_t* F = (const bf16_t*)(c.ws + WS_F); const bf16_t* P = (const bf16_t*)(c.ws + WS_P); const float* T = (const float*)(c.ws + WS_TAIL);
    bf16_t* Yo = (bf16_t*)(c.ws + WS_HY);
    LAS float* sg = (LAS float*)c.lds;
    const int tid = c.tid, lane = c.lane, wave = c.wave;
    for (int tile = c.wg; tile < MT / 16; tile += c.G) {
        const int r0 = tile * 16;
        __syncthreads();
        for (int i = tid; i < 16 * 160; i += NTHREADS) { const int tk = i / 160, j = i % 160; sg[i] = sigm(T[(size_t)(r0 + tk) * TW0 + 288 + j]); }
        __syncthreads();
        LAS float* gos = (LAS float*)(c.lds + 16384);
        {
            float go[16][2];
#pragma unroll
            for (int tk = 0; tk < 16; ++tk) go[tk][0] = go[tk][1] = 0.f;
            const float* gup = c.in[IN_GUP];
#pragma unroll 2
            for (int rr = 0; rr < 160; ++rr) { const float w0 = gup[(size_t)rr * 1024 + tid], w1 = gup[(size_t)rr * 1024 + tid + 512];
#pragma unroll
                for (int tk = 0; tk < 16; ++tk) { const float x = sg[tk * 160 + rr]; go[tk][0] += x * w0; go[tk][1] += x * w1; } }
#pragma unroll
            for (int tk = 0; tk < 16; ++tk) { gos[tk * 1024 + tid] = go[tk][0]; gos[tk * 1024 + tid + 512] = go[tk][1]; }
        }
#pragma unroll
        for (int j = 0; j < 2; ++j) {
            const int ch = tid + 512 * j;
            const float kaj = c.in[IN_KA][ch], rkj = c.in[IN_RK][ch], lnw = c.in[IN_LNW][ch], lnb = c.in[IN_LNB][ch];
#pragma unroll 4
            for (int tk = 0; tk < 16; ++tk) {
                const size_t row = (size_t)(r0 + tk);
                const float y = bf1(F[(size_t)0 * MT * 1024 + row * 1024 + ch]) + bf1(F[(size_t)1 * MT * 1024 + row * 1024 + ch]);
                const float rv = bf1(F[(size_t)3 * MT * 1024 + row * 1024 + ch]), kb = bf1(F[(size_t)5 * MT * 1024 + row * 1024 + ch]), vb = bf1(F[(size_t)6 * MT * 1024 + row * 1024 + ch]);
                const float a0 = bf1(P[row * PW0 + 2048 + ch]), a1 = bf1(P[row * PW0 + 3072 + ch]);
                const float mu = grp_sum<64>(y) * (1.f / 64.f), dv = y - mu, var = grp_sum<64>(dv * dv) * (1.f / 64.f);
                const float kts = kb * (2.f + (a0 + a1 - 2.f) * kaj);
                const float bonus = grp_sum<64>(rv * kts * rkj) * vb;
                const float o = (dv * (1.f / sqrtf(var + 64e-5f)) * lnw + lnb + bonus) * gos[tk * 1024 + ch];
                Yo[row * D + 1024 + ch] = (bf16_t)f2bf(o);
            }
        }
        {   const int ch = 2 * tid;
            const float nw0 = c.in[IN_GDNNW][ch & 127], nw1 = c.in[IN_GDNNW][(ch & 127) + 1];
#pragma unroll 4
            for (int tk = 0; tk < 16; ++tk) {
                const size_t row = (size_t)(r0 + tk);
                const unsigned uf = *(const unsigned*)(P + row * PW0 + 4096 + ch), ub = *(const unsigned*)(P + row * PW0 + 5120 + ch), uz = *(const unsigned*)(P + row * PW0 + 6144 + ch);
                const float o0 = bflo(uf) + bflo(ub), o1 = bfhi(uf) + bfhi(ub);
                const float ss = grp_sum<64>(o0 * o0 + o1 * o1), rstd = 1.f / sqrtf(ss * (1.f / 128.f) + 1e-6f);
                const float z0 = bflo(uz), z1 = bfhi(uz);
                *(unsigned*)(Yo + row * D + ch) = pk2(o0 * rstd * nw0 * silu_fast(z0), o1 * rstd * nw1 * silu_fast(z1));
            }
        }
    }
}

__device__ __forceinline__ void ml_gate_phase(const Ctx& c) {
    const float* T = (const float*)(c.ws + WS_TAIL); float* GA = (float*)(c.ws + WS_GA); float* GB = (float*)(c.ws + WS_GB);
    for (size_t i = (size_t)c.wg * NTHREADS + c.tid; i < (size_t)MT * 16; i += (size_t)c.G * NTHREADS) {
        const size_t r = i >> 4; const int k = (int)(i & 15);
        const float gi = T[r * TW1 + k] + c.in[IN_MLIB][k], gf = T[r * TW1 + 16 + k] + c.in[IN_MLFB][k];
        GA[i] = 15.f * tanhf(gi * (1.f / 15.f));
        GB[i] = logsigm_(15.f * tanhf(gf * (1.f / 15.f)));
    }
}
__device__ __forceinline__ void mlstm_scan_phase(const Ctx& c) {
    const bf16_t* P = (const bf16_t*)(c.ws + WS_P); bf16_t* Hs = (bf16_t*)(c.ws + WS_F);
    const float* GA = (const float*)(c.ws + WS_GA); const float* GB = (const float*)(c.ws + WS_GB);
    const int lane = c.lane, tid = c.tid, slab = lane & 15, cp = c.wave * 4 + (lane >> 4);
    for (int item = c.wg; item < 256; item += c.G) {
        const int chain = item >> 2, cq = item & 3, b = chain >> 4, h = (chain >> 1) & 7, dir = chain & 1;
        float C[8][2], n[8]; float m = 0.f;
#pragma unroll
        for (int i = 0; i < 8; ++i) { C[i][0] = C[i][1] = 0.f; n[i] = 0.f; }
        u32x4 rk[2], rq[2], rv; float rg = 0.f, rb = 0.f;
        auto gload = [&](int s) {
            const int row0 = chunk_row(b, dir, s);
#pragma unroll
            for (int i = 0; i < 2; ++i) { const int pc = tid + i * 512, tk = pc >> 4, o = (pc & 15) * 8;
                rk[i] = *(const u32x4*)(P + (size_t)(row0 + tk) * PW1 + 1024 + h * 128 + o);
                rq[i] = *(const u32x4*)(P + (size_t)(row0 + tk) * PW1 + h * 128 + o); }
            { const int tk = tid >> 3, o = (tid & 7) * 8; rv = *(const u32x4*)(P + (size_t)(row0 + tk) * PW1 + 2048 + h * 256 + cq * 64 + o); }
            if (tid < 64) { rg = GA[(size_t)(row0 + tid) * 16 + dir * 8 + h]; rb = GB[(size_t)(row0 + tid) * 16 + dir * 8 + h]; }
        };
        auto lstore = [&](int bufi) {
            LAS unsigned char* bp = c.lds + bufi * 41472;
#pragma unroll
            for (int i = 0; i < 2; ++i) { const int pc = tid + i * 512; *(LAS u32x4*)(bp + pc * 16) = rk[i]; *(LAS u32x4*)(bp + 16384 + pc * 16) = rq[i]; }
            *(LAS u32x4*)(bp + 32768 + tid * 16) = rv;
            if (tid < 64) { *(LAS float*)(bp + 40960 + tid * 4) = rg; *(LAS float*)(bp + 41216 + tid * 4) = rb; }
        };
        __syncthreads();
        gload(0); lstore(0);
        __syncthreads();
        LAS float* hst = (LAS float*)(c.lds + 82944);
#pragma unroll 1
        for (int s = 0; s < 68; ++s) {
            if (s + 1 < 68) gload(s + 1);
            const LAS unsigned char* bp = c.lds + (s & 1) * 41472;
#pragma unroll 2
            for (int j = 0; j < 64; ++j) {
                const int tl = dir == 0 ? j : 63 - j;
                float kf[8], qf[8];
                unpack8(*(const LAS u32x4*)(bp + tl * 256 + slab * 16), kf);
                unpack8(*(const LAS u32x4*)(bp + 16384 + tl * 256 + slab * 16), qf);
                const unsigned uv = *(const LAS unsigned*)(bp + 32768 + tl * 128 + cp * 4);
                const float v0 = bflo(uv), v1 = bfhi(uv);
                const float ig = *(const LAS float*)(bp + 40960 + tl * 4), lf = *(const LAS float*)(bp + 41216 + tl * 4);
                const float mn = fmaxf(lf + m, ig), fs = __expf(lf + m - mn), is = __expf(ig - mn);
                m = mn;
                float n0 = 0.f, n1 = 0.f, dn = 0.f;
#pragma unroll
                for (int i = 0; i < 8; ++i) { const float ki = is * kf[i], qi = qf[i] * 0.08838834764831845f;
                    C[i][0] = fs * C[i][0] + ki * v0; C[i][1] = fs * C[i][1] + ki * v1; n[i] = fs * n[i] + ki;
                    n0 += C[i][0] * qi; n1 += C[i][1] * qi; dn += n[i] * qi; }
                n0 = grp_sum<16>(n0); n1 = grp_sum<16>(n1); dn = grp_sum<16>(dn);
                if (slab == 0) { const float dd = 1.f / fmaxf(fabsf(dn), __expf(-mn)); hst[tl * 64 + cp * 2] = n0 * dd; hst[tl * 64 + cp * 2 + 1] = n1 * dd; }
            }
            __syncthreads();
            if (s >= 4) {
                const int row0 = chunk_row(b, dir, s), tk = tid >> 3, o = (tid & 7) * 8;
                float v[8];
#pragma unroll
                for (int i = 0; i < 8; ++i) v[i] = hst[tk * 64 + o + i];
                *(u32x4*)(Hs + (size_t)dir * ML * D + (size_t)(row0 + tk) * D + h * 256 + cq * 64 + o) = pack8(v);
            }
            if (s + 1 < 68) lstore((s + 1) & 1);
            __syncthreads();
        }
    }
}
__device__ __forceinline__ void ml_output_phase(const Ctx& c) {
    const bf16_t* Hs = (const bf16_t*)(c.ws + WS_F); const bf16_t* P = (const bf16_t*)(c.ws + WS_P); bf16_t* Yo = (bf16_t*)(c.ws + WS_HY);
    const float* nw = c.in[IN_MLNW];
    for (int r = c.gw; r < ML; r += c.NGW) {
#pragma unroll
        for (int blk = 0; blk < 4; ++blk) {
            const int ch = blk * 512 + c.lane * 8;
            float a[8], bb[8], o[8];
            unpack8(*(const u32x4*)(Hs + (size_t)r * D + ch), a); unpack8(*(const u32x4*)(Hs + (size_t)ML * D + (size_t)r * D + ch), bb);
            unpack8(*(const u32x4*)(P + (size_t)r * PW1 + 4096 + ch), o);
            float ss = 0.f;
#pragma unroll
            for (int j = 0; j < 8; ++j) { a[j] += bb[j]; ss += a[j] * a[j]; }
            ss = grp_sum<32>(ss); const float rstd = 1.f / sqrtf(ss * (1.f / 256.f) + 1e-6f);
            const f32x4 w0 = *(const f32x4*)(nw + ch), w1 = *(const f32x4*)(nw + ch + 4);
            const float wv[8] = {w0.x, w0.y, w0.z, w0.w, w1.x, w1.y, w1.z, w1.w};
#pragma unroll
            for (int j = 0; j < 8; ++j) a[j] = a[j] * rstd * wv[j] * sigm_fast(o[j]);
            *(u32x4*)(Yo + (size_t)r * D + ch) = pack8(a);
        }
    }
}


typedef short bf16x8 __attribute__((ext_vector_type(8)));
typedef short s16x4 __attribute__((ext_vector_type(4)));
#define MFMA16(a, b, c) __builtin_amdgcn_mfma_f32_16x16x32_bf16((a), (b), (c), 0, 0, 0)
__device__ __forceinline__ bf16x8 frag_row(const LAS unsigned char* img, int RS, int r0, int k0, int lane) {
    return *(const LAS bf16x8*)(img + (r0 + (lane & 15)) * RS + (k0 + 8 * (lane >> 4)) * 2);
}
__device__ __forceinline__ bf16x8 frag_tr(const LAS unsigned char* img, int RS, int r0, int k0, int lane) {
    const int g = lane >> 4, q = (lane & 15) >> 2, p = lane & 3;
    LAS unsigned char* a = (LAS unsigned char*)img + (k0 + 8 * g + q) * RS + (r0 + 4 * p) * 2;
    const s16x4 lo = __builtin_amdgcn_ds_read_tr16_b64_v4i16((LAS s16x4*)a);
    const s16x4 hi = __builtin_amdgcn_ds_read_tr16_b64_v4i16((LAS s16x4*)(a + 4 * RS));
    bf16x8 r; r[0] = lo[0]; r[1] = lo[1]; r[2] = lo[2]; r[3] = lo[3]; r[4] = hi[0]; r[5] = hi[1]; r[6] = hi[2]; r[7] = hi[3];
    return r;
}
__device__ __forceinline__ void tile_write(LAS unsigned char* img, int RS, int n0, int m0, int lane, const f32x4 v) {
    u32x2 o; o.x = pk2(v[0], v[1]); o.y = pk2(v[2], v[3]);
    *(LAS u32x2*)(img + (n0 + (lane & 15)) * RS + (m0 + 4 * (lane >> 4)) * 2) = o;
}
constexpr int MS = 68;
__device__ __forceinline__ void tri_inverse_64(LAS float* MF, LAS float* TMP, int tid) {
    if (tid < 64) {
        const int blk = tid >> 4, cc = tid & 15; LAS float* base = MF + (blk * 16) * MS + blk * 16; float x[16];
#pragma unroll
        for (int i = 0; i < 16; ++i) { float s = (i == cc) ? 1.f : 0.f;
#pragma unroll
            for (int j = 0; j < i; ++j) s -= base[i * MS + j] * x[j];
            x[i] = s; }
#pragma unroll
        for (int i = 0; i < 16; ++i) base[i * MS + cc] = x[i];
    }
    __syncthreads();
    {   const int h = tid >> 8, t = tid & 255, r = t >> 4, cc = t & 15, R0 = h ? 48 : 16, C0 = h ? 32 : 0;
        float s = 0.f;
#pragma unroll
        for (int k = 0; k < 16; ++k) s += MF[(R0 + r) * MS + C0 + k] * MF[(C0 + k) * MS + C0 + cc];
        TMP[tid] = s;
        __syncthreads();
        float s2 = 0.f;
#pragma unroll
        for (int k = 0; k < 16; ++k) s2 += MF[(R0 + r) * MS + R0 + k] * TMP[h * 256 + k * 16 + cc];
        MF[(R0 + r) * MS + C0 + cc] = -s2;
    }
    __syncthreads();
    {   float s[2];
#pragma unroll
        for (int q = 0; q < 2; ++q) { const int idx = tid * 2 + q, r = idx >> 5, cc = idx & 31; float a = 0.f;
#pragma unroll 8
            for (int k = 0; k < 32; ++k) a += MF[(32 + r) * MS + k] * MF[k * MS + cc];
            s[q] = a; }
        TMP[tid * 2] = s[0]; TMP[tid * 2 + 1] = s[1];
        __syncthreads();
#pragma unroll
        for (int q = 0; q < 2; ++q) { const int idx = tid * 2 + q, r = idx >> 5, cc = idx & 31; float a = 0.f;
#pragma unroll 8
            for (int k = 0; k < 32; ++k) a += MF[(32 + r) * MS + 32 + k] * TMP[k * 32 + cc];
            s[q] = a; }
#pragma unroll
        for (int q = 0; q < 2; ++q) { const int idx = tid * 2 + q, r = idx >> 5, cc = idx & 31; MF[(32 + r) * MS + cc] = -s[q]; }
    }
    __syncthreads();
}
__device__ __forceinline__ float wave_incl_scan_add(float x, int lane) {
#pragma unroll
    for (int o = 1; o < 64; o <<= 1) { const float t = __shfl_up(x, o); if (lane >= o) x += t; }
    return x;
}
__device__ __forceinline__ float wave_incl_scan_max(float x, int lane) {
#pragma unroll
    for (int o = 1; o < 64; o <<= 1) { const float t = __shfl_up(x, o); if (lane >= o) x = fmaxf(x, t); }
    return x;
}
constexpr int RS128 = 272, RS64 = 144, RS80 = 176;

__device__ __forceinline__ void mlstm_chunk_phase(const Ctx& c) {
    const bf16_t* P = (const bf16_t*)(c.ws + WS_P); bf16_t* Hs = (bf16_t*)(c.ws + WS_F);
    const float* GA = (const float*)(c.ws + WS_GA); const float* GB = (const float*)(c.ws + WS_GB);
    const int lane = c.lane, tid = c.tid, w = c.wave, g4 = lane >> 4, l15 = lane & 15;
    LAS unsigned char* KIMG = c.lds; LAS unsigned char* QIMG = c.lds + 17408; LAS unsigned char* VIMG = c.lds + 34816; LAS unsigned char* VS = c.lds + 46080;
    LAS unsigned char* SM = c.lds + 57344; LAS unsigned char* CT = c.lds + 66560;
    LAS float* sB = (LAS float*)(c.lds + 88320); LAS float* sCM = sB + 64; LAS float* sIGB = sB + 128;
    for (int item = c.wg; item < 256; item += c.G) {
        const int chain = item >> 2, cq = item & 3, b = chain >> 4, h = (chain >> 1) & 7, dir = chain & 1;
        f32x4 st[5];
#pragma unroll
        for (int e = 0; e < 5; ++e) st[e] = (f32x4){0.f, 0.f, 0.f, 0.f};
        float m = 0.f;
        u32x4 rk[2], rq[2], rv; float rg = 0.f, rb = 0.f;
        auto gload = [&](int s) {
            const int row0 = chunk_row(b, dir, s);
#pragma unroll
            for (int i = 0; i < 2; ++i) { const int pc = tid + i * 512, tk = pc >> 4, o = (pc & 15) * 8;
                rk[i] = *(const u32x4*)(P + (size_t)(row0 + tk) * PW1 + 1024 + h * 128 + o);
                rq[i] = *(const u32x4*)(P + (size_t)(row0 + tk) * PW1 + h * 128 + o); }
            { const int tk = tid >> 3, o = (tid & 7) * 8; rv = *(const u32x4*)(P + (size_t)(row0 + tk) * PW1 + 2048 + h * 256 + cq * 64 + o); }
            if (tid < 64) { rg = GA[(size_t)(row0 + tid) * 16 + dir * 8 + h]; rb = GB[(size_t)(row0 + tid) * 16 + dir * 8 + h]; }
        };
        __syncthreads();
        for (int i = tid; i < 80 * 34; i += NTHREADS) ((LAS u32x2*)CT)[i] = (u32x2){0u, 0u};
        gload(0);
#pragma unroll 1
        for (int s = 0; s < 68; ++s) {
#pragma unroll
            for (int i = 0; i < 2; ++i) { const int pc = tid + i * 512, tk = pc >> 4, o = pc & 15, ri = dir ? 63 - tk : tk;
                *(LAS u32x4*)(KIMG + ri * RS128 + o * 16) = rk[i]; *(LAS u32x4*)(QIMG + ri * RS128 + o * 16) = rq[i]; }
            { const int tk = tid >> 3, o = tid & 7, ri = dir ? 63 - tk : tk; *(LAS u32x4*)(VIMG + ri * RS80 + o * 16) = rv;
              if (o == 0) { *(LAS u32x4*)(VIMG + ri * RS80 + 128) = (u32x4){0x3F80u, 0u, 0u, 0u}; *(LAS u32x4*)(VIMG + ri * RS80 + 144) = (u32x4){0u, 0u, 0u, 0u}; } }
            if (w == 0) {
                const int src = dir ? 63 - lane : lane;
                const float ig = __shfl(rg, src), lf = __shfl(rb, src);
                const float bb = wave_incl_scan_add(lf, lane), igb = ig - bb, cm = wave_incl_scan_max(igb, lane);
                sB[lane] = bb; sCM[lane] = cm; sIGB[lane] = igb;
            }
            __syncthreads();
            if (s + 1 < 68) gload(s + 1);
            const float c63 = sCM[63], blast = sB[63], mx63 = fmaxf(m, c63);
            const float cscale = __expf(m - mx63);
            if (s >= 4) {
                const int ib = w >> 1;
                bf16x8 bq[4];
#pragma unroll
                for (int k = 0; k < 4; ++k) bq[k] = frag_row(QIMG, RS128, ib * 16, k * 32, lane);
                const float mxi = fmaxf(m, sCM[ib * 16 + l15]);
#pragma unroll
                for (int t = 0; t < 2; ++t) { const int jb = (w & 1) * 2 + t; f32x4 acc = {0.f, 0.f, 0.f, 0.f};
#pragma unroll
                    for (int k = 0; k < 4; ++k) acc = MFMA16(frag_row(KIMG, RS128, jb * 16, k * 32, lane), bq[k], acc);
                    const int i = ib * 16 + l15;
#pragma unroll
                    for (int r = 0; r < 4; ++r) { const int j = jb * 16 + 4 * g4 + r; acc[r] = (j <= i) ? acc[r] * 0.08838834764831845f * __expf(sIGB[j] - mxi) : 0.f; }
                    tile_write(SM, RS64, ib * 16, jb * 16, lane, acc); }
            }
            for (int pc = tid; pc < 640; pc += NTHREADS) { const int j = pc / 10, o = pc % 10; const float f = __expf(sIGB[j] - mx63);
                float v[8]; unpack8(*(const LAS u32x4*)(VIMG + j * RS80 + o * 16), v);
#pragma unroll
                for (int q = 0; q < 8; ++q) v[q] *= f;
                *(LAS u32x4*)(VS + j * RS80 + o * 16) = pack8(v); }
            __syncthreads();
            if (s >= 4) {
                const int ib = w & 3, eh = w >> 2, i = ib * 16 + l15;
                const float mxi = fmaxf(m, sCM[i]), inter = __expf(m - mxi) * 0.08838834764831845f, floorv = __expf(-(sB[i] + mxi));
                bf16x8 bs[2], bq[4];
#pragma unroll
                for (int k = 0; k < 2; ++k) bs[k] = frag_row(SM, RS64, ib * 16, k * 32, lane);
#pragma unroll
                for (int k = 0; k < 4; ++k) bq[k] = frag_row(QIMG, RS128, ib * 16, k * 32, lane);
                f32x4 val[3];
#pragma unroll
                for (int t = 0; t < 3; ++t) { const int eb = t < 2 ? eh * 2 + t : 4; f32x4 a1 = {0.f, 0.f, 0.f, 0.f}, a2 = {0.f, 0.f, 0.f, 0.f};
#pragma unroll
                    for (int k = 0; k < 2; ++k) a1 = MFMA16(frag_tr(VIMG, RS80, eb * 16, k * 32, lane), bs[k], a1);
#pragma unroll
                    for (int k = 0; k < 4; ++k) a2 = MFMA16(frag_row(CT, RS128, eb * 16, k * 32, lane), bq[k], a2);
                    val[t] = a1 + a2 * inter; }
                const float den = __shfl(val[2][0], l15);
                const float dd = 1.f / fmaxf(fabsf(den), floorv);
                const int tl = dir ? 63 - i : i, row0 = chunk_row(b, dir, s);
#pragma unroll
                for (int t = 0; t < 2; ++t) { const int e0 = (eh * 2 + t) * 16 + 4 * g4; u32x2 o; o.x = pk2(val[t][0] * dd, val[t][1] * dd); o.y = pk2(val[t][2] * dd, val[t][3] * dd);
                    *(u32x2*)(Hs + (size_t)dir * ML * D + (size_t)(row0 + tl) * D + h * 256 + cq * 64 + e0) = o; }
            }
            {   bf16x8 ak[2];
#pragma unroll
                for (int k = 0; k < 2; ++k) ak[k] = frag_tr(KIMG, RS128, w * 16, k * 32, lane);
#pragma unroll
                for (int e = 0; e < 5; ++e) { st[e] = st[e] * cscale;
#pragma unroll
                    for (int k = 0; k < 2; ++k) st[e] = MFMA16(ak[k], frag_tr(VS, RS80, e * 16, k * 32, lane), st[e]); }
            }
            m = blast + mx63;
            __syncthreads();
#pragma unroll
            for (int e = 0; e < 5; ++e) tile_write(CT, RS128, e * 16, w * 16, lane, st[e]);
        }
    }
}

__device__ __forceinline__ void gdn_chunk_items(const Ctx& c, int item0, int item_stride, int n_items) {
    const bf16_t* F = (const bf16_t*)(c.ws + WS_F); bf16_t* P = (bf16_t*)(c.ws + WS_P);
    const float* GA = (const float*)(c.ws + WS_GA); const float* GB = (const float*)(c.ws + WS_GB);
    const int lane = c.lane, tid = c.tid, w = c.wave, g4 = lane >> 4, l15 = lane & 15;
    LAS unsigned char* KIMG = c.lds; LAS unsigned char* QIMG = c.lds + 17408; LAS unsigned char* VIMG = c.lds + 34816; LAS unsigned char* ST = c.lds + 44032;
    LAS unsigned char* WIMG = c.lds + 61440; LAS unsigned char* QKM = c.lds + 78848; LAS unsigned char* VNT = c.lds + 88064; LAS unsigned char* VNS = c.lds + 97280;
    LAS unsigned char* TW = c.lds + 106496; LAS unsigned char* TU = c.lds + 115712; LAS float* MF = (LAS float*)(c.lds + 124928); LAS float* TMP = (LAS float*)VNT;
    LAS float* sGC = (LAS float*)(c.lds + 142336); LAS float* sEG = sGC + 64; LAS float* sEL = sGC + 128; LAS float* sBT = sGC + 192; LAS float* sBG = sGC + 256;
    for (int item = item0; item < n_items; item += item_stride) {
        const int chain = item >> 1, eh = item & 1, b = chain >> 4, h = (chain >> 1) & 7, dir = chain & 1;
        f32x4 st[4];
#pragma unroll
        for (int e = 0; e < 4; ++e) st[e] = (f32x4){0.f, 0.f, 0.f, 0.f};
        u32x4 rk[2], rq[2], rv; float rg = 0.f, rb = 0.f;
        auto gload = [&](int s) {
            const int row0 = chunk_row(b, dir, s);
#pragma unroll
            for (int i = 0; i < 2; ++i) { const int pc = tid + i * 512, tk = pc >> 4, o = (pc & 15) * 8;
                rk[i] = *(const u32x4*)(F + (size_t)1 * MT * 1024 + (size_t)(row0 + tk) * 1024 + h * 128 + o);
                rq[i] = *(const u32x4*)(F + (size_t)0 * MT * 1024 + (size_t)(row0 + tk) * 1024 + h * 128 + o); }
            { const int tk = tid >> 3, o = (tid & 7) * 8; rv = *(const u32x4*)(F + (size_t)2 * MT * 1024 + (size_t)(row0 + tk) * 1024 + h * 128 + eh * 64 + o); }
            if (tid < 64) { rg = GA[(size_t)(row0 + tid) * 16 + dir * 8 + h]; rb = GB[(size_t)(row0 + tid) * 16 + dir * 8 + h]; }
        };
        __syncthreads();
        for (int i = tid; i < 64 * 34; i += NTHREADS) ((LAS u32x2*)ST)[i] = (u32x2){0u, 0u};
        gload(0);
#pragma unroll 1
        for (int s = 0; s < 68; ++s) {
#pragma unroll
            for (int i = 0; i < 2; ++i) { const int pc = tid + i * 512, tk = pc >> 4, o = pc & 15, ri = dir ? 63 - tk : tk;
                *(LAS u32x4*)(KIMG + ri * RS128 + o * 16) = rk[i]; *(LAS u32x4*)(QIMG + ri * RS128 + o * 16) = rq[i]; }
            { const int tk = tid >> 3, o = tid & 7, ri = dir ? 63 - tk : tk; *(LAS u32x4*)(VIMG + ri * RS64 + o * 16) = rv; }
            if (w == 0) {
                const int src = dir ? 63 - lane : lane;
                const float gg = __shfl(rg, src), bt = __shfl(rb, src);
                const float gc = wave_incl_scan_add(gg, lane), gl = __shfl(gc, 63), eg = __expf(gc);
                sGC[lane] = gc; sEG[lane] = eg; sEL[lane] = __expf(gl - gc); sBT[lane] = bt; sBG[lane] = bt * eg;
            }
            __syncthreads();
            if (s + 1 < 68) gload(s + 1);
            {   const int ib = w >> 1, i = ib * 16 + l15; const float gci = sGC[i], bti = sBT[i];
                bf16x8 bk[4], bq[4];
#pragma unroll
                for (int k = 0; k < 4; ++k) { bk[k] = frag_row(KIMG, RS128, ib * 16, k * 32, lane); bq[k] = frag_row(QIMG, RS128, ib * 16, k * 32, lane); }
#pragma unroll
                for (int t = 0; t < 2; ++t) { const int jb = (w & 1) * 2 + t; f32x4 a1 = {0.f, 0.f, 0.f, 0.f}, a2 = {0.f, 0.f, 0.f, 0.f};
#pragma unroll
                    for (int k = 0; k < 4; ++k) { const bf16x8 aj = frag_row(KIMG, RS128, jb * 16, k * 32, lane); a1 = MFMA16(aj, bk[k], a1); a2 = MFMA16(aj, bq[k], a2); }
                    f32x4 mv;
#pragma unroll
                    for (int r = 0; r < 4; ++r) { const int j = jb * 16 + 4 * g4 + r; const float dec = __expf(gci - sGC[j]);
                        mv[r] = (j < i) ? bti * a1[r] * dec : 0.f; a2[r] = (j <= i) ? a2[r] * dec : 0.f; }
                    *(LAS f32x4*)(MF + i * MS + jb * 16 + 4 * g4) = mv;
                    tile_write(QKM, RS64, ib * 16, jb * 16, lane, a2); }
            }
            __syncthreads();
            tri_inverse_64(MF, TMP, tid);
            {   const int i = tid >> 3, j8 = (tid & 7) * 8; float tw[8], tu[8];
#pragma unroll
                for (int q = 0; q < 8; ++q) { const float x = MF[i * MS + j8 + q]; tw[q] = x * sBG[j8 + q]; tu[q] = x * sBT[j8 + q]; }
                *(LAS u32x4*)(TW + i * RS64 + j8 * 2) = pack8(tw); *(LAS u32x4*)(TU + i * RS64 + j8 * 2) = pack8(tu); }
            __syncthreads();
            f32x4 ut[2];
            {   const int ib = w >> 1;
                bf16x8 au[2];
#pragma unroll
                for (int k = 0; k < 2; ++k) au[k] = frag_row(TU, RS64, ib * 16, k * 32, lane);
#pragma unroll
                for (int t = 0; t < 2; ++t) { const int eb = (w & 1) * 2 + t; ut[t] = (f32x4){0.f, 0.f, 0.f, 0.f};
#pragma unroll
                    for (int k = 0; k < 2; ++k) ut[t] = MFMA16(au[k], frag_tr(VIMG, RS64, eb * 16, k * 32, lane), ut[t]); }
                bf16x8 akt[2];
#pragma unroll
                for (int k = 0; k < 2; ++k) akt[k] = frag_tr(KIMG, RS128, w * 16, k * 32, lane);
#pragma unroll
                for (int i2 = 0; i2 < 4; ++i2) { f32x4 a = {0.f, 0.f, 0.f, 0.f};
#pragma unroll
                    for (int k = 0; k < 2; ++k) a = MFMA16(akt[k], frag_row(TW, RS64, i2 * 16, k * 32, lane), a);
                    tile_write(WIMG, RS128, i2 * 16, w * 16, lane, a); }
            }
            __syncthreads();
            {   const int ib = w >> 1;
                bf16x8 aw[4];
#pragma unroll
                for (int k = 0; k < 4; ++k) aw[k] = frag_row(WIMG, RS128, ib * 16, k * 32, lane);
#pragma unroll
                for (int t = 0; t < 2; ++t) { const int eb = (w & 1) * 2 + t; f32x4 a = {0.f, 0.f, 0.f, 0.f};
#pragma unroll
                    for (int k = 0; k < 4; ++k) a = MFMA16(aw[k], frag_row(ST, RS128, eb * 16, k * 32, lane), a);
                    f32x4 vn = ut[t] - a, vs;
#pragma unroll
                    for (int r = 0; r < 4; ++r) vs[r] = vn[r] * sEL[ib * 16 + 4 * g4 + r];
                    tile_write(VNT, RS64, eb * 16, ib * 16, lane, vn); tile_write(VNS, RS64, eb * 16, ib * 16, lane, vs); }
            }
            __syncthreads();
            {   const int eb = w >> 1, row0 = chunk_row(b, dir, s);
                bf16x8 as[4], av[2];
#pragma unroll
                for (int k = 0; k < 4; ++k) as[k] = frag_row(ST, RS128, eb * 16, k * 32, lane);
#pragma unroll
                for (int k = 0; k < 2; ++k) av[k] = frag_row(VNT, RS64, eb * 16, k * 32, lane);
#pragma unroll
                for (int t = 0; t < 2; ++t) { const int ib = (w & 1) * 2 + t, i = ib * 16 + l15; f32x4 a = {0.f, 0.f, 0.f, 0.f};
#pragma unroll
                    for (int k = 0; k < 4; ++k) a = MFMA16(as[k], frag_row(QIMG, RS128, ib * 16, k * 32, lane), a);
                    a = a * sEG[i];
#pragma unroll
                    for (int k = 0; k < 2; ++k) a = MFMA16(av[k], frag_row(QKM, RS64, ib * 16, k * 32, lane), a);
                    const int tl = dir ? 63 - i : i; u32x2 o; o.x = pk2(a[0], a[1]); o.y = pk2(a[2], a[3]);
                    *(u32x2*)(P + (size_t)(row0 + tl) * PW0 + (4 + dir) * 1024 + h * 128 + eh * 64 + eb * 16 + 4 * g4) = o; }
                const float al = __expf(sGC[63]);
                bf16x8 akt[2];
#pragma unroll
                for (int k = 0; k < 2; ++k) akt[k] = frag_tr(KIMG, RS128, w * 16, k * 32, lane);
#pragma unroll
                for (int e = 0; e < 4; ++e) { st[e] = st[e] * al;
#pragma unroll
                    for (int k = 0; k < 2; ++k) st[e] = MFMA16(akt[k], frag_row(VNS, RS64, e * 16, k * 32, lane), st[e]); }
            }
            __syncthreads();
#pragma unroll
            for (int e = 0; e < 4; ++e) tile_write(ST, RS128, e * 16, w * 16, lane, st[e]);
        }
    }
}

__device__ __forceinline__ void rwkv_chunk_items(const Ctx& c, int item0, int item_stride, int n_items, bf16_t* Ybase, size_t ydir_stride, int ystride) {
    const bf16_t* F = (const bf16_t*)(c.ws + WS_F); const bf16_t* P = (const bf16_t*)(c.ws + WS_P);
    const int lane = c.lane, tid = c.tid, w = c.wave, g4 = lane >> 4, l15 = lane & 15;
    LAS unsigned char* KKP = c.lds; LAS unsigned char* RP = c.lds + 9216; LAS unsigned char* KTD = c.lds + 18432; LAS unsigned char* KADN = c.lds + 27648;
    LAS unsigned char* VIMG = c.lds + 36864; LAS unsigned char* ST = c.lds + 46080; LAS unsigned char* ART = c.lds + 55296; LAS unsigned char* ARAN = c.lds + 64512;
    LAS unsigned char* TI = c.lds + 73728; LAS unsigned char* KTI = c.lds + 82944; LAS unsigned char* KAI = c.lds + 92160; LAS unsigned char* AKT = c.lds + 101376;
    LAS unsigned char* TMPVT = KTI; LAS unsigned char* WK = KAI; LAS unsigned char* UT = AKT;
    LAS float* MF = (LAS float*)(c.lds + 110592); LAS float* LP = MF; LAS float* TMP = (LAS float*)(c.lds + 128000); LAS float* sPC = (LAS float*)(c.lds + 132096);
    for (int item = item0; item < n_items; item += item_stride) {
        const int chain = item, b = chain >> 5, h = (chain >> 1) & 15, dir = chain & 1;
        f32x4 st[2] = {{0.f, 0.f, 0.f, 0.f}, {0.f, 0.f, 0.f, 0.f}};
        const int tk = tid >> 3, o8 = tid & 7, ri = dir ? 63 - tk : tk;
        float kav[8];
        { const f32x4 k0 = *(const f32x4*)(c.in[IN_KA] + h * 64 + o8 * 8), k1 = *(const f32x4*)(c.in[IN_KA] + h * 64 + o8 * 8 + 4);
          kav[0] = k0.x; kav[1] = k0.y; kav[2] = k0.z; kav[3] = k0.w; kav[4] = k1.x; kav[5] = k1.y; kav[6] = k1.z; kav[7] = k1.w; }
        u32x4 rr[5], rv;
        auto gload = [&](int s) {
            const int row0 = chunk_row(b, dir, s); const int o = o8 * 8;
            rr[0] = *(const u32x4*)(F + (size_t)3 * MT * 1024 + (size_t)(row0 + tk) * 1024 + h * 64 + o);
            rr[1] = *(const u32x4*)(F + (size_t)4 * MT * 1024 + (size_t)(row0 + tk) * 1024 + h * 64 + o);
            rr[2] = *(const u32x4*)(F + (size_t)5 * MT * 1024 + (size_t)(row0 + tk) * 1024 + h * 64 + o);
            rr[3] = *(const u32x4*)(P + (size_t)(row0 + tk) * PW0 + (0 + dir) * 1024 + h * 64 + o);
            rr[4] = *(const u32x4*)(P + (size_t)(row0 + tk) * PW0 + (2 + dir) * 1024 + h * 64 + o);
            rv = *(const u32x4*)(F + (size_t)6 * MT * 1024 + (size_t)(row0 + tk) * 1024 + h * 64 + o);
        };
        __syncthreads();
        for (int i = tid; i < 64 * 18; i += NTHREADS) ((LAS u32x2*)ST)[i] = (u32x2){0u, 0u};
        gload(0);
#pragma unroll 1
        for (int s = 0; s < 68; ++s) {
            float lwf[8]; unpack8(rr[3], lwf);
            *(LAS f32x4*)(LP + ri * 64 + o8 * 8) = (f32x4){lwf[0], lwf[1], lwf[2], lwf[3]}; *(LAS f32x4*)(LP + ri * 64 + o8 * 8 + 4) = (f32x4){lwf[4], lwf[5], lwf[6], lwf[7]};
            __syncthreads();
            {   const int k = tid & 63, seg = tid >> 6; float x[8]; float run = 0.f;
#pragma unroll
                for (int i = 0; i < 8; ++i) { run += LP[(seg * 8 + i) * 64 + k]; x[i] = run; }
                TMP[seg * 64 + k] = run;
                __syncthreads();
                float off = 0.f;
#pragma unroll
                for (int q = 0; q < 8; ++q) off += (q < seg) ? TMP[q * 64 + k] : 0.f;
#pragma unroll
                for (int i = 0; i < 8; ++i) LP[(seg * 8 + i) * 64 + k] = x[i] + off;
            }
            __syncthreads();
            {
                float rf[8], kkf[8], kbf[8], af[8], lp[8], lpm[8], lpc[8];
                unpack8(rr[0], rf); unpack8(rr[1], kkf); unpack8(rr[2], kbf); unpack8(rr[4], af);
#pragma unroll
                for (int q = 0; q < 8; ++q) { lp[q] = LP[ri * 64 + o8 * 8 + q]; lpm[q] = ri > 0 ? LP[(ri - 1) * 64 + o8 * 8 + q] : 0.f; lpc[q] = LP[63 * 64 + o8 * 8 + q]; }
                float i0[8], i1[8], i2[8], i3[8], i4[8], i5[8];
#pragma unroll
                for (int q = 0; q < 8; ++q) { const float kt = kbf[q] * (1.f + (af[q] - 1.f) * kav[q]), kka = kkf[q] * af[q];
                    const float ei = __expf(-lp[q]), ed = __expf(lpc[q] - lp[q]);
                    i0[q] = kkf[q] * __expf(lpm[q]); i1[q] = rf[q] * __expf(lp[q]); i2[q] = kt * ei; i3[q] = kka * ei; i4[q] = kt * ed; i5[q] = -kka * ed; }
                const int off = ri * RS64 + o8 * 16;
                *(LAS u32x4*)(KKP + off) = pack8(i0); *(LAS u32x4*)(RP + off) = pack8(i1); *(LAS u32x4*)(KTI + off) = pack8(i2); *(LAS u32x4*)(KAI + off) = pack8(i3);
                *(LAS u32x4*)(KTD + off) = pack8(i4); *(LAS u32x4*)(KADN + off) = pack8(i5); *(LAS u32x4*)(VIMG + off) = rv;
                if (ri == 63) {
#pragma unroll
                    for (int q = 0; q < 8; ++q) sPC[o8 * 8 + q] = __expf(lpc[q]); }
            }
            __syncthreads();
            if (s + 1 < 68) gload(s + 1);
            {   const int tb = w >> 1, t = tb * 16 + l15;
                bf16x8 bkk[2], brp[2];
#pragma unroll
                for (int k = 0; k < 2; ++k) { bkk[k] = frag_row(KKP, RS64, tb * 16, k * 32, lane); brp[k] = frag_row(RP, RS64, tb * 16, k * 32, lane); }
#pragma unroll
                for (int q = 0; q < 2; ++q) { const int sb = (w & 1) * 2 + q; f32x4 aka = {0.f, 0.f, 0.f, 0.f}, akt = aka, ara = aka, art = aka;
#pragma unroll
                    for (int k = 0; k < 2; ++k) { const bf16x8 fa = frag_row(KAI, RS64, sb * 16, k * 32, lane), ft = frag_row(KTI, RS64, sb * 16, k * 32, lane);
                        aka = MFMA16(fa, bkk[k], aka); akt = MFMA16(ft, bkk[k], akt); ara = MFMA16(fa, brp[k], ara); art = MFMA16(ft, brp[k], art); }
#pragma unroll
                    for (int r = 0; r < 4; ++r) { const int ss = sb * 16 + 4 * g4 + r;
                        aka[r] = ss < t ? aka[r] : 0.f; akt[r] = ss < t ? akt[r] : 0.f; ara[r] = ss <= t ? -ara[r] : 0.f; art[r] = ss <= t ? art[r] : 0.f; }
                    tile_write(AKT, RS64, tb * 16, sb * 16, lane, akt); tile_write(ARAN, RS64, tb * 16, sb * 16, lane, ara); tile_write(ART, RS64, tb * 16, sb * 16, lane, art);
                    *(LAS f32x4*)(MF + t * MS + sb * 16 + 4 * g4) = aka; }
            }
            __syncthreads();
            tri_inverse_64(MF, TMP, tid);
            {   const int i = tid >> 3, j8 = (tid & 7) * 8; float x[8];
#pragma unroll
                for (int q = 0; q < 8; ++q) x[q] = MF[i * MS + j8 + q];
                *(LAS u32x4*)(TI + i * RS64 + j8 * 2) = pack8(x); }
            __syncthreads();
            f32x4 y0[2], u0[2];
            {   const int hb = w >> 1;
                bf16x8 aa[2], akk[2], av[2];
#pragma unroll
                for (int k = 0; k < 2; ++k) { aa[k] = frag_row(AKT, RS64, hb * 16, k * 32, lane); akk[k] = frag_tr(KKP, RS64, hb * 16, k * 32, lane); av[k] = frag_tr(VIMG, RS64, hb * 16, k * 32, lane); }
#pragma unroll
                for (int q = 0; q < 2; ++q) { const int ob = (w & 1) * 2 + q; f32x4 a = {0.f, 0.f, 0.f, 0.f}, bq = a; y0[q] = a;
#pragma unroll
                    for (int k = 0; k < 2; ++k) { a = MFMA16(aa[k], frag_tr(VIMG, RS64, ob * 16, k * 32, lane), a);
                        const bf16x8 fti = frag_row(TI, RS64, ob * 16, k * 32, lane);
                        bq = MFMA16(akk[k], fti, bq);
                        y0[q] = MFMA16(av[k], frag_row(ART, RS64, ob * 16, k * 32, lane), y0[q]); }
                    tile_write(TMPVT, RS64, ob * 16, hb * 16, lane, a); tile_write(WK, RS64, ob * 16, hb * 16, lane, bq); }
            }
            __syncthreads();
            {   const int tb = w >> 1;
                bf16x8 at[2], awk[2];
#pragma unroll
                for (int k = 0; k < 2; ++k) { at[k] = frag_row(TI, RS64, tb * 16, k * 32, lane); awk[k] = frag_row(WK, RS64, tb * 16, k * 32, lane); }
#pragma unroll
                for (int q = 0; q < 2; ++q) { const int vb = (w & 1) * 2 + q; u0[q] = (f32x4){0.f, 0.f, 0.f, 0.f};
#pragma unroll
                    for (int k = 0; k < 2; ++k) { u0[q] = MFMA16(at[k], frag_row(TMPVT, RS64, vb * 16, k * 32, lane), u0[q]); u0[q] = MFMA16(awk[k], frag_row(ST, RS64, vb * 16, k * 32, lane), u0[q]); }
                }
            }
            {   const int tb = w >> 1;
#pragma unroll
                for (int q = 0; q < 2; ++q) tile_write(UT, RS64, ((w & 1) * 2 + q) * 16, tb * 16, lane, u0[q]); }
            __syncthreads();
            {   const int hb = w >> 1, row0 = chunk_row(b, dir, s);
                bf16x8 as[2], au[2], aktd[2], akad[2];
#pragma unroll
                for (int k = 0; k < 2; ++k) { as[k] = frag_row(ST, RS64, hb * 16, k * 32, lane); au[k] = frag_row(UT, RS64, hb * 16, k * 32, lane);
                    aktd[k] = frag_tr(KTD, RS64, hb * 16, k * 32, lane); akad[k] = frag_tr(KADN, RS64, hb * 16, k * 32, lane); }
#pragma unroll
                for (int q = 0; q < 2; ++q) { const int ob = (w & 1) * 2 + q; f32x4 a = y0[q];
#pragma unroll
                    for (int k = 0; k < 2; ++k) { a = MFMA16(as[k], frag_row(RP, RS64, ob * 16, k * 32, lane), a); a = MFMA16(au[k], frag_row(ARAN, RS64, ob * 16, k * 32, lane), a); }
                    const int t = ob * 16 + l15, tl = dir ? 63 - t : t; u32x2 o; o.x = pk2(a[0], a[1]); o.y = pk2(a[2], a[3]);
                    *(u32x2*)(Ybase + (size_t)dir * ydir_stride + (size_t)(row0 + tl) * ystride + h * 64 + hb * 16 + 4 * g4) = o;
#pragma unroll
                    for (int r = 0; r < 4; ++r) st[q][r] *= sPC[hb * 16 + 4 * g4 + r];
#pragma unroll
                    for (int k = 0; k < 2; ++k) { st[q] = MFMA16(aktd[k], frag_tr(VIMG, RS64, ob * 16, k * 32, lane), st[q]); st[q] = MFMA16(akad[k], frag_row(UT, RS64, ob * 16, k * 32, lane), st[q]); } }
            }
            __syncthreads();
            {   const int hb = w >> 1;
#pragma unroll
                for (int q = 0; q < 2; ++q) tile_write(ST, RS64, ((w & 1) * 2 + q) * 16, hb * 16, lane, st[q]); }
        }
    }
}

#ifndef USE_CHUNK_ML
#define USE_CHUNK_ML 1
#endif
#ifndef USE_CHUNK_GDN
#define USE_CHUNK_GDN 1
#endif
#ifndef USE_CHUNK_RWKV
#define USE_CHUNK_RWKV 1
#endif
struct Args { const float* in[32]; float* out; unsigned char* ws; int ph_lo, ph_hi; };
constexpr int NPHASE = 24;
__global__ void __launch_bounds__(NTHREADS, 2) fwd_kernel(Args args) {
    extern __shared__ __attribute__((aligned(16))) unsigned char lds_raw[];
    Ctx c;
    c.lds = (LAS unsigned char*)lds_raw;
    c.tid = threadIdx.x; c.lane = c.tid & 63; c.wave = __builtin_amdgcn_readfirstlane(c.tid >> 6);
    c.G = gridDim.x; c.wg = blockIdx.x; c.gw = c.wg * NWAVES + c.wave; c.NGW = c.G * NWAVES;
#pragma unroll
    for (int i = 0; i < 32; ++i) c.in[i] = args.in[i];
    c.out = args.out; c.ws = args.ws;
    const int lo = args.ph_lo, hi = args.ph_hi;
    volatile LAS unsigned* bst = (volatile LAS unsigned*)(c.lds + LDS_BAR_OFF);
    if (c.tid < 4) bst[c.tid] = 0u;
    __syncthreads();
    XcdBarrier bar; bar.bar = (unsigned*)(c.ws + WS_CTL); bar.x = 0; bar.st = bst;
    if (hi - lo > 1) bar = xcd_barrier_post((unsigned*)(c.ws + WS_CTL), bst);
#define IN(k) (lo <= (k) && (k) < hi)
#ifndef REPEAT_MASK
#define REPEAT_MASK 0u
#endif
#define REP(k) for (int _rep = 0; _rep < (((REPEAT_MASK >> (k)) & 1u) ? 2 : 1); ++_rep)
#define SEAM(k) do { if (IN(k) && IN((k) + 1)) xcd_barrier(bar); } while (0)
    float* MOD = (float*)(c.ws + WS_MOD);
    float* XC = (float*)(c.ws + WS_XC);
    bf16_t* HY = (bf16_t*)(c.ws + WS_HY); bf16_t* Pb = (bf16_t*)(c.ws + WS_P); float* TL = (float*)(c.ws + WS_TAIL);
    bf16_t* Win = (bf16_t*)(c.ws + WS_WIN); bf16_t* Wout = (bf16_t*)(c.ws + WS_WOUT); bf16_t* W13 = (bf16_t*)(c.ws + WS_W13); bf16_t* W2 = (bf16_t*)(c.ws + WS_W2);
    const float* X = c.in[IN_X]; const float* CX = c.in[IN_CTX];

    if (IN(0)) REP(0) { ada_phase(c); __syncthreads(); convert_weights(c, 0); __syncthreads(); }
    SEAM(0);
    if (IN(1)) REP(1) norm_mod_phase(c, X, CX, c.in[IN_NORMW], MOD, 0, D, MT);
    SEAM(1);
    if (IN(2)) { pg8::Gemm g{HY, Win, MT, NIN0, D}; pg8::StaticOrder S; S.init(MT, NIN0, c.G, c.wg); EpiInProj E{Pb, PW0, PW0 / 256, TL, TW0};
        pg8::gemm_phase<EpiInProj, pg8::StaticOrder>(c.lds, g, S, E); }
    SEAM(2);
    if (IN(3)) REP(3) ab_feature_phase(c);
    SEAM(3);
    if (IN(4)) REP(4) rw_lora_phase(c);
    SEAM(4);
    if (IN(5)) REP(5) { if (USE_CHUNK_GDN) gdn_chunk_items(c, c.wg, c.G, 128); else gdn_scan_phase(c); }
    SEAM(5);
    if (IN(6)) REP(6) { if (USE_CHUNK_RWKV) rwkv_chunk_items(c, c.wg, c.G, 128, (bf16_t*)(c.ws + WS_F), (size_t)MT * 1024, 1024); else rwkv_scan_phase(c); }
    SEAM(6);
    if (IN(7)) REP(7) ab_output_phase(c);
    SEAM(7);
    if (IN(8)) { pg8::Gemm g{HY, Wout, MT, D, D}; pg8::StaticOrder S; S.init(MT, D, c.G, c.wg); EpiResid E{X, CX, c.out, XC, MOD + 2 * D};
        pg8::gemm_phase<EpiResid, pg8::StaticOrder>(c.lds, g, S, E); }
    SEAM(8);
    if (IN(9)) REP(9) norm_mod_phase(c, c.out, XC, c.in[IN_NORMW] + D, MOD, 3 * D, 4 * D, MT);
    SEAM(9);
    if (IN(10)) { pg8::Gemm g{HY, W13, MT, 2 * FF, D}; pg8::StaticOrder S; S.init(MT, 2 * FF, c.G, c.wg); EpiSwiGLU E{Pb, FF};
        pg8::gemm_phase<EpiSwiGLU, pg8::StaticOrder>(c.lds, g, S, E); }
    SEAM(10);
    if (IN(11)) { pg8::Gemm g{Pb, W2, MT, D, FF}; pg8::StaticOrder S; S.init(MT, D, c.G, c.wg); EpiResid E{c.out, XC, c.out, XC, MOD + 5 * D};
        pg8::gemm_phase<EpiResid, pg8::StaticOrder>(c.lds, g, S, E); }
    SEAM(11);
    if (IN(12)) REP(12) { convert_weights(c, 1); norm_mod_phase(c, c.out, XC, c.in[IN_NORMW] + 2 * D, MOD + 5 * MODW, 0, D, MT); }
    SEAM(12);
    if (IN(13)) { pg8::Gemm g{HY, Win, MT, NIN1, D}; pg8::StaticOrder S; S.init(MT, NIN1, c.G, c.wg); EpiInProj E{Pb, PW1, PW1 / 256, TL, TW1};
        pg8::gemm_phase<EpiInProj, pg8::StaticOrder>(c.lds, g, S, E); }
    SEAM(13);
    if (IN(14)) REP(14) ml_gate_phase(c);
    SEAM(14);
    if (IN(15)) REP(15) { if (USE_CHUNK_ML) mlstm_chunk_phase(c); else mlstm_scan_phase(c); }
    SEAM(15);
    if (IN(16)) REP(16) ml_output_phase(c);
    SEAM(16);
    if (IN(17)) { pg8::Gemm g{HY, Wout, ML, D, D}; pg8::StaticOrder S; S.init(ML, D, c.G, c.wg); EpiResid E{c.out, XC, c.out, XC, MOD + 5 * MODW + 2 * D};
        pg8::gemm_phase<EpiResid, pg8::StaticOrder>(c.lds, g, S, E); }
    SEAM(17);
    if (IN(18)) REP(18) norm_mod_phase(c, c.out, XC, c.in[IN_NORMW] + 3 * D, MOD + 5 * MODW, 3 * D, 4 * D, ML);
    SEAM(18);
    if (IN(19)) { pg8::Gemm g{HY, W13, ML, 2 * FF, D}; pg8::StaticOrder S; S.init(ML, 2 * FF, c.G, c.wg); EpiSwiGLU E{Pb, FF};
        pg8::gemm_phase<EpiSwiGLU, pg8::StaticOrder>(c.lds, g, S, E); }
    SEAM(19);
    if (IN(20)) { pg8::Gemm g{Pb, W2, ML, D, FF}; pg8::StaticOrder S; S.init(ML, D, c.G, c.wg); EpiResid E{c.out, XC, c.out, XC, MOD + 5 * MODW + 5 * D};
        pg8::gemm_phase<EpiResid, pg8::StaticOrder>(c.lds, g, S, E); }
    SEAM(20);
    if (IN(21)) final_norm_phase(c);
#undef IN
#undef SEAM
}

#ifndef N_LAUNCH_MODE
#define N_LAUNCH_MODE 1
#endif
extern "C" void kernel_launch(void* const* d_in, const int* in_sizes, int n_in, void* d_out, int out_size, void* d_ws, size_t ws_size, hipStream_t stream) {
    static int grid = 0;
    if (grid == 0) {
        if (n_in != 32 || out_size != ML * D || ws_size < WS_END) { fprintf(stderr, "kernel_launch: unexpected problem (n_in %d out %d ws %zu)\n", n_in, out_size, ws_size); grid = -1; return; }
        int dev = 0, cus = 0;
        if (hipGetDevice(&dev) != hipSuccess || hipDeviceGetAttribute(&cus, hipDeviceAttributeMultiprocessorCount, dev) != hipSuccess) { grid = -1; return; }
        if (hipFuncSetAttribute((const void*)fwd_kernel, hipFuncAttributeMaxDynamicSharedMemorySize, LDS_BYTES) != hipSuccess) { grid = -1; return; }
        int per_cu = 0;
        if (hipOccupancyMaxActiveBlocksPerMultiprocessor(&per_cu, (const void*)fwd_kernel, NTHREADS, LDS_BYTES) != hipSuccess || per_cu < 1) { fprintf(stderr, "kernel_launch: occupancy query says %d\n", per_cu); }
        (void)hipGetLastError();
        grid = cus;
    }
    if (grid < 0) return;
    (void)hipMemsetAsync((char*)d_ws + WS_CTL, 0, CTL_BYTES, stream);
    Args a{};
    for (int i = 0; i < 32; ++i) a.in[i] = (const float*)d_in[i];
    a.out = (float*)d_out; a.ws = (unsigned char*)d_ws;
#if N_LAUNCH_MODE == 1
    a.ph_lo = 0; a.ph_hi = NPHASE;
    hipLaunchKernelGGL(fwd_kernel, dim3(grid), dim3(NTHREADS), LDS_BYTES, stream, a);
#else
    for (int p = 0; p < 22; ++p) { a.ph_lo = p; a.ph_hi = p + 1; hipLaunchKernelGGL(fwd_kernel, dim3(grid), dim3(NTHREADS), LDS_BYTES, stream, a); }
#endif
}
```

```cpp
#include <hip/hip_runtime.h>
#include <cstdio>
#include <cstdint>
#define LAS __attribute__((address_space(3)))
#define GAS __attribute__((address_space(1)))
#define XB_TMO      128
#define XB_XCNT(j)  (256  + 64 * (j))
#define XB_XSUB(j)  (1280 + 64 * (j))
#define XB_XGEN(j)  (2304 + 64 * (j))
#define XB_TOP      3328
#define XB_TOPGEN   3392
#define XCD_BAR_WORDS 3456
#define XB_SPIN_CAP (1u << 20)

__device__ __forceinline__ unsigned xb_ld(unsigned* p)              { return __hip_atomic_load(p, __ATOMIC_RELAXED, __HIP_MEMORY_SCOPE_AGENT); }
__device__ __forceinline__ unsigned xb_add(unsigned* p, unsigned v) { return __hip_atomic_fetch_add(p, v, __ATOMIC_RELAXED, __HIP_MEMORY_SCOPE_AGENT); }
__device__ __forceinline__ unsigned xb_xcc_id() { return (unsigned)__builtin_amdgcn_s_getreg((3 << 11) | 20) & 0xFu; }
#define XB_SPIN(cond, bar) do { unsigned _sp = 0; while (cond) { __builtin_amdgcn_s_sleep(1); \
    if ((++_sp & 255u) == 0u) { if (xb_ld(&(bar)[XB_TMO])) break; if (_sp > XB_SPIN_CAP) { atomicAdd(&(bar)[XB_TMO], 1u); break; } } } } while (0)

struct XcdBarrier {
    unsigned* bar; unsigned x;
    volatile LAS unsigned* st;
};

__device__ __forceinline__ XcdBarrier xcd_barrier_post(unsigned* bar, volatile LAS unsigned* st) {
    XcdBarrier b; b.bar = bar; b.x = xb_xcc_id(); b.st = st;
    if (threadIdx.x == 0) (void)xb_add(&bar[XB_XCNT(b.x)], 1u);
    return b;
}
__device__ __forceinline__ void xcd_barrier_complete(unsigned* bar, unsigned x, unsigned& nloc, unsigned& nx) {
    const unsigned G = gridDim.x * gridDim.y * gridDim.z;
    unsigned sum, cnt, mine, sp = 0u;
    for (;;) {
        sum = 0u; cnt = 0u; mine = 0u;
#pragma unroll
        for (unsigned j = 0; j < 16; ++j) { const unsigned c = xb_ld(&bar[XB_XCNT(j)]); sum += c; cnt += (c > 0u) ? 1u : 0u; mine = (j == x) ? c : mine; }
        if (sum == G) break;
        __builtin_amdgcn_s_sleep(1);
        if ((++sp & 255u) == 0u) { if (xb_ld(&bar[XB_TMO])) break; if (sp > XB_SPIN_CAP) { atomicAdd(&bar[XB_TMO], 1u); break; } }
    }
    nloc = mine > 0u ? mine : 1u; nx = cnt > 0u ? cnt : 1u;
}

__device__ __forceinline__ void xcd_barrier(const XcdBarrier& b) {
    asm volatile("s_waitcnt vmcnt(0)" ::: "memory");
    __syncthreads();
    if (threadIdx.x == 0) {
        unsigned* bar = b.bar;
        __builtin_amdgcn_s_waitcnt(0);
        unsigned nloc = b.st[0], nx = b.st[1];
        if (nloc == 0u) { xcd_barrier_complete(bar, b.x, nloc, nx); b.st[0] = nloc; b.st[1] = nx; }
        const unsigned old = xb_add(&bar[XB_XSUB(b.x)], 1u);
        const unsigned gen = old / nloc;
        if (old + 1u == (gen + 1u) * nloc) {
            __builtin_amdgcn_fence(__ATOMIC_RELEASE, "agent");
            asm volatile("s_waitcnt vmcnt(0)" ::: "memory");
            const unsigned og = xb_add(&bar[XB_TOP], 1u);
            const unsigned tg = og / nx;
            if (og + 1u == (tg + 1u) * nx) xb_add(&bar[XB_TOPGEN], 1u);
            else XB_SPIN(xb_ld(&bar[XB_TOPGEN]) == tg, bar);
            __builtin_amdgcn_fence(__ATOMIC_ACQUIRE, "agent");
            xb_add(&bar[XB_XGEN(b.x)], 1u);
            asm volatile("s_waitcnt vmcnt(0)" ::: "memory");
        } else {
            XB_SPIN(xb_ld(&bar[XB_XGEN(b.x)]) == gen, bar);
            __builtin_amdgcn_fence(__ATOMIC_ACQUIRE, "agent");
            asm volatile("s_waitcnt vmcnt(0)" ::: "memory");
        }
    }
    __syncthreads();
}
#include <hip/hip_runtime.h>
namespace pg8 {
#define PG8_LAS __attribute__((address_space(3)))
typedef unsigned short bf16_t;
typedef short bf16x8 __attribute__((ext_vector_type(8)));
typedef float f32x4 __attribute__((ext_vector_type(4)));
typedef unsigned u32x4 __attribute__((ext_vector_type(4)));
constexpr int BM = 256, BK = 64, HALF = 128, HTB = HALF * BK * 2  , STAGE_BYTES = 8 * HTB, NXCD = 8, WGM = 8;

__host__ __device__ __forceinline__ int lds_byte(int r, int c) { const int st = (r >> 4) * 2 + (c >> 5), rr = r & 15, cc = c & 31, ob = rr * 64 + cc * 2; return st * 1024 + (ob ^ (((ob >> 9) & 1) << 5)); }
__host__ __device__ __forceinline__ void stage_rc(int b, int& R, int& C) { const int st = b / 1024, sb = b % 1024, swz = sb ^ (((sb >> 9) & 1) << 5); R = (st >> 1) * 16 + swz / 64; C = (st & 1) * 32 + (swz % 64) / 2; }
__host__ __device__ __forceinline__ int perm32(int rho) { const int n = rho >> 4, i = rho & 15; return 8 * (i >> 2) + 4 * n + (i & 3); }

struct Unit { int pm, pn; };
struct Gemm { const bf16_t* A; const bf16_t* Bt; int M, N, K; };

struct StaticOrder {
    int nM, nN, nwg, G, c;
    __host__ __device__ void init(int M, int N, int G_, int c_) { nM = M / BM; nN = N / BM; nwg = nM * nN; G = G_; c = c_; }
    __host__ __device__ bool next(int i, Unit& u) const {
        const long L = (long)i * G + c; if (L >= nwg) return false;
        int wgid = (int)L; { const int q = nwg / NXCD, r = nwg % NXCD, xcd = wgid % NXCD, off = wgid / NXCD; wgid = (xcd < r ? xcd * (q + 1) : r * (q + 1) + (xcd - r) * q) + off; }
        const int nig = WGM * nN, gid = wgid / nig, fm = gid * WGM, gsz = (nM - fm) < WGM ? (nM - fm) : WGM;
        u.pm = fm + ((wgid % nig) % gsz); u.pn = (wgid % nig) / gsz; return true;
    }
    __device__ __forceinline__ void a_ready(const Unit&) const {}
    __device__ __forceinline__ void done(const Unit&) const {}
};
template <class Epi, class Sched>
__device__ __forceinline__ void gemm_phase(PG8_LAS unsigned char* lds, const Gemm g, const Sched& S, const Epi& E) {
    const int tid = threadIdx.x, wid = __builtin_amdgcn_readfirstlane(tid >> 6), lane = tid & 63, wr = wid >> 2, wc = wid & 3, fr = lane & 15, fq = lane >> 4;
    const int K = g.K, nt = K / BK;
    unsigned voffA[2], voffB[2];
#pragma unroll
    for (int i = 0; i < 2; ++i) { int R, C; stage_rc(tid * 16 + i * 8192, R, C); const int Rb = Epi::PERM ? ((R & ~31) + perm32(R & 31)) : R;
        voffA[i] = (unsigned)(R * K + C) * 2u; voffB[i] = (unsigned)(Rb * K + C) * 2u; }
    const size_t kstep = (size_t)(BK * 2);
    const size_t hstep = (size_t)HALF * K * 2;
    const size_t tstep = 2 * hstep;
    const unsigned ldsw = (unsigned)wid * 1024u;
    const int aoff = lds_byte(wr * 64 + fr, fq * 8), boff = lds_byte(wc * 32 + fr, fq * 8);
#define PG8_SA(b, h) (((b) * 2 + (h)) * HTB)
#define PG8_SB(b, h) ((4 + (b) * 2 + (h)) * HTB)
#define PG8_STAGE(bufoff, gbase, voff) do { _Pragma("unroll") for (int _i = 0; _i < 2; ++_i) \
        __builtin_amdgcn_global_load_lds((const unsigned*)((const char*)(gbase) + (voff)[_i]), (PG8_LAS unsigned*)(lds + (bufoff) + ldsw + _i * 8192), 16, 0, 0); } while (0)
#define PG8_LDA(dst, b, h) do { _Pragma("unroll") for (int m = 0; m < 4; ++m) _Pragma("unroll") for (int k = 0; k < 2; ++k) dst[m][k] = *(const PG8_LAS bf16x8*)(lds + PG8_SA(b, h) + aoff + m * 2048 + k * 1024); } while (0)
#define PG8_LDB(dst, b, h) do { _Pragma("unroll") for (int n = 0; n < 2; ++n) _Pragma("unroll") for (int k = 0; k < 2; ++k) dst[n][k] = *(const PG8_LAS bf16x8*)(lds + PG8_SB(b, h) + boff + n * 2048 + k * 1024); } while (0)
#define PG8_MMA(ai, bj, At, Bt) do { __builtin_amdgcn_s_setprio(1); _Pragma("unroll") for (int m = 0; m < 4; ++m) _Pragma("unroll") for (int n = 0; n < 2; ++n) _Pragma("unroll") for (int k = 0; k < 2; ++k) \
        acc[ai][bj][m][n] = __builtin_amdgcn_mfma_f32_16x16x32_bf16(Bt[n][k], At[m][k], acc[ai][bj][m][n], 0, 0, 0); __builtin_amdgcn_s_setprio(0); } while (0)
#define PG8_WAIT_V(n) asm volatile("s_waitcnt vmcnt(" #n ")" ::: "memory")
#define PG8_WAIT_L(n) asm volatile("s_waitcnt lgkmcnt(" #n ")" ::: "memory")
#define PG8_BAR __builtin_amdgcn_s_barrier()
#define PG8_SCHED __builtin_amdgcn_sched_barrier(0)
    Unit cur, nxt; int ui = 0;
    if (!S.next(0, cur)) return;
    f32x4 acc[2][2][4][2];
#pragma unroll
    for (int a = 0; a < 2; ++a)
#pragma unroll
        for (int b = 0; b < 2; ++b)
#pragma unroll
            for (int m = 0; m < 4; ++m)
#pragma unroll
                for (int n = 0; n < 2; ++n) acc[a][b][m][n] = (f32x4){0.f, 0.f, 0.f, 0.f};
    bf16x8 At[4][2], B0[2][2], B1[2][2];
    const char* cA = (const char*)g.A + (size_t)cur.pm * tstep; const char* cB = (const char*)g.Bt + (size_t)cur.pn * tstep;
    S.a_ready(cur);
    PG8_STAGE(PG8_SB(0, 0), cB, voffB); PG8_STAGE(PG8_SA(0, 0), cA, voffA); PG8_STAGE(PG8_SB(0, 1), cB + hstep, voffB); PG8_STAGE(PG8_SA(0, 1), cA + hstep, voffA);
    if (wr == 1) PG8_BAR;
    PG8_WAIT_V(4); PG8_BAR;
    PG8_STAGE(PG8_SB(1, 0), cB + kstep, voffB); PG8_STAGE(PG8_SA(1, 0), cA + kstep, voffA); PG8_STAGE(PG8_SB(1, 1), cB + hstep + kstep, voffB);
    PG8_WAIT_V(6); PG8_BAR;
    for (;;) {
        const bool has_next = S.next(ui + 1, nxt);
        const char* nA = has_next ? (const char*)g.A + (size_t)nxt.pm * tstep : cA; const char* nB = has_next ? (const char*)g.Bt + (size_t)nxt.pn * tstep : cB;
        for (int t = 0; t < nt; t += 2) {
            const bool last = (t == nt - 2);
            const char* a1 = cA + (size_t)(t + 1) * kstep;
            const char* a2 = last ? nA : cA + (size_t)(t + 2) * kstep; const char* b2 = last ? nB : cB + (size_t)(t + 2) * kstep;
            const char* a3 = a2 + kstep; const char* b3 = b2 + kstep;
            if (last && has_next) S.a_ready(nxt);
            PG8_LDB(B0, 0, 0); PG8_SCHED; PG8_LDA(At, 0, 0); PG8_STAGE(PG8_SA(1, 1), a1 + hstep, voffA);
            PG8_WAIT_L(8); PG8_BAR; PG8_WAIT_L(0); PG8_MMA(0, 0, At, B0); PG8_BAR; PG8_SCHED;
            PG8_LDB(B1, 0, 1); PG8_STAGE(PG8_SB(0, 0), b2, voffB);
            PG8_BAR; PG8_WAIT_L(0); PG8_MMA(0, 1, At, B1); PG8_BAR;
            PG8_LDA(At, 0, 1); PG8_STAGE(PG8_SA(0, 0), a2, voffA);
            PG8_BAR; PG8_WAIT_L(0); PG8_MMA(1, 0, At, B0); PG8_BAR; PG8_SCHED;
            PG8_STAGE(PG8_SB(0, 1), b2 + hstep, voffB);
            PG8_WAIT_V(6); PG8_BAR; PG8_MMA(1, 1, At, B1); PG8_BAR;
            PG8_LDB(B0, 1, 0); PG8_SCHED; PG8_LDA(At, 1, 0); PG8_STAGE(PG8_SA(0, 1), a2 + hstep, voffA);
            PG8_WAIT_L(8); PG8_BAR; PG8_WAIT_L(0); PG8_MMA(0, 0, At, B0); PG8_BAR; PG8_SCHED;
            PG8_LDB(B1, 1, 1); PG8_STAGE(PG8_SB(1, 0), b3, voffB);
            PG8_BAR; PG8_WAIT_L(0); PG8_MMA(0, 1, At, B1); PG8_BAR;
            PG8_LDA(At, 1, 1); PG8_STAGE(PG8_SA(1, 0), a3, voffA);
            PG8_BAR; PG8_WAIT_L(0); PG8_MMA(1, 0, At, B0); PG8_BAR; PG8_SCHED;
            PG8_STAGE(PG8_SB(1, 1), b3 + hstep, voffB);
            PG8_WAIT_V(6); PG8_BAR; PG8_MMA(1, 1, At, B1); PG8_BAR;
        }
        if constexpr (!Epi::AFTER_DRAIN) { E(acc, cur, wr, wc, fr, fq); S.done(cur); }
        if (!has_next) break;
#pragma unroll
        for (int a = 0; a < 2; ++a)
#pragma unroll
            for (int b = 0; b < 2; ++b)
#pragma unroll
                for (int m = 0; m < 4; ++m)
#pragma unroll
                    for (int n = 0; n < 2; ++n) acc[a][b][m][n] = (f32x4){0.f, 0.f, 0.f, 0.f};
        cur = nxt; cA = nA; cB = nB; ++ui;
    }
    PG8_WAIT_V(0);
    if (wr == 0) PG8_BAR;
    PG8_BAR;
    if constexpr (Epi::AFTER_DRAIN) { E.fused(acc, cur, wr, wc, fr, fq, lds, wid, lane); S.done(cur); }
#undef PG8_SA
#undef PG8_SB
#undef PG8_STAGE
#undef PG8_LDA
#undef PG8_LDB
#undef PG8_MMA
#undef PG8_WAIT_V
#undef PG8_WAIT_L
#undef PG8_BAR
#undef PG8_SCHED
}
}

typedef unsigned short bf16_t;
typedef float f32x4 __attribute__((ext_vector_type(4)));
typedef float f32x2 __attribute__((ext_vector_type(2)));
typedef unsigned u32x4 __attribute__((ext_vector_type(4)));
typedef unsigned u32x2 __attribute__((ext_vector_type(2)));

constexpr int D = 2048, NB = 4, SEQ = 4096, CTXL = 256;
constexpr int ML = NB * SEQ;
constexpr int MC = NB * CTXL;
constexpr int MT = ML + MC;
constexpr int AB_IN = 7616, NIN0 = 7680, PW0 = 7168, TW0 = 512;
constexpr int C_INW = 6176, NIN1 = 6400, PW1 = 6144, TW1 = 256;
constexpr int FF = 5632;
constexpr int MODW = 6 * D;
constexpr int NTHREADS = 512, NWAVES = 8;

constexpr size_t MiB = 1u << 20;
constexpr size_t WS_CTL = 0, CTL_BYTES = 16384;
constexpr size_t WS_MOD = 1 * MiB;
constexpr size_t WS_GA = 2 * MiB, WS_GB = 4 * MiB;
constexpr size_t WS_XC = 6 * MiB;
constexpr size_t WS_HY = 14 * MiB;
constexpr size_t WS_TAIL = 82 * MiB;
constexpr size_t WS_WIN = 116 * MiB;
constexpr size_t WS_WOUT = 146 * MiB;
constexpr size_t WS_W13 = 154 * MiB;
constexpr size_t WS_W2 = 198 * MiB;
constexpr size_t WS_P = 220 * MiB;
constexpr size_t WS_F = 458 * MiB;
constexpr size_t FSLOT = (size_t)MT * 1024 * 2;
constexpr size_t WS_END = 696 * MiB;
static_assert(WS_F + 7 * FSLOT <= WS_END, "ws map");
static_assert(WS_HY + (size_t)MT * D * 2 <= WS_TAIL && WS_TAIL + (size_t)MT * TW0 * 4 <= WS_WIN && WS_W2 + (size_t)D * FF * 2 <= WS_P && WS_P + (size_t)MT * PW0 * 2 <= WS_F, "ws map");

constexpr int LDS_BYTES = 147456;
constexpr int LDS_BAR_OFF = LDS_BYTES - 64;

__device__ __forceinline__ float bflo(unsigned u) { return __builtin_bit_cast(float, u << 16); }
__device__ __forceinline__ float bfhi(unsigned u) { return __builtin_bit_cast(float, u & 0xffff0000u); }
__device__ __forceinline__ float bf1(bf16_t h) { return __builtin_bit_cast(float, (unsigned)h << 16); }
__device__ __forceinline__ unsigned f2bf(float f) { unsigned u = __builtin_bit_cast(unsigned, f); return (u + 0x7fffu + ((u >> 16) & 1u)) >> 16; }
__device__ __forceinline__ unsigned pk2(float lo, float hi) { return f2bf(lo) | (f2bf(hi) << 16); }
__device__ __forceinline__ float sigm(float x) { return 1.f / (1.f + expf(-x)); }
__device__ __forceinline__ float sigm_fast(float x) { return 1.f / (1.f + __expf(-x)); }
__device__ __forceinline__ float silu_fast(float x) { return x / (1.f + __expf(-x)); }
__device__ __forceinline__ float softplus_(float x) { return fmaxf(x, 0.f) + log1pf(expf(-fabsf(x))); }
__device__ __forceinline__ float logsigm_(float x) { return fminf(x, 0.f) - log1pf(expf(-fabsf(x))); }
template <int W> __device__ __forceinline__ float grp_sum(float v) {
#pragma unroll
    for (int o = 1; o < W; o <<= 1) v += __shfl_xor(v, o);
    return v;
}
__device__ __forceinline__ void unpack8(const u32x4 u, float (&f)[8]) {
    f[0] = bflo(u.x); f[1] = bfhi(u.x); f[2] = bflo(u.y); f[3] = bfhi(u.y); f[4] = bflo(u.z); f[5] = bfhi(u.z); f[6] = bflo(u.w); f[7] = bfhi(u.w);
}
__device__ __forceinline__ u32x4 pack8(const float (&f)[8]) { u32x4 o; o.x = pk2(f[0], f[1]); o.y = pk2(f[2], f[3]); o.z = pk2(f[4], f[5]); o.w = pk2(f[6], f[7]); return o; }

struct EpiInProj {
    static constexpr bool PERM = true, AFTER_DRAIN = false;
    bf16_t* P; int ldp; int nPt; float* T; int ldt;
    __device__ __forceinline__ void operator()(const pg8::f32x4 (&acc)[2][2][4][2], const pg8::Unit& u, int wr, int wc, int fr, int fq) const {
        const int row0 = u.pm * 256 + wr * 64 + fr;
        if (u.pn < nPt) {
            const int col0 = u.pn * 256 + wc * 32 + 8 * fq;
#pragma unroll
            for (int ai = 0; ai < 2; ++ai)
#pragma unroll
                for (int m = 0; m < 4; ++m) { bf16_t* rowp = P + (size_t)(row0 + ai * 128 + m * 16) * ldp + col0;
#pragma unroll
                    for (int bj = 0; bj < 2; ++bj) { const pg8::f32x4 v0 = acc[ai][bj][m][0], v1 = acc[ai][bj][m][1];
                        u32x4 o; o.x = pk2(v0[0], v0[1]); o.y = pk2(v0[2], v0[3]); o.z = pk2(v1[0], v1[1]); o.w = pk2(v1[2], v1[3]);
                        *(u32x4*)(rowp + bj * 128) = o; } }
        } else {
            const int col0 = (u.pn - nPt) * 256 + wc * 32 + 8 * fq;
#pragma unroll
            for (int ai = 0; ai < 2; ++ai)
#pragma unroll
                for (int m = 0; m < 4; ++m) { float* rowp = T + (size_t)(row0 + ai * 128 + m * 16) * ldt + col0;
#pragma unroll
                    for (int bj = 0; bj < 2; ++bj) { *(pg8::f32x4*)(rowp + bj * 128) = acc[ai][bj][m][0]; *(pg8::f32x4*)(rowp + bj * 128 + 4) = acc[ai][bj][m][1]; } }
        }
    }
};
struct EpiResid {
    static constexpr bool PERM = false, AFTER_DRAIN = false;
    const float* srcL; const float* srcC; float* dstL; float* dstC; const float* gate;
    __device__ __forceinline__ void operator()(const pg8::f32x4 (&acc)[2][2][4][2], const pg8::Unit& u, int wr, int wc, int fr, int fq) const {
        const bool lat = u.pm < 64;
        const int rowl = (lat ? u.pm : u.pm - 64) * 256 + wr * 64 + fr, col0 = u.pn * 256 + wc * 32 + 4 * fq;
        const float* src = lat ? srcL : srcC; float* dst = lat ? dstL : dstC;
        const float* g = gate + (size_t)(lat ? (u.pm >> 4) : 4) * MODW + col0;
        pg8::f32x4 gv[2][2];
#pragma unroll
        for (int bj = 0; bj < 2; ++bj)
#pragma unroll
            for (int n = 0; n < 2; ++n) gv[bj][n] = *(const pg8::f32x4*)(g + bj * 128 + n * 16);
#pragma unroll
        for (int ai = 0; ai < 2; ++ai)
#pragma unroll
            for (int m = 0; m < 4; ++m) { const size_t ro = (size_t)(rowl + ai * 128 + m * 16) * D + col0;
#pragma unroll
                for (int bj = 0; bj < 2; ++bj)
#pragma unroll
                    for (int n = 0; n < 2; ++n) { const pg8::f32x4 s = *(const pg8::f32x4*)(src + ro + bj * 128 + n * 16);
                        *(pg8::f32x4*)(dst + ro + bj * 128 + n * 16) = s + gv[bj][n] * acc[ai][bj][m][n]; } }
    }
};
struct EpiSwiGLU {
    static constexpr bool PERM = true, AFTER_DRAIN = false;
    bf16_t* H; int ldh;
    __device__ __forceinline__ void operator()(const pg8::f32x4 (&acc)[2][2][4][2], const pg8::Unit& u, int wr, int wc, int fr, int fq) const {
        const int row0 = u.pm * 256 + wr * 64 + fr, col0 = u.pn * 128 + wc * 32 + 8 * fq;
#pragma unroll
        for (int ai = 0; ai < 2; ++ai)
#pragma unroll
            for (int m = 0; m < 4; ++m) { float h[8];
#pragma unroll
                for (int n = 0; n < 2; ++n)
#pragma unroll
                    for (int j = 0; j < 4; ++j) h[n * 4 + j] = silu_fast(acc[ai][0][m][n][j]) * acc[ai][1][m][n][j];
                *(u32x4*)(H + (size_t)(row0 + ai * 128 + m * 16) * ldh + col0) = pack8(h); }
    }
};

struct Ctx {
    LAS unsigned char* lds; int tid, lane, wave, G, wg, gw, NGW;
    const float* in[32]; float* out; unsigned char* ws;
};
#define IN_X 0
#define IN_C 1
#define IN_CTX 2
#define IN_CCTX 3
#define IN_ADAW 4
#define IN_ADAB 5
#define IN_NORMW 6
#define IN_ABWIN 7
#define IN_CONVW 8
#define IN_ALOG 9
#define IN_DTB 10
#define IN_GDNNW 11
#define IN_W0 12
#define IN_WUP 13
#define IN_A0 14
#define IN_AUP 15
#define IN_GUP 16
#define IN_KK 17
#define IN_KA 18
#define IN_RK 19
#define IN_LNW 20
#define IN_LNB 21
#define IN_ABWOUT 22
#define IN_MLWIN 23
#define IN_MLIB 24
#define IN_MLFB 25
#define IN_MLNW 26
#define IN_MLWOUT 27
#define IN_W1 28
#define IN_W3 29
#define IN_W2 30
#define IN_FNW 31

__device__ __forceinline__ void transpose_item(const float* W, int K, int N, bf16_t* WT, int out_row0, LAS float* scr, int k0, int n0, int lane) {
#pragma unroll 8
    for (int i = 0; i < 32; ++i) { const int kk = 2 * i + (lane >> 5); scr[kk * 33 + (lane & 31)] = W[(size_t)(k0 + kk) * N + n0 + (lane & 31)]; }
    asm volatile("s_waitcnt lgkmcnt(0)" ::: "memory");
    const int c = lane & 7;
#pragma unroll
    for (int j = 0; j < 4; ++j) { const int n = (lane >> 3) + 8 * j; const LAS float* s = scr + (8 * c) * 33 + n;
        u32x4 o; o.x = pk2(s[0 * 33], s[1 * 33]); o.y = pk2(s[2 * 33], s[3 * 33]); o.z = pk2(s[4 * 33], s[5 * 33]); o.w = pk2(s[6 * 33], s[7 * 33]);
        *(u32x4*)(WT + (size_t)(out_row0 + n) * K + k0 + 8 * c) = o; }
    asm volatile("s_waitcnt lgkmcnt(0)" ::: "memory");
}
__device__ __forceinline__ void transpose_matrix(const Ctx& c, const float* W, int K, int N, bf16_t* WT, int mode, LAS float* scr) {
    const int nblk = N / 32, items = (K / 64) * nblk;
    for (int it = c.gw; it < items; it += c.NGW) {
        const int kb = it / nblk, nb = it % nblk, n0 = nb * 32;
        const int orow = mode == 0 ? n0 : ((n0 >> 7) * 256 + (n0 & 127) + (mode == 2 ? 128 : 0));
        transpose_item(W, K, N, WT, orow, scr, kb * 64, n0, c.lane);
    }
}
__device__ __forceinline__ void zero_rows(const Ctx& c, bf16_t* WT, int K, int r0, int r1) {
    u32x4* p = (u32x4*)(WT + (size_t)r0 * K); const size_t n = (size_t)(r1 - r0) * K / 8;
    for (size_t i = (size_t)c.wg * NTHREADS + c.tid; i < n; i += (size_t)c.G * NTHREADS) p[i] = (u32x4){0u, 0u, 0u, 0u};
}
__device__ __forceinline__ void convert_weights(const Ctx& c, int layer) {
    LAS float* scr = (LAS float*)(c.lds + 65536) + c.wave * (64 * 33);
    bf16_t* Win = (bf16_t*)(c.ws + WS_WIN); bf16_t* Wout = (bf16_t*)(c.ws + WS_WOUT); bf16_t* W13 = (bf16_t*)(c.ws + WS_W13); bf16_t* W2 = (bf16_t*)(c.ws + WS_W2);
    if (layer == 0) { transpose_matrix(c, c.in[IN_ABWIN], D, AB_IN, Win, 0, scr); zero_rows(c, Win, D, AB_IN, NIN0); transpose_matrix(c, c.in[IN_ABWOUT], D, D, Wout, 0, scr); }
    else { transpose_matrix(c, c.in[IN_MLWIN], D, C_INW, Win, 0, scr); zero_rows(c, Win, D, C_INW, NIN1); transpose_matrix(c, c.in[IN_MLWOUT], D, D, Wout, 0, scr); }
    transpose_matrix(c, c.in[IN_W1] + (size_t)layer * D * FF, D, FF, W13, 1, scr);
    transpose_matrix(c, c.in[IN_W3] + (size_t)layer * D * FF, D, FF, W13, 2, scr);
    transpose_matrix(c, c.in[IN_W2] + (size_t)layer * FF * D, FF, D, W2, 0, scr);
}
__device__ __forceinline__ void ada_phase(const Ctx& c) {
    LAS float* sc = (LAS float*)c.lds;
    LAS float* red = sc + 5 * D;
    for (int i = c.tid; i < 5 * D; i += NTHREADS) { const int b = i / D, k = i % D; const float v = b < 4 ? c.in[IN_C][b * D + k] : c.in[IN_CCTX][k]; sc[i] = v / (1.f + expf(-v)); }
    __syncthreads();
    float* MOD = (float*)(c.ws + WS_MOD);
    for (int u = c.wg; u < 2 * (MODW / 64); u += c.G) {
        const int layer = u / (MODW / 64), cb = (u % (MODW / 64)) * 64;
        const float* wp = c.in[IN_ADAW] + (size_t)layer * D * MODW + cb + c.lane;
        float acc[5] = {0.f, 0.f, 0.f, 0.f, 0.f};
        const int k0 = c.wave * 256;
#pragma unroll 16
        for (int k = k0; k < k0 + 256; ++k) { const float w = wp[(size_t)k * MODW];
#pragma unroll
            for (int b = 0; b < 5; ++b) acc[b] += sc[b * D + k] * w; }
#pragma unroll
        for (int b = 0; b < 5; ++b) red[(c.wave * 5 + b) * 64 + c.lane] = acc[b];
        __syncthreads();
        if (c.tid < 320) { const int b = c.tid / 64, l = c.tid % 64; float s = 0.f;
#pragma unroll
            for (int w = 0; w < 8; ++w) s += red[(w * 5 + b) * 64 + l];
            MOD[(size_t)(layer * 5 + b) * MODW + cb + l] = s + c.in[IN_ADAB][layer * MODW + cb + l]; }
        __syncthreads();
    }
}
__device__ __forceinline__ void norm_mod_phase(const Ctx& c, const float* srcL, const float* srcC, const float* nw, const float* modl, int shift_off, int scale_off, int nrows) {
    bf16_t* H = (bf16_t*)(c.ws + WS_HY);
    for (int r = c.gw; r < nrows; r += c.NGW) {
        const float* xr = r < ML ? srcL + (size_t)r * D : srcC + (size_t)(r - ML) * D;
        const float* mr = modl + (size_t)(r < ML ? (r >> 12) : 4) * MODW;
        f32x4 v[8]; float ss = 0.f;
#pragma unroll
        for (int j = 0; j < 8; ++j) { v[j] = ((const f32x4*)xr)[c.lane + 64 * j]; ss += v[j].x * v[j].x + v[j].y * v[j].y + v[j].z * v[j].z + v[j].w * v[j].w; }
        ss = grp_sum<64>(ss);
        const float rstd = 1.f / sqrtf(ss * (1.f / D) + 1e-6f);
#pragma unroll
        for (int j = 0; j < 8; ++j) { const f32x4 w4 = ((const f32x4*)nw)[c.lane + 64 * j], s4 = ((const f32x4*)(mr + scale_off))[c.lane + 64 * j], h4 = ((const f32x4*)(mr + shift_off))[c.lane + 64 * j];
            const f32x4 y = v[j] * rstd * w4 * (s4 + 1.f) + h4;
            u32x2 o; o.x = pk2(y.x, y.y); o.y = pk2(y.z, y.w);
            ((u32x2*)(H + (size_t)r * D))[c.lane + 64 * j] = o; }
    }
}
__device__ __forceinline__ void final_norm_phase(const Ctx& c) {
    const float* nw = c.in[IN_FNW];
    for (int r = c.gw; r < ML; r += c.NGW) {
        f32x4* xr = (f32x4*)(c.out + (size_t)r * D);
        f32x4 v[8]; float ss = 0.f;
#pragma unroll
        for (int j = 0; j < 8; ++j) { v[j] = xr[c.lane + 64 * j]; ss += v[j].x * v[j].x + v[j].y * v[j].y + v[j].z * v[j].z + v[j].w * v[j].w; }
        ss = grp_sum<64>(ss);
        const float rstd = 1.f / sqrtf(ss * (1.f / D) + 1e-6f);
#pragma unroll
        for (int j = 0; j < 8; ++j) xr[c.lane + 64 * j] = v[j] * rstd * ((const f32x4*)nw)[c.lane + 64 * j];
    }
}

__device__ __forceinline__ void ab_feature_phase(const Ctx& c) {
    const bf16_t* P = (const bf16_t*)(c.ws + WS_P); const float* T = (const float*)(c.ws + WS_TAIL);
    bf16_t* F = (bf16_t*)(c.ws + WS_F);
    float* GA = (float*)(c.ws + WS_GA); float* GB = (float*)(c.ws + WS_GB);
    const float* cw = c.in[IN_CONVW];
    const int lane = c.lane;
    for (int it = 0; it * c.NGW < MT; ++it) {
        const int r = it * c.NGW + c.wg * NWAVES + c.wave;
        if (r >= MT) break;
        int nb[9];
        if (r < ML) { const int b = r >> 12, t = r & 4095, gr = t >> 6, gc = t & 63;
#pragma unroll
            for (int dr = 0; dr < 3; ++dr)
#pragma unroll
                for (int dc = 0; dc < 3; ++dc) { const int rr = gr + dr - 1, cc = gc + dc - 1; nb[dr * 3 + dc] = (rr >= 0 && rr < 64 && cc >= 0 && cc < 64) ? (b * 4096 + rr * 64 + cc) : -1; } }
        else { const int q = r - ML, b = q >> 8, t = q & 255;
#pragma unroll
            for (int k = 0; k < 9; ++k) nb[k] = -1;
#pragma unroll
            for (int dc = 0; dc < 3; ++dc) { const int cc = t + dc - 1; nb[3 + dc] = (cc >= 0 && cc < 256) ? (ML + b * 256 + cc) : -1; } }
#pragma unroll 1
        for (int blk = 0; blk < 12; ++blk) {
            const int ch = blk * 512 + lane * 8;
            float cv[8];
#pragma unroll
            for (int j = 0; j < 8; ++j) cv[j] = 0.f;
#pragma unroll
            for (int k = 0; k < 9; ++k) if (nb[k] >= 0) {
                const u32x4 pv = *(const u32x4*)(P + (size_t)nb[k] * PW0 + ch);
                const f32x4 w0 = *(const f32x4*)(cw + k * 6144 + ch), w1 = *(const f32x4*)(cw + k * 6144 + ch + 4);
                float pf[8]; unpack8(pv, pf);
                cv[0] += pf[0] * w0.x; cv[1] += pf[1] * w0.y; cv[2] += pf[2] * w0.z; cv[3] += pf[3] * w0.w;
                cv[4] += pf[4] * w1.x; cv[5] += pf[5] * w1.y; cv[6] += pf[6] * w1.z; cv[7] += pf[7] * w1.w; }
            const int grp = blk >> 1, cl = (blk & 1) * 512 + lane * 8;
            if (grp < 3) {
                float ss = 0.f;
#pragma unroll
                for (int j = 0; j < 8; ++j) { cv[j] = cv[j] / (1.f + __expf(-cv[j])); ss += cv[j] * cv[j]; }
                if (grp < 2) { ss = grp_sum<16>(ss); const float sc = (1.f / sqrtf(ss + 1e-6f)) * (grp == 0 ? 0.08838834764831845f : 1.f);
#pragma unroll
                    for (int j = 0; j < 8; ++j) cv[j] *= sc; }
                *(u32x4*)(F + (size_t)grp * MT * 1024 + (size_t)r * 1024 + cl) = pack8(cv);
            } else if (grp == 3) { *(u32x4*)(F + (size_t)3 * MT * 1024 + (size_t)r * 1024 + cl) = pack8(cv);
            } else if (grp == 5) { *(u32x4*)(F + (size_t)6 * MT * 1024 + (size_t)r * 1024 + cl) = pack8(cv);
            } else {
                *(u32x4*)(F + (size_t)5 * MT * 1024 + (size_t)r * 1024 + cl) = pack8(cv);
                const f32x4 k0 = *(const f32x4*)(c.in[IN_KK] + cl), k1 = *(const f32x4*)(c.in[IN_KK] + cl + 4);
                float t[8] = {cv[0] * k0.x, cv[1] * k0.y, cv[2] * k0.z, cv[3] * k0.w, cv[4] * k1.x, cv[5] * k1.y, cv[6] * k1.z, cv[7] * k1.w};
                float ss = 0.f;
#pragma unroll
                for (int j = 0; j < 8; ++j) ss += t[j] * t[j];
                ss = grp_sum<8>(ss); const float sc = 1.f / sqrtf(ss + 1e-6f);
#pragma unroll
                for (int j = 0; j < 8; ++j) t[j] *= sc;
                *(u32x4*)(F + (size_t)4 * MT * 1024 + (size_t)r * 1024 + cl) = pack8(t);
            }
        }
        if (lane < 16) {
            const float g0 = T[(size_t)r * TW0 + lane], g1 = T[(size_t)r * TW0 + 16 + lane];
            GA[(size_t)r * 16 + lane] = -expf(c.in[IN_ALOG][lane]) * softplus_(g0 + c.in[IN_DTB][lane]);
            GB[(size_t)r * 16 + lane] = sigm(g1);
        }
    }
}
__device__ __forceinline__ void rw_lora_phase(const Ctx& c) {
    bf16_t* P = (bf16_t*)(c.ws + WS_P); const float* T = (const float*)(c.ws + WS_TAIL);
    LAS float* xin = (LAS float*)c.lds;
    const int tid = c.tid;
    for (int tile = c.wg; tile < MT / 16; tile += c.G) {
        const int r0 = tile * 16;
#pragma unroll 1
        for (int pass = 0; pass < 2; ++pass) {
            __syncthreads();
            for (int i = tid; i < 16 * 128; i += NTHREADS) { const int tk = i >> 7, j = i & 127; const float v = T[(size_t)(r0 + tk) * TW0 + 32 + pass * 128 + j]; xin[i] = pass == 0 ? tanhf(v) : v; }
            __syncthreads();
            const float* up = c.in[pass == 0 ? IN_WUP : IN_AUP];
            float acc[16][2][2];
#pragma unroll
            for (int tk = 0; tk < 16; ++tk) { acc[tk][0][0] = acc[tk][0][1] = acc[tk][1][0] = acc[tk][1][1] = 0.f; }
#pragma unroll 2
            for (int rr = 0; rr < 64; ++rr) {
                const float w00 = up[(size_t)rr * 1024 + tid], w01 = up[(size_t)rr * 1024 + tid + 512], w10 = up[(size_t)(64 + rr) * 1024 + tid], w11 = up[(size_t)(64 + rr) * 1024 + tid + 512];
#pragma unroll
                for (int tk = 0; tk < 16; ++tk) { const float x0 = xin[tk * 128 + rr], x1 = xin[tk * 128 + 64 + rr];
                    acc[tk][0][0] += x0 * w00; acc[tk][0][1] += x0 * w01; acc[tk][1][0] += x1 * w10; acc[tk][1][1] += x1 * w11; }
            }
            const float* bias = c.in[pass == 0 ? IN_W0 : IN_A0];
#pragma unroll
            for (int d = 0; d < 2; ++d)
#pragma unroll
                for (int j = 0; j < 2; ++j) { const int ch = tid + 512 * j; const float bz = bias[d * 1024 + ch];
#pragma unroll
                    for (int tk = 0; tk < 16; ++tk) { const float s = sigm(bz + acc[tk][d][j]);
                        P[(size_t)(r0 + tk) * PW0 + (pass * 2 + d) * 1024 + ch] = (bf16_t)f2bf(pass == 0 ? -0.6065306597126334f * s : s); } }
        }
    }
}
__device__ __forceinline__ int chunk_row(int b, int dir, int s) {
    if (s < 4) return ML + b * 256 + (dir == 0 ? s : 3 - s) * 64;
    return b * 4096 + (dir == 0 ? s - 4 : 67 - s) * 64;
}
__device__ __forceinline__ void gdn_scan_phase(const Ctx& c) {
    const bf16_t* F = (const bf16_t*)(c.ws + WS_F); bf16_t* P = (bf16_t*)(c.ws + WS_P);
    const float* GA = (const float*)(c.ws + WS_GA); const float* GB = (const float*)(c.ws + WS_GB);
    const int lane = c.lane, tid = c.tid, slab = lane & 15, cl = c.wave * 4 + (lane >> 4);
    for (int item = c.wg; item < 256; item += c.G) {
        const int chain = item >> 2, cq = item & 3, b = chain >> 4, h = (chain >> 1) & 7, dir = chain & 1;
        float S[8];
#pragma unroll
        for (int i = 0; i < 8; ++i) S[i] = 0.f;
        u32x4 rk[2], rq[2], rv; float rg = 0.f, rb = 0.f;
        auto gload = [&](int s) {
            const int row0 = chunk_row(b, dir, s);
#pragma unroll
            for (int i = 0; i < 2; ++i) { const int pc = tid + i * 512, tk = pc >> 4, o = (pc & 15) * 8;
                rk[i] = *(const u32x4*)(F + (size_t)1 * MT * 1024 + (size_t)(row0 + tk) * 1024 + h * 128 + o);
                rq[i] = *(const u32x4*)(F + (size_t)0 * MT * 1024 + (size_t)(row0 + tk) * 1024 + h * 128 + o); }
            if (tid < 256) { const int tk = tid >> 2, o = (tid & 3) * 8; rv = *(const u32x4*)(F + (size_t)2 * MT * 1024 + (size_t)(row0 + tk) * 1024 + h * 128 + cq * 32 + o); }
            if (tid < 64) { rg = GA[(size_t)(row0 + tid) * 16 + dir * 8 + h]; rb = GB[(size_t)(row0 + tid) * 16 + dir * 8 + h]; }
        };
        auto lstore = [&](int bufi) {
            LAS unsigned char* bp = c.lds + bufi * 40960;
#pragma unroll
            for (int i = 0; i < 2; ++i) { const int pc = tid + i * 512; *(LAS u32x4*)(bp + pc * 16) = rk[i]; *(LAS u32x4*)(bp + 16384 + pc * 16) = rq[i]; }
            if (tid < 256) *(LAS u32x4*)(bp + 32768 + tid * 16) = rv;
            if (tid < 64) { *(LAS float*)(bp + 36864 + tid * 4) = rg; *(LAS float*)(bp + 37120 + tid * 4) = rb; }
        };
        __syncthreads();
        gload(0); lstore(0);
        __syncthreads();
        LAS float* ost = (LAS float*)(c.lds + 81920);
#pragma unroll 1
        for (int s = 0; s < 68; ++s) {
            if (s + 1 < 68) gload(s + 1);
            const LAS unsigned char* bp = c.lds + (s & 1) * 40960;
#pragma unroll 2
            for (int j = 0; j < 64; ++j) {
                const int tl = dir == 0 ? j : 63 - j;
                float kf[8], qf[8];
                unpack8(*(const LAS u32x4*)(bp + tl * 256 + slab * 16), kf);
                unpack8(*(const LAS u32x4*)(bp + 16384 + tl * 256 + slab * 16), qf);
                const float vv = bf1(*(const LAS bf16_t*)(bp + 32768 + tl * 64 + cl * 2));
                const float a = __expf(*(const LAS float*)(bp + 36864 + tl * 4)), bt = *(const LAS float*)(bp + 37120 + tl * 4);
                float dot = 0.f;
#pragma unroll
                for (int i = 0; i < 8; ++i) dot += S[i] * kf[i];
                dot = grp_sum<16>(dot);
                const float dlt = bt * (vv - a * dot);
                float od = 0.f;
#pragma unroll
                for (int i = 0; i < 8; ++i) { S[i] = a * S[i] + kf[i] * dlt; od += S[i] * qf[i]; }
                od = grp_sum<16>(od);
                if (slab == 0) ost[tl * 32 + cl] = od;
            }
            __syncthreads();
            {
                const int row0 = chunk_row(b, dir, s), tk = tid >> 3, o = (tid & 7) * 4;
                const f32x4 v = *(const LAS f32x4*)(ost + tk * 32 + o);
                u32x2 w; w.x = pk2(v.x, v.y); w.y = pk2(v.z, v.w);
                *(u32x2*)(P + (size_t)(row0 + tk) * PW0 + (4 + dir) * 1024 + h * 128 + cq * 32 + o) = w;
            }
            if (s + 1 < 68) lstore((s + 1) & 1);
            __syncthreads();
        }
    }
}
__device__ __forceinline__ void rwkv_scan_phase(const Ctx& c) {
    const bf16_t* F = (const bf16_t*)(c.ws + WS_F); const bf16_t* P = (const bf16_t*)(c.ws + WS_P);
    bf16_t* Y = (bf16_t*)(c.ws + WS_F);
    const int lane = c.lane, tid = c.tid, slab = lane & 15, rl = c.wave * 4 + (lane >> 4);
    for (int item = c.wg; item < 256; item += c.G) {
        const int chain = item >> 1, rh = item & 1, b = chain >> 5, h = (chain >> 1) & 15, dir = chain & 1;
        float S[4] = {0.f, 0.f, 0.f, 0.f};
        const f32x4 ka = *(const f32x4*)(c.in[IN_KA] + h * 64 + slab * 4);
        u32x4 rr[5]; u32x4 rv;
        auto gload = [&](int s) {
            const int row0 = chunk_row(b, dir, s);
            const int tk = tid >> 3, o = (tid & 7) * 8;
            rr[0] = *(const u32x4*)(F + (size_t)3 * MT * 1024 + (size_t)(row0 + tk) * 1024 + h * 64 + o);
            rr[1] = *(const u32x4*)(F + (size_t)4 * MT * 1024 + (size_t)(row0 + tk) * 1024 + h * 64 + o);
            rr[2] = *(const u32x4*)(F + (size_t)5 * MT * 1024 + (size_t)(row0 + tk) * 1024 + h * 64 + o);
            rr[3] = *(const u32x4*)(P + (size_t)(row0 + tk) * PW0 + (0 + dir) * 1024 + h * 64 + o);
            rr[4] = *(const u32x4*)(P + (size_t)(row0 + tk) * PW0 + (2 + dir) * 1024 + h * 64 + o);
            if (tid < 256) { const int t2 = tid >> 2, o2 = (tid & 3) * 8; rv = *(const u32x4*)(F + (size_t)6 * MT * 1024 + (size_t)(row0 + t2) * 1024 + h * 64 + rh * 32 + o2); }
        };
        auto lstore = [&](int bufi) {
            LAS unsigned char* bp = c.lds + bufi * 45056;
#pragma unroll
            for (int q = 0; q < 5; ++q) *(LAS u32x4*)(bp + q * 8192 + tid * 16) = rr[q];
            if (tid < 256) *(LAS u32x4*)(bp + 40960 + tid * 16) = rv;
        };
        __syncthreads();
        gload(0); lstore(0);
        __syncthreads();
        LAS float* yst = (LAS float*)(c.lds + 90112);
#pragma unroll 1
        for (int s = 0; s < 68; ++s) {
            if (s + 1 < 68) gload(s + 1);
            const LAS unsigned char* bp = c.lds + (s & 1) * 45056;
#pragma unroll 2
            for (int j = 0; j < 64; ++j) {
                const int tl = dir == 0 ? j : 63 - j;
                const u32x2 ur = *(const LAS u32x2*)(bp + tl * 128 + slab * 8), ukk = *(const LAS u32x2*)(bp + 8192 + tl * 128 + slab * 8), ukb = *(const LAS u32x2*)(bp + 16384 + tl * 128 + slab * 8),
                            ulw = *(const LAS u32x2*)(bp + 24576 + tl * 128 + slab * 8), ua = *(const LAS u32x2*)(bp + 32768 + tl * 128 + slab * 8);
                const float vv = bf1(*(const LAS bf16_t*)(bp + 40960 + tl * 64 + rl * 2));
                const float rf[4] = {bflo(ur.x), bfhi(ur.x), bflo(ur.y), bfhi(ur.y)}, kkf[4] = {bflo(ukk.x), bfhi(ukk.x), bflo(ukk.y), bfhi(ukk.y)}, kbf[4] = {bflo(ukb.x), bfhi(ukb.x), bflo(ukb.y), bfhi(ukb.y)},
                            lwf[4] = {bflo(ulw.x), bfhi(ulw.x), bflo(ulw.y), bfhi(ulw.y)}, af[4] = {bflo(ua.x), bfhi(ua.x), bflo(ua.y), bfhi(ua.y)};
                float sk = 0.f;
#pragma unroll
                for (int i = 0; i < 4; ++i) sk += S[i] * kkf[i];
                sk = grp_sum<16>(sk);
                float y = 0.f;
#pragma unroll
                for (int i = 0; i < 4; ++i) { const float w = __expf(lwf[i]), kka = kkf[i] * af[i], kt = kbf[i] * (1.f + (af[i] - 1.f) * ka[i]);
                    S[i] = S[i] * w - sk * kka + vv * kt; y += S[i] * rf[i]; }
                y = grp_sum<16>(y);
                if (slab == 0) yst[tl * 32 + rl] = y;
            }
            __syncthreads();
            {   const int row0 = chunk_row(b, dir, s), tk = tid >> 3, o = (tid & 7) * 4;
                const f32x4 v = *(const LAS f32x4*)(yst + tk * 32 + o);
                u32x2 w; w.x = pk2(v.x, v.y); w.y = pk2(v.z, v.w);
                *(u32x2*)(Y + (size_t)dir * MT * 1024 + (size_t)(row0 + tk) * 1024 + h * 64 + rh * 32 + o) = w;
            }
            if (s + 1 < 68) lstore((s + 1) & 1);
            __syncthreads();
        }
    }
}
__device__ __forceinline__ void ab_output_phase(const Ctx& c) {
    const bf16_t* F = (const bf16_t*)(c.ws + WS_F); const bf16_t* P = (const bf16_t*)(c.ws + WS_P); const float* T = (const float*)(c.ws + WS_TAIL);
    bf16_t* Yo = (bf16_t*)(c.ws + WS_HY);
    LAS float* sg = (LAS float*)c.lds;
    const int tid = c.tid, lane = c.lane, wave = c.wave;
    for (int tile = c.wg; tile < MT / 16; tile += c.G) {
        const int r0 = tile * 16;
        __syncthreads();
        for (int i = tid; i < 16 * 160; i += NTHREADS) { const int tk = i / 160, j = i % 160; sg[i] = sigm(T[(size_t)(r0 + tk) * TW0 + 288 + j]); }
        __syncthreads();
        LAS float* gos = (LAS float*)(c.lds + 16384);
        {
            float go[16][2];
#pragma unroll
            for (int tk = 0; tk < 16; ++tk) go[tk][0] = go[tk][1] = 0.f;
            const float* gup = c.in[IN_GUP];
#pragma unroll 2
            for (int rr = 0; rr < 160; ++rr) { const float w0 = gup[(size_t)rr * 1024 + tid], w1 = gup[(size_t)rr * 1024 + tid + 512];
#pragma unroll
                for (int tk = 0; tk < 16; ++tk) { const float x = sg[tk * 160 + rr]; go[tk][0] += x * w0; go[tk][1] += x * w1; } }
#pragma unroll
            for (int tk = 0; tk < 16; ++tk) { gos[tk * 1024 + tid] = go[tk][0]; gos[tk * 1024 + tid + 512] = go[tk][1]; }
        }
#pragma unroll
        for (int j = 0; j < 2; ++j) {
            const int ch = tid + 512 * j;
            const float kaj = c.in[IN_KA][ch], rkj = c.in[IN_RK][ch], lnw = c.in[IN_LNW][ch], lnb = c.in[IN_LNB][ch];
#pragma unroll 4
            for (int tk = 0; tk < 16; ++tk) {
                const size_t row = (size_t)(r0 + tk);
                const float y = bf1(Yo[row * D + 1024 + ch]) + bf1(Yo[row * D + ch]);
                const float rv = bf1(F[(size_t)3 * MT * 1024 + row * 1024 + ch]), kb = bf1(F[(size_t)5 * MT * 1024 + row * 1024 + ch]), vb = bf1(F[(size_t)6 * MT * 1024 + row * 1024 + ch]);
                const float a0 = bf1(P[row * PW0 + 2048 + ch]), a1 = bf1(P[row * PW0 + 3072 + ch]);
                const float mu = grp_sum<64>(y) * (1.f / 64.f), dv = y - mu, var = grp_sum<64>(dv * dv) * (1.f / 64.f);
                const float kts = kb * (2.f + (a0 + a1 - 2.f) * kaj);
                const float bonus = grp_sum<64>(rv * kts * rkj) * vb;
                const float o = (dv * (1.f / sqrtf(var + 64e-5f)) * lnw + lnb + bonus) * gos[tk * 1024 + ch];
                Yo[row * D + 1024 + ch] = (bf16_t)f2bf(o);
            }
        }
        __syncthreads();
        {   const int ch = 2 * tid;
            const float nw0 = c.in[IN_GDNNW][ch & 127], nw1 = c.in[IN_GDNNW][(ch & 127) + 1];
#pragma unroll 4
            for (int tk = 0; tk < 16; ++tk) {
                const size_t row = (size_t)(r0 + tk);
                const unsigned uf = *(const unsigned*)(P + row * PW0 + 4096 + ch), ub = *(const unsigned*)(P + row * PW0 + 5120 + ch), uz = *(const unsigned*)(P + row * PW0 + 6144 + ch);
                const float o0 = bflo(uf) + bflo(ub), o1 = bfhi(uf) + bfhi(ub);
                const float ss = grp_sum<64>(o0 * o0 + o1 * o1), rstd = 1.f / sqrtf(ss * (1.f / 128.f) + 1e-6f);
                const float z0 = bflo(uz), z1 = bfhi(uz);
                *(unsigned*)(Yo + row * D + ch) = pk2(o0 * rstd * nw0 * silu_fast(z0), o1 * rstd * nw1 * silu_fast(z1));
            }
        }
    }
}

__device__ __forceinline__ void ml_gate_phase(const Ctx& c) {
    const float* T = (const float*)(c.ws + WS_TAIL); float* GA = (float*)(c.ws + WS_GA); float* GB = (float*)(c.ws + WS_GB);
    for (size_t i = (size_t)c.wg * NTHREADS + c.tid; i < (size_t)MT * 16; i += (size_t)c.G * NTHREADS) {
        const size_t r = i >> 4; const int k = (int)(i & 15);
        const float gi = T[r * TW1 + k] + c.in[IN_MLIB][k], gf = T[r * TW1 + 16 + k] + c.in[IN_MLFB][k];
        GA[i] = 15.f * tanhf(gi * (1.f / 15.f));
        GB[i] = logsigm_(15.f * tanhf(gf * (1.f / 15.f)));
    }
}
__device__ __forceinline__ void mlstm_scan_phase(const Ctx& c) {
    const bf16_t* P = (const bf16_t*)(c.ws + WS_P); bf16_t* Hs = (bf16_t*)(c.ws + WS_F);
    const float* GA = (const float*)(c.ws + WS_GA); const float* GB = (const float*)(c.ws + WS_GB);
    const int lane = c.lane, tid = c.tid, slab = lane & 15, cp = c.wave * 4 + (lane >> 4);
    for (int item = c.wg; item < 256; item += c.G) {
        const int chain = item >> 2, cq = item & 3, b = chain >> 4, h = (chain >> 1) & 7, dir = chain & 1;
        float C[8][2], n[8]; float m = 0.f;
#pragma unroll
        for (int i = 0; i < 8; ++i) { C[i][0] = C[i][1] = 0.f; n[i] = 0.f; }
        u32x4 rk[2], rq[2], rv; float rg = 0.f, rb = 0.f;
        auto gload = [&](int s) {
            const int row0 = chunk_row(b, dir, s);
#pragma unroll
            for (int i = 0; i < 2; ++i) { const int pc = tid + i * 512, tk = pc >> 4, o = (pc & 15) * 8;
                rk[i] = *(const u32x4*)(P + (size_t)(row0 + tk) * PW1 + 1024 + h * 128 + o);
                rq[i] = *(const u32x4*)(P + (size_t)(row0 + tk) * PW1 + h * 128 + o); }
            { const int tk = tid >> 3, o = (tid & 7) * 8; rv = *(const u32x4*)(P + (size_t)(row0 + tk) * PW1 + 2048 + h * 256 + cq * 64 + o); }
            if (tid < 64) { rg = GA[(size_t)(row0 + tid) * 16 + dir * 8 + h]; rb = GB[(size_t)(row0 + tid) * 16 + dir * 8 + h]; }
        };
        auto lstore = [&](int bufi) {
            LAS unsigned char* bp = c.lds + bufi * 41472;
#pragma unroll
            for (int i = 0; i < 2; ++i) { const int pc = tid + i * 512; *(LAS u32x4*)(bp + pc * 16) = rk[i]; *(LAS u32x4*)(bp + 16384 + pc * 16) = rq[i]; }
            *(LAS u32x4*)(bp + 32768 + tid * 16) = rv;
            if (tid < 64) { *(LAS float*)(bp + 40960 + tid * 4) = rg; *(LAS float*)(bp + 41216 + tid * 4) = rb; }
        };
        __syncthreads();
        gload(0); lstore(0);
        __syncthreads();
        LAS float* hst = (LAS float*)(c.lds + 82944);
#pragma unroll 1
        for (int s = 0; s < 68; ++s) {
            if (s + 1 < 68) gload(s + 1);
            const LAS unsigned char* bp = c.lds + (s & 1) * 41472;
#pragma unroll 2
            for (int j = 0; j < 64; ++j) {
                const int tl = dir == 0 ? j : 63 - j;
                float kf[8], qf[8];
                unpack8(*(const LAS u32x4*)(bp + tl * 256 + slab * 16), kf);
                unpack8(*(const LAS u32x4*)(bp + 16384 + tl * 256 + slab * 16), qf);
                const unsigned uv = *(const LAS unsigned*)(bp + 32768 + tl * 128 + cp * 4);
                const float v0 = bflo(uv), v1 = bfhi(uv);
                const float ig = *(const LAS float*)(bp + 40960 + tl * 4), lf = *(const LAS float*)(bp + 41216 + tl * 4);
                const float mn = fmaxf(lf + m, ig), fs = __expf(lf + m - mn), is = __expf(ig - mn);
                m = mn;
                float n0 = 0.f, n1 = 0.f, dn = 0.f;
#pragma unroll
                for (int i = 0; i < 8; ++i) { const float ki = is * kf[i], qi = qf[i] * 0.08838834764831845f;
                    C[i][0] = fs * C[i][0] + ki * v0; C[i][1] = fs * C[i][1] + ki * v1; n[i] = fs * n[i] + ki;
                    n0 += C[i][0] * qi; n1 += C[i][1] * qi; dn += n[i] * qi; }
                n0 = grp_sum<16>(n0); n1 = grp_sum<16>(n1); dn = grp_sum<16>(dn);
                if (slab == 0) { const float dd = 1.f / fmaxf(fabsf(dn), __expf(-mn)); hst[tl * 64 + cp * 2] = n0 * dd; hst[tl * 64 + cp * 2 + 1] = n1 * dd; }
            }
            __syncthreads();
            if (s >= 4) {
                const int row0 = chunk_row(b, dir, s), tk = tid >> 3, o = (tid & 7) * 8;
                float v[8];
#pragma unroll
                for (int i = 0; i < 8; ++i) v[i] = hst[tk * 64 + o + i];
                *(u32x4*)(Hs + (size_t)dir * ML * D + (size_t)(row0 + tk) * D + h * 256 + cq * 64 + o) = pack8(v);
            }
            if (s + 1 < 68) lstore((s + 1) & 1);
            __syncthreads();
        }
    }
}
__device__ __forceinline__ void ml_output_phase(const Ctx& c) {
    const bf16_t* Hs = (const bf16_t*)(c.ws + WS_F); const bf16_t* P = (const bf16_t*)(c.ws + WS_P); bf16_t* Yo = (bf16_t*)(c.ws + WS_HY);
    const float* nw = c.in[IN_MLNW];
    for (int r = c.gw; r < ML; r += c.NGW) {
#pragma unroll
        for (int blk = 0; blk < 4; ++blk) {
            const int ch = blk * 512 + c.lane * 8;
            float a[8], bb[8], o[8];
            unpack8(*(const u32x4*)(Hs + (size_t)r * D + ch), a); unpack8(*(const u32x4*)(Hs + (size_t)ML * D + (size_t)r * D + ch), bb);
            unpack8(*(const u32x4*)(P + (size_t)r * PW1 + 4096 + ch), o);
            float ss = 0.f;
#pragma unroll
            for (int j = 0; j < 8; ++j) { a[j] += bb[j]; ss += a[j] * a[j]; }
            ss = grp_sum<32>(ss); const float rstd = 1.f / sqrtf(ss * (1.f / 256.f) + 1e-6f);
            const f32x4 w0 = *(const f32x4*)(nw + ch), w1 = *(const f32x4*)(nw + ch + 4);
            const float wv[8] = {w0.x, w0.y, w0.z, w0.w, w1.x, w1.y, w1.z, w1.w};
#pragma unroll
            for (int j = 0; j < 8; ++j) a[j] = a[j] * rstd * wv[j] * sigm_fast(o[j]);
            *(u32x4*)(Yo + (size_t)r * D + ch) = pack8(a);
        }
    }
}


typedef short bf16x8 __attribute__((ext_vector_type(8)));
typedef short s16x4 __attribute__((ext_vector_type(4)));
#define MFMA16(a, b, c) __builtin_amdgcn_mfma_f32_16x16x32_bf16((a), (b), (c), 0, 0, 0)
__device__ __forceinline__ bf16x8 frag_row(const LAS unsigned char* img, int RS, int r0, int k0, int lane) {
    return *(const LAS bf16x8*)(img + (r0 + (lane & 15)) * RS + (k0 + 8 * (lane >> 4)) * 2);
}
__device__ __forceinline__ bf16x8 frag_tr(const LAS unsigned char* img, int RS, int r0, int k0, int lane) {
    const int g = lane >> 4, q = (lane & 15) >> 2, p = lane & 3;
    LAS unsigned char* a = (LAS unsigned char*)img + (k0 + 8 * g + q) * RS + (r0 + 4 * p) * 2;
    const s16x4 lo = __builtin_amdgcn_ds_read_tr16_b64_v4i16((LAS s16x4*)a);
    const s16x4 hi = __builtin_amdgcn_ds_read_tr16_b64_v4i16((LAS s16x4*)(a + 4 * RS));
    bf16x8 r; r[0] = lo[0]; r[1] = lo[1]; r[2] = lo[2]; r[3] = lo[3]; r[4] = hi[0]; r[5] = hi[1]; r[6] = hi[2]; r[7] = hi[3];
    return r;
}
__device__ __forceinline__ void tile_write(LAS unsigned char* img, int RS, int n0, int m0, int lane, const f32x4 v) {
    u32x2 o; o.x = pk2(v[0], v[1]); o.y = pk2(v[2], v[3]);
    *(LAS u32x2*)(img + (n0 + (lane & 15)) * RS + (m0 + 4 * (lane >> 4)) * 2) = o;
}
constexpr int MS = 68;
__device__ __forceinline__ void tri_inverse_64(LAS float* MF, LAS float* TMP, int tid) {
    if (tid < 64) {
        const int blk = tid >> 4, cc = tid & 15; LAS float* base = MF + (blk * 16) * MS + blk * 16; float x[16];
#pragma unroll
        for (int i = 0; i < 16; ++i) { float s = (i == cc) ? 1.f : 0.f;
#pragma unroll
            for (int j = 0; j < i; ++j) s -= base[i * MS + j] * x[j];
            x[i] = s; }
#pragma unroll
        for (int i = 0; i < 16; ++i) base[i * MS + cc] = x[i];
    }
    __syncthreads();
    {   const int h = tid >> 8, t = tid & 255, r = t >> 4, cc = t & 15, R0 = h ? 48 : 16, C0 = h ? 32 : 0;
        float s = 0.f;
#pragma unroll
        for (int k = 0; k < 16; ++k) s += MF[(R0 + r) * MS + C0 + k] * MF[(C0 + k) * MS + C0 + cc];
        TMP[tid] = s;
        __syncthreads();
        float s2 = 0.f;
#pragma unroll
        for (int k = 0; k < 16; ++k) s2 += MF[(R0 + r) * MS + R0 + k] * TMP[h * 256 + k * 16 + cc];
        MF[(R0 + r) * MS + C0 + cc] = -s2;
    }
    __syncthreads();
    {   float s[2];
#pragma unroll
        for (int q = 0; q < 2; ++q) { const int idx = tid * 2 + q, r = idx >> 5, cc = idx & 31; float a = 0.f;
#pragma unroll 8
            for (int k = 0; k < 32; ++k) a += MF[(32 + r) * MS + k] * MF[k * MS + cc];
            s[q] = a; }
        TMP[tid * 2] = s[0]; TMP[tid * 2 + 1] = s[1];
        __syncthreads();
#pragma unroll
        for (int q = 0; q < 2; ++q) { const int idx = tid * 2 + q, r = idx >> 5, cc = idx & 31; float a = 0.f;
#pragma unroll 8
            for (int k = 0; k < 32; ++k) a += MF[(32 + r) * MS + 32 + k] * TMP[k * 32 + cc];
            s[q] = a; }
#pragma unroll
        for (int q = 0; q < 2; ++q) { const int idx = tid * 2 + q, r = idx >> 5, cc = idx & 31; MF[(32 + r) * MS + cc] = -s[q]; }
    }
    __syncthreads();
}
__device__ __forceinline__ float wave_incl_scan_add(float x, int lane) {
#pragma unroll
    for (int o = 1; o < 64; o <<= 1) { const float t = __shfl_up(x, o); if (lane >= o) x += t; }
    return x;
}
__device__ __forceinline__ float wave_incl_scan_max(float x, int lane) {
#pragma unroll
    for (int o = 1; o < 64; o <<= 1) { const float t = __shfl_up(x, o); if (lane >= o) x = fmaxf(x, t); }
    return x;
}
constexpr int RS128 = 272, RS64 = 144, RS80 = 176;

__device__ __forceinline__ void mlstm_chunk_phase(const Ctx& c) {
    const bf16_t* P = (const bf16_t*)(c.ws + WS_P); bf16_t* Hs = (bf16_t*)(c.ws + WS_F);
    const float* GA = (const float*)(c.ws + WS_GA); const float* GB = (const float*)(c.ws + WS_GB);
    const int lane = c.lane, tid = c.tid, w = c.wave, g4 = lane >> 4, l15 = lane & 15;
    LAS unsigned char* KIMG = c.lds; LAS unsigned char* QIMG = c.lds + 17408; LAS unsigned char* VIMG = c.lds + 34816; LAS unsigned char* VS = c.lds + 46080;
    LAS unsigned char* SM = c.lds + 57344; LAS unsigned char* CT = c.lds + 66560;
    LAS float* sB = (LAS float*)(c.lds + 88320); LAS float* sCM = sB + 64; LAS float* sIGB = sB + 128;
    for (int item = c.wg; item < 256; item += c.G) {
        const int chain = item >> 2, cq = item & 3, b = chain >> 4, h = (chain >> 1) & 7, dir = chain & 1;
        f32x4 st[5];
#pragma unroll
        for (int e = 0; e < 5; ++e) st[e] = (f32x4){0.f, 0.f, 0.f, 0.f};
        float m = 0.f;
        u32x4 rk[2], rq[2], rv; float rg = 0.f, rb = 0.f;
        auto gload = [&](int s) {
            const int row0 = chunk_row(b, dir, s);
#pragma unroll
            for (int i = 0; i < 2; ++i) { const int pc = tid + i * 512, tk = pc >> 4, o = (pc & 15) * 8;
                rk[i] = *(const u32x4*)(P + (size_t)(row0 + tk) * PW1 + 1024 + h * 128 + o);
                rq[i] = *(const u32x4*)(P + (size_t)(row0 + tk) * PW1 + h * 128 + o); }
            { const int tk = tid >> 3, o = (tid & 7) * 8; rv = *(const u32x4*)(P + (size_t)(row0 + tk) * PW1 + 2048 + h * 256 + cq * 64 + o); }
            if (tid < 64) { rg = GA[(size_t)(row0 + tid) * 16 + dir * 8 + h]; rb = GB[(size_t)(row0 + tid) * 16 + dir * 8 + h]; }
        };
        __syncthreads();
        for (int i = tid; i < 80 * 34; i += NTHREADS) ((LAS u32x2*)CT)[i] = (u32x2){0u, 0u};
        gload(0);
#pragma unroll 1
        for (int s = 0; s < 68; ++s) {
#pragma unroll
            for (int i = 0; i < 2; ++i) { const int pc = tid + i * 512, tk = pc >> 4, o = pc & 15, ri = dir ? 63 - tk : tk;
                *(LAS u32x4*)(KIMG + ri * RS128 + o * 16) = rk[i]; *(LAS u32x4*)(QIMG + ri * RS128 + o * 16) = rq[i]; }
            { const int tk = tid >> 3, o = tid & 7, ri = dir ? 63 - tk : tk; *(LAS u32x4*)(VIMG + ri * RS80 + o * 16) = rv;
              if (o == 0) { *(LAS u32x4*)(VIMG + ri * RS80 + 128) = (u32x4){0x3F80u, 0u, 0u, 0u}; *(LAS u32x4*)(VIMG + ri * RS80 + 144) = (u32x4){0u, 0u, 0u, 0u}; } }
            if (w == 0) {
                const int src = dir ? 63 - lane : lane;
                const float ig = __shfl(rg, src), lf = __shfl(rb, src);
                const float bb = wave_incl_scan_add(lf, lane), igb = ig - bb, cm = wave_incl_scan_max(igb, lane);
                sB[lane] = bb; sCM[lane] = cm; sIGB[lane] = igb;
            }
            __syncthreads();
            if (s + 1 < 68) gload(s + 1);
            const float c63 = sCM[63], blast = sB[63], mx63 = fmaxf(m, c63);
            const float cscale = __expf(m - mx63);
            if (s >= 4) {
                const int ib = w >> 1;
                bf16x8 bq[4];
#pragma unroll
                for (int k = 0; k < 4; ++k) bq[k] = frag_row(QIMG, RS128, ib * 16, k * 32, lane);
                const float mxi = fmaxf(m, sCM[ib * 16 + l15]);
#pragma unroll
                for (int t = 0; t < 2; ++t) { const int jb = (w & 1) * 2 + t; f32x4 acc = {0.f, 0.f, 0.f, 0.f};
#pragma unroll
                    for (int k = 0; k < 4; ++k) acc = MFMA16(frag_row(KIMG, RS128, jb * 16, k * 32, lane), bq[k], acc);
                    const int i = ib * 16 + l15;
#pragma unroll
                    for (int r = 0; r < 4; ++r) { const int j = jb * 16 + 4 * g4 + r; acc[r] = (j <= i) ? acc[r] * 0.08838834764831845f * __expf(sIGB[j] - mxi) : 0.f; }
                    tile_write(SM, RS64, ib * 16, jb * 16, lane, acc); }
            }
            for (int pc = tid; pc < 640; pc += NTHREADS) { const int j = pc / 10, o = pc % 10; const float f = __expf(sIGB[j] - mx63);
                float v[8]; unpack8(*(const LAS u32x4*)(VIMG + j * RS80 + o * 16), v);
#pragma unroll
                for (int q = 0; q < 8; ++q) v[q] *= f;
                *(LAS u32x4*)(VS + j * RS80 + o * 16) = pack8(v); }
            __syncthreads();
            if (s >= 4) {
                const int ib = w & 3, eh = w >> 2, i = ib * 16 + l15;
                const float mxi = fmaxf(m, sCM[i]), inter = __expf(m - mxi) * 0.08838834764831845f, floorv = __expf(-(sB[i] + mxi));
                bf16x8 bs[2], bq[4];
#pragma unroll
                for (int k = 0; k < 2; ++k) bs[k] = frag_row(SM, RS64, ib * 16, k * 32, lane);
#pragma unroll
                for (int k = 0; k < 4; ++k) bq[k] = frag_row(QIMG, RS128, ib * 16, k * 32, lane);
                f32x4 val[3];
#pragma unroll
                for (int t = 0; t < 3; ++t) { const int eb = t < 2 ? eh * 2 + t : 4; f32x4 a1 = {0.f, 0.f, 0.f, 0.f}, a2 = {0.f, 0.f, 0.f, 0.f};
#pragma unroll
                    for (int k = 0; k < 2; ++k) a1 = MFMA16(frag_tr(VIMG, RS80, eb * 16, k * 32, lane), bs[k], a1);
#pragma unroll
                    for (int k = 0; k < 4; ++k) a2 = MFMA16(frag_row(CT, RS128, eb * 16, k * 32, lane), bq[k], a2);
                    val[t] = a1 + a2 * inter; }
                const float den = __shfl(val[2][0], l15);
                const float dd = 1.f / fmaxf(fabsf(den), floorv);
                const int tl = dir ? 63 - i : i, row0 = chunk_row(b, dir, s);
#pragma unroll
                for (int t = 0; t < 2; ++t) { const int e0 = (eh * 2 + t) * 16 + 4 * g4; u32x2 o; o.x = pk2(val[t][0] * dd, val[t][1] * dd); o.y = pk2(val[t][2] * dd, val[t][3] * dd);
                    *(u32x2*)(Hs + (size_t)dir * ML * D + (size_t)(row0 + tl) * D + h * 256 + cq * 64 + e0) = o; }
            }
            {   bf16x8 ak[2];
#pragma unroll
                for (int k = 0; k < 2; ++k) ak[k] = frag_tr(KIMG, RS128, w * 16, k * 32, lane);
#pragma unroll
                for (int e = 0; e < 5; ++e) { st[e] = st[e] * cscale;
#pragma unroll
                    for (int k = 0; k < 2; ++k) st[e] = MFMA16(ak[k], frag_tr(VS, RS80, e * 16, k * 32, lane), st[e]); }
            }
            m = blast + mx63;
            __syncthreads();
#pragma unroll
            for (int e = 0; e < 5; ++e) tile_write(CT, RS128, e * 16, w * 16, lane, st[e]);
        }
    }
}

__device__ __forceinline__ void gdn_chunk_items(const Ctx& c, int item0, int item_stride, int n_items) {
    const bf16_t* F = (const bf16_t*)(c.ws + WS_F); bf16_t* P = (bf16_t*)(c.ws + WS_P);
    const float* GA = (const float*)(c.ws + WS_GA); const float* GB = (const float*)(c.ws + WS_GB);
    const int lane = c.lane, tid = c.tid, w = c.wave, g4 = lane >> 4, l15 = lane & 15;
    LAS unsigned char* KIMG = c.lds; LAS unsigned char* QIMG = c.lds + 17408; LAS unsigned char* VIMG = c.lds + 34816; LAS unsigned char* ST = c.lds + 44032;
    LAS unsigned char* WIMG = c.lds + 61440; LAS unsigned char* QKM = c.lds + 78848; LAS unsigned char* VNT = c.lds + 88064; LAS unsigned char* VNS = c.lds + 97280;
    LAS unsigned char* TW = c.lds + 106496; LAS unsigned char* TU = c.lds + 115712; LAS float* MF = (LAS float*)(c.lds + 124928); LAS float* TMP = (LAS float*)VNT;
    LAS float* sGC = (LAS float*)(c.lds + 142336); LAS float* sEG = sGC + 64; LAS float* sEL = sGC + 128; LAS float* sBT = sGC + 192; LAS float* sBG = sGC + 256;
    for (int item = item0; item < n_items; item += item_stride) {
        const int chain = item >> 1, eh = item & 1, b = chain >> 4, h = (chain >> 1) & 7, dir = chain & 1;
        f32x4 st[4];
#pragma unroll
        for (int e = 0; e < 4; ++e) st[e] = (f32x4){0.f, 0.f, 0.f, 0.f};
        u32x4 rk[2], rq[2], rv; float rg = 0.f, rb = 0.f;
        auto gload = [&](int s) {
            const int row0 = chunk_row(b, dir, s);
#pragma unroll
            for (int i = 0; i < 2; ++i) { const int pc = tid + i * 512, tk = pc >> 4, o = (pc & 15) * 8;
                rk[i] = *(const u32x4*)(F + (size_t)1 * MT * 1024 + (size_t)(row0 + tk) * 1024 + h * 128 + o);
                rq[i] = *(const u32x4*)(F + (size_t)0 * MT * 1024 + (size_t)(row0 + tk) * 1024 + h * 128 + o); }
            { const int tk = tid >> 3, o = (tid & 7) * 8; rv = *(const u32x4*)(F + (size_t)2 * MT * 1024 + (size_t)(row0 + tk) * 1024 + h * 128 + eh * 64 + o); }
            if (tid < 64) { rg = GA[(size_t)(row0 + tid) * 16 + dir * 8 + h]; rb = GB[(size_t)(row0 + tid) * 16 + dir * 8 + h]; }
        };
        __syncthreads();
        for (int i = tid; i < 64 * 34; i += NTHREADS) ((LAS u32x2*)ST)[i] = (u32x2){0u, 0u};
        gload(0);
#pragma unroll 1
        for (int s = 0; s < 68; ++s) {
#pragma unroll
            for (int i = 0; i < 2; ++i) { const int pc = tid + i * 512, tk = pc >> 4, o = pc & 15, ri = dir ? 63 - tk : tk;
                *(LAS u32x4*)(KIMG + ri * RS128 + o * 16) = rk[i]; *(LAS u32x4*)(QIMG + ri * RS128 + o * 16) = rq[i]; }
            { const int tk = tid >> 3, o = tid & 7, ri = dir ? 63 - tk : tk; *(LAS u32x4*)(VIMG + ri * RS64 + o * 16) = rv; }
            if (w == 0) {
                const int src = dir ? 63 - lane : lane;
                const float gg = __shfl(rg, src), bt = __shfl(rb, src);
                const float gc = wave_incl_scan_add(gg, lane), gl = __shfl(gc, 63), eg = __expf(gc);
                sGC[lane] = gc; sEG[lane] = eg; sEL[lane] = __expf(gl - gc); sBT[lane] = bt; sBG[lane] = bt * eg;
            }
            __syncthreads();
            if (s + 1 < 68) gload(s + 1);
            {   const int ib = w >> 1, i = ib * 16 + l15; const float gci = sGC[i], bti = sBT[i];
                bf16x8 bk[4], bq[4];
#pragma unroll
                for (int k = 0; k < 4; ++k) { bk[k] = frag_row(KIMG, RS128, ib * 16, k * 32, lane); bq[k] = frag_row(QIMG, RS128, ib * 16, k * 32, lane); }
#pragma unroll
                for (int t = 0; t < 2; ++t) { const int jb = (w & 1) * 2 + t; f32x4 a1 = {0.f, 0.f, 0.f, 0.f}, a2 = {0.f, 0.f, 0.f, 0.f};
#pragma unroll
                    for (int k = 0; k < 4; ++k) { const bf16x8 aj = frag_row(KIMG, RS128, jb * 16, k * 32, lane); a1 = MFMA16(aj, bk[k], a1); a2 = MFMA16(aj, bq[k], a2); }
                    f32x4 mv;
#pragma unroll
                    for (int r = 0; r < 4; ++r) { const int j = jb * 16 + 4 * g4 + r; const float dec = __expf(gci - sGC[j]);
                        mv[r] = (j < i) ? bti * a1[r] * dec : 0.f; a2[r] = (j <= i) ? a2[r] * dec : 0.f; }
                    *(LAS f32x4*)(MF + i * MS + jb * 16 + 4 * g4) = mv;
                    tile_write(QKM, RS64, ib * 16, jb * 16, lane, a2); }
            }
            __syncthreads();
            tri_inverse_64(MF, TMP, tid);
            {   const int i = tid >> 3, j8 = (tid & 7) * 8; float tw[8], tu[8];
#pragma unroll
                for (int q = 0; q < 8; ++q) { const float x = MF[i * MS + j8 + q]; tw[q] = x * sBG[j8 + q]; tu[q] = x * sBT[j8 + q]; }
                *(LAS u32x4*)(TW + i * RS64 + j8 * 2) = pack8(tw); *(LAS u32x4*)(TU + i * RS64 + j8 * 2) = pack8(tu); }
            __syncthreads();
            f32x4 ut[2];
            {   const int ib = w >> 1;
                bf16x8 au[2];
#pragma unroll
                for (int k = 0; k < 2; ++k) au[k] = frag_row(TU, RS64, ib * 16, k * 32, lane);
#pragma unroll
                for (int t = 0; t < 2; ++t) { const int eb = (w & 1) * 2 + t; ut[t] = (f32x4){0.f, 0.f, 0.f, 0.f};
#pragma unroll
                    for (int k = 0; k < 2; ++k) ut[t] = MFMA16(au[k], frag_tr(VIMG, RS64, eb * 16, k * 32, lane), ut[t]); }
                bf16x8 akt[2];
#pragma unroll
                for (int k = 0; k < 2; ++k) akt[k] = frag_tr(KIMG, RS128, w * 16, k * 32, lane);
#pragma unroll
                for (int i2 = 0; i2 < 4; ++i2) { f32x4 a = {0.f, 0.f, 0.f, 0.f};
#pragma unroll
                    for (int k = 0; k < 2; ++k) a = MFMA16(akt[k], frag_row(TW, RS64, i2 * 16, k * 32, lane), a);
                    tile_write(WIMG, RS128, i2 * 16, w * 16, lane, a); }
            }
            __syncthreads();
            {   const int ib = w >> 1;
                bf16x8 aw[4];
#pragma unroll
                for (int k = 0; k < 4; ++k) aw[k] = frag_row(WIMG, RS128, ib * 16, k * 32, lane);
#pragma unroll
                for (int t = 0; t < 2; ++t) { const int eb = (w & 1) * 2 + t; f32x4 a = {0.f, 0.f, 0.f, 0.f};
#pragma unroll
                    for (int k = 0; k < 4; ++k) a = MFMA16(aw[k], frag_row(ST, RS128, eb * 16, k * 32, lane), a);
                    f32x4 vn = ut[t] - a, vs;
#pragma unroll
                    for (int r = 0; r < 4; ++r) vs[r] = vn[r] * sEL[ib * 16 + 4 * g4 + r];
                    tile_write(VNT, RS64, eb * 16, ib * 16, lane, vn); tile_write(VNS, RS64, eb * 16, ib * 16, lane, vs); }
            }
            __syncthreads();
            {   const int eb = w >> 1, row0 = chunk_row(b, dir, s);
                bf16x8 as[4], av[2];
#pragma unroll
                for (int k = 0; k < 4; ++k) as[k] = frag_row(ST, RS128, eb * 16, k * 32, lane);
#pragma unroll
                for (int k = 0; k < 2; ++k) av[k] = frag_row(VNT, RS64, eb * 16, k * 32, lane);
#pragma unroll
                for (int t = 0; t < 2; ++t) { const int ib = (w & 1) * 2 + t, i = ib * 16 + l15; f32x4 a = {0.f, 0.f, 0.f, 0.f};
#pragma unroll
                    for (int k = 0; k < 4; ++k) a = MFMA16(as[k], frag_row(QIMG, RS128, ib * 16, k * 32, lane), a);
                    a = a * sEG[i];
#pragma unroll
                    for (int k = 0; k < 2; ++k) a = MFMA16(av[k], frag_row(QKM, RS64, ib * 16, k * 32, lane), a);
                    const int tl = dir ? 63 - i : i; u32x2 o; o.x = pk2(a[0], a[1]); o.y = pk2(a[2], a[3]);
                    *(u32x2*)(P + (size_t)(row0 + tl) * PW0 + (4 + dir) * 1024 + h * 128 + eh * 64 + eb * 16 + 4 * g4) = o; }
                const float al = __expf(sGC[63]);
                bf16x8 akt[2];
#pragma unroll
                for (int k = 0; k < 2; ++k) akt[k] = frag_tr(KIMG, RS128, w * 16, k * 32, lane);
#pragma unroll
                for (int e = 0; e < 4; ++e) { st[e] = st[e] * al;
#pragma unroll
                    for (int k = 0; k < 2; ++k) st[e] = MFMA16(akt[k], frag_row(VNS, RS64, e * 16, k * 32, lane), st[e]); }
            }
            __syncthreads();
#pragma unroll
            for (int e = 0; e < 4; ++e) tile_write(ST, RS128, e * 16, w * 16, lane, st[e]);
        }
    }
}

__device__ __forceinline__ void rwkv_chunk_items(const Ctx& c, int item0, int item_stride, int n_items, bf16_t* Ybase, long ydir_stride, int ystride) {
    const bf16_t* F = (const bf16_t*)(c.ws + WS_F); const bf16_t* P = (const bf16_t*)(c.ws + WS_P);
    const int lane = c.lane, tid = c.tid, w = c.wave, g4 = lane >> 4, l15 = lane & 15;
    LAS unsigned char* KKP = c.lds; LAS unsigned char* RP = c.lds + 9216; LAS unsigned char* KTD = c.lds + 18432; LAS unsigned char* KADN = c.lds + 27648;
    LAS unsigned char* VIMG = c.lds + 36864; LAS unsigned char* ST = c.lds + 46080; LAS unsigned char* ART = c.lds + 55296; LAS unsigned char* ARAN = c.lds + 64512;
    LAS unsigned char* TI = c.lds + 73728; LAS unsigned char* KTI = c.lds + 82944; LAS unsigned char* KAI = c.lds + 92160; LAS unsigned char* AKT = c.lds + 101376;
    LAS unsigned char* TMPVT = KTI; LAS unsigned char* WK = KAI; LAS unsigned char* UT = AKT;
    LAS float* MF = (LAS float*)(c.lds + 110592); LAS float* LP = MF; LAS float* TMP = (LAS float*)(c.lds + 128000); LAS float* sPC = (LAS float*)(c.lds + 132096);
    for (int item = item0; item < n_items; item += item_stride) {
        const int chain = item, b = chain >> 5, h = (chain >> 1) & 15, dir = chain & 1;
        f32x4 st[2] = {{0.f, 0.f, 0.f, 0.f}, {0.f, 0.f, 0.f, 0.f}};
        const int tk = tid >> 3, o8 = tid & 7, ri = dir ? 63 - tk : tk;
        float kav[8];
        { const f32x4 k0 = *(const f32x4*)(c.in[IN_KA] + h * 64 + o8 * 8), k1 = *(const f32x4*)(c.in[IN_KA] + h * 64 + o8 * 8 + 4);
          kav[0] = k0.x; kav[1] = k0.y; kav[2] = k0.z; kav[3] = k0.w; kav[4] = k1.x; kav[5] = k1.y; kav[6] = k1.z; kav[7] = k1.w; }
        u32x4 rr[5], rv;
        auto gload = [&](int s) {
            const int row0 = chunk_row(b, dir, s); const int o = o8 * 8;
            rr[0] = *(const u32x4*)(F + (size_t)3 * MT * 1024 + (size_t)(row0 + tk) * 1024 + h * 64 + o);
            rr[1] = *(const u32x4*)(F + (size_t)4 * MT * 1024 + (size_t)(row0 + tk) * 1024 + h * 64 + o);
            rr[2] = *(const u32x4*)(F + (size_t)5 * MT * 1024 + (size_t)(row0 + tk) * 1024 + h * 64 + o);
            rr[3] = *(const u32x4*)(P + (size_t)(row0 + tk) * PW0 + (0 + dir) * 1024 + h * 64 + o);
            rr[4] = *(const u32x4*)(P + (size_t)(row0 + tk) * PW0 + (2 + dir) * 1024 + h * 64 + o);
            rv = *(const u32x4*)(F + (size_t)6 * MT * 1024 + (size_t)(row0 + tk) * 1024 + h * 64 + o);
        };
        __syncthreads();
        for (int i = tid; i < 64 * 18; i += NTHREADS) ((LAS u32x2*)ST)[i] = (u32x2){0u, 0u};
        gload(0);
#pragma unroll 1
        for (int s = 0; s < 68; ++s) {
            float lwf[8]; unpack8(rr[3], lwf);
            *(LAS f32x4*)(LP + ri * 64 + o8 * 8) = (f32x4){lwf[0], lwf[1], lwf[2], lwf[3]}; *(LAS f32x4*)(LP + ri * 64 + o8 * 8 + 4) = (f32x4){lwf[4], lwf[5], lwf[6], lwf[7]};
            __syncthreads();
            {   const int k = tid & 63, seg = tid >> 6; float x[8]; float run = 0.f;
#pragma unroll
                for (int i = 0; i < 8; ++i) { run += LP[(seg * 8 + i) * 64 + k]; x[i] = run; }
                TMP[seg * 64 + k] = run;
                __syncthreads();
                float off = 0.f;
#pragma unroll
                for (int q = 0; q < 8; ++q) off += (q < seg) ? TMP[q * 64 + k] : 0.f;
#pragma unroll
                for (int i = 0; i < 8; ++i) LP[(seg * 8 + i) * 64 + k] = x[i] + off;
            }
            __syncthreads();
            {
                float rf[8], kkf[8], kbf[8], af[8], lp[8], lpm[8], lpc[8];
                unpack8(rr[0], rf); unpack8(rr[1], kkf); unpack8(rr[2], kbf); unpack8(rr[4], af);
#pragma unroll
                for (int q = 0; q < 8; ++q) { lp[q] = LP[ri * 64 + o8 * 8 + q]; lpm[q] = ri > 0 ? LP[(ri - 1) * 64 + o8 * 8 + q] : 0.f; lpc[q] = LP[63 * 64 + o8 * 8 + q]; }
                float i0[8], i1[8], i2[8], i3[8], i4[8], i5[8];
#pragma unroll
                for (int q = 0; q < 8; ++q) { const float kt = kbf[q] * (1.f + (af[q] - 1.f) * kav[q]), kka = kkf[q] * af[q];
                    const float ei = __expf(-lp[q]), ed = __expf(lpc[q] - lp[q]);
                    i0[q] = kkf[q] * __expf(lpm[q]); i1[q] = rf[q] * __expf(lp[q]); i2[q] = kt * ei; i3[q] = kka * ei; i4[q] = kt * ed; i5[q] = -kka * ed; }
                const int off = ri * RS64 + o8 * 16;
                *(LAS u32x4*)(KKP + off) = pack8(i0); *(LAS u32x4*)(RP + off) = pack8(i1); *(LAS u32x4*)(KTI + off) = pack8(i2); *(LAS u32x4*)(KAI + off) = pack8(i3);
                *(LAS u32x4*)(KTD + off) = pack8(i4); *(LAS u32x4*)(KADN + off) = pack8(i5); *(LAS u32x4*)(VIMG + off) = rv;
                if (ri == 63) {
#pragma unroll
                    for (int q = 0; q < 8; ++q) sPC[o8 * 8 + q] = __expf(lpc[q]); }
            }
            __syncthreads();
            if (s + 1 < 68) gload(s + 1);
            {   const int tb = w >> 1, t = tb * 16 + l15;
                bf16x8 bkk[2], brp[2];
#pragma unroll
                for (int k = 0; k < 2; ++k) { bkk[k] = frag_row(KKP, RS64, tb * 16, k * 32, lane); brp[k] = frag_row(RP, RS64, tb * 16, k * 32, lane); }
#pragma unroll
                for (int q = 0; q < 2; ++q) { const int sb = (w & 1) * 2 + q; f32x4 aka = {0.f, 0.f, 0.f, 0.f}, akt = aka, ara = aka, art = aka;
#pragma unroll
                    for (int k = 0; k < 2; ++k) { const bf16x8 fa = frag_row(KAI, RS64, sb * 16, k * 32, lane), ft = frag_row(KTI, RS64, sb * 16, k * 32, lane);
                        aka = MFMA16(fa, bkk[k], aka); akt = MFMA16(ft, bkk[k], akt); ara = MFMA16(fa, brp[k], ara); art = MFMA16(ft, brp[k], art); }
#pragma unroll
                    for (int r = 0; r < 4; ++r) { const int ss = sb * 16 + 4 * g4 + r;
                        aka[r] = ss < t ? aka[r] : 0.f; akt[r] = ss < t ? akt[r] : 0.f; ara[r] = ss <= t ? -ara[r] : 0.f; art[r] = ss <= t ? art[r] : 0.f; }
                    tile_write(AKT, RS64, tb * 16, sb * 16, lane, akt); tile_write(ARAN, RS64, tb * 16, sb * 16, lane, ara); tile_write(ART, RS64, tb * 16, sb * 16, lane, art);
                    *(LAS f32x4*)(MF + t * MS + sb * 16 + 4 * g4) = aka; }
            }
            __syncthreads();
            tri_inverse_64(MF, TMP, tid);
            {   const int i = tid >> 3, j8 = (tid & 7) * 8; float x[8];
#pragma unroll
                for (int q = 0; q < 8; ++q) x[q] = MF[i * MS + j8 + q];
                *(LAS u32x4*)(TI + i * RS64 + j8 * 2) = pack8(x); }
            __syncthreads();
            f32x4 y0[2], u0[2];
            {   const int hb = w >> 1;
                bf16x8 aa[2], akk[2], av[2];
#pragma unroll
                for (int k = 0; k < 2; ++k) { aa[k] = frag_row(AKT, RS64, hb * 16, k * 32, lane); akk[k] = frag_tr(KKP, RS64, hb * 16, k * 32, lane); av[k] = frag_tr(VIMG, RS64, hb * 16, k * 32, lane); }
#pragma unroll
                for (int q = 0; q < 2; ++q) { const int ob = (w & 1) * 2 + q; f32x4 a = {0.f, 0.f, 0.f, 0.f}, bq = a; y0[q] = a;
#pragma unroll
                    for (int k = 0; k < 2; ++k) { a = MFMA16(aa[k], frag_tr(VIMG, RS64, ob * 16, k * 32, lane), a);
                        const bf16x8 fti = frag_row(TI, RS64, ob * 16, k * 32, lane);
                        bq = MFMA16(akk[k], fti, bq);
                        y0[q] = MFMA16(av[k], frag_row(ART, RS64, ob * 16, k * 32, lane), y0[q]); }
                    tile_write(TMPVT, RS64, ob * 16, hb * 16, lane, a); tile_write(WK, RS64, ob * 16, hb * 16, lane, bq); }
            }
            __syncthreads();
            {   const int tb = w >> 1;
                bf16x8 at[2], awk[2];
#pragma unroll
                for (int k = 0; k < 2; ++k) { at[k] = frag_row(TI, RS64, tb * 16, k * 32, lane); awk[k] = frag_row(WK, RS64, tb * 16, k * 32, lane); }
#pragma unroll
                for (int q = 0; q < 2; ++q) { const int vb = (w & 1) * 2 + q; u0[q] = (f32x4){0.f, 0.f, 0.f, 0.f};
#pragma unroll
                    for (int k = 0; k < 2; ++k) { u0[q] = MFMA16(at[k], frag_row(TMPVT, RS64, vb * 16, k * 32, lane), u0[q]); u0[q] = MFMA16(awk[k], frag_row(ST, RS64, vb * 16, k * 32, lane), u0[q]); }
                }
            }
            {   const int tb = w >> 1;
#pragma unroll
                for (int q = 0; q < 2; ++q) tile_write(UT, RS64, ((w & 1) * 2 + q) * 16, tb * 16, lane, u0[q]); }
            __syncthreads();
            {   const int hb = w >> 1, row0 = chunk_row(b, dir, s);
                bf16x8 as[2], au[2], aktd[2], akad[2];
#pragma unroll
                for (int k = 0; k < 2; ++k) { as[k] = frag_row(ST, RS64, hb * 16, k * 32, lane); au[k] = frag_row(UT, RS64, hb * 16, k * 32, lane);
                    aktd[k] = frag_tr(KTD, RS64, hb * 16, k * 32, lane); akad[k] = frag_tr(KADN, RS64, hb * 16, k * 32, lane); }
#pragma unroll
                for (int q = 0; q < 2; ++q) { const int ob = (w & 1) * 2 + q; f32x4 a = y0[q];
#pragma unroll
                    for (int k = 0; k < 2; ++k) { a = MFMA16(as[k], frag_row(RP, RS64, ob * 16, k * 32, lane), a); a = MFMA16(au[k], frag_row(ARAN, RS64, ob * 16, k * 32, lane), a); }
                    const int t = ob * 16 + l15, tl = dir ? 63 - t : t; u32x2 o; o.x = pk2(a[0], a[1]); o.y = pk2(a[2], a[3]);
                    *(u32x2*)(Ybase + (long)dir * ydir_stride + (size_t)(row0 + tl) * ystride + h * 64 + hb * 16 + 4 * g4) = o;
#pragma unroll
                    for (int r = 0; r < 4; ++r) st[q][r] *= sPC[hb * 16 + 4 * g4 + r];
#pragma unroll
                    for (int k = 0; k < 2; ++k) { st[q] = MFMA16(aktd[k], frag_tr(VIMG, RS64, ob * 16, k * 32, lane), st[q]); st[q] = MFMA16(akad[k], frag_row(UT, RS64, ob * 16, k * 32, lane), st[q]); } }
            }
            __syncthreads();
            {   const int hb = w >> 1;
#pragma unroll
                for (int q = 0; q < 2; ++q) tile_write(ST, RS64, ((w & 1) * 2 + q) * 16, hb * 16, lane, st[q]); }
        }
    }
}

#ifndef USE_CHUNK_ML
#define USE_CHUNK_ML 1
#endif
#ifndef USE_CHUNK_GDN
#define USE_CHUNK_GDN 1
#endif
#ifndef USE_CHUNK_RWKV
#define USE_CHUNK_RWKV 1
#endif
struct Args { const float* in[32]; float* out; unsigned char* ws; int ph_lo, ph_hi; };
constexpr int NPHASE = 24;
__global__ void __launch_bounds__(NTHREADS, 2) fwd_kernel(Args args) {
    extern __shared__ __attribute__((aligned(16))) unsigned char lds_raw[];
    Ctx c;
    c.lds = (LAS unsigned char*)lds_raw;
    c.tid = threadIdx.x; c.lane = c.tid & 63; c.wave = __builtin_amdgcn_readfirstlane(c.tid >> 6);
    c.G = gridDim.x; c.wg = blockIdx.x; c.gw = c.wg * NWAVES + c.wave; c.NGW = c.G * NWAVES;
#pragma unroll
    for (int i = 0; i < 32; ++i) c.in[i] = args.in[i];
    c.out = args.out; c.ws = args.ws;
    const int lo = args.ph_lo, hi = args.ph_hi;
    volatile LAS unsigned* bst = (volatile LAS unsigned*)(c.lds + LDS_BAR_OFF);
    if (c.tid < 4) bst[c.tid] = 0u;
    __syncthreads();
    XcdBarrier bar; bar.bar = (unsigned*)(c.ws + WS_CTL); bar.x = 0; bar.st = bst;
    if (hi - lo > 1) bar = xcd_barrier_post((unsigned*)(c.ws + WS_CTL), bst);
#define IN(k) (lo <= (k) && (k) < hi)
#ifndef REPEAT_MASK
#define REPEAT_MASK 0u
#endif
#define REP(k) for (int _rep = 0; _rep < (((REPEAT_MASK >> (k)) & 1u) ? 2 : 1); ++_rep)
#define SEAM(k) do { if (IN(k) && IN((k) + 1)) xcd_barrier(bar); } while (0)
    float* MOD = (float*)(c.ws + WS_MOD);
    float* XC = (float*)(c.ws + WS_XC);
    bf16_t* HY = (bf16_t*)(c.ws + WS_HY); bf16_t* Pb = (bf16_t*)(c.ws + WS_P); float* TL = (float*)(c.ws + WS_TAIL);
    bf16_t* Win = (bf16_t*)(c.ws + WS_WIN); bf16_t* Wout = (bf16_t*)(c.ws + WS_WOUT); bf16_t* W13 = (bf16_t*)(c.ws + WS_W13); bf16_t* W2 = (bf16_t*)(c.ws + WS_W2);
    const float* X = c.in[IN_X]; const float* CX = c.in[IN_CTX];

    if (IN(0)) REP(0) { ada_phase(c); __syncthreads(); convert_weights(c, 0); __syncthreads(); }
    SEAM(0);
    if (IN(1)) REP(1) norm_mod_phase(c, X, CX, c.in[IN_NORMW], MOD, 0, D, MT);
    SEAM(1);
    if (IN(2)) { pg8::Gemm g{HY, Win, MT, NIN0, D}; pg8::StaticOrder S; S.init(MT, NIN0, c.G, c.wg); EpiInProj E{Pb, PW0, PW0 / 256, TL, TW0};
        pg8::gemm_phase<EpiInProj, pg8::StaticOrder>(c.lds, g, S, E); }
    SEAM(2);
    if (IN(3)) REP(3) ab_feature_phase(c);
    SEAM(3);
    if (IN(4)) REP(4) rw_lora_phase(c);
    SEAM(4);
    if (IN(5)) REP(5) {
        gdn_chunk_items(c, c.wg, c.G, 128);
        rwkv_chunk_items(c, (c.wg + c.G / 2) % c.G, c.G, 128, HY + 1024, -1024L, D); }
    SEAM(5);
    SEAM(6);
    if (IN(7)) REP(7) ab_output_phase(c);
    SEAM(7);
    if (IN(8)) { pg8::Gemm g{HY, Wout, MT, D, D}; pg8::StaticOrder S; S.init(MT, D, c.G, c.wg); EpiResid E{X, CX, c.out, XC, MOD + 2 * D};
        pg8::gemm_phase<EpiResid, pg8::StaticOrder>(c.lds, g, S, E); }
    SEAM(8);
    if (IN(9)) REP(9) norm_mod_phase(c, c.out, XC, c.in[IN_NORMW] + D, MOD, 3 * D, 4 * D, MT);
    SEAM(9);
    if (IN(10)) { pg8::Gemm g{HY, W13, MT, 2 * FF, D}; pg8::StaticOrder S; S.init(MT, 2 * FF, c.G, c.wg); EpiSwiGLU E{Pb, FF};
        pg8::gemm_phase<EpiSwiGLU, pg8::StaticOrder>(c.lds, g, S, E); }
    SEAM(10);
    if (IN(11)) { pg8::Gemm g{Pb, W2, MT, D, FF}; pg8::StaticOrder S; S.init(MT, D, c.G, c.wg); EpiResid E{c.out, XC, c.out, XC, MOD + 5 * D};
        pg8::gemm_phase<EpiResid, pg8::StaticOrder>(c.lds, g, S, E); }
    SEAM(11);
    if (IN(12)) REP(12) { convert_weights(c, 1); norm_mod_phase(c, c.out, XC, c.in[IN_NORMW] + 2 * D, MOD + 5 * MODW, 0, D, MT); }
    SEAM(12);
    if (IN(13)) { pg8::Gemm g{HY, Win, MT, NIN1, D}; pg8::StaticOrder S; S.init(MT, NIN1, c.G, c.wg); EpiInProj E{Pb, PW1, PW1 / 256, TL, TW1};
        pg8::gemm_phase<EpiInProj, pg8::StaticOrder>(c.lds, g, S, E); }
    SEAM(13);
    if (IN(14)) REP(14) ml_gate_phase(c);
    SEAM(14);
    if (IN(15)) REP(15) { if (USE_CHUNK_ML) mlstm_chunk_phase(c); else mlstm_scan_phase(c); }
    SEAM(15);
    if (IN(16)) REP(16) ml_output_phase(c);
    SEAM(16);
    if (IN(17)) { pg8::Gemm g{HY, Wout, ML, D, D}; pg8::StaticOrder S; S.init(ML, D, c.G, c.wg); EpiResid E{c.out, XC, c.out, XC, MOD + 5 * MODW + 2 * D};
        pg8::gemm_phase<EpiResid, pg8::StaticOrder>(c.lds, g, S, E); }
    SEAM(17);
    if (IN(18)) REP(18) norm_mod_phase(c, c.out, XC, c.in[IN_NORMW] + 3 * D, MOD + 5 * MODW, 3 * D, 4 * D, ML);
    SEAM(18);
    if (IN(19)) { pg8::Gemm g{HY, W13, ML, 2 * FF, D}; pg8::StaticOrder S; S.init(ML, 2 * FF, c.G, c.wg); EpiSwiGLU E{Pb, FF};
        pg8::gemm_phase<EpiSwiGLU, pg8::StaticOrder>(c.lds, g, S, E); }
    SEAM(19);
    if (IN(20)) { pg8::Gemm g{Pb, W2, ML, D, FF}; pg8::StaticOrder S; S.init(ML, D, c.G, c.wg); EpiResid E{c.out, XC, c.out, XC, MOD + 5 * MODW + 5 * D};
        pg8::gemm_phase<EpiResid, pg8::StaticOrder>(c.lds, g, S, E); }
    SEAM(20);
    if (IN(21)) final_norm_phase(c);
#undef IN
#undef SEAM
}

#ifndef N_LAUNCH_MODE
#define N_LAUNCH_MODE 1
#endif
extern "C" void kernel_launch(void* const* d_in, const int* in_sizes, int n_in, void* d_out, int out_size, void* d_ws, size_t ws_size, hipStream_t stream) {
    static int grid = 0;
    if (grid == 0) {
        if (n_in != 32 || out_size != ML * D || ws_size < WS_END) { fprintf(stderr, "kernel_launch: unexpected problem (n_in %d out %d ws %zu)\n", n_in, out_size, ws_size); grid = -1; return; }
        int dev = 0, cus = 0;
        if (hipGetDevice(&dev) != hipSuccess || hipDeviceGetAttribute(&cus, hipDeviceAttributeMultiprocessorCount, dev) != hipSuccess) { grid = -1; return; }
        if (hipFuncSetAttribute((const void*)fwd_kernel, hipFuncAttributeMaxDynamicSharedMemorySize, LDS_BYTES) != hipSuccess) { grid = -1; return; }
        int per_cu = 0;
        if (hipOccupancyMaxActiveBlocksPerMultiprocessor(&per_cu, (const void*)fwd_kernel, NTHREADS, LDS_BYTES) != hipSuccess || per_cu < 1) { fprintf(stderr, "kernel_launch: occupancy query says %d\n", per_cu); }
        (void)hipGetLastError();
        grid = cus;
    }
    if (grid < 0) return;
    (void)hipMemsetAsync((char*)d_ws + WS_CTL, 0, CTL_BYTES, stream);
    Args a{};
    for (int i = 0; i < 32; ++i) a.in[i] = (const float*)d_in[i];
    a.out = (float*)d_out; a.ws = (unsigned char*)d_ws;
#if N_LAUNCH_MODE == 1
    a.ph_lo = 0; a.ph_hi = NPHASE;
    hipLaunchKernelGGL(fwd_kernel, dim3(grid), dim3(NTHREADS), LDS_BYTES, stream, a);
#else
    for (int p = 0; p < 22; ++p) { a.ph_lo = p; a.ph_hi = p + 1; hipLaunchKernelGGL(fwd_kernel, dim3(grid), dim3(NTHREADS), LDS_BYTES, stream, a); }
#endif
}
```

```cpp
#include <hip/hip_runtime.h>
#include <cstdio>
#include <cstdint>
#define LAS __attribute__((address_space(3)))
#define GAS __attribute__((address_space(1)))
#define XB_TMO      128
#define XB_XCNT(j)  (256  + 64 * (j))
#define XB_XSUB(j)  (1280 + 64 * (j))
#define XB_XGEN(j)  (2304 + 64 * (j))
#define XB_TOP      3328
#define XB_TOPGEN   3392
#define XCD_BAR_WORDS 3456
#define XB_SPIN_CAP (1u << 20)

__device__ __forceinline__ unsigned xb_ld(unsigned* p)              { return __hip_atomic_load(p, __ATOMIC_RELAXED, __HIP_MEMORY_SCOPE_AGENT); }
__device__ __forceinline__ unsigned xb_add(unsigned* p, unsigned v) { return __hip_atomic_fetch_add(p, v, __ATOMIC_RELAXED, __HIP_MEMORY_SCOPE_AGENT); }
__device__ __forceinline__ unsigned xb_xcc_id() { return (unsigned)__builtin_amdgcn_s_getreg((3 << 11) | 20) & 0xFu; }
#define XB_SPIN(cond, bar) do { unsigned _sp = 0; while (cond) { __builtin_amdgcn_s_sleep(1); \
    if ((++_sp & 255u) == 0u) { if (xb_ld(&(bar)[XB_TMO])) break; if (_sp > XB_SPIN_CAP) { atomicAdd(&(bar)[XB_TMO], 1u); break; } } } } while (0)

struct XcdBarrier {
    unsigned* bar; unsigned x;
    volatile LAS unsigned* st;
};

__device__ __forceinline__ XcdBarrier xcd_barrier_post(unsigned* bar, volatile LAS unsigned* st) {
    XcdBarrier b; b.bar = bar; b.x = xb_xcc_id(); b.st = st;
    if (threadIdx.x == 0) (void)xb_add(&bar[XB_XCNT(b.x)], 1u);
    return b;
}
__device__ __forceinline__ void xcd_barrier_complete(unsigned* bar, unsigned x, unsigned& nloc, unsigned& nx) {
    const unsigned G = gridDim.x * gridDim.y * gridDim.z;
    unsigned sum, cnt, mine, sp = 0u;
    for (;;) {
        sum = 0u; cnt = 0u; mine = 0u;
#pragma unroll
        for (unsigned j = 0; j < 16; ++j) { const unsigned c = xb_ld(&bar[XB_XCNT(j)]); sum += c; cnt += (c > 0u) ? 1u : 0u; mine = (j == x) ? c : mine; }
        if (sum == G) break;
        __builtin_amdgcn_s_sleep(1);
        if ((++sp & 255u) == 0u) { if (xb_ld(&bar[XB_TMO])) break; if (sp > XB_SPIN_CAP) { atomicAdd(&bar[XB_TMO], 1u); break; } }
    }
    nloc = mine > 0u ? mine : 1u; nx = cnt > 0u ? cnt : 1u;
}

__device__ __forceinline__ void xcd_barrier(const XcdBarrier& b) {
    asm volatile("s_waitcnt vmcnt(0)" ::: "memory");
    __syncthreads();
    if (threadIdx.x == 0) {
        unsigned* bar = b.bar;
        __builtin_amdgcn_s_waitcnt(0);
        unsigned nloc = b.st[0], nx = b.st[1];
        if (nloc == 0u) { xcd_barrier_complete(bar, b.x, nloc, nx); b.st[0] = nloc; b.st[1] = nx; }
        const unsigned old = xb_add(&bar[XB_XSUB(b.x)], 1u);
        const unsigned gen = old / nloc;
        if (old + 1u == (gen + 1u) * nloc) {
            __builtin_amdgcn_fence(__ATOMIC_RELEASE, "agent");
            asm volatile("s_waitcnt vmcnt(0)" ::: "memory");
            const unsigned og = xb_add(&bar[XB_TOP], 1u);
            const unsigned tg = og / nx;
            if (og + 1u == (tg + 1u) * nx) xb_add(&bar[XB_TOPGEN], 1u);
            else XB_SPIN(xb_ld(&bar[XB_TOPGEN]) == tg, bar);
            __builtin_amdgcn_fence(__ATOMIC_ACQUIRE, "agent");
            xb_add(&bar[XB_XGEN(b.x)], 1u);
            asm volatile("s_waitcnt vmcnt(0)" ::: "memory");
        } else {
            XB_SPIN(xb_ld(&bar[XB_XGEN(b.x)]) == gen, bar);
            __builtin_amdgcn_fence(__ATOMIC_ACQUIRE, "agent");
            asm volatile("s_waitcnt vmcnt(0)" ::: "memory");
        }
    }
    __syncthreads();
}
#include <hip/hip_runtime.h>
namespace pg8 {
#define PG8_LAS __attribute__((address_space(3)))
typedef unsigned short bf16_t;
typedef short bf16x8 __attribute__((ext_vector_type(8)));
typedef float f32x4 __attribute__((ext_vector_type(4)));
typedef unsigned u32x4 __attribute__((ext_vector_type(4)));
constexpr int BM = 256, BK = 64, HALF = 128, HTB = HALF * BK * 2  , STAGE_BYTES = 8 * HTB, NXCD = 8, WGM = 8;

__host__ __device__ __forceinline__ int lds_byte(int r, int c) { const int st = (r >> 4) * 2 + (c >> 5), rr = r & 15, cc = c & 31, ob = rr * 64 + cc * 2; return st * 1024 + (ob ^ (((ob >> 9) & 1) << 5)); }
__host__ __device__ __forceinline__ void stage_rc(int b, int& R, int& C) { const int st = b / 1024, sb = b % 1024, swz = sb ^ (((sb >> 9) & 1) << 5); R = (st >> 1) * 16 + swz / 64; C = (st & 1) * 32 + (swz % 64) / 2; }
__host__ __device__ __forceinline__ int perm32(int rho) { const int n = rho >> 4, i = rho & 15; return 8 * (i >> 2) + 4 * n + (i & 3); }

struct Unit { int pm, pn; };
struct Gemm { const bf16_t* A; const bf16_t* Bt; int M, N, K; };

struct StaticOrder {
    int nM, nN, nwg, G, c;
    __host__ __device__ void init(int M, int N, int G_, int c_) { nM = M / BM; nN = N / BM; nwg = nM * nN; G = G_; c = c_; }
    __host__ __device__ bool next(int i, Unit& u) const {
        const long L = (long)i * G + c; if (L >= nwg) return false;
        int wgid = (int)L; { const int q = nwg / NXCD, r = nwg % NXCD, xcd = wgid % NXCD, off = wgid / NXCD; wgid = (xcd < r ? xcd * (q + 1) : r * (q + 1) + (xcd - r) * q) + off; }
        const int nig = WGM * nN, gid = wgid / nig, fm = gid * WGM, gsz = (nM - fm) < WGM ? (nM - fm) : WGM;
        u.pm = fm + ((wgid % nig) % gsz); u.pn = (wgid % nig) / gsz; return true;
    }
    __device__ __forceinline__ void a_ready(const Unit&) const {}
    __device__ __forceinline__ void done(const Unit&) const {}
};
template <class Epi, class Sched>
__device__ __forceinline__ void gemm_phase(PG8_LAS unsigned char* lds, const Gemm g, const Sched& S, const Epi& E) {
    const int tid = threadIdx.x, wid = __builtin_amdgcn_readfirstlane(tid >> 6), lane = tid & 63, wr = wid >> 2, wc = wid & 3, fr = lane & 15, fq = lane >> 4;
    const int K = g.K, nt = K / BK;
    unsigned voffA[2], voffB[2];
#pragma unroll
    for (int i = 0; i < 2; ++i) { int R, C; stage_rc(tid * 16 + i * 8192, R, C); const int Rb = Epi::PERM ? ((R & ~31) + perm32(R & 31)) : R;
        voffA[i] = (unsigned)(R * K + C) * 2u; voffB[i] = (unsigned)(Rb * K + C) * 2u; }
    const size_t kstep = (size_t)(BK * 2);
    const size_t hstep = (size_t)HALF * K * 2;
    const size_t tstep = 2 * hstep;
    const unsigned ldsw = (unsigned)wid * 1024u;
    const int aoff = lds_byte(wr * 64 + fr, fq * 8), boff = lds_byte(wc * 32 + fr, fq * 8);
#define PG8_SA(b, h) (((b) * 2 + (h)) * HTB)
#define PG8_SB(b, h) ((4 + (b) * 2 + (h)) * HTB)
#define PG8_STAGE(bufoff, gbase, voff) do { _Pragma("unroll") for (int _i = 0; _i < 2; ++_i) \
        __builtin_amdgcn_global_load_lds((const unsigned*)((const char*)(gbase) + (voff)[_i]), (PG8_LAS unsigned*)(lds + (bufoff) + ldsw + _i * 8192), 16, 0, 0); } while (0)
#define PG8_LDA(dst, b, h) do { _Pragma("unroll") for (int m = 0; m < 4; ++m) _Pragma("unroll") for (int k = 0; k < 2; ++k) dst[m][k] = *(const PG8_LAS bf16x8*)(lds + PG8_SA(b, h) + aoff + m * 2048 + k * 1024); } while (0)
#define PG8_LDB(dst, b, h) do { _Pragma("unroll") for (int n = 0; n < 2; ++n) _Pragma("unroll") for (int k = 0; k < 2; ++k) dst[n][k] = *(const PG8_LAS bf16x8*)(lds + PG8_SB(b, h) + boff + n * 2048 + k * 1024); } while (0)
#define PG8_MMA(ai, bj, At, Bt) do { __builtin_amdgcn_s_setprio(1); _Pragma("unroll") for (int m = 0; m < 4; ++m) _Pragma("unroll") for (int n = 0; n < 2; ++n) _Pragma("unroll") for (int k = 0; k < 2; ++k) \
        acc[ai][bj][m][n] = __builtin_amdgcn_mfma_f32_16x16x32_bf16(Bt[n][k], At[m][k], acc[ai][bj][m][n], 0, 0, 0); __builtin_amdgcn_s_setprio(0); } while (0)
#define PG8_WAIT_V(n) asm volatile("s_waitcnt vmcnt(" #n ")" ::: "memory")
#define PG8_WAIT_L(n) asm volatile("s_waitcnt lgkmcnt(" #n ")" ::: "memory")
#define PG8_BAR __builtin_amdgcn_s_barrier()
#define PG8_SCHED __builtin_amdgcn_sched_barrier(0)
    Unit cur, nxt; int ui = 0;
    if (!S.next(0, cur)) return;
    f32x4 acc[2][2][4][2];
#pragma unroll
    for (int a = 0; a < 2; ++a)
#pragma unroll
        for (int b = 0; b < 2; ++b)
#pragma unroll
            for (int m = 0; m < 4; ++m)
#pragma unroll
                for (int n = 0; n < 2; ++n) acc[a][b][m][n] = (f32x4){0.f, 0.f, 0.f, 0.f};
    bf16x8 At[4][2], B0[2][2], B1[2][2];
    const char* cA = (const char*)g.A + (size_t)cur.pm * tstep; const char* cB = (const char*)g.Bt + (size_t)cur.pn * tstep;
    S.a_ready(cur);
    PG8_STAGE(PG8_SB(0, 0), cB, voffB); PG8_STAGE(PG8_SA(0, 0), cA, voffA); PG8_STAGE(PG8_SB(0, 1), cB + hstep, voffB); PG8_STAGE(PG8_SA(0, 1), cA + hstep, voffA);
    if (wr == 1) PG8_BAR;
    PG8_WAIT_V(4); PG8_BAR;
    PG8_STAGE(PG8_SB(1, 0), cB + kstep, voffB); PG8_STAGE(PG8_SA(1, 0), cA + kstep, voffA); PG8_STAGE(PG8_SB(1, 1), cB + hstep + kstep, voffB);
    PG8_WAIT_V(6); PG8_BAR;
    for (;;) {
        const bool has_next = S.next(ui + 1, nxt);
        const char* nA = has_next ? (const char*)g.A + (size_t)nxt.pm * tstep : cA; const char* nB = has_next ? (const char*)g.Bt + (size_t)nxt.pn * tstep : cB;
        for (int t = 0; t < nt; t += 2) {
            const bool last = (t == nt - 2);
            const char* a1 = cA + (size_t)(t + 1) * kstep;
            const char* a2 = last ? nA : cA + (size_t)(t + 2) * kstep; const char* b2 = last ? nB : cB + (size_t)(t + 2) * kstep;
            const char* a3 = a2 + kstep; const char* b3 = b2 + kstep;
            if (last && has_next) S.a_ready(nxt);
            PG8_LDB(B0, 0, 0); PG8_SCHED; PG8_LDA(At, 0, 0); PG8_STAGE(PG8_SA(1, 1), a1 + hstep, voffA);
            PG8_WAIT_L(8); PG8_BAR; PG8_WAIT_L(0); PG8_MMA(0, 0, At, B0); PG8_BAR; PG8_SCHED;
            PG8_LDB(B1, 0, 1); PG8_STAGE(PG8_SB(0, 0), b2, voffB);
            PG8_BAR; PG8_WAIT_L(0); PG8_MMA(0, 1, At, B1); PG8_BAR;
            PG8_LDA(At, 0, 1); PG8_STAGE(PG8_SA(0, 0), a2, voffA);
            PG8_BAR; PG8_WAIT_L(0); PG8_MMA(1, 0, At, B0); PG8_BAR; PG8_SCHED;
            PG8_STAGE(PG8_SB(0, 1), b2 + hstep, voffB);
            PG8_WAIT_V(6); PG8_BAR; PG8_MMA(1, 1, At, B1); PG8_BAR;
            PG8_LDB(B0, 1, 0); PG8_SCHED; PG8_LDA(At, 1, 0); PG8_STAGE(PG8_SA(0, 1), a2 + hstep, voffA);
            PG8_WAIT_L(8); PG8_BAR; PG8_WAIT_L(0); PG8_MMA(0, 0, At, B0); PG8_BAR; PG8_SCHED;
            PG8_LDB(B1, 1, 1); PG8_STAGE(PG8_SB(1, 0), b3, voffB);
            PG8_BAR; PG8_WAIT_L(0); PG8_MMA(0, 1, At, B1); PG8_BAR;
            PG8_LDA(At, 1, 1); PG8_STAGE(PG8_SA(1, 0), a3, voffA);
            PG8_BAR; PG8_WAIT_L(0); PG8_MMA(1, 0, At, B0); PG8_BAR; PG8_SCHED;
            PG8_STAGE(PG8_SB(1, 1), b3 + hstep, voffB);
            PG8_WAIT_V(6); PG8_BAR; PG8_MMA(1, 1, At, B1); PG8_BAR;
        }
        if constexpr (!Epi::AFTER_DRAIN) { E(acc, cur, wr, wc, fr, fq); S.done(cur); }
        if (!has_next) break;
#pragma unroll
        for (int a = 0; a < 2; ++a)
#pragma unroll
            for (int b = 0; b < 2; ++b)
#pragma unroll
                for (int m = 0; m < 4; ++m)
#pragma unroll
                    for (int n = 0; n < 2; ++n) acc[a][b][m][n] = (f32x4){0.f, 0.f, 0.f, 0.f};
        cur = nxt; cA = nA; cB = nB; ++ui;
    }
    PG8_WAIT_V(0);
    if (wr == 0) PG8_BAR;
    PG8_BAR;
    if constexpr (Epi::AFTER_DRAIN) { E.fused(acc, cur, wr, wc, fr, fq, lds, wid, lane); S.done(cur); }
#undef PG8_SA
#undef PG8_SB
#undef PG8_STAGE
#undef PG8_LDA
#undef PG8_LDB
#undef PG8_MMA
#undef PG8_WAIT_V
#undef PG8_WAIT_L
#undef PG8_BAR
#undef PG8_SCHED
}
}

typedef unsigned short bf16_t;
typedef float f32x4 __attribute__((ext_vector_type(4)));
typedef float f32x2 __attribute__((ext_vector_type(2)));
typedef unsigned u32x4 __attribute__((ext_vector_type(4)));
typedef unsigned u32x2 __attribute__((ext_vector_type(2)));

constexpr int D = 2048, NB = 4, SEQ = 4096, CTXL = 256;
constexpr int ML = NB * SEQ;
constexpr int MC = NB * CTXL;
constexpr int MT = ML + MC;
constexpr int AB_IN = 7616, NIN0 = 7680, PW0 = 7168, TW0 = 512;
constexpr int C_INW = 6176, NIN1 = 6400, PW1 = 6144, TW1 = 256;
constexpr int FF = 5632;
constexpr int MODW = 6 * D;
constexpr int NTHREADS = 512, NWAVES = 8;

constexpr size_t MiB = 1u << 20;
constexpr size_t WS_CTL = 0, CTL_BYTES = 16384;
constexpr size_t WS_MOD = 1 * MiB;
constexpr size_t WS_GA = 2 * MiB, WS_GB = 4 * MiB;
constexpr size_t WS_XC = 6 * MiB;
constexpr size_t WS_HY = 14 * MiB;
constexpr size_t WS_TAIL = 82 * MiB;
constexpr size_t WS_WIN = 116 * MiB;
constexpr size_t WS_WOUT = 146 * MiB;
constexpr size_t WS_W13 = 154 * MiB;
constexpr size_t WS_W2 = 198 * MiB;
constexpr size_t WS_P = 220 * MiB;
constexpr size_t WS_F = 458 * MiB;
constexpr size_t FSLOT = (size_t)MT * 1024 * 2;
constexpr size_t WS_WL = 696 * MiB;
constexpr size_t WS_WG = 698 * MiB;
constexpr size_t WS_END = 700 * MiB;
constexpr size_t WS_A1 = WS_HY, WS_A2 = WS_HY + 16 * MiB;
constexpr size_t WS_GOUT = WS_TAIL;
static_assert(WS_F + 7 * FSLOT <= WS_END, "ws map");
static_assert(WS_HY + (size_t)MT * D * 2 <= WS_TAIL && WS_TAIL + (size_t)MT * TW0 * 4 <= WS_WIN && WS_W2 + (size_t)D * FF * 2 <= WS_P && WS_P + (size_t)MT * PW0 * 2 <= WS_F, "ws map");

constexpr int LDS_BYTES = 147456;
constexpr int LDS_BAR_OFF = LDS_BYTES - 64;

__device__ __forceinline__ float bflo(unsigned u) { return __builtin_bit_cast(float, u << 16); }
__device__ __forceinline__ float bfhi(unsigned u) { return __builtin_bit_cast(float, u & 0xffff0000u); }
__device__ __forceinline__ float bf1(bf16_t h) { return __builtin_bit_cast(float, (unsigned)h << 16); }
__device__ __forceinline__ unsigned f2bf(float f) { unsigned u = __builtin_bit_cast(unsigned, f); return (u + 0x7fffu + ((u >> 16) & 1u)) >> 16; }
__device__ __forceinline__ unsigned pk2(float lo, float hi) { return f2bf(lo) | (f2bf(hi) << 16); }
__device__ __forceinline__ float sigm(float x) { return 1.f / (1.f + expf(-x)); }
__device__ __forceinline__ float sigm_fast(float x) { return 1.f / (1.f + __expf(-x)); }
__device__ __forceinline__ float silu_fast(float x) { return x / (1.f + __expf(-x)); }
__device__ __forceinline__ float softplus_(float x) { return fmaxf(x, 0.f) + log1pf(expf(-fabsf(x))); }
__device__ __forceinline__ float logsigm_(float x) { return fminf(x, 0.f) - log1pf(expf(-fabsf(x))); }
template <int W> __device__ __forceinline__ float grp_sum(float v) {
#pragma unroll
    for (int o = 1; o < W; o <<= 1) v += __shfl_xor(v, o);
    return v;
}
__device__ __forceinline__ void unpack8(const u32x4 u, float (&f)[8]) {
    f[0] = bflo(u.x); f[1] = bfhi(u.x); f[2] = bflo(u.y); f[3] = bfhi(u.y); f[4] = bflo(u.z); f[5] = bfhi(u.z); f[6] = bflo(u.w); f[7] = bfhi(u.w);
}
__device__ __forceinline__ u32x4 pack8(const float (&f)[8]) { u32x4 o; o.x = pk2(f[0], f[1]); o.y = pk2(f[2], f[3]); o.z = pk2(f[4], f[5]); o.w = pk2(f[6], f[7]); return o; }

struct EpiInProj {
    static constexpr bool PERM = true, AFTER_DRAIN = false;
    bf16_t* P; int ldp; int nPt; float* T; int ldt;
    __device__ __forceinline__ void operator()(const pg8::f32x4 (&acc)[2][2][4][2], const pg8::Unit& u, int wr, int wc, int fr, int fq) const {
        const int row0 = u.pm * 256 + wr * 64 + fr;
        if (u.pn < nPt) {
            const int col0 = u.pn * 256 + wc * 32 + 8 * fq;
#pragma unroll
            for (int ai = 0; ai < 2; ++ai)
#pragma unroll
                for (int m = 0; m < 4; ++m) { bf16_t* rowp = P + (size_t)(row0 + ai * 128 + m * 16) * ldp + col0;
#pragma unroll
                    for (int bj = 0; bj < 2; ++bj) { const pg8::f32x4 v0 = acc[ai][bj][m][0], v1 = acc[ai][bj][m][1];
                        u32x4 o; o.x = pk2(v0[0], v0[1]); o.y = pk2(v0[2], v0[3]); o.z = pk2(v1[0], v1[1]); o.w = pk2(v1[2], v1[3]);
                        *(u32x4*)(rowp + bj * 128) = o; } }
        } else {
            const int col0 = (u.pn - nPt) * 256 + wc * 32 + 8 * fq;
#pragma unroll
            for (int ai = 0; ai < 2; ++ai)
#pragma unroll
                for (int m = 0; m < 4; ++m) { float* rowp = T + (size_t)(row0 + ai * 128 + m * 16) * ldt + col0;
#pragma unroll
                    for (int bj = 0; bj < 2; ++bj) { *(pg8::f32x4*)(rowp + bj * 128) = acc[ai][bj][m][0]; *(pg8::f32x4*)(rowp + bj * 128 + 4) = acc[ai][bj][m][1]; } }
        }
    }
};
struct EpiResid {
    static constexpr bool PERM = false, AFTER_DRAIN = false;
    const float* srcL; const float* srcC; float* dstL; float* dstC; const float* gate;
    __device__ __forceinline__ void operator()(const pg8::f32x4 (&acc)[2][2][4][2], const pg8::Unit& u, int wr, int wc, int fr, int fq) const {
        const bool lat = u.pm < 64;
        const int rowl = (lat ? u.pm : u.pm - 64) * 256 + wr * 64 + fr, col0 = u.pn * 256 + wc * 32 + 4 * fq;
        const float* src = lat ? srcL : srcC; float* dst = lat ? dstL : dstC;
        const float* g = gate + (size_t)(lat ? (u.pm >> 4) : 4) * MODW + col0;
        pg8::f32x4 gv[2][2];
#pragma unroll
        for (int bj = 0; bj < 2; ++bj)
#pragma unroll
            for (int n = 0; n < 2; ++n) gv[bj][n] = *(const pg8::f32x4*)(g + bj * 128 + n * 16);
#pragma unroll
        for (int ai = 0; ai < 2; ++ai)
#pragma unroll
            for (int m = 0; m < 4; ++m) { const size_t ro = (size_t)(rowl + ai * 128 + m * 16) * D + col0;
#pragma unroll
                for (int bj = 0; bj < 2; ++bj)
#pragma unroll
                    for (int n = 0; n < 2; ++n) { const pg8::f32x4 s = *(const pg8::f32x4*)(src + ro + bj * 128 + n * 16);
                        *(pg8::f32x4*)(dst + ro + bj * 128 + n * 16) = s + gv[bj][n] * acc[ai][bj][m][n]; } }
    }
};
struct EpiSwiGLU {
    static constexpr bool PERM = true, AFTER_DRAIN = false;
    bf16_t* H; int ldh;
    __device__ __forceinline__ void operator()(const pg8::f32x4 (&acc)[2][2][4][2], const pg8::Unit& u, int wr, int wc, int fr, int fq) const {
        const int row0 = u.pm * 256 + wr * 64 + fr, col0 = u.pn * 128 + wc * 32 + 8 * fq;
#pragma unroll
        for (int ai = 0; ai < 2; ++ai)
#pragma unroll
            for (int m = 0; m < 4; ++m) { float h[8];
#pragma unroll
                for (int n = 0; n < 2; ++n)
#pragma unroll
                    for (int j = 0; j < 4; ++j) h[n * 4 + j] = silu_fast(acc[ai][0][m][n][j]) * acc[ai][1][m][n][j];
                *(u32x4*)(H + (size_t)(row0 + ai * 128 + m * 16) * ldh + col0) = pack8(h); }
    }
};

struct EpiLora {
    static constexpr bool PERM = true, AFTER_DRAIN = false;
    bf16_t* P; int ldp; const float* w0; const float* a0;
    __device__ __forceinline__ void operator()(const pg8::f32x4 (&acc)[2][2][4][2], const pg8::Unit& u, int wr, int wc, int fr, int fq) const {
        const int row0 = u.pm * 256 + wr * 64 + fr, col0 = u.pn * 256 + wc * 32 + 8 * fq;
        const bool isw = u.pn < 8; const float* bp = isw ? w0 + col0 : a0 + (col0 - 2048); const float sc = isw ? -0.6065306597126334f : 1.f;
#pragma unroll
        for (int bj = 0; bj < 2; ++bj) {
            const pg8::f32x4 b0 = *(const pg8::f32x4*)(bp + bj * 128), b1 = *(const pg8::f32x4*)(bp + bj * 128 + 4);
#pragma unroll
            for (int ai = 0; ai < 2; ++ai)
#pragma unroll
                for (int m = 0; m < 4; ++m) { float h[8];
#pragma unroll
                    for (int j = 0; j < 4; ++j) { h[j] = sc * sigm_fast(acc[ai][bj][m][0][j] + b0[j]); h[4 + j] = sc * sigm_fast(acc[ai][bj][m][1][j] + b1[j]); }
                    *(u32x4*)(P + (size_t)(row0 + ai * 128 + m * 16) * ldp + col0 + bj * 128) = pack8(h); } }
    }
};
struct EpiBf16Plain {
    static constexpr bool PERM = true, AFTER_DRAIN = false;
    bf16_t* O; int ldo;
    __device__ __forceinline__ void operator()(const pg8::f32x4 (&acc)[2][2][4][2], const pg8::Unit& u, int wr, int wc, int fr, int fq) const {
        const int row0 = u.pm * 256 + wr * 64 + fr, col0 = u.pn * 256 + wc * 32 + 8 * fq;
#pragma unroll
        for (int ai = 0; ai < 2; ++ai)
#pragma unroll
            for (int m = 0; m < 4; ++m) { bf16_t* rowp = O + (size_t)(row0 + ai * 128 + m * 16) * ldo + col0;
#pragma unroll
                for (int bj = 0; bj < 2; ++bj) { const pg8::f32x4 v0 = acc[ai][bj][m][0], v1 = acc[ai][bj][m][1];
                    u32x4 o; o.x = pk2(v0[0], v0[1]); o.y = pk2(v0[2], v0[3]); o.z = pk2(v1[0], v1[1]); o.w = pk2(v1[2], v1[3]);
                    *(u32x4*)(rowp + bj * 128) = o; } }
    }
};

struct Ctx {
    LAS unsigned char* lds; int tid, lane, wave, G, wg, gw, NGW;
    const float* in[32]; float* out; unsigned char* ws;
};
#define IN_X 0
#define IN_C 1
#define IN_CTX 2
#define IN_CCTX 3
#define IN_ADAW 4
#define IN_ADAB 5
#define IN_NORMW 6
#define IN_ABWIN 7
#define IN_CONVW 8
#define IN_ALOG 9
#define IN_DTB 10
#define IN_GDNNW 11
#define IN_W0 12
#define IN_WUP 13
#define IN_A0 14
#define IN_AUP 15
#define IN_GUP 16
#define IN_KK 17
#define IN_KA 18
#define IN_RK 19
#define IN_LNW 20
#define IN_LNB 21
#define IN_ABWOUT 22
#define IN_MLWIN 23
#define IN_MLIB 24
#define IN_MLFB 25
#define IN_MLNW 26
#define IN_MLWOUT 27
#define IN_W1 28
#define IN_W3 29
#define IN_W2 30
#define IN_FNW 31

__device__ __forceinline__ void transpose_item(const float* W, int K, int N, bf16_t* WT, int out_row0, LAS float* scr, int k0, int n0, int lane) {
#pragma unroll 8
    for (int i = 0; i < 32; ++i) { const int kk = 2 * i + (lane >> 5); scr[kk * 33 + (lane & 31)] = W[(size_t)(k0 + kk) * N + n0 + (lane & 31)]; }
    asm volatile("s_waitcnt lgkmcnt(0)" ::: "memory");
    const int c = lane & 7;
#pragma unroll
    for (int j = 0; j < 4; ++j) { const int n = (lane >> 3) + 8 * j; const LAS float* s = scr + (8 * c) * 33 + n;
        u32x4 o; o.x = pk2(s[0 * 33], s[1 * 33]); o.y = pk2(s[2 * 33], s[3 * 33]); o.z = pk2(s[4 * 33], s[5 * 33]); o.w = pk2(s[6 * 33], s[7 * 33]);
        *(u32x4*)(WT + (size_t)(out_row0 + n) * K + k0 + 8 * c) = o; }
    asm volatile("s_waitcnt lgkmcnt(0)" ::: "memory");
}
__device__ __forceinline__ void transpose_matrix(const Ctx& c, const float* W, int K, int N, bf16_t* WT, int mode, LAS float* scr) {
    const int nblk = N / 32, items = (K / 64) * nblk;
    for (int it = c.gw; it < items; it += c.NGW) {
        const int kb = it / nblk, nb = it % nblk, n0 = nb * 32;
        const int orow = mode == 0 ? n0 : ((n0 >> 7) * 256 + (n0 & 127) + (mode == 2 ? 128 : 0));
        transpose_item(W, K, N, WT, orow, scr, kb * 64, n0, c.lane);
    }
}
__device__ __forceinline__ void zero_rows(const Ctx& c, bf16_t* WT, int K, int r0, int r1) {
    u32x4* p = (u32x4*)(WT + (size_t)r0 * K); const size_t n = (size_t)(r1 - r0) * K / 8;
    for (size_t i = (size_t)c.wg * NTHREADS + c.tid; i < n; i += (size_t)c.G * NTHREADS) p[i] = (u32x4){0u, 0u, 0u, 0u};
}
__device__ __forceinline__ void convert_weights(const Ctx& c, int layer) {
    LAS float* scr = (LAS float*)(c.lds + 65536) + c.wave * (64 * 33);
    bf16_t* Win = (bf16_t*)(c.ws + WS_WIN); bf16_t* Wout = (bf16_t*)(c.ws + WS_WOUT); bf16_t* W13 = (bf16_t*)(c.ws + WS_W13); bf16_t* W2 = (bf16_t*)(c.ws + WS_W2);
    if (layer == 0) { transpose_matrix(c, c.in[IN_ABWIN], D, AB_IN, Win, 0, scr); zero_rows(c, Win, D, AB_IN, NIN0); transpose_matrix(c, c.in[IN_ABWOUT], D, D, Wout, 0, scr); }
    else { transpose_matrix(c, c.in[IN_MLWIN], D, C_INW, Win, 0, scr); zero_rows(c, Win, D, C_INW, NIN1); transpose_matrix(c, c.in[IN_MLWOUT], D, D, Wout, 0, scr); }
    transpose_matrix(c, c.in[IN_W1] + (size_t)layer * D * FF, D, FF, W13, 1, scr);
    transpose_matrix(c, c.in[IN_W3] + (size_t)layer * D * FF, D, FF, W13, 2, scr);
    transpose_matrix(c, c.in[IN_W2] + (size_t)layer * FF * D, FF, D, W2, 0, scr);
}
__device__ __forceinline__ void lora_weight_phase(const Ctx& c) {
    bf16_t* Wl = (bf16_t*)(c.ws + WS_WL); bf16_t* Wg = (bf16_t*)(c.ws + WS_WG);
    for (int idx = c.wg * NTHREADS + c.tid; idx < 32 * 4096; idx += c.G * NTHREADS) {
        const int k8 = idx >> 12, n = idx & 4095, slot = n >> 10, ch = n & 1023; float v[8];
        const float* src = c.in[slot < 2 ? IN_WUP : IN_AUP] + (size_t)(slot & 1) * 64 * 1024 + ch;
#pragma unroll
        for (int q = 0; q < 8; ++q) { const int kk = k8 * 8 + q; v[q] = ((kk >> 6) == slot) ? src[(size_t)(kk & 63) * 1024] : 0.f; }
        *(u32x4*)(Wl + (size_t)n * 256 + k8 * 8) = pack8(v);
    }
    for (int idx = c.wg * NTHREADS + c.tid; idx < 32 * 1024; idx += c.G * NTHREADS) {
        const int k8 = idx >> 10, ch = idx & 1023; float v[8];
#pragma unroll
        for (int q = 0; q < 8; ++q) { const int kk = k8 * 8 + q; v[q] = kk < 160 ? c.in[IN_GUP][(size_t)kk * 1024 + ch] : 0.f; }
        *(u32x4*)(Wg + (size_t)ch * 256 + k8 * 8) = pack8(v);
    }
}
__device__ __forceinline__ void ada_phase(const Ctx& c) {
    LAS float* sc = (LAS float*)c.lds;
    LAS float* red = sc + 5 * D;
    for (int i = c.tid; i < 5 * D; i += NTHREADS) { const int b = i / D, k = i % D; const float v = b < 4 ? c.in[IN_C][b * D + k] : c.in[IN_CCTX][k]; sc[i] = v / (1.f + expf(-v)); }
    __syncthreads();
    float* MOD = (float*)(c.ws + WS_MOD);
    for (int u = c.wg; u < 2 * (MODW / 64); u += c.G) {
        const int layer = u / (MODW / 64), cb = (u % (MODW / 64)) * 64;
        const float* wp = c.in[IN_ADAW] + (size_t)layer * D * MODW + cb + c.lane;
        float acc[5] = {0.f, 0.f, 0.f, 0.f, 0.f};
        const int k0 = c.wave * 256;
#pragma unroll 16
        for (int k = k0; k < k0 + 256; ++k) { const float w = wp[(size_t)k * MODW];
#pragma unroll
            for (int b = 0; b < 5; ++b) acc[b] += sc[b * D + k] * w; }
#pragma unroll
        for (int b = 0; b < 5; ++b) red[(c.wave * 5 + b) * 64 + c.lane] = acc[b];
        __syncthreads();
        if (c.tid < 320) { const int b = c.tid / 64, l = c.tid % 64; float s = 0.f;
#pragma unroll
            for (int w = 0; w < 8; ++w) s += red[(w * 5 + b) * 64 + l];
            MOD[(size_t)(layer * 5 + b) * MODW + cb + l] = s + c.in[IN_ADAB][layer * MODW + cb + l]; }
        __syncthreads();
    }
}
__device__ __forceinline__ void norm_mod_phase(const Ctx& c, const float* srcL, const float* srcC, const float* nw, const float* modl, int shift_off, int scale_off, int nrows) {
    bf16_t* H = (bf16_t*)(c.ws + WS_HY);
    for (int r = c.gw; r < nrows; r += c.NGW) {
        const float* xr = r < ML ? srcL + (size_t)r * D : srcC + (size_t)(r - ML) * D;
        const float* mr = modl + (size_t)(r < ML ? (r >> 12) : 4) * MODW;
        f32x4 v[8]; float ss = 0.f;
#pragma unroll
        for (int j = 0; j < 8; ++j) { v[j] = ((const f32x4*)xr)[c.lane + 64 * j]; ss += v[j].x * v[j].x + v[j].y * v[j].y + v[j].z * v[j].z + v[j].w * v[j].w; }
        ss = grp_sum<64>(ss);
        const float rstd = 1.f / sqrtf(ss * (1.f / D) + 1e-6f);
#pragma unroll
        for (int j = 0; j < 8; ++j) { const f32x4 w4 = ((const f32x4*)nw)[c.lane + 64 * j], s4 = ((const f32x4*)(mr + scale_off))[c.lane + 64 * j], h4 = ((const f32x4*)(mr + shift_off))[c.lane + 64 * j];
            const f32x4 y = v[j] * rstd * w4 * (s4 + 1.f) + h4;
            u32x2 o; o.x = pk2(y.x, y.y); o.y = pk2(y.z, y.w);
            ((u32x2*)(H + (size_t)r * D))[c.lane + 64 * j] = o; }
    }
}
__device__ __forceinline__ void final_norm_phase(const Ctx& c) {
    const float* nw = c.in[IN_FNW];
    for (int r = c.gw; r < ML; r += c.NGW) {
        f32x4* xr = (f32x4*)(c.out + (size_t)r * D);
        f32x4 v[8]; float ss = 0.f;
#pragma unroll
        for (int j = 0; j < 8; ++j) { v[j] = xr[c.lane + 64 * j]; ss += v[j].x * v[j].x + v[j].y * v[j].y + v[j].z * v[j].z + v[j].w * v[j].w; }
        ss = grp_sum<64>(ss);
        const float rstd = 1.f / sqrtf(ss * (1.f / D) + 1e-6f);
#pragma unroll
        for (int j = 0; j < 8; ++j) xr[c.lane + 64 * j] = v[j] * rstd * ((const f32x4*)nw)[c.lane + 64 * j];
    }
}

__device__ __forceinline__ void ab_feature_phase(const Ctx& c) {
    const bf16_t* P = (const bf16_t*)(c.ws + WS_P); const float* T = (const float*)(c.ws + WS_TAIL);
    bf16_t* F = (bf16_t*)(c.ws + WS_F);
    float* GA = (float*)(c.ws + WS_GA); float* GB = (float*)(c.ws + WS_GB);
    const float* cw = c.in[IN_CONVW];
    const int lane = c.lane;
    for (int it = 0; it * c.NGW < MT; ++it) {
        const int r = it * c.NGW + c.wg * NWAVES + c.wave;
        if (r >= MT) break;
        int nb[9];
        if (r < ML) { const int b = r >> 12, t = r & 4095, gr = t >> 6, gc = t & 63;
#pragma unroll
            for (int dr = 0; dr < 3; ++dr)
#pragma unroll
                for (int dc = 0; dc < 3; ++dc) { const int rr = gr + dr - 1, cc = gc + dc - 1; nb[dr * 3 + dc] = (rr >= 0 && rr < 64 && cc >= 0 && cc < 64) ? (b * 4096 + rr * 64 + cc) : -1; } }
        else { const int q = r - ML, b = q >> 8, t = q & 255;
#pragma unroll
            for (int k = 0; k < 9; ++k) nb[k] = -1;
#pragma unroll
            for (int dc = 0; dc < 3; ++dc) { const int cc = t + dc - 1; nb[3 + dc] = (cc >= 0 && cc < 256) ? (ML + b * 256 + cc) : -1; } }
#pragma unroll 1
        for (int blk = 0; blk < 12; ++blk) {
            const int ch = blk * 512 + lane * 8;
            float cv[8];
#pragma unroll
            for (int j = 0; j < 8; ++j) cv[j] = 0.f;
#pragma unroll
            for (int k = 0; k < 9; ++k) if (nb[k] >= 0) {
                const u32x4 pv = *(const u32x4*)(P + (size_t)nb[k] * PW0 + ch);
                const f32x4 w0 = *(const f32x4*)(cw + k * 6144 + ch), w1 = *(const f32x4*)(cw + k * 6144 + ch + 4);
                float pf[8]; unpack8(pv, pf);
                cv[0] += pf[0] * w0.x; cv[1] += pf[1] * w0.y; cv[2] += pf[2] * w0.z; cv[3] += pf[3] * w0.w;
                cv[4] += pf[4] * w1.x; cv[5] += pf[5] * w1.y; cv[6] += pf[6] * w1.z; cv[7] += pf[7] * w1.w; }
            const int grp = blk >> 1, cl = (blk & 1) * 512 + lane * 8;
            if (grp < 3) {
                float ss = 0.f;
#pragma unroll
                for (int j = 0; j < 8; ++j) { cv[j] = cv[j] / (1.f + __expf(-cv[j])); ss += cv[j] * cv[j]; }
                if (grp < 2) { ss = grp_sum<16>(ss); const float sc = (1.f / sqrtf(ss + 1e-6f)) * (grp == 0 ? 0.08838834764831845f : 1.f);
#pragma unroll
                    for (int j = 0; j < 8; ++j) cv[j] *= sc; }
                *(u32x4*)(F + (size_t)grp * MT * 1024 + (size_t)r * 1024 + cl) = pack8(cv);
            } else if (grp == 3) { *(u32x4*)(F + (size_t)3 * MT * 1024 + (size_t)r * 1024 + cl) = pack8(cv);
            } else if (grp == 5) { *(u32x4*)(F + (size_t)6 * MT * 1024 + (size_t)r * 1024 + cl) = pack8(cv);
            } else {
                *(u32x4*)(F + (size_t)5 * MT * 1024 + (size_t)r * 1024 + cl) = pack8(cv);
                const f32x4 k0 = *(const f32x4*)(c.in[IN_KK] + cl), k1 = *(const f32x4*)(c.in[IN_KK] + cl + 4);
                float t[8] = {cv[0] * k0.x, cv[1] * k0.y, cv[2] * k0.z, cv[3] * k0.w, cv[4] * k1.x, cv[5] * k1.y, cv[6] * k1.z, cv[7] * k1.w};
                float ss = 0.f;
#pragma unroll
                for (int j = 0; j < 8; ++j) ss += t[j] * t[j];
                ss = grp_sum<8>(ss); const float sc = 1.f / sqrtf(ss + 1e-6f);
#pragma unroll
                for (int j = 0; j < 8; ++j) t[j] *= sc;
                *(u32x4*)(F + (size_t)4 * MT * 1024 + (size_t)r * 1024 + cl) = pack8(t);
            }
        }
        {
            bf16_t* A1 = (bf16_t*)(c.ws + WS_A1); bf16_t* A2 = (bf16_t*)(c.ws + WS_A2);
            const f32x4 t1 = *(const f32x4*)(T + (size_t)r * TW0 + 32 + lane * 4);
            u32x2 o1; if (lane < 32) { o1.x = pk2(tanhf(t1.x), tanhf(t1.y)); o1.y = pk2(tanhf(t1.z), tanhf(t1.w)); } else { o1.x = pk2(t1.x, t1.y); o1.y = pk2(t1.z, t1.w); }
            *(u32x2*)(A1 + (size_t)r * 256 + lane * 4) = o1;
            u32x2 o2 = {0u, 0u};
            if (lane < 40) { const f32x4 t2 = *(const f32x4*)(T + (size_t)r * TW0 + 288 + lane * 4); o2.x = pk2(sigm(t2.x), sigm(t2.y)); o2.y = pk2(sigm(t2.z), sigm(t2.w)); }
            *(u32x2*)(A2 + (size_t)r * 256 + lane * 4) = o2;
        }
        if (lane < 16) {
            const float g0 = T[(size_t)r * TW0 + lane], g1 = T[(size_t)r * TW0 + 16 + lane];
            GA[(size_t)r * 16 + lane] = -expf(c.in[IN_ALOG][lane]) * softplus_(g0 + c.in[IN_DTB][lane]);
            GB[(size_t)r * 16 + lane] = sigm(g1);
        }
    }
}
__device__ __forceinline__ void rw_lora_phase(const Ctx& c) {
    bf16_t* P = (bf16_t*)(c.ws + WS_P); const float* T = (const float*)(c.ws + WS_TAIL);
    LAS float* xin = (LAS float*)c.lds;
    const int tid = c.tid;
    for (int tile = c.wg; tile < MT / 16; tile += c.G) {
        const int r0 = tile * 16;
#pragma unroll 1
        for (int pass = 0; pass < 2; ++pass) {
            __syncthreads();
            for (int i = tid; i < 16 * 128; i += NTHREADS) { const int tk = i >> 7, j = i & 127; const float v = T[(size_t)(r0 + tk) * TW0 + 32 + pass * 128 + j]; xin[i] = pass == 0 ? tanhf(v) : v; }
            __syncthreads();
            const float* up = c.in[pass == 0 ? IN_WUP : IN_AUP];
            float acc[16][2][2];
#pragma unroll
            for (int tk = 0; tk < 16; ++tk) { acc[tk][0][0] = acc[tk][0][1] = acc[tk][1][0] = acc[tk][1][1] = 0.f; }
#pragma unroll 2
            for (int rr = 0; rr < 64; ++rr) {
                const float w00 = up[(size_t)rr * 1024 + tid], w01 = up[(size_t)rr * 1024 + tid + 512], w10 = up[(size_t)(64 + rr) * 1024 + tid], w11 = up[(size_t)(64 + rr) * 1024 + tid + 512];
#pragma unroll
                for (int tk = 0; tk < 16; ++tk) { const float x0 = xin[tk * 128 + rr], x1 = xin[tk * 128 + 64 + rr];
                    acc[tk][0][0] += x0 * w00; acc[tk][0][1] += x0 * w01; acc[tk][1][0] += x1 * w10; acc[tk][1][1] += x1 * w11; }
            }
            const float* bias = c.in[pass == 0 ? IN_W0 : IN_A0];
#pragma unroll
            for (int d = 0; d < 2; ++d)
#pragma unroll
                for (int j = 0; j < 2; ++j) { const int ch = tid + 512 * j; const float bz = bias[d * 1024 + ch];
#pragma unroll
                    for (int tk = 0; tk < 16; ++tk) { const float s = sigm(bz + acc[tk][d][j]);
                        P[(size_t)(r0 + tk) * PW0 + (pass * 2 + d) * 1024 + ch] = (bf16_t)f2bf(pass == 0 ? -0.6065306597126334f * s : s); } }
        }
    }
}
__device__ __forceinline__ int chunk_row(int b, int dir, int s) {
    if (s < 4) return ML + b * 256 + (dir == 0 ? s : 3 - s) * 64;
    return b * 4096 + (dir == 0 ? s - 4 : 67 - s) * 64;
}
__device__ __forceinline__ void gdn_scan_phase(const Ctx& c) {
    const bf16_t* F = (const bf16_t*)(c.ws + WS_F); bf16_t* P = (bf16_t*)(c.ws + WS_P);
    const float* GA = (const float*)(c.ws + WS_GA); const float* GB = (const float*)(c.ws + WS_GB);
    const int lane = c.lane, tid = c.tid, slab = lane & 15, cl = c.wave * 4 + (lane >> 4);
    for (int item = c.wg; item < 256; item += c.G) {
        const int chain = item >> 2, cq = item & 3, b = chain >> 4, h = (chain >> 1) & 7, dir = chain & 1;
        float S[8];
#pragma unroll
        for (int i = 0; i < 8; ++i) S[i] = 0.f;
        u32x4 rk[2], rq[2], rv; float rg = 0.f, rb = 0.f;
        auto gload = [&](int s) {
            const int row0 = chunk_row(b, dir, s);
#pragma unroll
            for (int i = 0; i < 2; ++i) { const int pc = tid + i * 512, tk = pc >> 4, o = (pc & 15) * 8;
                rk[i] = *(const u32x4*)(F + (size_t)1 * MT * 1024 + (size_t)(row0 + tk) * 1024 + h * 128 + o);
                rq[i] = *(const u32x4*)(F + (size_t)0 * MT * 1024 + (size_t)(row0 + tk) * 1024 + h * 128 + o); }
            if (tid < 256) { const int tk = tid >> 2, o = (tid & 3) * 8; rv = *(const u32x4*)(F + (size_t)2 * MT * 1024 + (size_t)(row0 + tk) * 1024 + h * 128 + cq * 32 + o); }
            if (tid < 64) { rg = GA[(size_t)(row0 + tid) * 16 + dir * 8 + h]; rb = GB[(size_t)(row0 + tid) * 16 + dir * 8 + h]; }
        };
        auto lstore = [&](int bufi) {
            LAS unsigned char* bp = c.lds + bufi * 40960;
#pragma unroll
            for (int i = 0; i < 2; ++i) { const int pc = tid + i * 512; *(LAS u32x4*)(bp + pc * 16) = rk[i]; *(LAS u32x4*)(bp + 16384 + pc * 16) = rq[i]; }
            if (tid < 256) *(LAS u32x4*)(bp + 32768 + tid * 16) = rv;
            if (tid < 64) { *(LAS float*)(bp + 36864 + tid * 4) = rg; *(LAS float*)(bp + 37120 + tid * 4) = rb; }
        };
        __syncthreads();
        gload(0); lstore(0);
        __syncthreads();
        LAS float* ost = (LAS float*)(c.lds + 81920);
#pragma unroll 1
        for (int s = 0; s < 68; ++s) {
            if (s + 1 < 68) gload(s + 1);
            const LAS unsigned char* bp = c.lds + (s & 1) * 40960;
#pragma unroll 2
            for (int j = 0; j < 64; ++j) {
                const int tl = dir == 0 ? j : 63 - j;
                float kf[8], qf[8];
                unpack8(*(const LAS u32x4*)(bp + tl * 256 + slab * 16), kf);
                unpack8(*(const LAS u32x4*)(bp + 16384 + tl * 256 + slab * 16), qf);
                const float vv = bf1(*(const LAS bf16_t*)(bp + 32768 + tl * 64 + cl * 2));
                const float a = __expf(*(const LAS float*)(bp + 36864 + tl * 4)), bt = *(const LAS float*)(bp + 37120 + tl * 4);
                float dot = 0.f;
#pragma unroll
                for (int i = 0; i < 8; ++i) dot += S[i] * kf[i];
                dot = grp_sum<16>(dot);
                const float dlt = bt * (vv - a * dot);
                float od = 0.f;
#pragma unroll
                for (int i = 0; i < 8; ++i) { S[i] = a * S[i] + kf[i] * dlt; od += S[i] * qf[i]; }
                od = grp_sum<16>(od);
                if (slab == 0) ost[tl * 32 + cl] = od;
            }
            __syncthreads();
            {
                const int row0 = chunk_row(b, dir, s), tk = tid >> 3, o = (tid & 7) * 4;
                const f32x4 v = *(const LAS f32x4*)(ost + tk * 32 + o);
                u32x2 w; w.x = pk2(v.x, v.y); w.y = pk2(v.z, v.w);
                *(u32x2*)(P + (size_t)(row0 + tk) * PW0 + (4 + dir) * 1024 + h * 128 + cq * 32 + o) = w;
            }
            if (s + 1 < 68) lstore((s + 1) & 1);
            __syncthreads();
        }
    }
}
__device__ __forceinline__ void rwkv_scan_phase(const Ctx& c) {
    const bf16_t* F = (const bf16_t*)(c.ws + WS_F); const bf16_t* P = (const bf16_t*)(c.ws + WS_P);
    bf16_t* Y = (bf16_t*)(c.ws + WS_F);
    const int lane = c.lane, tid = c.tid, slab = lane & 15, rl = c.wave * 4 + (lane >> 4);
    for (int item = c.wg; item < 256; item += c.G) {
        const int chain = item >> 1, rh = item & 1, b = chain >> 5, h = (chain >> 1) & 15, dir = chain & 1;
        float S[4] = {0.f, 0.f, 0.f, 0.f};
        const f32x4 ka = *(const f32x4*)(c.in[IN_KA] + h * 64 + slab * 4);
        u32x4 rr[5]; u32x4 rv;
        auto gload = [&](int s) {
            const int row0 = chunk_row(b, dir, s);
            const int tk = tid >> 3, o = (tid & 7) * 8;
            rr[0] = *(const u32x4*)(F + (size_t)3 * MT * 1024 + (size_t)(row0 + tk) * 1024 + h * 64 + o);
            rr[1] = *(const u32x4*)(F + (size_t)4 * MT * 1024 + (size_t)(row0 + tk) * 1024 + h * 64 + o);
            rr[2] = *(const u32x4*)(F + (size_t)5 * MT * 1024 + (size_t)(row0 + tk) * 1024 + h * 64 + o);
            rr[3] = *(const u32x4*)(P + (size_t)(row0 + tk) * PW0 + (0 + dir) * 1024 + h * 64 + o);
            rr[4] = *(const u32x4*)(P + (size_t)(row0 + tk) * PW0 + (2 + dir) * 1024 + h * 64 + o);
            if (tid < 256) { const int t2 = tid >> 2, o2 = (tid & 3) * 8; rv = *(const u32x4*)(F + (size_t)6 * MT * 1024 + (size_t)(row0 + t2) * 1024 + h * 64 + rh * 32 + o2); }
        };
        auto lstore = [&](int bufi) {
            LAS unsigned char* bp = c.lds + bufi * 45056;
#pragma unroll
            for (int q = 0; q < 5; ++q) *(LAS u32x4*)(bp + q * 8192 + tid * 16) = rr[q];
            if (tid < 256) *(LAS u32x4*)(bp + 40960 + tid * 16) = rv;
        };
        __syncthreads();
        gload(0); lstore(0);
        __syncthreads();
        LAS float* yst = (LAS float*)(c.lds + 90112);
#pragma unroll 1
        for (int s = 0; s < 68; ++s) {
            if (s + 1 < 68) gload(s + 1);
            const LAS unsigned char* bp = c.lds + (s & 1) * 45056;
#pragma unroll 2
            for (int j = 0; j < 64; ++j) {
                const int tl = dir == 0 ? j : 63 - j;
                const u32x2 ur = *(const LAS u32x2*)(bp + tl * 128 + slab * 8), ukk = *(const LAS u32x2*)(bp + 8192 + tl * 128 + slab * 8), ukb = *(const LAS u32x2*)(bp + 16384 + tl * 128 + slab * 8),
                            ulw = *(const LAS u32x2*)(bp + 24576 + tl * 128 + slab * 8), ua = *(const LAS u32x2*)(bp + 32768 + tl * 128 + slab * 8);
                const float vv = bf1(*(const LAS bf16_t*)(bp + 40960 + tl * 64 + rl * 2));
                const float rf[4] = {bflo(ur.x), bfhi(ur.x), bflo(ur.y), bfhi(ur.y)}, kkf[4] = {bflo(ukk.x), bfhi(ukk.x), bflo(ukk.y), bfhi(ukk.y)}, kbf[4] = {bflo(ukb.x), bfhi(ukb.x), bflo(ukb.y), bfhi(ukb.y)},
                            lwf[4] = {bflo(ulw.x), bfhi(ulw.x), bflo(ulw.y), bfhi(ulw.y)}, af[4] = {bflo(ua.x), bfhi(ua.x), bflo(ua.y), bfhi(ua.y)};
                float sk = 0.f;
#pragma unroll
                for (int i = 0; i < 4; ++i) sk += S[i] * kkf[i];
                sk = grp_sum<16>(sk);
                float y = 0.f;
#pragma unroll
                for (int i = 0; i < 4; ++i) { const float w = __expf(lwf[i]), kka = kkf[i] * af[i], kt = kbf[i] * (1.f + (af[i] - 1.f) * ka[i]);
                    S[i] = S[i] * w - sk * kka + vv * kt; y += S[i] * rf[i]; }
                y = grp_sum<16>(y);
                if (slab == 0) yst[tl * 32 + rl] = y;
            }
            __syncthreads();
            {   const int row0 = chunk_row(b, dir, s), tk = tid >> 3, o = (tid & 7) * 4;
                const f32x4 v = *(const LAS f32x4*)(yst + tk * 32 + o);
                u32x2 w; w.x = pk2(v.x, v.y); w.y = pk2(v.z, v.w);
                *(u32x2*)(Y + (size_t)dir * MT * 1024 + (size_t)(row0 + tk) * 1024 + h * 64 + rh * 32 + o) = w;
            }
            if (s + 1 < 68) lstore((s + 1) & 1);
            __syncthreads();
        }
    }
}
__device__ __forceinline__ void ab_output_phase(const Ctx& c) {
    const bf16_t* F = (const bf16_t*)(c.ws + WS_F); const bf16_t* P = (const bf16_t*)(c.ws + WS_P); const float* T = (const float*)(c.ws + WS_TAIL);
    bf16_t* Yo = (bf16_t*)(c.ws + WS_HY);
    const bf16_t* GO = (const bf16_t*)(c.ws + WS_GOUT);
    const int tid = c.tid, lane = c.lane, wave = c.wave;
    for (int tile = c.wg; tile < MT / 16; tile += c.G) {
        const int r0 = tile * 16;
#pragma unroll
        for (int j = 0; j < 2; ++j) {
            const int ch = tid + 512 * j;
            const float kaj = c.in[IN_KA][ch], rkj = c.in[IN_RK][ch], lnw = c.in[IN_LNW][ch], lnb = c.in[IN_LNB][ch];
#pragma unroll 4
            for (int tk = 0; tk < 16; ++tk) {
                const size_t row = (size_t)(r0 + tk);
                const float y = bf1(Yo[row * D + 1024 + ch]) + bf1(Yo[row * D + ch]);
                const float rv = bf1(F[(size_t)3 * MT * 1024 + row * 1024 + ch]), kb = bf1(F[(size_t)5 * MT * 1024 + row * 1024 + ch]), vb = bf1(F[(size_t)6 * MT * 1024 + row * 1024 + ch]);
                const float a0 = bf1(P[row * PW0 + 2048 + ch]), a1 = bf1(P[row * PW0 + 3072 + ch]);
                const float mu = grp_sum<64>(y) * (1.f / 64.f), dv = y - mu, var = grp_sum<64>(dv * dv) * (1.f / 64.f);
                const float kts = kb * (2.f + (a0 + a1 - 2.f) * kaj);
                const float bonus = grp_sum<64>(rv * kts * rkj) * vb;
                const float o = (dv * (1.f / sqrtf(var + 64e-5f)) * lnw + lnb + bonus) * bf1(GO[row * 1024 + ch]);
                Yo[row * D + 1024 + ch] = (bf16_t)f2bf(o);
            }
        }
        __syncthreads();
        {   const int ch = 2 * tid;
            const float nw0 = c.in[IN_GDNNW][ch & 127], nw1 = c.in[IN_GDNNW][(ch & 127) + 1];
#pragma unroll 4
            for (int tk = 0; tk < 16; ++tk) {
                const size_t row = (size_t)(r0 + tk);
                const unsigned uf = *(const unsigned*)(P + row * PW0 + 4096 + ch), ub = *(const unsigned*)(P + row * PW0 + 5120 + ch), uz = *(const unsigned*)(P + row * PW0 + 6144 + ch);
                const float o0 = bflo(uf) + bflo(ub), o1 = bfhi(uf) + bfhi(ub);
                const float ss = grp_sum<64>(o0 * o0 + o1 * o1), rstd = 1.f / sqrtf(ss * (1.f / 128.f) + 1e-6f);
                const float z0 = bflo(uz), z1 = bfhi(uz);
                *(unsigned*)(Yo + row * D + ch) = pk2(o0 * rstd * nw0 * silu_fast(z0), o1 * rstd * nw1 * silu_fast(z1));
            }
        }
    }
}

__device__ __forceinline__ void ml_gate_phase(const Ctx& c) {
    const float* T = (const float*)(c.ws + WS_TAIL); float* GA = (float*)(c.ws + WS_GA); float* GB = (float*)(c.ws + WS_GB);
    for (size_t i = (size_t)c.wg * NTHREADS + c.tid; i < (size_t)MT * 16; i += (size_t)c.G * NTHREADS) {
        const size_t r = i >> 4; const int k = (int)(i & 15);
        const float gi = T[r * TW1 + k] + c.in[IN_MLIB][k], gf = T[r * TW1 + 16 + k] + c.in[IN_MLFB][k];
        GA[i] = 15.f * tanhf(gi * (1.f / 15.f));
        GB[i] = logsigm_(15.f * tanhf(gf * (1.f / 15.f)));
    }
}
__device__ __forceinline__ void mlstm_scan_phase(const Ctx& c) {
    const bf16_t* P = (const bf16_t*)(c.ws + WS_P); bf16_t* Hs = (bf16_t*)(c.ws + WS_F);
    const float* GA = (const float*)(c.ws + WS_GA); const float* GB = (const float*)(c.ws + WS_GB);
    const int lane = c.lane, tid = c.tid, slab = lane & 15, cp = c.wave * 4 + (lane >> 4);
    for (int item = c.wg; item < 256; item += c.G) {
        const int chain = item >> 2, cq = item & 3, b = chain >> 4, h = (chain >> 1) & 7, dir = chain & 1;
        float C[8][2], n[8]; float m = 0.f;
#pragma unroll
        for (int i = 0; i < 8; ++i) { C[i][0] = C[i][1] = 0.f; n[i] = 0.f; }
        u32x4 rk[2], rq[2], rv; float rg = 0.f, rb = 0.f;
        auto gload = [&](int s) {
            const int row0 = chunk_row(b, dir, s);
#pragma unroll
            for (int i = 0; i < 2; ++i) { const int pc = tid + i * 512, tk = pc >> 4, o = (pc & 15) * 8;
                rk[i] = *(const u32x4*)(P + (size_t)(row0 + tk) * PW1 + 1024 + h * 128 + o);
                rq[i] = *(const u32x4*)(P + (size_t)(row0 + tk) * PW1 + h * 128 + o); }
            { const int tk = tid >> 3, o = (tid & 7) * 8; rv = *(const u32x4*)(P + (size_t)(row0 + tk) * PW1 + 2048 + h * 256 + cq * 64 + o); }
            if (tid < 64) { rg = GA[(size_t)(row0 + tid) * 16 + dir * 8 + h]; rb = GB[(size_t)(row0 + tid) * 16 + dir * 8 + h]; }
        };
        auto lstore = [&](int bufi) {
            LAS unsigned char* bp = c.lds + bufi * 41472;
#pragma unroll
            for (int i = 0; i < 2; ++i) { const int pc = tid + i * 512; *(LAS u32x4*)(bp + pc * 16) = rk[i]; *(LAS u32x4*)(bp + 16384 + pc * 16) = rq[i]; }
            *(LAS u32x4*)(bp + 32768 + tid * 16) = rv;
            if (tid < 64) { *(LAS float*)(bp + 40960 + tid * 4) = rg; *(LAS float*)(bp + 41216 + tid * 4) = rb; }
        };
        __syncthreads();
        gload(0); lstore(0);
        __syncthreads();
        LAS float* hst = (LAS float*)(c.lds + 82944);
#pragma unroll 1
        for (int s = 0; s < 68; ++s) {
            if (s + 1 < 68) gload(s + 1);
            const LAS unsigned char* bp = c.lds + (s & 1) * 41472;
#pragma unroll 2
            for (int j = 0; j < 64; ++j) {
                const int tl = dir == 0 ? j : 63 - j;
                float kf[8], qf[8];
                unpack8(*(const LAS u32x4*)(bp + tl * 256 + slab * 16), kf);
                unpack8(*(const LAS u32x4*)(bp + 16384 + tl * 256 + slab * 16), qf);
                const unsigned uv = *(const LAS unsigned*)(bp + 32768 + tl * 128 + cp * 4);
                const float v0 = bflo(uv), v1 = bfhi(uv);
                const float ig = *(const LAS float*)(bp + 40960 + tl * 4), lf = *(const LAS float*)(bp + 41216 + tl * 4);
                const float mn = fmaxf(lf + m, ig), fs = __expf(lf + m - mn), is = __expf(ig - mn);
                m = mn;
                float n0 = 0.f, n1 = 0.f, dn = 0.f;
#pragma unroll
                for (int i = 0; i < 8; ++i) { const float ki = is * kf[i], qi = qf[i] * 0.08838834764831845f;
                    C[i][0] = fs * C[i][0] + ki * v0; C[i][1] = fs * C[i][1] + ki * v1; n[i] = fs * n[i] + ki;
                    n0 += C[i][0] * qi; n1 += C[i][1] * qi; dn += n[i] * qi; }
                n0 = grp_sum<16>(n0); n1 = grp_sum<16>(n1); dn = grp_sum<16>(dn);
                if (slab == 0) { const float dd = 1.f / fmaxf(fabsf(dn), __expf(-mn)); hst[tl * 64 + cp * 2] = n0 * dd; hst[tl * 64 + cp * 2 + 1] = n1 * dd; }
            }
            __syncthreads();
            if (s >= 4) {
                const int row0 = chunk_row(b, dir, s), tk = tid >> 3, o = (tid & 7) * 8;
                float v[8];
#pragma unroll
                for (int i = 0; i < 8; ++i) v[i] = hst[tk * 64 + o + i];
                *(u32x4*)(Hs + (size_t)dir * ML * D + (size_t)(row0 + tk) * D + h * 256 + cq * 64 + o) = pack8(v);
            }
            if (s + 1 < 68) lstore((s + 1) & 1);
            __syncthreads();
        }
    }
}
__device__ __forceinline__ void ml_output_phase(const Ctx& c) {
    const bf16_t* Hs = (const bf16_t*)(c.ws + WS_F); const bf16_t* P = (const bf16_t*)(c.ws + WS_P); bf16_t* Yo = (bf16_t*)(c.ws + WS_HY);
    const float* nw = c.in[IN_MLNW];
    for (int r = c.gw; r < ML; r += c.NGW) {
#pragma unroll
        for (int blk = 0; blk < 4; ++blk) {
            const int ch = blk * 512 + c.lane * 8;
            float a[8], bb[8], o[8];
            unpack8(*(const u32x4*)(Hs + (size_t)r * D + ch), a); unpack8(*(const u32x4*)(Hs + (size_t)ML * D + (size_t)r * D + ch), bb);
            unpack8(*(const u32x4*)(P + (size_t)r * PW1 + 4096 + ch), o);
            float ss = 0.f;
#pragma unroll
            for (int j = 0; j < 8; ++j) { a[j] += bb[j]; ss += a[j] * a[j]; }
            ss = grp_sum<32>(ss); const float rstd = 1.f / sqrtf(ss * (1.f / 256.f) + 1e-6f);
            const f32x4 w0 = *(const f32x4*)(nw + ch), w1 = *(const f32x4*)(nw + ch + 4);
            const float wv[8] = {w0.x, w0.y, w0.z, w0.w, w1.x, w1.y, w1.z, w1.w};
#pragma unroll
            for (int j = 0; j < 8; ++j) a[j] = a[j] * rstd * wv[j] * sigm_fast(o[j]);
            *(u32x4*)(Yo + (size_t)r * D + ch) = pack8(a);
        }
    }
}


typedef short bf16x8 __attribute__((ext_vector_type(8)));
typedef short s16x4 __attribute__((ext_vector_type(4)));
#define MFMA16(a, b, c) __builtin_amdgcn_mfma_f32_16x16x32_bf16((a), (b), (c), 0, 0, 0)
__device__ __forceinline__ bf16x8 frag_row(const LAS unsigned char* img, int RS, int r0, int k0, int lane) {
    return *(const LAS bf16x8*)(img + (r0 + (lane & 15)) * RS + (k0 + 8 * (lane >> 4)) * 2);
}
__device__ __forceinline__ bf16x8 frag_tr(const LAS unsigned char* img, int RS, int r0, int k0, int lane) {
    const int g = lane >> 4, q = (lane & 15) >> 2, p = lane & 3;
    LAS unsigned char* a = (LAS unsigned char*)img + (k0 + 8 * g + q) * RS + (r0 + 4 * p) * 2;
    const s16x4 lo = __builtin_amdgcn_ds_read_tr16_b64_v4i16((LAS s16x4*)a);
    const s16x4 hi = __builtin_amdgcn_ds_read_tr16_b64_v4i16((LAS s16x4*)(a + 4 * RS));
    bf16x8 r; r[0] = lo[0]; r[1] = lo[1]; r[2] = lo[2]; r[3] = lo[3]; r[4] = hi[0]; r[5] = hi[1]; r[6] = hi[2]; r[7] = hi[3];
    return r;
}
__device__ __forceinline__ void tile_write(LAS unsigned char* img, int RS, int n0, int m0, int lane, const f32x4 v) {
    u32x2 o; o.x = pk2(v[0], v[1]); o.y = pk2(v[2], v[3]);
    *(LAS u32x2*)(img + (n0 + (lane & 15)) * RS + (m0 + 4 * (lane >> 4)) * 2) = o;
}
constexpr int MS = 68;
__device__ __forceinline__ void tri_inverse_64(LAS float* MF, LAS float* TMP, int tid) {
    if (tid < 64) {
        const int blk = tid >> 4, cc = tid & 15; LAS float* base = MF + (blk * 16) * MS + blk * 16; float x[16];
#pragma unroll
        for (int i = 0; i < 16; ++i) { float s = (i == cc) ? 1.f : 0.f;
#pragma unroll
            for (int j = 0; j < i; ++j) s -= base[i * MS + j] * x[j];
            x[i] = s; }
#pragma unroll
        for (int i = 0; i < 16; ++i) base[i * MS + cc] = x[i];
    }
    __syncthreads();
    {   const int h = tid >> 8, t = tid & 255, r = t >> 4, cc = t & 15, R0 = h ? 48 : 16, C0 = h ? 32 : 0;
        float s = 0.f;
#pragma unroll
        for (int k = 0; k < 16; ++k) s += MF[(R0 + r) * MS + C0 + k] * MF[(C0 + k) * MS + C0 + cc];
        TMP[tid] = s;
        __syncthreads();
        float s2 = 0.f;
#pragma unroll
        for (int k = 0; k < 16; ++k) s2 += MF[(R0 + r) * MS + R0 + k] * TMP[h * 256 + k * 16 + cc];
        MF[(R0 + r) * MS + C0 + cc] = -s2;
    }
    __syncthreads();
    {   float s[2];
#pragma unroll
        for (int q = 0; q < 2; ++q) { const int idx = tid * 2 + q, r = idx >> 5, cc = idx & 31; float a = 0.f;
#pragma unroll 8
            for (int k = 0; k < 32; ++k) a += MF[(32 + r) * MS + k] * MF[k * MS + cc];
            s[q] = a; }
        TMP[tid * 2] = s[0]; TMP[tid * 2 + 1] = s[1];
        __syncthreads();
#pragma unroll
        for (int q = 0; q < 2; ++q) { const int idx = tid * 2 + q, r = idx >> 5, cc = idx & 31; float a = 0.f;
#pragma unroll 8
            for (int k = 0; k < 32; ++k) a += MF[(32 + r) * MS + 32 + k] * TMP[k * 32 + cc];
            s[q] = a; }
#pragma unroll
        for (int q = 0; q < 2; ++q) { const int idx = tid * 2 + q, r = idx >> 5, cc = idx & 31; MF[(32 + r) * MS + cc] = -s[q]; }
    }
    __syncthreads();
}
__device__ __forceinline__ float wave_incl_scan_add(float x, int lane) {
#pragma unroll
    for (int o = 1; o < 64; o <<= 1) { const float t = __shfl_up(x, o); if (lane >= o) x += t; }
    return x;
}
__device__ __forceinline__ float wave_incl_scan_max(float x, int lane) {
#pragma unroll
    for (int o = 1; o < 64; o <<= 1) { const float t = __shfl_up(x, o); if (lane >= o) x = fmaxf(x, t); }
    return x;
}
constexpr int RS128 = 272, RS64 = 144, RS80 = 176;

__device__ __forceinline__ void mlstm_chunk_phase(const Ctx& c) {
    const bf16_t* P = (const bf16_t*)(c.ws + WS_P); bf16_t* Hs = (bf16_t*)(c.ws + WS_F);
    const float* GA = (const float*)(c.ws + WS_GA); const float* GB = (const float*)(c.ws + WS_GB);
    const int lane = c.lane, tid = c.tid, w = c.wave, g4 = lane >> 4, l15 = lane & 15;
    LAS unsigned char* KIMG = c.lds; LAS unsigned char* QIMG = c.lds + 17408; LAS unsigned char* VIMG = c.lds + 34816; LAS unsigned char* VS = c.lds + 46080;
    LAS unsigned char* SM = c.lds + 57344; LAS unsigned char* CT = c.lds + 66560;
    LAS float* sB = (LAS float*)(c.lds + 88320); LAS float* sCM = sB + 64; LAS float* sIGB = sB + 128;
    for (int item = c.wg; item < 256; item += c.G) {
        const int chain = item >> 2, cq = item & 3, b = chain >> 4, h = (chain >> 1) & 7, dir = chain & 1;
        f32x4 st[5];
#pragma unroll
        for (int e = 0; e < 5; ++e) st[e] = (f32x4){0.f, 0.f, 0.f, 0.f};
        float m = 0.f;
        u32x4 rk[2], rq[2], rv; float rg = 0.f, rb = 0.f;
        auto gload = [&](int s) {
            const int row0 = chunk_row(b, dir, s);
#pragma unroll
            for (int i = 0; i < 2; ++i) { const int pc = tid + i * 512, tk = pc >> 4, o = (pc & 15) * 8;
                rk[i] = *(const u32x4*)(P + (size_t)(row0 + tk) * PW1 + 1024 + h * 128 + o);
                rq[i] = *(const u32x4*)(P + (size_t)(row0 + tk) * PW1 + h * 128 + o); }
            { const int tk = tid >> 3, o = (tid & 7) * 8; rv = *(const u32x4*)(P + (size_t)(row0 + tk) * PW1 + 2048 + h * 256 + cq * 64 + o); }
            if (tid < 64) { rg = GA[(size_t)(row0 + tid) * 16 + dir * 8 + h]; rb = GB[(size_t)(row0 + tid) * 16 + dir * 8 + h]; }
        };
        __syncthreads();
        for (int i = tid; i < 80 * 34; i += NTHREADS) ((LAS u32x2*)CT)[i] = (u32x2){0u, 0u};
        gload(0);
#pragma unroll 1
        for (int s = 0; s < 68; ++s) {
#pragma unroll
            for (int i = 0; i < 2; ++i) { const int pc = tid + i * 512, tk = pc >> 4, o = pc & 15, ri = dir ? 63 - tk : tk;
                *(LAS u32x4*)(KIMG + ri * RS128 + o * 16) = rk[i]; *(LAS u32x4*)(QIMG + ri * RS128 + o * 16) = rq[i]; }
            { const int tk = tid >> 3, o = tid & 7, ri = dir ? 63 - tk : tk; *(LAS u32x4*)(VIMG + ri * RS80 + o * 16) = rv;
              if (o == 0) { *(LAS u32x4*)(VIMG + ri * RS80 + 128) = (u32x4){0x3F80u, 0u, 0u, 0u}; *(LAS u32x4*)(VIMG + ri * RS80 + 144) = (u32x4){0u, 0u, 0u, 0u}; } }
            if (w == 0) {
                const int src = dir ? 63 - lane : lane;
                const float ig = __shfl(rg, src), lf = __shfl(rb, src);
                const float bb = wave_incl_scan_add(lf, lane), igb = ig - bb, cm = wave_incl_scan_max(igb, lane);
                sB[lane] = bb; sCM[lane] = cm; sIGB[lane] = igb;
            }
            __syncthreads();
            if (s + 1 < 68) gload(s + 1);
            const float c63 = sCM[63], blast = sB[63], mx63 = fmaxf(m, c63);
            const float cscale = __expf(m - mx63);
            if (s >= 4) {
                const int ib = w >> 1;
                bf16x8 bq[4];
#pragma unroll
                for (int k = 0; k < 4; ++k) bq[k] = frag_row(QIMG, RS128, ib * 16, k * 32, lane);
                const float mxi = fmaxf(m, sCM[ib * 16 + l15]);
#pragma unroll
                for (int t = 0; t < 2; ++t) { const int jb = (w & 1) * 2 + t; f32x4 acc = {0.f, 0.f, 0.f, 0.f};
#pragma unroll
                    for (int k = 0; k < 4; ++k) acc = MFMA16(frag_row(KIMG, RS128, jb * 16, k * 32, lane), bq[k], acc);
                    const int i = ib * 16 + l15;
#pragma unroll
                    for (int r = 0; r < 4; ++r) { const int j = jb * 16 + 4 * g4 + r; acc[r] = (j <= i) ? acc[r] * 0.08838834764831845f * __expf(sIGB[j] - mxi) : 0.f; }
                    tile_write(SM, RS64, ib * 16, jb * 16, lane, acc); }
            }
            for (int pc = tid; pc < 640; pc += NTHREADS) { const int j = pc / 10, o = pc % 10; const float f = __expf(sIGB[j] - mx63);
                float v[8]; unpack8(*(const LAS u32x4*)(VIMG + j * RS80 + o * 16), v);
#pragma unroll
                for (int q = 0; q < 8; ++q) v[q] *= f;
                *(LAS u32x4*)(VS + j * RS80 + o * 16) = pack8(v); }
            __syncthreads();
            if (s >= 4) {
                const int ib = w & 3, eh = w >> 2, i = ib * 16 + l15;
                const float mxi = fmaxf(m, sCM[i]), inter = __expf(m - mxi) * 0.08838834764831845f, floorv = __expf(-(sB[i] + mxi));
                bf16x8 bs[2], bq[4];
#pragma unroll
                for (int k = 0; k < 2; ++k) bs[k] = frag_row(SM, RS64, ib * 16, k * 32, lane);
#pragma unroll
                for (int k = 0; k < 4; ++k) bq[k] = frag_row(QIMG, RS128, ib * 16, k * 32, lane);
                f32x4 val[3];
#pragma unroll
                for (int t = 0; t < 3; ++t) { const int eb = t < 2 ? eh * 2 + t : 4; f32x4 a1 = {0.f, 0.f, 0.f, 0.f}, a2 = {0.f, 0.f, 0.f, 0.f};
#pragma unroll
                    for (int k = 0; k < 2; ++k) a1 = MFMA16(frag_tr(VIMG, RS80, eb * 16, k * 32, lane), bs[k], a1);
#pragma unroll
                    for (int k = 0; k < 4; ++k) a2 = MFMA16(frag_row(CT, RS128, eb * 16, k * 32, lane), bq[k], a2);
                    val[t] = a1 + a2 * inter; }
                const float den = __shfl(val[2][0], l15);
                const float dd = 1.f / fmaxf(fabsf(den), floorv);
                const int tl = dir ? 63 - i : i, row0 = chunk_row(b, dir, s);
#pragma unroll
                for (int t = 0; t < 2; ++t) { const int e0 = (eh * 2 + t) * 16 + 4 * g4; u32x2 o; o.x = pk2(val[t][0] * dd, val[t][1] * dd); o.y = pk2(val[t][2] * dd, val[t][3] * dd);
                    *(u32x2*)(Hs + (size_t)dir * ML * D + (size_t)(row0 + tl) * D + h * 256 + cq * 64 + e0) = o; }
            }
            {   bf16x8 ak[2];
#pragma unroll
                for (int k = 0; k < 2; ++k) ak[k] = frag_tr(KIMG, RS128, w * 16, k * 32, lane);
#pragma unroll
                for (int e = 0; e < 5; ++e) { st[e] = st[e] * cscale;
#pragma unroll
                    for (int k = 0; k < 2; ++k) st[e] = MFMA16(ak[k], frag_tr(VS, RS80, e * 16, k * 32, lane), st[e]); }
            }
            m = blast + mx63;
            __syncthreads();
#pragma unroll
            for (int e = 0; e < 5; ++e) tile_write(CT, RS128, e * 16, w * 16, lane, st[e]);
        }
    }
}

__device__ __forceinline__ void gdn_chunk_items(const Ctx& c, int item0, int item_stride, int n_items) {
    const bf16_t* F = (const bf16_t*)(c.ws + WS_F); bf16_t* P = (bf16_t*)(c.ws + WS_P);
    const float* GA = (const float*)(c.ws + WS_GA); const float* GB = (const float*)(c.ws + WS_GB);
    const int lane = c.lane, tid = c.tid, w = c.wave, g4 = lane >> 4, l15 = lane & 15;
    LAS unsigned char* KIMG = c.lds; LAS unsigned char* QIMG = c.lds + 17408; LAS unsigned char* VIMG = c.lds + 34816; LAS unsigned char* ST = c.lds + 44032;
    LAS unsigned char* WIMG = c.lds + 61440; LAS unsigned char* QKM = c.lds + 78848; LAS unsigned char* VNT = c.lds + 88064; LAS unsigned char* VNS = c.lds + 97280;
    LAS unsigned char* TW = c.lds + 106496; LAS unsigned char* TU = c.lds + 115712; LAS float* MF = (LAS float*)(c.lds + 124928); LAS float* TMP = (LAS float*)VNT;
    LAS float* sGC = (LAS float*)(c.lds + 142336); LAS float* sEG = sGC + 64; LAS float* sEL = sGC + 128; LAS float* sBT = sGC + 192; LAS float* sBG = sGC + 256;
    for (int item = item0; item < n_items; item += item_stride) {
        const int chain = item >> 1, eh = item & 1, b = chain >> 4, h = (chain >> 1) & 7, dir = chain & 1;
        f32x4 st[4];
#pragma unroll
        for (int e = 0; e < 4; ++e) st[e] = (f32x4){0.f, 0.f, 0.f, 0.f};
        u32x4 rk[2], rq[2], rv; float rg = 0.f, rb = 0.f;
        auto gload = [&](int s) {
            const int row0 = chunk_row(b, dir, s);
#pragma unroll
            for (int i = 0; i < 2; ++i) { const int pc = tid + i * 512, tk = pc >> 4, o = (pc & 15) * 8;
                rk[i] = *(const u32x4*)(F + (size_t)1 * MT * 1024 + (size_t)(row0 + tk) * 1024 + h * 128 + o);
                rq[i] = *(const u32x4*)(F + (size_t)0 * MT * 1024 + (size_t)(row0 + tk) * 1024 + h * 128 + o); }
            { const int tk = tid >> 3, o = (tid & 7) * 8; rv = *(const u32x4*)(F + (size_t)2 * MT * 1024 + (size_t)(row0 + tk) * 1024 + h * 128 + eh * 64 + o); }
            if (tid < 64) { rg = GA[(size_t)(row0 + tid) * 16 + dir * 8 + h]; rb = GB[(size_t)(row0 + tid) * 16 + dir * 8 + h]; }
        };
        __syncthreads();
        for (int i = tid; i < 64 * 34; i += NTHREADS) ((LAS u32x2*)ST)[i] = (u32x2){0u, 0u};
        gload(0);
#pragma unroll 1
        for (int s = 0; s < 68; ++s) {
#pragma unroll
            for (int i = 0; i < 2; ++i) { const int pc = tid + i * 512, tk = pc >> 4, o = pc & 15, ri = dir ? 63 - tk : tk;
                *(LAS u32x4*)(KIMG + ri * RS128 + o * 16) = rk[i]; *(LAS u32x4*)(QIMG + ri * RS128 + o * 16) = rq[i]; }
            { const int tk = tid >> 3, o = tid & 7, ri = dir ? 63 - tk : tk; *(LAS u32x4*)(VIMG + ri * RS64 + o * 16) = rv; }
            if (w == 0) {
                const int src = dir ? 63 - lane : lane;
                const float gg = __shfl(rg, src), bt = __shfl(rb, src);
                const float gc = wave_incl_scan_add(gg, lane), gl = __shfl(gc, 63), eg = __expf(gc);
                sGC[lane] = gc; sEG[lane] = eg; sEL[lane] = __expf(gl - gc); sBT[lane] = bt; sBG[lane] = bt * eg;
            }
            __syncthreads();
            if (s + 1 < 68) gload(s + 1);
            {   const int ib = w >> 1, i = ib * 16 + l15; const float gci = sGC[i], bti = sBT[i];
                bf16x8 bk[4], bq[4];
#pragma unroll
                for (int k = 0; k < 4; ++k) { bk[k] = frag_row(KIMG, RS128, ib * 16, k * 32, lane); bq[k] = frag_row(QIMG, RS128, ib * 16, k * 32, lane); }
#pragma unroll
                for (int t = 0; t < 2; ++t) { const int jb = (w & 1) * 2 + t; f32x4 a1 = {0.f, 0.f, 0.f, 0.f}, a2 = {0.f, 0.f, 0.f, 0.f};
#pragma unroll
                    for (int k = 0; k < 4; ++k) { const bf16x8 aj = frag_row(KIMG, RS128, jb * 16, k * 32, lane); a1 = MFMA16(aj, bk[k], a1); a2 = MFMA16(aj, bq[k], a2); }
                    f32x4 mv;
#pragma unroll
                    for (int r = 0; r < 4; ++r) { const int j = jb * 16 + 4 * g4 + r; const float dec = __expf(gci - sGC[j]);
                        mv[r] = (j < i) ? bti * a1[r] * dec : 0.f; a2[r] = (j <= i) ? a2[r] * dec : 0.f; }
                    *(LAS f32x4*)(MF + i * MS + jb * 16 + 4 * g4) = mv;
                    tile_write(QKM, RS64, ib * 16, jb * 16, lane, a2); }
            }
            __syncthreads();
            tri_inverse_64(MF, TMP, tid);
            {   const int i = tid >> 3, j8 = (tid & 7) * 8; float tw[8], tu[8];
#pragma unroll
                for (int q = 0; q < 8; ++q) { const float x = MF[i * MS + j8 + q]; tw[q] = x * sBG[j8 + q]; tu[q] = x * sBT[j8 + q]; }
                *(LAS u32x4*)(TW + i * RS64 + j8 * 2) = pack8(tw); *(LAS u32x4*)(TU + i * RS64 + j8 * 2) = pack8(tu); }
            __syncthreads();
            f32x4 ut[2];
            {   const int ib = w >> 1;
                bf16x8 au[2];
#pragma unroll
                for (int k = 0; k < 2; ++k) au[k] = frag_row(TU, RS64, ib * 16, k * 32, lane);
#pragma unroll
                for (int t = 0; t < 2; ++t) { const int eb = (w & 1) * 2 + t; ut[t] = (f32x4){0.f, 0.f, 0.f, 0.f};
#pragma unroll
                    for (int k = 0; k < 2; ++k) ut[t] = MFMA16(au[k], frag_tr(VIMG, RS64, eb * 16, k * 32, lane), ut[t]); }
                bf16x8 akt[2];
#pragma unroll
                for (int k = 0; k < 2; ++k) akt[k] = frag_tr(KIMG, RS128, w * 16, k * 32, lane);
#pragma unroll
                for (int i2 = 0; i2 < 4; ++i2) { f32x4 a = {0.f, 0.f, 0.f, 0.f};
#pragma unroll
                    for (int k = 0; k < 2; ++k) a = MFMA16(akt[k], frag_row(TW, RS64, i2 * 16, k * 32, lane), a);
                    tile_write(WIMG, RS128, i2 * 16, w * 16, lane, a); }
            }
            __syncthreads();
            {   const int ib = w >> 1;
                bf16x8 aw[4];
#pragma unroll
                for (int k = 0; k < 4; ++k) aw[k] = frag_row(WIMG, RS128, ib * 16, k * 32, lane);
#pragma unroll
                for (int t = 0; t < 2; ++t) { const int eb = (w & 1) * 2 + t; f32x4 a = {0.f, 0.f, 0.f, 0.f};
#pragma unroll
                    for (int k = 0; k < 4; ++k) a = MFMA16(aw[k], frag_row(ST, RS128, eb * 16, k * 32, lane), a);
                    f32x4 vn = ut[t] - a, vs;
#pragma unroll
                    for (int r = 0; r < 4; ++r) vs[r] = vn[r] * sEL[ib * 16 + 4 * g4 + r];
                    tile_write(VNT, RS64, eb * 16, ib * 16, lane, vn); tile_write(VNS, RS64, eb * 16, ib * 16, lane, vs); }
            }
            __syncthreads();
            {   const int eb = w >> 1, row0 = chunk_row(b, dir, s);
                bf16x8 as[4], av[2];
#pragma unroll
                for (int k = 0; k < 4; ++k) as[k] = frag_row(ST, RS128, eb * 16, k * 32, lane);
#pragma unroll
                for (int k = 0; k < 2; ++k) av[k] = frag_row(VNT, RS64, eb * 16, k * 32, lane);
#pragma unroll
                for (int t = 0; t < 2; ++t) { const int ib = (w & 1) * 2 + t, i = ib * 16 + l15; f32x4 a = {0.f, 0.f, 0.f, 0.f};
#pragma unroll
                    for (int k = 0; k < 4; ++k) a = MFMA16(as[k], frag_row(QIMG, RS128, ib * 16, k * 32, lane), a);
                    a = a * sEG[i];
#pragma unroll
                    for (int k = 0; k < 2; ++k) a = MFMA16(av[k], frag_row(QKM, RS64, ib * 16, k * 32, lane), a);
                    const int tl = dir ? 63 - i : i; u32x2 o; o.x = pk2(a[0], a[1]); o.y = pk2(a[2], a[3]);
                    *(u32x2*)(P + (size_t)(row0 + tl) * PW0 + (4 + dir) * 1024 + h * 128 + eh * 64 + eb * 16 + 4 * g4) = o; }
                const float al = __expf(sGC[63]);
                bf16x8 akt[2];
#pragma unroll
                for (int k = 0; k < 2; ++k) akt[k] = frag_tr(KIMG, RS128, w * 16, k * 32, lane);
#pragma unroll
                for (int e = 0; e < 4; ++e) { st[e] = st[e] * al;
#pragma unroll
                    for (int k = 0; k < 2; ++k) st[e] = MFMA16(akt[k], frag_row(VNS, RS64, e * 16, k * 32, lane), st[e]); }
            }
            __syncthreads();
#pragma unroll
            for (int e = 0; e < 4; ++e) tile_write(ST, RS128, e * 16, w * 16, lane, st[e]);
        }
    }
}

__device__ __forceinline__ void rwkv_chunk_items(const Ctx& c, int item0, int item_stride, int n_items, bf16_t* Ybase, long ydir_stride, int ystride) {
    const bf16_t* F = (const bf16_t*)(c.ws + WS_F); const bf16_t* P = (const bf16_t*)(c.ws + WS_P);
    const int lane = c.lane, tid = c.tid, w = c.wave, g4 = lane >> 4, l15 = lane & 15;
    LAS unsigned char* KKP = c.lds; LAS unsigned char* RP = c.lds + 9216; LAS unsigned char* KTD = c.lds + 18432; LAS unsigned char* KADN = c.lds + 27648;
    LAS unsigned char* VIMG = c.lds + 36864; LAS unsigned char* ST = c.lds + 46080; LAS unsigned char* ART = c.lds + 55296; LAS unsigned char* ARAN = c.lds + 64512;
    LAS unsigned char* TI = c.lds + 73728; LAS unsigned char* KTI = c.lds + 82944; LAS unsigned char* KAI = c.lds + 92160; LAS unsigned char* AKT = c.lds + 101376;
    LAS unsigned char* TMPVT = KTI; LAS unsigned char* WK = KAI; LAS unsigned char* UT = AKT;
    LAS float* MF = (LAS float*)(c.lds + 110592); LAS float* LP = MF; LAS float* TMP = (LAS float*)(c.lds + 128000); LAS float* sPC = (LAS float*)(c.lds + 132096);
    for (int item = item0; item < n_items; item += item_stride) {
        const int chain = item, b = chain >> 5, h = (chain >> 1) & 15, dir = chain & 1;
        f32x4 st[2] = {{0.f, 0.f, 0.f, 0.f}, {0.f, 0.f, 0.f, 0.f}};
        const int tk = tid >> 3, o8 = tid & 7, ri = dir ? 63 - tk : tk;
        float kav[8];
        { const f32x4 k0 = *(const f32x4*)(c.in[IN_KA] + h * 64 + o8 * 8), k1 = *(const f32x4*)(c.in[IN_KA] + h * 64 + o8 * 8 + 4);
          kav[0] = k0.x; kav[1] = k0.y; kav[2] = k0.z; kav[3] = k0.w; kav[4] = k1.x; kav[5] = k1.y; kav[6] = k1.z; kav[7] = k1.w; }
        u32x4 rr[5], rv;
        auto gload = [&](int s) {
            const int row0 = chunk_row(b, dir, s); const int o = o8 * 8;
            rr[0] = *(const u32x4*)(F + (size_t)3 * MT * 1024 + (size_t)(row0 + tk) * 1024 + h * 64 + o);
            rr[1] = *(const u32x4*)(F + (size_t)4 * MT * 1024 + (size_t)(row0 + tk) * 1024 + h * 64 + o);
            rr[2] = *(const u32x4*)(F + (size_t)5 * MT * 1024 + (size_t)(row0 + tk) * 1024 + h * 64 + o);
            rr[3] = *(const u32x4*)(P + (size_t)(row0 + tk) * PW0 + (0 + dir) * 1024 + h * 64 + o);
            rr[4] = *(const u32x4*)(P + (size_t)(row0 + tk) * PW0 + (2 + dir) * 1024 + h * 64 + o);
            rv = *(const u32x4*)(F + (size_t)6 * MT * 1024 + (size_t)(row0 + tk) * 1024 + h * 64 + o);
        };
        __syncthreads();
        for (int i = tid; i < 64 * 18; i += NTHREADS) ((LAS u32x2*)ST)[i] = (u32x2){0u, 0u};
        gload(0);
#pragma unroll 1
        for (int s = 0; s < 68; ++s) {
            float lwf[8]; unpack8(rr[3], lwf);
            *(LAS f32x4*)(LP + ri * 64 + o8 * 8) = (f32x4){lwf[0], lwf[1], lwf[2], lwf[3]}; *(LAS f32x4*)(LP + ri * 64 + o8 * 8 + 4) = (f32x4){lwf[4], lwf[5], lwf[6], lwf[7]};
            __syncthreads();
            {   const int k = tid & 63, seg = tid >> 6; float x[8]; float run = 0.f;
#pragma unroll
                for (int i = 0; i < 8; ++i) { run += LP[(seg * 8 + i) * 64 + k]; x[i] = run; }
                TMP[seg * 64 + k] = run;
                __syncthreads();
                float off = 0.f;
#pragma unroll
                for (int q = 0; q < 8; ++q) off += (q < seg) ? TMP[q * 64 + k] : 0.f;
#pragma unroll
                for (int i = 0; i < 8; ++i) LP[(seg * 8 + i) * 64 + k] = x[i] + off;
            }
            __syncthreads();
            {
                float rf[8], kkf[8], kbf[8], af[8], lp[8], lpm[8], lpc[8];
                unpack8(rr[0], rf); unpack8(rr[1], kkf); unpack8(rr[2], kbf); unpack8(rr[4], af);
#pragma unroll
                for (int q = 0; q < 8; ++q) { lp[q] = LP[ri * 64 + o8 * 8 + q]; lpm[q] = ri > 0 ? LP[(ri - 1) * 64 + o8 * 8 + q] : 0.f; lpc[q] = LP[63 * 64 + o8 * 8 + q]; }
                float i0[8], i1[8], i2[8], i3[8], i4[8], i5[8];
#pragma unroll
                for (int q = 0; q < 8; ++q) { const float kt = kbf[q] * (1.f + (af[q] - 1.f) * kav[q]), kka = kkf[q] * af[q];
                    const float ei = __expf(-lp[q]), ed = __expf(lpc[q] - lp[q]);
                    i0[q] = kkf[q] * __expf(lpm[q]); i1[q] = rf[q] * __expf(lp[q]); i2[q] = kt * ei; i3[q] = kka * ei; i4[q] = kt * ed; i5[q] = -kka * ed; }
                const int off = ri * RS64 + o8 * 16;
                *(LAS u32x4*)(KKP + off) = pack8(i0); *(LAS u32x4*)(RP + off) = pack8(i1); *(LAS u32x4*)(KTI + off) = pack8(i2); *(LAS u32x4*)(KAI + off) = pack8(i3);
                *(LAS u32x4*)(KTD + off) = pack8(i4); *(LAS u32x4*)(KADN + off) = pack8(i5); *(LAS u32x4*)(VIMG + off) = rv;
                if (ri == 63) {
#pragma unroll
                    for (int q = 0; q < 8; ++q) sPC[o8 * 8 + q] = __expf(lpc[q]); }
            }
            __syncthreads();
            if (s + 1 < 68) gload(s + 1);
            {   const int tb = w >> 1, t = tb * 16 + l15;
                bf16x8 bkk[2], brp[2];
#pragma unroll
                for (int k = 0; k < 2; ++k) { bkk[k] = frag_row(KKP, RS64, tb * 16, k * 32, lane); brp[k] = frag_row(RP, RS64, tb * 16, k * 32, lane); }
#pragma unroll
                for (int q = 0; q < 2; ++q) { const int sb = (w & 1) * 2 + q; f32x4 aka = {0.f, 0.f, 0.f, 0.f}, akt = aka, ara = aka, art = aka;
#pragma unroll
                    for (int k = 0; k < 2; ++k) { const bf16x8 fa = frag_row(KAI, RS64, sb * 16, k * 32, lane), ft = frag_row(KTI, RS64, sb * 16, k * 32, lane);
                        aka = MFMA16(fa, bkk[k], aka); akt = MFMA16(ft, bkk[k], akt); ara = MFMA16(fa, brp[k], ara); art = MFMA16(ft, brp[k], art); }
#pragma unroll
                    for (int r = 0; r < 4; ++r) { const int ss = sb * 16 + 4 * g4 + r;
                        aka[r] = ss < t ? aka[r] : 0.f; akt[r] = ss < t ? akt[r] : 0.f; ara[r] = ss <= t ? -ara[r] : 0.f; art[r] = ss <= t ? art[r] : 0.f; }
                    tile_write(AKT, RS64, tb * 16, sb * 16, lane, akt); tile_write(ARAN, RS64, tb * 16, sb * 16, lane, ara); tile_write(ART, RS64, tb * 16, sb * 16, lane, art);
                    *(LAS f32x4*)(MF + t * MS + sb * 16 + 4 * g4) = aka; }
            }
            __syncthreads();
            tri_inverse_64(MF, TMP, tid);
            {   const int i = tid >> 3, j8 = (tid & 7) * 8; float x[8];
#pragma unroll
                for (int q = 0; q < 8; ++q) x[q] = MF[i * MS + j8 + q];
                *(LAS u32x4*)(TI + i * RS64 + j8 * 2) = pack8(x); }
            __syncthreads();
            f32x4 y0[2], u0[2];
            {   const int hb = w >> 1;
                bf16x8 aa[2], akk[2], av[2];
#pragma unroll
                for (int k = 0; k < 2; ++k) { aa[k] = frag_row(AKT, RS64, hb * 16, k * 32, lane); akk[k] = frag_tr(KKP, RS64, hb * 16, k * 32, lane); av[k] = frag_tr(VIMG, RS64, hb * 16, k * 32, lane); }
#pragma unroll
                for (int q = 0; q < 2; ++q) { const int ob = (w & 1) * 2 + q; f32x4 a = {0.f, 0.f, 0.f, 0.f}, bq = a; y0[q] = a;
#pragma unroll
                    for (int k = 0; k < 2; ++k) { a = MFMA16(aa[k], frag_tr(VIMG, RS64, ob * 16, k * 32, lane), a);
                        const bf16x8 fti = frag_row(TI, RS64, ob * 16, k * 32, lane);
                        bq = MFMA16(akk[k], fti, bq);
                        y0[q] = MFMA16(av[k], frag_row(ART, RS64, ob * 16, k * 32, lane), y0[q]); }
                    tile_write(TMPVT, RS64, ob * 16, hb * 16, lane, a); tile_write(WK, RS64, ob * 16, hb * 16, lane, bq); }
            }
            __syncthreads();
            {   const int tb = w >> 1;
                bf16x8 at[2], awk[2];
#pragma unroll
                for (int k = 0; k < 2; ++k) { at[k] = frag_row(TI, RS64, tb * 16, k * 32, lane); awk[k] = frag_row(WK, RS64, tb * 16, k * 32, lane); }
#pragma unroll
                for (int q = 0; q < 2; ++q) { const int vb = (w & 1) * 2 + q; u0[q] = (f32x4){0.f, 0.f, 0.f, 0.f};
#pragma unroll
                    for (int k = 0; k < 2; ++k) { u0[q] = MFMA16(at[k], frag_row(TMPVT, RS64, vb * 16, k * 32, lane), u0[q]); u0[q] = MFMA16(awk[k], frag_row(ST, RS64, vb * 16, k * 32, lane), u0[q]); }
                }
            }
            {   const int tb = w >> 1;
#pragma unroll
                for (int q = 0; q < 2; ++q) tile_write(UT, RS64, ((w & 1) * 2 + q) * 16, tb * 16, lane, u0[q]); }
            __syncthreads();
            {   const int hb = w >> 1, row0 = chunk_row(b, dir, s);
                bf16x8 as[2], au[2], aktd[2], akad[2];
#pragma unroll
                for (int k = 0; k < 2; ++k) { as[k] = frag_row(ST, RS64, hb * 16, k * 32, lane); au[k] = frag_row(UT, RS64, hb * 16, k * 32, lane);
                    aktd[k] = frag_tr(KTD, RS64, hb * 16, k * 32, lane); akad[k] = frag_tr(KADN, RS64, hb * 16, k * 32, lane); }
#pragma unroll
                for (int q = 0; q < 2; ++q) { const int ob = (w & 1) * 2 + q; f32x4 a = y0[q];
#pragma unroll
                    for (int k = 0; k < 2; ++k) { a = MFMA16(as[k], frag_row(RP, RS64, ob * 16, k * 32, lane), a); a = MFMA16(au[k], frag_row(ARAN, RS64, ob * 16, k * 32, lane), a); }
                    const int t = ob * 16 + l15, tl = dir ? 63 - t : t; u32x2 o; o.x = pk2(a[0], a[1]); o.y = pk2(a[2], a[3]);
                    *(u32x2*)(Ybase + (long)dir * ydir_stride + (size_t)(row0 + tl) * ystride + h * 64 + hb * 16 + 4 * g4) = o;
#pragma unroll
                    for (int r = 0; r < 4; ++r) st[q][r] *= sPC[hb * 16 + 4 * g4 + r];
#pragma unroll
                    for (int k = 0; k < 2; ++k) { st[q] = MFMA16(aktd[k], frag_tr(VIMG, RS64, ob * 16, k * 32, lane), st[q]); st[q] = MFMA16(akad[k], frag_row(UT, RS64, ob * 16, k * 32, lane), st[q]); } }
            }
            __syncthreads();
            {   const int hb = w >> 1;
#pragma unroll
                for (int q = 0; q < 2; ++q) tile_write(ST, RS64, ((w & 1) * 2 + q) * 16, hb * 16, lane, st[q]); }
        }
    }
}

#ifndef USE_CHUNK_ML
#define USE_CHUNK_ML 1
#endif
#ifndef USE_CHUNK_GDN
#define USE_CHUNK_GDN 1
#endif
#ifndef USE_CHUNK_RWKV
#define USE_CHUNK_RWKV 1
#endif
struct Args { const float* in[32]; float* out; unsigned char* ws; int ph_lo, ph_hi; };
constexpr int NPHASE = 24;
__global__ void __launch_bounds__(NTHREADS, 2) fwd_kernel(Args args) {
    extern __shared__ __attribute__((aligned(16))) unsigned char lds_raw[];
    Ctx c;
    c.lds = (LAS unsigned char*)lds_raw;
    c.tid = threadIdx.x; c.lane = c.tid & 63; c.wave = __builtin_amdgcn_readfirstlane(c.tid >> 6);
    c.G = gridDim.x; c.wg = blockIdx.x; c.gw = c.wg * NWAVES + c.wave; c.NGW = c.G * NWAVES;
#pragma unroll
    for (int i = 0; i < 32; ++i) c.in[i] = args.in[i];
    c.out = args.out; c.ws = args.ws;
    const int lo = args.ph_lo, hi = args.ph_hi;
    volatile LAS unsigned* bst = (volatile LAS unsigned*)(c.lds + LDS_BAR_OFF);
    if (c.tid < 4) bst[c.tid] = 0u;
    __syncthreads();
    XcdBarrier bar; bar.bar = (unsigned*)(c.ws + WS_CTL); bar.x = 0; bar.st = bst;
    if (hi - lo > 1) bar = xcd_barrier_post((unsigned*)(c.ws + WS_CTL), bst);
#define IN(k) (lo <= (k) && (k) < hi)
#ifndef REPEAT_MASK
#define REPEAT_MASK 0u
#endif
#define REP(k) for (int _rep = 0; _rep < (((REPEAT_MASK >> (k)) & 1u) ? 2 : 1); ++_rep)
#define SEAM(k) do { if (IN(k) && IN((k) + 1)) xcd_barrier(bar); } while (0)
    float* MOD = (float*)(c.ws + WS_MOD);
    float* XC = (float*)(c.ws + WS_XC);
    bf16_t* HY = (bf16_t*)(c.ws + WS_HY); bf16_t* Pb = (bf16_t*)(c.ws + WS_P); float* TL = (float*)(c.ws + WS_TAIL);
    bf16_t* Win = (bf16_t*)(c.ws + WS_WIN); bf16_t* Wout = (bf16_t*)(c.ws + WS_WOUT); bf16_t* W13 = (bf16_t*)(c.ws + WS_W13); bf16_t* W2 = (bf16_t*)(c.ws + WS_W2);
    const float* X = c.in[IN_X]; const float* CX = c.in[IN_CTX];

    if (IN(0)) REP(0) { ada_phase(c); __syncthreads(); convert_weights(c, 0); lora_weight_phase(c); __syncthreads(); }
    SEAM(0);
    if (IN(1)) REP(1) norm_mod_phase(c, X, CX, c.in[IN_NORMW], MOD, 0, D, MT);
    SEAM(1);
    if (IN(2)) { pg8::Gemm g{HY, Win, MT, NIN0, D}; pg8::StaticOrder S; S.init(MT, NIN0, c.G, c.wg); EpiInProj E{Pb, PW0, PW0 / 256, TL, TW0};
        pg8::gemm_phase<EpiInProj, pg8::StaticOrder>(c.lds, g, S, E); }
    SEAM(2);
    if (IN(3)) REP(3) ab_feature_phase(c);
    SEAM(3);
    if (IN(4)) {
        int k256 = 256; asm volatile("" : "+s"(k256));
        { pg8::Gemm g{(const bf16_t*)(c.ws + WS_A1), (const bf16_t*)(c.ws + WS_WL), MT, 4096, k256}; pg8::StaticOrder S; S.init(MT, 4096, c.G, c.wg); EpiLora E{Pb, PW0, c.in[IN_W0], c.in[IN_A0]};
          pg8::gemm_phase<EpiLora, pg8::StaticOrder>(c.lds, g, S, E); }
        { pg8::Gemm g{(const bf16_t*)(c.ws + WS_A2), (const bf16_t*)(c.ws + WS_WG), MT, 1024, k256}; pg8::StaticOrder S; S.init(MT, 1024, c.G, c.wg); EpiBf16Plain E{(bf16_t*)(c.ws + WS_GOUT), 1024};
          pg8::gemm_phase<EpiBf16Plain, pg8::StaticOrder>(c.lds, g, S, E); } }
    SEAM(4);
    if (IN(5)) REP(5) {
        gdn_chunk_items(c, c.wg, c.G, 128);
        rwkv_chunk_items(c, (c.wg + c.G / 2) % c.G, c.G, 128, HY + 1024, -1024L, D); }
    SEAM(5);
    SEAM(6);
    if (IN(7)) REP(7) ab_output_phase(c);
    SEAM(7);
    if (IN(8)) { pg8::Gemm g{HY, Wout, MT, D, D}; pg8::StaticOrder S; S.init(MT, D, c.G, c.wg); EpiResid E{X, CX, c.out, XC, MOD + 2 * D};
        pg8::gemm_phase<EpiResid, pg8::StaticOrder>(c.lds, g, S, E); }
    SEAM(8);
    if (IN(9)) REP(9) norm_mod_phase(c, c.out, XC, c.in[IN_NORMW] + D, MOD, 3 * D, 4 * D, MT);
    SEAM(9);
    if (IN(10)) { pg8::Gemm g{HY, W13, MT, 2 * FF, D}; pg8::StaticOrder S; S.init(MT, 2 * FF, c.G, c.wg); EpiSwiGLU E{Pb, FF};
        pg8::gemm_phase<EpiSwiGLU, pg8::StaticOrder>(c.lds, g, S, E); }
    SEAM(10);
    if (IN(11)) { pg8::Gemm g{Pb, W2, MT, D, FF}; pg8::StaticOrder S; S.init(MT, D, c.G, c.wg); EpiResid E{c.out, XC, c.out, XC, MOD + 5 * D};
        pg8::gemm_phase<EpiResid, pg8::StaticOrder>(c.lds, g, S, E); }
    SEAM(11);
    if (IN(12)) REP(12) { convert_weights(c, 1); norm_mod_phase(c, c.out, XC, c.in[IN_NORMW] + 2 * D, MOD + 5 * MODW, 0, D, MT); }
    SEAM(12);
    if (IN(13)) { pg8::Gemm g{HY, Win, MT, NIN1, D}; pg8::StaticOrder S; S.init(MT, NIN1, c.G, c.wg); EpiInProj E{Pb, PW1, PW1 / 256, TL, TW1};
        pg8::gemm_phase<EpiInProj, pg8::StaticOrder>(c.lds, g, S, E); }
    SEAM(13);
    if (IN(14)) REP(14) ml_gate_phase(c);
    SEAM(14);
    if (IN(15)) REP(15) { if (USE_CHUNK_ML) mlstm_chunk_phase(c); else mlstm_scan_phase(c); }
    SEAM(15);
    if (IN(16)) REP(16) ml_output_phase(c);
    SEAM(16);
    if (IN(17)) { pg8::Gemm g{HY, Wout, ML, D, D}; pg8::StaticOrder S; S.init(ML, D, c.G, c.wg); EpiResid E{c.out, XC, c.out, XC, MOD + 5 * MODW + 2 * D};
        pg8::gemm_phase<EpiResid, pg8::StaticOrder>(c.lds, g, S, E); }
    SEAM(17);
    if (IN(18)) REP(18) norm_mod_phase(c, c.out, XC, c.in[IN_NORMW] + 3 * D, MOD + 5 * MODW, 3 * D, 4 * D, ML);
    SEAM(18);
    if (IN(19)) { pg8::Gemm g{HY, W13, ML, 2 * FF, D}; pg8::StaticOrder S; S.init(ML, 2 * FF, c.G, c.wg); EpiSwiGLU E{Pb, FF};
        pg8::gemm_phase<EpiSwiGLU, pg8::StaticOrder>(c.lds, g, S, E); }
    SEAM(19);
    if (IN(20)) { pg8::Gemm g{Pb, W2, ML, D, FF}; pg8::StaticOrder S; S.init(ML, D, c.G, c.wg); EpiResid E{c.out, XC, c.out, XC, MOD + 5 * MODW + 5 * D};
        pg8::gemm_phase<EpiResid, pg8::StaticOrder>(c.lds, g, S, E); }
    SEAM(20);
    if (IN(21)) final_norm_phase(c);
#undef IN
#undef SEAM
}

#ifndef N_LAUNCH_MODE
#define N_LAUNCH_MODE 1
#endif
extern "C" void kernel_launch(void* const* d_in, const int* in_sizes, int n_in, void* d_out, int out_size, void* d_ws, size_t ws_size, hipStream_t stream) {
    static int grid = 0;
    if (grid == 0) {
        if (n_in != 32 || out_size != ML * D || ws_size < WS_END) { fprintf(stderr, "kernel_launch: unexpected problem (n_in %d out %d ws %zu)\n", n_in, out_size, ws_size); grid = -1; return; }
        int dev = 0, cus = 0;
        if (hipGetDevice(&dev) != hipSuccess || hipDeviceGetAttribute(&cus, hipDeviceAttributeMultiprocessorCount, dev) != hipSuccess) { grid = -1; return; }
        if (hipFuncSetAttribute((const void*)fwd_kernel, hipFuncAttributeMaxDynamicSharedMemorySize, LDS_BYTES) != hipSuccess) { grid = -1; return; }
        int per_cu = 0;
        if (hipOccupancyMaxActiveBlocksPerMultiprocessor(&per_cu, (const void*)fwd_kernel, NTHREADS, LDS_BYTES) != hipSuccess || per_cu < 1) { fprintf(stderr, "kernel_launch: occupancy query says %d\n", per_cu); }
        (void)hipGetLastError();
        grid = cus;
    }
    if (grid < 0) return;
    (void)hipMemsetAsync((char*)d_ws + WS_CTL, 0, CTL_BYTES, stream);
    Args a{};
    for (int i = 0; i < 32; ++i) a.in[i] = (const float*)d_in[i];
    a.out = (float*)d_out; a.ws = (unsigned char*)d_ws;
#if N_LAUNCH_MODE == 1
    a.ph_lo = 0; a.ph_hi = NPHASE;
    hipLaunchKernelGGL(fwd_kernel, dim3(grid), dim3(NTHREADS), LDS_BYTES, stream, a);
#else
    for (int p = 0; p < 22; ++p) { a.ph_lo = p; a.ph_hi = p + 1; hipLaunchKernelGGL(fwd_kernel, dim3(grid), dim3(NTHREADS), LDS_BYTES, stream, a); }
#endif
}
```

```cpp
#include <hip/hip_runtime.h>
#include <cstdio>
#include <cstdint>
#define LAS __attribute__((address_space(3)))
#define GAS __attribute__((address_space(1)))
#define XB_TMO      128
#define XB_XCNT(j)  (256  + 64 * (j))
#define XB_XSUB(j)  (1280 + 64 * (j))
#define XB_XGEN(j)  (2304 + 64 * (j))
#define XB_TOP      3328
#define XB_TOPGEN   3392
#define XCD_BAR_WORDS 3456
#define XB_SPIN_CAP (1u << 20)

__device__ __forceinline__ unsigned xb_ld(unsigned* p)              { return __hip_atomic_load(p, __ATOMIC_RELAXED, __HIP_MEMORY_SCOPE_AGENT); }
__device__ __forceinline__ unsigned xb_add(unsigned* p, unsigned v) { return __hip_atomic_fetch_add(p, v, __ATOMIC_RELAXED, __HIP_MEMORY_SCOPE_AGENT); }
__device__ __forceinline__ unsigned xb_xcc_id() { return (unsigned)__builtin_amdgcn_s_getreg((3 << 11) | 20) & 0xFu; }
#define XB_SPIN(cond, bar) do { unsigned _sp = 0; while (cond) { __builtin_amdgcn_s_sleep(1); \
    if ((++_sp & 255u) == 0u) { if (xb_ld(&(bar)[XB_TMO])) break; if (_sp > XB_SPIN_CAP) { atomicAdd(&(bar)[XB_TMO], 1u); break; } } } } while (0)

struct XcdBarrier {
    unsigned* bar; unsigned x;
    volatile LAS unsigned* st;
};

__device__ __forceinline__ XcdBarrier xcd_barrier_post(unsigned* bar, volatile LAS unsigned* st) {
    XcdBarrier b; b.bar = bar; b.x = xb_xcc_id(); b.st = st;
    if (threadIdx.x == 0) (void)xb_add(&bar[XB_XCNT(b.x)], 1u);
    return b;
}
__device__ __forceinline__ void xcd_barrier_complete(unsigned* bar, unsigned x, unsigned& nloc, unsigned& nx) {
    const unsigned G = gridDim.x * gridDim.y * gridDim.z;
    unsigned sum, cnt, mine, sp = 0u;
    for (;;) {
        sum = 0u; cnt = 0u; mine = 0u;
#pragma unroll
        for (unsigned j = 0; j < 16; ++j) { const unsigned c = xb_ld(&bar[XB_XCNT(j)]); sum += c; cnt += (c > 0u) ? 1u : 0u; mine = (j == x) ? c : mine; }
        if (sum == G) break;
        __builtin_amdgcn_s_sleep(1);
        if ((++sp & 255u) == 0u) { if (xb_ld(&bar[XB_TMO])) break; if (sp > XB_SPIN_CAP) { atomicAdd(&bar[XB_TMO], 1u); break; } }
    }
    nloc = mine > 0u ? mine : 1u; nx = cnt > 0u ? cnt : 1u;
}

__device__ __forceinline__ void xcd_barrier(const XcdBarrier& b) {
    asm volatile("s_waitcnt vmcnt(0)" ::: "memory");
    __syncthreads();
    if (threadIdx.x == 0) {
        unsigned* bar = b.bar;
        __builtin_amdgcn_s_waitcnt(0);
        unsigned nloc = b.st[0], nx = b.st[1];
        if (nloc == 0u) { xcd_barrier_complete(bar, b.x, nloc, nx); b.st[0] = nloc; b.st[1] = nx; }
        const unsigned old = xb_add(&bar[XB_XSUB(b.x)], 1u);
        const unsigned gen = old / nloc;
        if (old + 1u == (gen + 1u) * nloc) {
            __builtin_amdgcn_fence(__ATOMIC_RELEASE, "agent");
            asm volatile("s_waitcnt vmcnt(0)" ::: "memory");
            const unsigned og = xb_add(&bar[XB_TOP], 1u);
            const unsigned tg = og / nx;
            if (og + 1u == (tg + 1u) * nx) xb_add(&bar[XB_TOPGEN], 1u);
            else XB_SPIN(xb_ld(&bar[XB_TOPGEN]) == tg, bar);
            __builtin_amdgcn_fence(__ATOMIC_ACQUIRE, "agent");
            xb_add(&bar[XB_XGEN(b.x)], 1u);
            asm volatile("s_waitcnt vmcnt(0)" ::: "memory");
        } else {
            XB_SPIN(xb_ld(&bar[XB_XGEN(b.x)]) == gen, bar);
            __builtin_amdgcn_fence(__ATOMIC_ACQUIRE, "agent");
            asm volatile("s_waitcnt vmcnt(0)" ::: "memory");
        }
    }
    __syncthreads();
}
#include <hip/hip_runtime.h>
namespace pg8 {
#define PG8_LAS __attribute__((address_space(3)))
typedef unsigned short bf16_t;
typedef short bf16x8 __attribute__((ext_vector_type(8)));
typedef float f32x4 __attribute__((ext_vector_type(4)));
typedef unsigned u32x4 __attribute__((ext_vector_type(4)));
constexpr int BM = 256, BK = 64, HALF = 128, HTB = HALF * BK * 2  , STAGE_BYTES = 8 * HTB, NXCD = 8, WGM = 8;

__host__ __device__ __forceinline__ int lds_byte(int r, int c) { const int st = (r >> 4) * 2 + (c >> 5), rr = r & 15, cc = c & 31, ob = rr * 64 + cc * 2; return st * 1024 + (ob ^ (((ob >> 9) & 1) << 5)); }
__host__ __device__ __forceinline__ void stage_rc(int b, int& R, int& C) { const int st = b / 1024, sb = b % 1024, swz = sb ^ (((sb >> 9) & 1) << 5); R = (st >> 1) * 16 + swz / 64; C = (st & 1) * 32 + (swz % 64) / 2; }
__host__ __device__ __forceinline__ int perm32(int rho) { const int n = rho >> 4, i = rho & 15; return 8 * (i >> 2) + 4 * n + (i & 3); }

struct Unit { int pm, pn; };
struct Gemm { const bf16_t* A; const bf16_t* Bt; int M, N, K; };

struct StaticOrder {
    int nM, nN, nwg, G, c;
    __host__ __device__ void init(int M, int N, int G_, int c_) { nM = M / BM; nN = N / BM; nwg = nM * nN; G = G_; c = c_; }
    __host__ __device__ bool next(int i, Unit& u) const {
        const long L = (long)i * G + c; if (L >= nwg) return false;
        int wgid = (int)L; { const int q = nwg / NXCD, r = nwg % NXCD, xcd = wgid % NXCD, off = wgid / NXCD; wgid = (xcd < r ? xcd * (q + 1) : r * (q + 1) + (xcd - r) * q) + off; }
        const int nig = WGM * nN, gid = wgid / nig, fm = gid * WGM, gsz = (nM - fm) < WGM ? (nM - fm) : WGM;
        u.pm = fm + ((wgid % nig) % gsz); u.pn = (wgid % nig) / gsz; return true;
    }
    __device__ __forceinline__ void a_ready(const Unit&) const {}
    __device__ __forceinline__ void done(const Unit&) const {}
};
template <class Epi, class Sched>
__device__ __forceinline__ void gemm_phase(PG8_LAS unsigned char* lds, const Gemm g, const Sched& S, const Epi& E) {
    const int tid = threadIdx.x, wid = __builtin_amdgcn_readfirstlane(tid >> 6), lane = tid & 63, wr = wid >> 2, wc = wid & 3, fr = lane & 15, fq = lane >> 4;
    const int K = g.K, nt = K / BK;
    unsigned voffA[2], voffB[2];
#pragma unroll
    for (int i = 0; i < 2; ++i) { int R, C; stage_rc(tid * 16 + i * 8192, R, C); const int Rb = Epi::PERM ? ((R & ~31) + perm32(R & 31)) : R;
        voffA[i] = (unsigned)(R * K + C) * 2u; voffB[i] = (unsigned)(Rb * K + C) * 2u; }
    const size_t kstep = (size_t)(BK * 2);
    const size_t hstep = (size_t)HALF * K * 2;
    const size_t tstep = 2 * hstep;
    const unsigned ldsw = (unsigned)wid * 1024u;
    const int aoff = lds_byte(wr * 64 + fr, fq * 8), boff = lds_byte(wc * 32 + fr, fq * 8);
#define PG8_SA(b, h) (((b) * 2 + (h)) * HTB)
#define PG8_SB(b, h) ((4 + (b) * 2 + (h)) * HTB)
#define PG8_STAGE(bufoff, gbase, voff) do { _Pragma("unroll") for (int _i = 0; _i < 2; ++_i) \
        __builtin_amdgcn_global_load_lds((const unsigned*)((const char*)(gbase) + (voff)[_i]), (PG8_LAS unsigned*)(lds + (bufoff) + ldsw + _i * 8192), 16, 0, 0); } while (0)
#define PG8_LDA(dst, b, h) do { _Pragma("unroll") for (int m = 0; m < 4; ++m) _Pragma("unroll") for (int k = 0; k < 2; ++k) dst[m][k] = *(const PG8_LAS bf16x8*)(lds + PG8_SA(b, h) + aoff + m * 2048 + k * 1024); } while (0)
#define PG8_LDB(dst, b, h) do { _Pragma("unroll") for (int n = 0; n < 2; ++n) _Pragma("unroll") for (int k = 0; k < 2; ++k) dst[n][k] = *(const PG8_LAS bf16x8*)(lds + PG8_SB(b, h) + boff + n * 2048 + k * 1024); } while (0)
#define PG8_MMA(ai, bj, At, Bt) do { __builtin_amdgcn_s_setprio(1); _Pragma("unroll") for (int m = 0; m < 4; ++m) _Pragma("unroll") for (int n = 0; n < 2; ++n) _Pragma("unroll") for (int k = 0; k < 2; ++k) \
        acc[ai][bj][m][n] = __builtin_amdgcn_mfma_f32_16x16x32_bf16(Bt[n][k], At[m][k], acc[ai][bj][m][n], 0, 0, 0); __builtin_amdgcn_s_setprio(0); } while (0)
#define PG8_WAIT_V(n) asm volatile("s_waitcnt vmcnt(" #n ")" ::: "memory")
#define PG8_WAIT_L(n) asm volatile("s_waitcnt lgkmcnt(" #n ")" ::: "memory")
#define PG8_BAR __builtin_amdgcn_s_barrier()
#define PG8_SCHED __builtin_amdgcn_sched_barrier(0)
    Unit cur, nxt; int ui = 0;
    if (!S.next(0, cur)) return;
    f32x4 acc[2][2][4][2];
#pragma unroll
    for (int a = 0; a < 2; ++a)
#pragma unroll
        for (int b = 0; b < 2; ++b)
#pragma unroll
            for (int m = 0; m < 4; ++m)
#pragma unroll
                for (int n = 0; n < 2; ++n) acc[a][b][m][n] = (f32x4){0.f, 0.f, 0.f, 0.f};
    bf16x8 At[4][2], B0[2][2], B1[2][2];
    const char* cA = (const char*)g.A + (size_t)cur.pm * tstep; const char* cB = (const char*)g.Bt + (size_t)cur.pn * tstep;
    S.a_ready(cur);
    PG8_STAGE(PG8_SB(0, 0), cB, voffB); PG8_STAGE(PG8_SA(0, 0), cA, voffA); PG8_STAGE(PG8_SB(0, 1), cB + hstep, voffB); PG8_STAGE(PG8_SA(0, 1), cA + hstep, voffA);
    if (wr == 1) PG8_BAR;
    PG8_WAIT_V(4); PG8_BAR;
    PG8_STAGE(PG8_SB(1, 0), cB + kstep, voffB); PG8_STAGE(PG8_SA(1, 0), cA + kstep, voffA); PG8_STAGE(PG8_SB(1, 1), cB + hstep + kstep, voffB);
    PG8_WAIT_V(6); PG8_BAR;
    for (;;) {
        const bool has_next = S.next(ui + 1, nxt);
        const char* nA = has_next ? (const char*)g.A + (size_t)nxt.pm * tstep : cA; const char* nB = has_next ? (const char*)g.Bt + (size_t)nxt.pn * tstep : cB;
        for (int t = 0; t < nt; t += 2) {
            const bool last = (t == nt - 2);
            const char* a1 = cA + (size_t)(t + 1) * kstep;
            const char* a2 = last ? nA : cA + (size_t)(t + 2) * kstep; const char* b2 = last ? nB : cB + (size_t)(t + 2) * kstep;
            const char* a3 = a2 + kstep; const char* b3 = b2 + kstep;
            if (last && has_next) S.a_ready(nxt);
            PG8_LDB(B0, 0, 0); PG8_SCHED; PG8_LDA(At, 0, 0); PG8_STAGE(PG8_SA(1, 1), a1 + hstep, voffA);
            PG8_WAIT_L(8); PG8_BAR; PG8_WAIT_L(0); PG8_MMA(0, 0, At, B0); PG8_BAR; PG8_SCHED;
            PG8_LDB(B1, 0, 1); PG8_STAGE(PG8_SB(0, 0), b2, voffB);
            PG8_BAR; PG8_WAIT_L(0); PG8_MMA(0, 1, At, B1); PG8_BAR;
            PG8_LDA(At, 0, 1); PG8_STAGE(PG8_SA(0, 0), a2, voffA);
            PG8_BAR; PG8_WAIT_L(0); PG8_MMA(1, 0, At, B0); PG8_BAR; PG8_SCHED;
            PG8_STAGE(PG8_SB(0, 1), b2 + hstep, voffB);
            PG8_WAIT_V(6); PG8_BAR; PG8_MMA(1, 1, At, B1); PG8_BAR;
            PG8_LDB(B0, 1, 0); PG8_SCHED; PG8_LDA(At, 1, 0); PG8_STAGE(PG8_SA(0, 1), a2 + hstep, voffA);
            PG8_WAIT_L(8); PG8_BAR; PG8_WAIT_L(0); PG8_MMA(0, 0, At, B0); PG8_BAR; PG8_SCHED;
            PG8_LDB(B1, 1, 1); PG8_STAGE(PG8_SB(1, 0), b3, voffB);
            PG8_BAR; PG8_WAIT_L(0); PG8_MMA(0, 1, At, B1); PG8_BAR;
            PG8_LDA(At, 1, 1); PG8_STAGE(PG8_SA(1, 0), a3, voffA);
            PG8_BAR; PG8_WAIT_L(0); PG8_MMA(1, 0, At, B0); PG8_BAR; PG8_SCHED;
            PG8_STAGE(PG8_SB(1, 1), b3 + hstep, voffB);
            PG8_WAIT_V(6); PG8_BAR; PG8_MMA(1, 1, At, B1); PG8_BAR;
        }
        if constexpr (!Epi::AFTER_DRAIN) { E(acc, cur, wr, wc, fr, fq); S.done(cur); }
        if (!has_next) break;
#pragma unroll
        for (int a = 0; a < 2; ++a)
#pragma unroll
            for (int b = 0; b < 2; ++b)
#pragma unroll
                for (int m = 0; m < 4; ++m)
#pragma unroll
                    for (int n = 0; n < 2; ++n) acc[a][b][m][n] = (f32x4){0.f, 0.f, 0.f, 0.f};
        cur = nxt; cA = nA; cB = nB; ++ui;
    }
    PG8_WAIT_V(0);
    if (wr == 0) PG8_BAR;
    PG8_BAR;
    if constexpr (Epi::AFTER_DRAIN) { E.fused(acc, cur, wr, wc, fr, fq, lds, wid, lane); S.done(cur); }
#undef PG8_SA
#undef PG8_SB
#undef PG8_STAGE
#undef PG8_LDA
#undef PG8_LDB
#undef PG8_MMA
#undef PG8_WAIT_V
#undef PG8_WAIT_L
#undef PG8_BAR
#undef PG8_SCHED
}
}

typedef unsigned short bf16_t;
typedef float f32x4 __attribute__((ext_vector_type(4)));
typedef float f32x2 __attribute__((ext_vector_type(2)));
typedef unsigned u32x4 __attribute__((ext_vector_type(4)));
typedef unsigned u32x2 __attribute__((ext_vector_type(2)));

constexpr int D = 2048, NB = 4, SEQ = 4096, CTXL = 256;
constexpr int ML = NB * SEQ;
constexpr int MC = NB * CTXL;
constexpr int MT = ML + MC;
constexpr int AB_IN = 7616, NIN0 = 7680, PW0 = 7168, TW0 = 512;
constexpr int C_INW = 6176, NIN1 = 6400, PW1 = 6144, TW1 = 256;
constexpr int FF = 5632;
constexpr int MODW = 6 * D;
constexpr int NTHREADS = 512, NWAVES = 8;

constexpr size_t MiB = 1u << 20;
constexpr size_t WS_CTL = 0, CTL_BYTES = 16384;
constexpr size_t WS_MOD = 1 * MiB;
constexpr size_t WS_GA = 2 * MiB, WS_GB = 4 * MiB;
constexpr size_t WS_XC = 6 * MiB;
constexpr size_t WS_HY = 14 * MiB;
constexpr size_t WS_TAIL = 82 * MiB;
constexpr size_t WS_WIN = 116 * MiB;
constexpr size_t WS_WOUT = 146 * MiB;
constexpr size_t WS_W13 = 154 * MiB;
constexpr size_t WS_W2 = 198 * MiB;
constexpr size_t WS_P = 220 * MiB;
constexpr size_t WS_F = 458 * MiB;
constexpr size_t FSLOT = (size_t)MT * 1024 * 2;
constexpr size_t WS_WL = 696 * MiB;
constexpr size_t WS_WG = 698 * MiB;
constexpr size_t WS_END = 700 * MiB;
constexpr size_t WS_A1 = WS_HY, WS_A2 = WS_HY + 16 * MiB;
constexpr size_t WS_GOUT = WS_TAIL;
static_assert(WS_F + 7 * FSLOT <= WS_END, "ws map");
static_assert(WS_HY + (size_t)MT * D * 2 <= WS_TAIL && WS_TAIL + (size_t)MT * TW0 * 4 <= WS_WIN && WS_W2 + (size_t)D * FF * 2 <= WS_P && WS_P + (size_t)MT * PW0 * 2 <= WS_F, "ws map");

constexpr int LDS_BYTES = 147456;
constexpr int LDS_BAR_OFF = LDS_BYTES - 64;

__device__ __forceinline__ float bflo(unsigned u) { return __builtin_bit_cast(float, u << 16); }
__device__ __forceinline__ float bfhi(unsigned u) { return __builtin_bit_cast(float, u & 0xffff0000u); }
__device__ __forceinline__ float bf1(bf16_t h) { return __builtin_bit_cast(float, (unsigned)h << 16); }
__device__ __forceinline__ unsigned f2bf(float f) { unsigned u = __builtin_bit_cast(unsigned, f); return (u + 0x7fffu + ((u >> 16) & 1u)) >> 16; }
__device__ __forceinline__ unsigned pk2(float lo, float hi) { return f2bf(lo) | (f2bf(hi) << 16); }
__device__ __forceinline__ float sigm(float x) { return 1.f / (1.f + expf(-x)); }
__device__ __forceinline__ float sigm_fast(float x) { return 1.f / (1.f + __expf(-x)); }
__device__ __forceinline__ float silu_fast(float x) { return x / (1.f + __expf(-x)); }
__device__ __forceinline__ float softplus_(float x) { return fmaxf(x, 0.f) + log1pf(expf(-fabsf(x))); }
__device__ __forceinline__ float logsigm_(float x) { return fminf(x, 0.f) - log1pf(expf(-fabsf(x))); }
template <int W> __device__ __forceinline__ float grp_sum(float v) {
#pragma unroll
    for (int o = 1; o < W; o <<= 1) v += __shfl_xor(v, o);
    return v;
}
__device__ __forceinline__ void unpack8(const u32x4 u, float (&f)[8]) {
    f[0] = bflo(u.x); f[1] = bfhi(u.x); f[2] = bflo(u.y); f[3] = bfhi(u.y); f[4] = bflo(u.z); f[5] = bfhi(u.z); f[6] = bflo(u.w); f[7] = bfhi(u.w);
}
__device__ __forceinline__ u32x4 pack8(const float (&f)[8]) { u32x4 o; o.x = pk2(f[0], f[1]); o.y = pk2(f[2], f[3]); o.z = pk2(f[4], f[5]); o.w = pk2(f[6], f[7]); return o; }

struct EpiInProj {
    static constexpr bool PERM = true, AFTER_DRAIN = false;
    bf16_t* P; int ldp; int nPt; float* T; int ldt;
    __device__ __forceinline__ void operator()(const pg8::f32x4 (&acc)[2][2][4][2], const pg8::Unit& u, int wr, int wc, int fr, int fq) const {
        const int row0 = u.pm * 256 + wr * 64 + fr;
        if (u.pn < nPt) {
            const int col0 = u.pn * 256 + wc * 32 + 8 * fq;
#pragma unroll
            for (int ai = 0; ai < 2; ++ai)
#pragma unroll
                for (int m = 0; m < 4; ++m) { bf16_t* rowp = P + (size_t)(row0 + ai * 128 + m * 16) * ldp + col0;
#pragma unroll
                    for (int bj = 0; bj < 2; ++bj) { const pg8::f32x4 v0 = acc[ai][bj][m][0], v1 = acc[ai][bj][m][1];
                        u32x4 o; o.x = pk2(v0[0], v0[1]); o.y = pk2(v0[2], v0[3]); o.z = pk2(v1[0], v1[1]); o.w = pk2(v1[2], v1[3]);
                        *(u32x4*)(rowp + bj * 128) = o; } }
        } else {
            const int col0 = (u.pn - nPt) * 256 + wc * 32 + 8 * fq;
#pragma unroll
            for (int ai = 0; ai < 2; ++ai)
#pragma unroll
                for (int m = 0; m < 4; ++m) { float* rowp = T + (size_t)(row0 + ai * 128 + m * 16) * ldt + col0;
#pragma unroll
                    for (int bj = 0; bj < 2; ++bj) { *(pg8::f32x4*)(rowp + bj * 128) = acc[ai][bj][m][0]; *(pg8::f32x4*)(rowp + bj * 128 + 4) = acc[ai][bj][m][1]; } }
        }
    }
};
struct EpiResid {
    static constexpr bool PERM = false, AFTER_DRAIN = false;
    const float* srcL; const float* srcC; float* dstL; float* dstC; const float* gate;
    __device__ __forceinline__ void operator()(const pg8::f32x4 (&acc)[2][2][4][2], const pg8::Unit& u, int wr, int wc, int fr, int fq) const {
        const bool lat = u.pm < 64;
        const int rowl = (lat ? u.pm : u.pm - 64) * 256 + wr * 64 + fr, col0 = u.pn * 256 + wc * 32 + 4 * fq;
        const float* src = lat ? srcL : srcC; float* dst = lat ? dstL : dstC;
        const float* g = gate + (size_t)(lat ? (u.pm >> 4) : 4) * MODW + col0;
        pg8::f32x4 gv[2][2];
#pragma unroll
        for (int bj = 0; bj < 2; ++bj)
#pragma unroll
            for (int n = 0; n < 2; ++n) gv[bj][n] = *(const pg8::f32x4*)(g + bj * 128 + n * 16);
#pragma unroll
        for (int ai = 0; ai < 2; ++ai)
#pragma unroll
            for (int m = 0; m < 4; ++m) { const size_t ro = (size_t)(rowl + ai * 128 + m * 16) * D + col0;
#pragma unroll
                for (int bj = 0; bj < 2; ++bj)
#pragma unroll
                    for (int n = 0; n < 2; ++n) { const pg8::f32x4 s = *(const pg8::f32x4*)(src + ro + bj * 128 + n * 16);
                        *(pg8::f32x4*)(dst + ro + bj * 128 + n * 16) = s + gv[bj][n] * acc[ai][bj][m][n]; } }
    }
};
struct EpiSwiGLU {
    static constexpr bool PERM = true, AFTER_DRAIN = false;
    bf16_t* H; int ldh;
    __device__ __forceinline__ void operator()(const pg8::f32x4 (&acc)[2][2][4][2], const pg8::Unit& u, int wr, int wc, int fr, int fq) const {
        const int row0 = u.pm * 256 + wr * 64 + fr, col0 = u.pn * 128 + wc * 32 + 8 * fq;
#pragma unroll
        for (int ai = 0; ai < 2; ++ai)
#pragma unroll
            for (int m = 0; m < 4; ++m) { float h[8];
#pragma unroll
                for (int n = 0; n < 2; ++n)
#pragma unroll
                    for (int j = 0; j < 4; ++j) h[n * 4 + j] = silu_fast(acc[ai][0][m][n][j]) * acc[ai][1][m][n][j];
                *(u32x4*)(H + (size_t)(row0 + ai * 128 + m * 16) * ldh + col0) = pack8(h); }
    }
};

struct EpiLora {
    static constexpr bool PERM = true, AFTER_DRAIN = false;
    bf16_t* P; int ldp; const float* w0; const float* a0;
    __device__ __forceinline__ void operator()(const pg8::f32x4 (&acc)[2][2][4][2], const pg8::Unit& u, int wr, int wc, int fr, int fq) const {
        const int row0 = u.pm * 256 + wr * 64 + fr, col0 = u.pn * 256 + wc * 32 + 8 * fq;
        const bool isw = u.pn < 8; const float* bp = isw ? w0 + col0 : a0 + (col0 - 2048); const float sc = isw ? -0.6065306597126334f : 1.f;
#pragma unroll
        for (int bj = 0; bj < 2; ++bj) {
            const pg8::f32x4 b0 = *(const pg8::f32x4*)(bp + bj * 128), b1 = *(const pg8::f32x4*)(bp + bj * 128 + 4);
#pragma unroll
            for (int ai = 0; ai < 2; ++ai)
#pragma unroll
                for (int m = 0; m < 4; ++m) { float h[8];
#pragma unroll
                    for (int j = 0; j < 4; ++j) { h[j] = sc * sigm_fast(acc[ai][bj][m][0][j] + b0[j]); h[4 + j] = sc * sigm_fast(acc[ai][bj][m][1][j] + b1[j]); }
                    *(u32x4*)(P + (size_t)(row0 + ai * 128 + m * 16) * ldp + col0 + bj * 128) = pack8(h); } }
    }
};
struct EpiBf16Plain {
    static constexpr bool PERM = true, AFTER_DRAIN = false;
    bf16_t* O; int ldo;
    __device__ __forceinline__ void operator()(const pg8::f32x4 (&acc)[2][2][4][2], const pg8::Unit& u, int wr, int wc, int fr, int fq) const {
        const int row0 = u.pm * 256 + wr * 64 + fr, col0 = u.pn * 256 + wc * 32 + 8 * fq;
#pragma unroll
        for (int ai = 0; ai < 2; ++ai)
#pragma unroll
            for (int m = 0; m < 4; ++m) { bf16_t* rowp = O + (size_t)(row0 + ai * 128 + m * 16) * ldo + col0;
#pragma unroll
                for (int bj = 0; bj < 2; ++bj) { const pg8::f32x4 v0 = acc[ai][bj][m][0], v1 = acc[ai][bj][m][1];
                    u32x4 o; o.x = pk2(v0[0], v0[1]); o.y = pk2(v0[2], v0[3]); o.z = pk2(v1[0], v1[1]); o.w = pk2(v1[2], v1[3]);
                    *(u32x4*)(rowp + bj * 128) = o; } }
    }
};

struct Ctx {
    LAS unsigned char* lds; int tid, lane, wave, G, wg, gw, NGW;
    const float* in[32]; float* out; unsigned char* ws;
};
#define IN_X 0
#define IN_C 1
#define IN_CTX 2
#define IN_CCTX 3
#define IN_ADAW 4
#define IN_ADAB 5
#define IN_NORMW 6
#define IN_ABWIN 7
#define IN_CONVW 8
#define IN_ALOG 9
#define IN_DTB 10
#define IN_GDNNW 11
#define IN_W0 12
#define IN_WUP 13
#define IN_A0 14
#define IN_AUP 15
#define IN_GUP 16
#define IN_KK 17
#define IN_KA 18
#define IN_RK 19
#define IN_LNW 20
#define IN_LNB 21
#define IN_ABWOUT 22
#define IN_MLWIN 23
#define IN_MLIB 24
#define IN_MLFB 25
#define IN_MLNW 26
#define IN_MLWOUT 27
#define IN_W1 28
#define IN_W3 29
#define IN_W2 30
#define IN_FNW 31

__device__ __forceinline__ void transpose_item(const float* W, int K, int N, bf16_t* WT, int out_row0, LAS float* scr, int k0, int n0, int lane) {
#pragma unroll 8
    for (int i = 0; i < 32; ++i) { const int kk = 2 * i + (lane >> 5); scr[kk * 33 + (lane & 31)] = W[(size_t)(k0 + kk) * N + n0 + (lane & 31)]; }
    asm volatile("s_waitcnt lgkmcnt(0)" ::: "memory");
    const int c = lane & 7;
#pragma unroll
    for (int j = 0; j < 4; ++j) { const int n = (lane >> 3) + 8 * j; const LAS float* s = scr + (8 * c) * 33 + n;
        u32x4 o; o.x = pk2(s[0 * 33], s[1 * 33]); o.y = pk2(s[2 * 33], s[3 * 33]); o.z = pk2(s[4 * 33], s[5 * 33]); o.w = pk2(s[6 * 33], s[7 * 33]);
        *(u32x4*)(WT + (size_t)(out_row0 + n) * K + k0 + 8 * c) = o; }
    asm volatile("s_waitcnt lgkmcnt(0)" ::: "memory");
}
__device__ __forceinline__ void transpose_matrix(const Ctx& c, const float* W, int K, int N, bf16_t* WT, int mode, LAS float* scr) {
    const int nblk = N / 32, items = (K / 64) * nblk;
    for (int it = c.gw; it < items; it += c.NGW) {
        const int kb = it / nblk, nb = it % nblk, n0 = nb * 32;
        const int orow = mode == 0 ? n0 : ((n0 >> 7) * 256 + (n0 & 127) + (mode == 2 ? 128 : 0));
        transpose_item(W, K, N, WT, orow, scr, kb * 64, n0, c.lane);
    }
}
__device__ __forceinline__ void zero_rows(const Ctx& c, bf16_t* WT, int K, int r0, int r1) {
    u32x4* p = (u32x4*)(WT + (size_t)r0 * K); const size_t n = (size_t)(r1 - r0) * K / 8;
    for (size_t i = (size_t)c.wg * NTHREADS + c.tid; i < n; i += (size_t)c.G * NTHREADS) p[i] = (u32x4){0u, 0u, 0u, 0u};
}
__device__ __forceinline__ void convert_weights(const Ctx& c, int layer) {
    LAS float* scr = (LAS float*)(c.lds + 65536) + c.wave * (64 * 33);
    bf16_t* Win = (bf16_t*)(c.ws + WS_WIN); bf16_t* Wout = (bf16_t*)(c.ws + WS_WOUT); bf16_t* W13 = (bf16_t*)(c.ws + WS_W13); bf16_t* W2 = (bf16_t*)(c.ws + WS_W2);
    if (layer == 0) { transpose_matrix(c, c.in[IN_ABWIN], D, AB_IN, Win, 0, scr); zero_rows(c, Win, D, AB_IN, NIN0); transpose_matrix(c, c.in[IN_ABWOUT], D, D, Wout, 0, scr); }
    else { transpose_matrix(c, c.in[IN_MLWIN], D, C_INW, Win, 0, scr); zero_rows(c, Win, D, C_INW, NIN1); transpose_matrix(c, c.in[IN_MLWOUT], D, D, Wout, 0, scr); }
    transpose_matrix(c, c.in[IN_W1] + (size_t)layer * D * FF, D, FF, W13, 1, scr);
    transpose_matrix(c, c.in[IN_W3] + (size_t)layer * D * FF, D, FF, W13, 2, scr);
    transpose_matrix(c, c.in[IN_W2] + (size_t)layer * FF * D, FF, D, W2, 0, scr);
}
__device__ __forceinline__ void lora_weight_phase(const Ctx& c) {
    bf16_t* Wl = (bf16_t*)(c.ws + WS_WL); bf16_t* Wg = (bf16_t*)(c.ws + WS_WG);
    for (int idx = c.wg * NTHREADS + c.tid; idx < 32 * 4096; idx += c.G * NTHREADS) {
        const int k8 = idx >> 12, n = idx & 4095, slot = n >> 10, ch = n & 1023; float v[8];
        const float* src = c.in[slot < 2 ? IN_WUP : IN_AUP] + (size_t)(slot & 1) * 64 * 1024 + ch;
#pragma unroll
        for (int q = 0; q < 8; ++q) { const int kk = k8 * 8 + q; v[q] = ((kk >> 6) == slot) ? src[(size_t)(kk & 63) * 1024] : 0.f; }
        *(u32x4*)(Wl + (size_t)n * 256 + k8 * 8) = pack8(v);
    }
    for (int idx = c.wg * NTHREADS + c.tid; idx < 32 * 1024; idx += c.G * NTHREADS) {
        const int k8 = idx >> 10, ch = idx & 1023; float v[8];
#pragma unroll
        for (int q = 0; q < 8; ++q) { const int kk = k8 * 8 + q; v[q] = kk < 160 ? c.in[IN_GUP][(size_t)kk * 1024 + ch] : 0.f; }
        *(u32x4*)(Wg + (size_t)ch * 256 + k8 * 8) = pack8(v);
    }
}
__device__ __forceinline__ void ada_phase(const Ctx& c) {
    LAS float* sc = (LAS float*)c.lds;
    LAS float* red = sc + 5 * D;
    for (int i = c.tid; i < 5 * D; i += NTHREADS) { const int b = i / D, k = i % D; const float v = b < 4 ? c.in[IN_C][b * D + k] : c.in[IN_CCTX][k]; sc[i] = v / (1.f + expf(-v)); }
    __syncthreads();
    float* MOD = (float*)(c.ws + WS_MOD);
    for (int u = c.wg; u < 2 * (MODW / 64); u += c.G) {
        const int layer = u / (MODW / 64), cb = (u % (MODW / 64)) * 64;
        const float* wp = c.in[IN_ADAW] + (size_t)layer * D * MODW + cb + c.lane;
        float acc[5] = {0.f, 0.f, 0.f, 0.f, 0.f};
        const int k0 = c.wave * 256;
#pragma unroll 16
        for (int k = k0; k < k0 + 256; ++k) { const float w = wp[(size_t)k * MODW];
#pragma unroll
            for (int b = 0; b < 5; ++b) acc[b] += sc[b * D + k] * w; }
#pragma unroll
        for (int b = 0; b < 5; ++b) red[(c.wave * 5 + b) * 64 + c.lane] = acc[b];
        __syncthreads();
        if (c.tid < 320) { const int b = c.tid / 64, l = c.tid % 64; float s = 0.f;
#pragma unroll
            for (int w = 0; w < 8; ++w) s += red[(w * 5 + b) * 64 + l];
            MOD[(size_t)(layer * 5 + b) * MODW + cb + l] = s + c.in[IN_ADAB][layer * MODW + cb + l]; }
        __syncthreads();
    }
}
__device__ __forceinline__ void norm_mod_phase(const Ctx& c, const float* srcL, const float* srcC, const float* nw, const float* modl, int shift_off, int scale_off, int nrows) {
    bf16_t* H = (bf16_t*)(c.ws + WS_HY);
    for (int r = c.gw; r < nrows; r += c.NGW) {
        const float* xr = r < ML ? srcL + (size_t)r * D : srcC + (size_t)(r - ML) * D;
        const float* mr = modl + (size_t)(r < ML ? (r >> 12) : 4) * MODW;
        f32x4 v[8]; float ss = 0.f;
#pragma unroll
        for (int j = 0; j < 8; ++j) { v[j] = ((const f32x4*)xr)[c.lane + 64 * j]; ss += v[j].x * v[j].x + v[j].y * v[j].y + v[j].z * v[j].z + v[j].w * v[j].w; }
        ss = grp_sum<64>(ss);
        const float rstd = 1.f / sqrtf(ss * (1.f / D) + 1e-6f);
#pragma unroll
        for (int j = 0; j < 8; ++j) { const f32x4 w4 = ((const f32x4*)nw)[c.lane + 64 * j], s4 = ((const f32x4*)(mr + scale_off))[c.lane + 64 * j], h4 = ((const f32x4*)(mr + shift_off))[c.lane + 64 * j];
            const f32x4 y = v[j] * rstd * w4 * (s4 + 1.f) + h4;
            u32x2 o; o.x = pk2(y.x, y.y); o.y = pk2(y.z, y.w);
            ((u32x2*)(H + (size_t)r * D))[c.lane + 64 * j] = o; }
    }
}
__device__ __forceinline__ void final_norm_phase(const Ctx& c) {
    const float* nw = c.in[IN_FNW];
    for (int r = c.gw; r < ML; r += c.NGW) {
        f32x4* xr = (f32x4*)(c.out + (size_t)r * D);
        f32x4 v[8]; float ss = 0.f;
#pragma unroll
        for (int j = 0; j < 8; ++j) { v[j] = xr[c.lane + 64 * j]; ss += v[j].x * v[j].x + v[j].y * v[j].y + v[j].z * v[j].z + v[j].w * v[j].w; }
        ss = grp_sum<64>(ss);
        const float rstd = 1.f / sqrtf(ss * (1.f / D) + 1e-6f);
#pragma unroll
        for (int j = 0; j < 8; ++j) xr[c.lane + 64 * j] = v[j] * rstd * ((const f32x4*)nw)[c.lane + 64 * j];
    }
}

__device__ __forceinline__ void ab_feature_phase(const Ctx& c) {
    const bf16_t* P = (const bf16_t*)(c.ws + WS_P); const float* T = (const float*)(c.ws + WS_TAIL);
    bf16_t* F = (bf16_t*)(c.ws + WS_F);
    float* GA = (float*)(c.ws + WS_GA); float* GB = (float*)(c.ws + WS_GB);
    const float* cw = c.in[IN_CONVW];
    const int lane = c.lane;
    for (int it = 0; it * c.NGW < MT; ++it) {
        const int r = it * c.NGW + c.wg * NWAVES + c.wave;
        if (r >= MT) break;
        int nb[9];
        if (r < ML) { const int b = r >> 12, t = r & 4095, gr = t >> 6, gc = t & 63;
#pragma unroll
            for (int dr = 0; dr < 3; ++dr)
#pragma unroll
                for (int dc = 0; dc < 3; ++dc) { const int rr = gr + dr - 1, cc = gc + dc - 1; nb[dr * 3 + dc] = (rr >= 0 && rr < 64 && cc >= 0 && cc < 64) ? (b * 4096 + rr * 64 + cc) : -1; } }
        else { const int q = r - ML, b = q >> 8, t = q & 255;
#pragma unroll
            for (int k = 0; k < 9; ++k) nb[k] = -1;
#pragma unroll
            for (int dc = 0; dc < 3; ++dc) { const int cc = t + dc - 1; nb[3 + dc] = (cc >= 0 && cc < 256) ? (ML + b * 256 + cc) : -1; } }
#pragma unroll 1
        for (int blk = 0; blk < 12; ++blk) {
            const int ch = blk * 512 + lane * 8;
            float cv[8];
#pragma unroll
            for (int j = 0; j < 8; ++j) cv[j] = 0.f;
#pragma unroll
            for (int k = 0; k < 9; ++k) if (nb[k] >= 0) {
                const u32x4 pv = *(const u32x4*)(P + (size_t)nb[k] * PW0 + ch);
                const f32x4 w0 = *(const f32x4*)(cw + k * 6144 + ch), w1 = *(const f32x4*)(cw + k * 6144 + ch + 4);
                float pf[8]; unpack8(pv, pf);
                cv[0] += pf[0] * w0.x; cv[1] += pf[1] * w0.y; cv[2] += pf[2] * w0.z; cv[3] += pf[3] * w0.w;
                cv[4] += pf[4] * w1.x; cv[5] += pf[5] * w1.y; cv[6] += pf[6] * w1.z; cv[7] += pf[7] * w1.w; }
            const int grp = blk >> 1, cl = (blk & 1) * 512 + lane * 8;
            if (grp < 3) {
                float ss = 0.f;
#pragma unroll
                for (int j = 0; j < 8; ++j) { cv[j] = cv[j] / (1.f + __expf(-cv[j])); ss += cv[j] * cv[j]; }
                if (grp < 2) { ss = grp_sum<16>(ss); const float sc = (1.f / sqrtf(ss + 1e-6f)) * (grp == 0 ? 0.08838834764831845f : 1.f);
#pragma unroll
                    for (int j = 0; j < 8; ++j) cv[j] *= sc; }
                *(u32x4*)(F + (size_t)grp * MT * 1024 + (size_t)r * 1024 + cl) = pack8(cv);
            } else if (grp == 3) { *(u32x4*)(F + (size_t)3 * MT * 1024 + (size_t)r * 1024 + cl) = pack8(cv);
            } else if (grp == 5) { *(u32x4*)(F + (size_t)6 * MT * 1024 + (size_t)r * 1024 + cl) = pack8(cv);
            } else {
                *(u32x4*)(F + (size_t)5 * MT * 1024 + (size_t)r * 1024 + cl) = pack8(cv);
                const f32x4 k0 = *(const f32x4*)(c.in[IN_KK] + cl), k1 = *(const f32x4*)(c.in[IN_KK] + cl + 4);
                float t[8] = {cv[0] * k0.x, cv[1] * k0.y, cv[2] * k0.z, cv[3] * k0.w, cv[4] * k1.x, cv[5] * k1.y, cv[6] * k1.z, cv[7] * k1.w};
                float ss = 0.f;
#pragma unroll
                for (int j = 0; j < 8; ++j) ss += t[j] * t[j];
                ss = grp_sum<8>(ss); const float sc = 1.f / sqrtf(ss + 1e-6f);
#pragma unroll
                for (int j = 0; j < 8; ++j) t[j] *= sc;
                *(u32x4*)(F + (size_t)4 * MT * 1024 + (size_t)r * 1024 + cl) = pack8(t);
            }
        }
        {
            bf16_t* A1 = (bf16_t*)(c.ws + WS_A1); bf16_t* A2 = (bf16_t*)(c.ws + WS_A2);
            const f32x4 t1 = *(const f32x4*)(T + (size_t)r * TW0 + 32 + lane * 4);
            u32x2 o1; if (lane < 32) { o1.x = pk2(tanhf(t1.x), tanhf(t1.y)); o1.y = pk2(tanhf(t1.z), tanhf(t1.w)); } else { o1.x = pk2(t1.x, t1.y); o1.y = pk2(t1.z, t1.w); }
            *(u32x2*)(A1 + (size_t)r * 256 + lane * 4) = o1;
            u32x2 o2 = {0u, 0u};
            if (lane < 40) { const f32x4 t2 = *(const f32x4*)(T + (size_t)r * TW0 + 288 + lane * 4); o2.x = pk2(sigm(t2.x), sigm(t2.y)); o2.y = pk2(sigm(t2.z), sigm(t2.w)); }
            *(u32x2*)(A2 + (size_t)r * 256 + lane * 4) = o2;
        }
        if (lane < 16) {
            const float g0 = T[(size_t)r * TW0 + lane], g1 = T[(size_t)r * TW0 + 16 + lane];
            GA[(size_t)r * 16 + lane] = -expf(c.in[IN_ALOG][lane]) * softplus_(g0 + c.in[IN_DTB][lane]);
            GB[(size_t)r * 16 + lane] = sigm(g1);
        }
    }
}
__device__ __forceinline__ void rw_lora_phase(const Ctx& c) {
    bf16_t* P = (bf16_t*)(c.ws + WS_P); const float* T = (const float*)(c.ws + WS_TAIL);
    LAS float* xin = (LAS float*)c.lds;
    const int tid = c.tid;
    for (int tile = c.wg; tile < MT / 16; tile += c.G) {
        const int r0 = tile * 16;
#pragma unroll 1
        for (int pass = 0; pass < 2; ++pass) {
            __syncthreads();
            for (int i = tid; i < 16 * 128; i += NTHREADS) { const int tk = i >> 7, j = i & 127; const float v = T[(size_t)(r0 + tk) * TW0 + 32 + pass * 128 + j]; xin[i] = pass == 0 ? tanhf(v) : v; }
            __syncthreads();
            const float* up = c.in[pass == 0 ? IN_WUP : IN_AUP];
            float acc[16][2][2];
#pragma unroll
            for (int tk = 0; tk < 16; ++tk) { acc[tk][0][0] = acc[tk][0][1] = acc[tk][1][0] = acc[tk][1][1] = 0.f; }
#pragma unroll 2
            for (int rr = 0; rr < 64; ++rr) {
                const float w00 = up[(size_t)rr * 1024 + tid], w01 = up[(size_t)rr * 1024 + tid + 512], w10 = up[(size_t)(64 + rr) * 1024 + tid], w11 = up[(size_t)(64 + rr) * 1024 + tid + 512];
#pragma unroll
                for (int tk = 0; tk < 16; ++tk) { const float x0 = xin[tk * 128 + rr], x1 = xin[tk * 128 + 64 + rr];
                    acc[tk][0][0] += x0 * w00; acc[tk][0][1] += x0 * w01; acc[tk][1][0] += x1 * w10; acc[tk][1][1] += x1 * w11; }
            }
            const float* bias = c.in[pass == 0 ? IN_W0 : IN_A0];
#pragma unroll
            for (int d = 0; d < 2; ++d)
#pragma unroll
                for (int j = 0; j < 2; ++j) { const int ch = tid + 512 * j; const float bz = bias[d * 1024 + ch];
#pragma unroll
                    for (int tk = 0; tk < 16; ++tk) { const float s = sigm(bz + acc[tk][d][j]);
                        P[(size_t)(r0 + tk) * PW0 + (pass * 2 + d) * 1024 + ch] = (bf16_t)f2bf(pass == 0 ? -0.6065306597126334f * s : s); } }
        }
    }
}
__device__ __forceinline__ int chunk_row(int b, int dir, int s) {
    if (s < 4) return ML + b * 256 + (dir == 0 ? s : 3 - s) * 64;
    return b * 4096 + (dir == 0 ? s - 4 : 67 - s) * 64;
}
__device__ __forceinline__ void gdn_scan_phase(const Ctx& c) {
    const bf16_t* F = (const bf16_t*)(c.ws + WS_F); bf16_t* P = (bf16_t*)(c.ws + WS_P);
    const float* GA = (const float*)(c.ws + WS_GA); const float* GB = (const float*)(c.ws + WS_GB);
    const int lane = c.lane, tid = c.tid, slab = lane & 15, cl = c.wave * 4 + (lane >> 4);
    for (int item = c.wg; item < 256; item += c.G) {
        const int chain = item >> 2, cq = item & 3, b = chain >> 4, h = (chain >> 1) & 7, dir = chain & 1;
        float S[8];
#pragma unroll
        for (int i = 0; i < 8; ++i) S[i] = 0.f;
        u32x4 rk[2], rq[2], rv; float rg = 0.f, rb = 0.f;
        auto gload = [&](int s) {
            const int row0 = chunk_row(b, dir, s);
#pragma unroll
            for (int i = 0; i < 2; ++i) { const int pc = tid + i * 512, tk = pc >> 4, o = (pc & 15) * 8;
                rk[i] = *(const u32x4*)(F + (size_t)1 * MT * 1024 + (size_t)(row0 + tk) * 1024 + h * 128 + o);
                rq[i] = *(const u32x4*)(F + (size_t)0 * MT * 1024 + (size_t)(row0 + tk) * 1024 + h * 128 + o); }
            if (tid < 256) { const int tk = tid >> 2, o = (tid & 3) * 8; rv = *(const u32x4*)(F + (size_t)2 * MT * 1024 + (size_t)(row0 + tk) * 1024 + h * 128 + cq * 32 + o); }
            if (tid < 64) { rg = GA[(size_t)(row0 + tid) * 16 + dir * 8 + h]; rb = GB[(size_t)(row0 + tid) * 16 + dir * 8 + h]; }
        };
        auto lstore = [&](int bufi) {
            LAS unsigned char* bp = c.lds + bufi * 40960;
#pragma unroll
            for (int i = 0; i < 2; ++i) { const int pc = tid + i * 512; *(LAS u32x4*)(bp + pc * 16) = rk[i]; *(LAS u32x4*)(bp + 16384 + pc * 16) = rq[i]; }
            if (tid < 256) *(LAS u32x4*)(bp + 32768 + tid * 16) = rv;
            if (tid < 64) { *(LAS float*)(bp + 36864 + tid * 4) = rg; *(LAS float*)(bp + 37120 + tid * 4) = rb; }
        };
        __syncthreads();
        gload(0); lstore(0);
        __syncthreads();
        LAS float* ost = (LAS float*)(c.lds + 81920);
#pragma unroll 1
        for (int s = 0; s < 68; ++s) {
            if (s + 1 < 68) gload(s + 1);
            const LAS unsigned char* bp = c.lds + (s & 1) * 40960;
#pragma unroll 2
            for (int j = 0; j < 64; ++j) {
                const int tl = dir == 0 ? j : 63 - j;
                float kf[8], qf[8];
                unpack8(*(const LAS u32x4*)(bp + tl * 256 + slab * 16), kf);
                unpack8(*(const LAS u32x4*)(bp + 16384 + tl * 256 + slab * 16), qf);
                const float vv = bf1(*(const LAS bf16_t*)(bp + 32768 + tl * 64 + cl * 2));
                const float a = __expf(*(const LAS float*)(bp + 36864 + tl * 4)), bt = *(const LAS float*)(bp + 37120 + tl * 4);
                float dot = 0.f;
#pragma unroll
                for (int i = 0; i < 8; ++i) dot += S[i] * kf[i];
                dot = grp_sum<16>(dot);
                const float dlt = bt * (vv - a * dot);
                float od = 0.f;
#pragma unroll
                for (int i = 0; i < 8; ++i) { S[i] = a * S[i] + kf[i] * dlt; od += S[i] * qf[i]; }
                od = grp_sum<16>(od);
                if (slab == 0) ost[tl * 32 + cl] = od;
            }
            __syncthreads();
            {
                const int row0 = chunk_row(b, dir, s), tk = tid >> 3, o = (tid & 7) * 4;
                const f32x4 v = *(const LAS f32x4*)(ost + tk * 32 + o);
                u32x2 w; w.x = pk2(v.x, v.y); w.y = pk2(v.z, v.w);
                *(u32x2*)(P + (size_t)(row0 + tk) * PW0 + (4 + dir) * 1024 + h * 128 + cq * 32 + o) = w;
            }
            if (s + 1 < 68) lstore((s + 1) & 1);
            __syncthreads();
        }
    }
}
__device__ __forceinline__ void rwkv_scan_phase(const Ctx& c) {
    const bf16_t* F = (const bf16_t*)(c.ws + WS_F); const bf16_t* P = (const bf16_t*)(c.ws + WS_P);
    bf16_t* Y = (bf16_t*)(c.ws + WS_F);
    const int lane = c.lane, tid = c.tid, slab = lane & 15, rl = c.wave * 4 + (lane >> 4);
    for (int item = c.wg; item < 256; item += c.G) {
        const int chain = item >> 1, rh = item & 1, b = chain >> 5, h = (chain >> 1) & 15, dir = chain & 1;
        float S[4] = {0.f, 0.f, 0.f, 0.f};
        const f32x4 ka = *(const f32x4*)(c.in[IN_KA] + h * 64 + slab * 4);
        u32x4 rr[5]; u32x4 rv;
        auto gload = [&](int s) {
            const int row0 = chunk_row(b, dir, s);
            const int tk = tid >> 3, o = (tid & 7) * 8;
            rr[0] = *(const u32x4*)(F + (size_t)3 * MT * 1024 + (size_t)(row0 + tk) * 1024 + h * 64 + o);
            rr[1] = *(const u32x4*)(F + (size_t)4 * MT * 1024 + (size_t)(row0 + tk) * 1024 + h * 64 + o);
            rr[2] = *(const u32x4*)(F + (size_t)5 * MT * 1024 + (size_t)(row0 + tk) * 1024 + h * 64 + o);
            rr[3] = *(const u32x4*)(P + (size_t)(row0 + tk) * PW0 + (0 + dir) * 1024 + h * 64 + o);
            rr[4] = *(const u32x4*)(P + (size_t)(row0 + tk) * PW0 + (2 + dir) * 1024 + h * 64 + o);
            if (tid < 256) { const int t2 = tid >> 2, o2 = (tid & 3) * 8; rv = *(const u32x4*)(F + (size_t)6 * MT * 1024 + (size_t)(row0 + t2) * 1024 + h * 64 + rh * 32 + o2); }
        };
        auto lstore = [&](int bufi) {
            LAS unsigned char* bp = c.lds + bufi * 45056;
#pragma unroll
            for (int q = 0; q < 5; ++q) *(LAS u32x4*)(bp + q * 8192 + tid * 16) = rr[q];
            if (tid < 256) *(LAS u32x4*)(bp + 40960 + tid * 16) = rv;
        };
        __syncthreads();
        gload(0); lstore(0);
        __syncthreads();
        LAS float* yst = (LAS float*)(c.lds + 90112);
#pragma unroll 1
        for (int s = 0; s < 68; ++s) {
            if (s + 1 < 68) gload(s + 1);
            const LAS unsigned char* bp = c.lds + (s & 1) * 45056;
#pragma unroll 2
            for (int j = 0; j < 64; ++j) {
                const int tl = dir == 0 ? j : 63 - j;
                const u32x2 ur = *(const LAS u32x2*)(bp + tl * 128 + slab * 8), ukk = *(const LAS u32x2*)(bp + 8192 + tl * 128 + slab * 8), ukb = *(const LAS u32x2*)(bp + 16384 + tl * 128 + slab * 8),
                            ulw = *(const LAS u32x2*)(bp + 24576 + tl * 128 + slab * 8), ua = *(const LAS u32x2*)(bp + 32768 + tl * 128 + slab * 8);
                const float vv = bf1(*(const LAS bf16_t*)(bp + 40960 + tl * 64 + rl * 2));
                const float rf[4] = {bflo(ur.x), bfhi(ur.x), bflo(ur.y), bfhi(ur.y)}, kkf[4] = {bflo(ukk.x), bfhi(ukk.x), bflo(ukk.y), bfhi(ukk.y)}, kbf[4] = {bflo(ukb.x), bfhi(ukb.x), bflo(ukb.y), bfhi(ukb.y)},
                            lwf[4] = {bflo(ulw.x), bfhi(ulw.x), bflo(ulw.y), bfhi(ulw.y)}, af[4] = {bflo(ua.x), bfhi(ua.x), bflo(ua.y), bfhi(ua.y)};
                float sk = 0.f;
#pragma unroll
                for (int i = 0; i < 4; ++i) sk += S[i] * kkf[i];
                sk = grp_sum<16>(sk);
                float y = 0.f;
#pragma unroll
                for (int i = 0; i < 4; ++i) { const float w = __expf(lwf[i]), kka = kkf[i] * af[i], kt = kbf[i] * (1.f + (af[i] - 1.f) * ka[i]);
                    S[i] = S[i] * w - sk * kka + vv * kt; y += S[i] * rf[i]; }
                y = grp_sum<16>(y);
                if (slab == 0) yst[tl * 32 + rl] = y;
            }
            __syncthreads();
            {   const int row0 = chunk_row(b, dir, s), tk = tid >> 3, o = (tid & 7) * 4;
                const f32x4 v = *(const LAS f32x4*)(yst + tk * 32 + o);
                u32x2 w; w.x = pk2(v.x, v.y); w.y = pk2(v.z, v.w);
                *(u32x2*)(Y + (size_t)dir * MT * 1024 + (size_t)(row0 + tk) * 1024 + h * 64 + rh * 32 + o) = w;
            }
            if (s + 1 < 68) lstore((s + 1) & 1);
            __syncthreads();
        }
    }
}
__device__ __forceinline__ void ab_output_phase(const Ctx& c) {
    const bf16_t* F = (const bf16_t*)(c.ws + WS_F); const bf16_t* P = (const bf16_t*)(c.ws + WS_P); const float* T = (const float*)(c.ws + WS_TAIL);
    bf16_t* Yo = (bf16_t*)(c.ws + WS_HY);
    const bf16_t* GO = (const bf16_t*)(c.ws + WS_GOUT);
    const int tid = c.tid, lane = c.lane, wave = c.wave;
    for (int tile = c.wg; tile < MT / 16; tile += c.G) {
        const int r0 = tile * 16;
#pragma unroll
        for (int j = 0; j < 2; ++j) {
            const int ch = tid + 512 * j;
            const float kaj = c.in[IN_KA][ch], rkj = c.in[IN_RK][ch], lnw = c.in[IN_LNW][ch], lnb = c.in[IN_LNB][ch];
#pragma unroll 4
            for (int tk = 0; tk < 16; ++tk) {
                const size_t row = (size_t)(r0 + tk);
                const float y = bf1(Yo[row * D + 1024 + ch]) + bf1(Yo[row * D + ch]);
                const float rv = bf1(F[(size_t)3 * MT * 1024 + row * 1024 + ch]), kb = bf1(F[(size_t)5 * MT * 1024 + row * 1024 + ch]), vb = bf1(F[(size_t)6 * MT * 1024 + row * 1024 + ch]);
                const float a0 = bf1(P[row * PW0 + 2048 + ch]), a1 = bf1(P[row * PW0 + 3072 + ch]);
                const float mu = grp_sum<64>(y) * (1.f / 64.f), dv = y - mu, var = grp_sum<64>(dv * dv) * (1.f / 64.f);
                const float kts = kb * (2.f + (a0 + a1 - 2.f) * kaj);
                const float bonus = grp_sum<64>(rv * kts * rkj) * vb;
                const float o = (dv * (1.f / sqrtf(var + 64e-5f)) * lnw + lnb + bonus) * bf1(GO[row * 1024 + ch]);
                Yo[row * D + 1024 + ch] = (bf16_t)f2bf(o);
            }
        }
        __syncthreads();
        {   const int ch = 2 * tid;
            const float nw0 = c.in[IN_GDNNW][ch & 127], nw1 = c.in[IN_GDNNW][(ch & 127) + 1];
#pragma unroll 4
            for (int tk = 0; tk < 16; ++tk) {
                const size_t row = (size_t)(r0 + tk);
                const unsigned uf = *(const unsigned*)(P + row * PW0 + 4096 + ch), ub = *(const unsigned*)(P + row * PW0 + 5120 + ch), uz = *(const unsigned*)(P + row * PW0 + 6144 + ch);
                const float o0 = bflo(uf) + bflo(ub), o1 = bfhi(uf) + bfhi(ub);
                const float ss = grp_sum<64>(o0 * o0 + o1 * o1), rstd = 1.f / sqrtf(ss * (1.f / 128.f) + 1e-6f);
                const float z0 = bflo(uz), z1 = bfhi(uz);
                *(unsigned*)(Yo + row * D + ch) = pk2(o0 * rstd * nw0 * silu_fast(z0), o1 * rstd * nw1 * silu_fast(z1));
            }
        }
    }
}

__device__ __forceinline__ void ml_gate_phase(const Ctx& c) {
    const float* T = (const float*)(c.ws + WS_TAIL); float* GA = (float*)(c.ws + WS_GA); float* GB = (float*)(c.ws + WS_GB);
    for (size_t i = (size_t)c.wg * NTHREADS + c.tid; i < (size_t)MT * 16; i += (size_t)c.G * NTHREADS) {
        const size_t r = i >> 4; const int k = (int)(i & 15);
        const float gi = T[r * TW1 + k] + c.in[IN_MLIB][k], gf = T[r * TW1 + 16 + k] + c.in[IN_MLFB][k];
        GA[i] = 15.f * tanhf(gi * (1.f / 15.f));
        GB[i] = logsigm_(15.f * tanhf(gf * (1.f / 15.f)));
    }
}
__device__ __forceinline__ void mlstm_scan_phase(const Ctx& c) {
    const bf16_t* P = (const bf16_t*)(c.ws + WS_P); bf16_t* Hs = (bf16_t*)(c.ws + WS_F);
    const float* GA = (const float*)(c.ws + WS_GA); const float* GB = (const float*)(c.ws + WS_GB);
    const int lane = c.lane, tid = c.tid, slab = lane & 15, cp = c.wave * 4 + (lane >> 4);
    for (int item = c.wg; item < 256; item += c.G) {
        const int chain = item >> 2, cq = item & 3, b = chain >> 4, h = (chain >> 1) & 7, dir = chain & 1;
        float C[8][2], n[8]; float m = 0.f;
#pragma unroll
        for (int i = 0; i < 8; ++i) { C[i][0] = C[i][1] = 0.f; n[i] = 0.f; }
        u32x4 rk[2], rq[2], rv; float rg = 0.f, rb = 0.f;
        auto gload = [&](int s) {
            const int row0 = chunk_row(b, dir, s);
#pragma unroll
            for (int i = 0; i < 2; ++i) { const int pc = tid + i * 512, tk = pc >> 4, o = (pc & 15) * 8;
                rk[i] = *(const u32x4*)(P + (size_t)(row0 + tk) * PW1 + 1024 + h * 128 + o);
                rq[i] = *(const u32x4*)(P + (size_t)(row0 + tk) * PW1 + h * 128 + o); }
            { const int tk = tid >> 3, o = (tid & 7) * 8; rv = *(const u32x4*)(P + (size_t)(row0 + tk) * PW1 + 2048 + h * 256 + cq * 64 + o); }
            if (tid < 64) { rg = GA[(size_t)(row0 + tid) * 16 + dir * 8 + h]; rb = GB[(size_t)(row0 + tid) * 16 + dir * 8 + h]; }
        };
        auto lstore = [&](int bufi) {
            LAS unsigned char* bp = c.lds + bufi * 41472;
#pragma unroll
            for (int i = 0; i < 2; ++i) { const int pc = tid + i * 512; *(LAS u32x4*)(bp + pc * 16) = rk[i]; *(LAS u32x4*)(bp + 16384 + pc * 16) = rq[i]; }
            *(LAS u32x4*)(bp + 32768 + tid * 16) = rv;
            if (tid < 64) { *(LAS float*)(bp + 40960 + tid * 4) = rg; *(LAS float*)(bp + 41216 + tid * 4) = rb; }
        };
        __syncthreads();
        gload(0); lstore(0);
        __syncthreads();
        LAS float* hst = (LAS float*)(c.lds + 82944);
#pragma unroll 1
        for (int s = 0; s < 68; ++s) {
            if (s + 1 < 68) gload(s + 1);
            const LAS unsigned char* bp = c.lds + (s & 1) * 41472;
#pragma unroll 2
            for (int j = 0; j < 64; ++j) {
                const int tl = dir == 0 ? j : 63 - j;
                float kf[8], qf[8];
                unpack8(*(const LAS u32x4*)(bp + tl * 256 + slab * 16), kf);
                unpack8(*(const LAS u32x4*)(bp + 16384 + tl * 256 + slab * 16), qf);
                const unsigned uv = *(const LAS unsigned*)(bp + 32768 + tl * 128 + cp * 4);
                const float v0 = bflo(uv), v1 = bfhi(uv);
                const float ig = *(const LAS float*)(bp + 40960 + tl * 4), lf = *(const LAS float*)(bp + 41216 + tl * 4);
                const float mn = fmaxf(lf + m, ig), fs = __expf(lf + m - mn), is = __expf(ig - mn);
                m = mn;
                float n0 = 0.f, n1 = 0.f, dn = 0.f;
#pragma unroll
                for (int i = 0; i < 8; ++i) { const float ki = is * kf[i], qi = qf[i] * 0.08838834764831845f;
                    C[i][0] = fs * C[i][0] + ki * v0; C[i][1] = fs * C[i][1] + ki * v1; n[i] = fs * n[i] + ki;
                    n0 += C[i][0] * qi; n1 += C[i][1] * qi; dn += n[i] * qi; }
                n0 = grp_sum<16>(n0); n1 = grp_sum<16>(n1); dn = grp_sum<16>(dn);
                if (slab == 0) { const float dd = 1.f / fmaxf(fabsf(dn), __expf(-mn)); hst[tl * 64 + cp * 2] = n0 * dd; hst[tl * 64 + cp * 2 + 1] = n1 * dd; }
            }
            __syncthreads();
            if (s >= 4) {
                const int row0 = chunk_row(b, dir, s), tk = tid >> 3, o = (tid & 7) * 8;
                float v[8];
#pragma unroll
                for (int i = 0; i < 8; ++i) v[i] = hst[tk * 64 + o + i];
                *(u32x4*)(Hs + (size_t)dir * ML * D + (size_t)(row0 + tk) * D + h * 256 + cq * 64 + o) = pack8(v);
            }
            if (s + 1 < 68) lstore((s + 1) & 1);
            __syncthreads();
        }
    }
}
__device__ __forceinline__ void ml_output_phase(const Ctx& c) {
    const bf16_t* Hs = (const bf16_t*)(c.ws + WS_F); const bf16_t* P = (const bf16_t*)(c.ws + WS_P); bf16_t* Yo = (bf16_t*)(c.ws + WS_HY);
    const float* nw = c.in[IN_MLNW];
    for (int r = c.gw; r < ML; r += c.NGW) {
#pragma unroll
        for (int blk = 0; blk < 4; ++blk) {
            const int ch = blk * 512 + c.lane * 8;
            float a[8], bb[8], o[8];
            unpack8(*(const u32x4*)(Hs + (size_t)r * D + ch), a); unpack8(*(const u32x4*)(Hs + (size_t)ML * D + (size_t)r * D + ch), bb);
            unpack8(*(const u32x4*)(P + (size_t)r * PW1 + 4096 + ch), o);
            float ss = 0.f;
#pragma unroll
            for (int j = 0; j < 8; ++j) { a[j] += bb[j]; ss += a[j] * a[j]; }
            ss = grp_sum<32>(ss); const float rstd = 1.f / sqrtf(ss * (1.f / 256.f) + 1e-6f);
            const f32x4 w0 = *(const f32x4*)(nw + ch), w1 = *(const f32x4*)(nw + ch + 4);
            const float wv[8] = {w0.x, w0.y, w0.z, w0.w, w1.x, w1.y, w1.z, w1.w};
#pragma unroll
            for (int j = 0; j < 8; ++j) a[j] = a[j] * rstd * wv[j] * sigm_fast(o[j]);
            *(u32x4*)(Yo + (size_t)r * D + ch) = pack8(a);
        }
    }
}


typedef short bf16x8 __attribute__((ext_vector_type(8)));
typedef short s16x4 __attribute__((ext_vector_type(4)));
#define MFMA16(a, b, c) __builtin_amdgcn_mfma_f32_16x16x32_bf16((a), (b), (c), 0, 0, 0)
__device__ __forceinline__ bf16x8 frag_row(const LAS unsigned char* img, int RS, int r0, int k0, int lane) {
    return *(const LAS bf16x8*)(img + (r0 + (lane & 15)) * RS + (k0 + 8 * (lane >> 4)) * 2);
}
__device__ __forceinline__ bf16x8 frag_tr(const LAS unsigned char* img, int RS, int r0, int k0, int lane) {
    const int g = lane >> 4, q = (lane & 15) >> 2, p = lane & 3;
    LAS unsigned char* a = (LAS unsigned char*)img + (k0 + 8 * g + q) * RS + (r0 + 4 * p) * 2;
    const s16x4 lo = __builtin_amdgcn_ds_read_tr16_b64_v4i16((LAS s16x4*)a);
    const s16x4 hi = __builtin_amdgcn_ds_read_tr16_b64_v4i16((LAS s16x4*)(a + 4 * RS));
    bf16x8 r; r[0] = lo[0]; r[1] = lo[1]; r[2] = lo[2]; r[3] = lo[3]; r[4] = hi[0]; r[5] = hi[1]; r[6] = hi[2]; r[7] = hi[3];
    return r;
}
__device__ __forceinline__ void tile_write(LAS unsigned char* img, int RS, int n0, int m0, int lane, const f32x4 v) {
    u32x2 o; o.x = pk2(v[0], v[1]); o.y = pk2(v[2], v[3]);
    *(LAS u32x2*)(img + (n0 + (lane & 15)) * RS + (m0 + 4 * (lane >> 4)) * 2) = o;
}
constexpr int MS = 68;
__device__ __forceinline__ bf16x8 frag_pack(const f32x4 a, const f32x4 b) { u32x4 u; u.x = pk2(a[0], a[1]); u.y = pk2(a[2], a[3]); u.z = pk2(b[0], b[1]); u.w = pk2(b[2], b[3]); return __builtin_bit_cast(bf16x8, u); }
__device__ __forceinline__ void tri_inverse_64(LAS float* MF, LAS float* TMP, int tid) {
    (void)TMP;
    if (tid < 64) {
        const int lane = tid, g = lane >> 4, i = lane & 15;
        const f32x4 z4 = {0.f, 0.f, 0.f, 0.f};
        {   LAS float* base = MF + (g * 16) * MS + g * 16; float acc[16];
#pragma unroll
            for (int r = 0; r < 16; ++r) acc[r] = (r == i) ? 1.f : 0.f;
#pragma unroll
            for (int j = 0; j < 15; ++j) { const float xj = acc[j];
#pragma unroll
                for (int r = j + 1; r < 16; ++r) acc[r] -= base[r * MS + j] * xj; }
#pragma unroll
            for (int r = 0; r < 16; ++r) base[r * MS + i] = acc[r];
        }
#pragma unroll
        for (int h = 0; h < 2; ++h) {
            const int R0 = h ? 48 : 16, C0 = h ? 32 : 0;
            bf16x8 a1, b1;
            {   const LAS float* pa = MF + (R0 + i) * MS + C0 + 8 * (g & 1);
                const f32x4 x0 = *(const LAS f32x4*)pa, x1 = *(const LAS f32x4*)(pa + 4);
                f32x4 y0, y1;
#pragma unroll
                for (int j = 0; j < 4; ++j) { y0[j] = MF[(C0 + 8 * (g & 1) + j) * MS + C0 + i]; y1[j] = MF[(C0 + 8 * (g & 1) + 4 + j) * MS + C0 + i]; }
                a1 = g < 2 ? frag_pack(x0, x1) : frag_pack(z4, z4); b1 = g < 2 ? frag_pack(y0, y1) : frag_pack(z4, z4); }
            const f32x4 t = MFMA16(a1, b1, z4);
            const f32x4 xa = *(const LAS f32x4*)(MF + (R0 + i) * MS + R0 + 4 * g);
            const f32x4 x = MFMA16(frag_pack(xa, z4), frag_pack(t, z4), z4);
#pragma unroll
            for (int r = 0; r < 4; ++r) MF[(R0 + 4 * g + r) * MS + C0 + i] = -x[r];
        }
        {   bf16x8 a[2], b[2];
#pragma unroll
            for (int I = 0; I < 2; ++I) { const LAS float* pa = MF + (32 + 16 * I + i) * MS + 8 * g; a[I] = frag_pack(*(const LAS f32x4*)pa, *(const LAS f32x4*)(pa + 4)); }
#pragma unroll
            for (int J = 0; J < 2; ++J) { f32x4 y0, y1;
#pragma unroll
                for (int j = 0; j < 4; ++j) { y0[j] = MF[(8 * g + j) * MS + 16 * J + i]; y1[j] = MF[(8 * g + 4 + j) * MS + 16 * J + i]; }
                b[J] = frag_pack(y0, y1); }
            f32x4 t[2][2];
#pragma unroll
            for (int I = 0; I < 2; ++I)
#pragma unroll
                for (int J = 0; J < 2; ++J) t[I][J] = MFMA16(a[I], b[J], z4);
            bf16x8 a2[2];
#pragma unroll
            for (int I = 0; I < 2; ++I) { const LAS float* pa = MF + (32 + 16 * I + i) * MS + 32 + 4 * g; a2[I] = frag_pack(*(const LAS f32x4*)pa, *(const LAS f32x4*)(pa + 16)); }
#pragma unroll
            for (int I = 0; I < 2; ++I)
#pragma unroll
                for (int J = 0; J < 2; ++J) { const f32x4 x = MFMA16(a2[I], frag_pack(t[0][J], t[1][J]), z4);
#pragma unroll
                    for (int r = 0; r < 4; ++r) MF[(32 + 16 * I + 4 * g + r) * MS + 16 * J + i] = -x[r]; }
        }
    }
    __syncthreads();
}
__device__ __forceinline__ float wave_incl_scan_add(float x, int lane) {
#pragma unroll
    for (int o = 1; o < 64; o <<= 1) { const float t = __shfl_up(x, o); if (lane >= o) x += t; }
    return x;
}
__device__ __forceinline__ float wave_incl_scan_max(float x, int lane) {
#pragma unroll
    for (int o = 1; o < 64; o <<= 1) { const float t = __shfl_up(x, o); if (lane >= o) x = fmaxf(x, t); }
    return x;
}
constexpr int RS128 = 272, RS64 = 144, RS80 = 176;

__device__ __forceinline__ void mlstm_chunk_phase(const Ctx& c) {
    const bf16_t* P = (const bf16_t*)(c.ws + WS_P); bf16_t* Hs = (bf16_t*)(c.ws + WS_F);
    const float* GA = (const float*)(c.ws + WS_GA); const float* GB = (const float*)(c.ws + WS_GB);
    const int lane = c.lane, tid = c.tid, w = c.wave, g4 = lane >> 4, l15 = lane & 15;
    LAS unsigned char* KIMG = c.lds; LAS unsigned char* QIMG = c.lds + 17408; LAS unsigned char* VIMG = c.lds + 34816; LAS unsigned char* VS = c.lds + 46080;
    LAS unsigned char* SM = c.lds + 57344; LAS unsigned char* CT = c.lds + 66560;
    LAS float* sB = (LAS float*)(c.lds + 88320); LAS float* sCM = sB + 64; LAS float* sIGB = sB + 128;
    for (int item = c.wg; item < 256; item += c.G) {
        const int chain = item >> 2, cq = item & 3, b = chain >> 4, h = (chain >> 1) & 7, dir = chain & 1;
        f32x4 st[5];
#pragma unroll
        for (int e = 0; e < 5; ++e) st[e] = (f32x4){0.f, 0.f, 0.f, 0.f};
        float m = 0.f;
        u32x4 rk[2], rq[2], rv; float rg = 0.f, rb = 0.f;
        auto gload = [&](int s) {
            const int row0 = chunk_row(b, dir, s);
#pragma unroll
            for (int i = 0; i < 2; ++i) { const int pc = tid + i * 512, tk = pc >> 4, o = (pc & 15) * 8;
                rk[i] = *(const u32x4*)(P + (size_t)(row0 + tk) * PW1 + 1024 + h * 128 + o);
                rq[i] = *(const u32x4*)(P + (size_t)(row0 + tk) * PW1 + h * 128 + o); }
            { const int tk = tid >> 3, o = (tid & 7) * 8; rv = *(const u32x4*)(P + (size_t)(row0 + tk) * PW1 + 2048 + h * 256 + cq * 64 + o); }
            if (tid < 64) { rg = GA[(size_t)(row0 + tid) * 16 + dir * 8 + h]; rb = GB[(size_t)(row0 + tid) * 16 + dir * 8 + h]; }
        };
        __syncthreads();
        for (int i = tid; i < 80 * 34; i += NTHREADS) ((LAS u32x2*)CT)[i] = (u32x2){0u, 0u};
        gload(0);
#pragma unroll 1
        for (int s = 0; s < 68; ++s) {
#pragma unroll
            for (int i = 0; i < 2; ++i) { const int pc = tid + i * 512, tk = pc >> 4, o = pc & 15, ri = dir ? 63 - tk : tk;
                *(LAS u32x4*)(KIMG + ri * RS128 + o * 16) = rk[i]; *(LAS u32x4*)(QIMG + ri * RS128 + o * 16) = rq[i]; }
            { const int tk = tid >> 3, o = tid & 7, ri = dir ? 63 - tk : tk; *(LAS u32x4*)(VIMG + ri * RS80 + o * 16) = rv;
              if (o == 0) { *(LAS u32x4*)(VIMG + ri * RS80 + 128) = (u32x4){0x3F80u, 0u, 0u, 0u}; *(LAS u32x4*)(VIMG + ri * RS80 + 144) = (u32x4){0u, 0u, 0u, 0u}; } }
            if (w == 0) {
                const int src = dir ? 63 - lane : lane;
                const float ig = __shfl(rg, src), lf = __shfl(rb, src);
                const float bb = wave_incl_scan_add(lf, lane), igb = ig - bb, cm = wave_incl_scan_max(igb, lane);
                sB[lane] = bb; sCM[lane] = cm; sIGB[lane] = igb;
            }
            __syncthreads();
            if (s + 1 < 68) gload(s + 1);
            const float c63 = sCM[63], blast = sB[63], mx63 = fmaxf(m, c63);
            const float cscale = __expf(m - mx63);
            if (s >= 4) {
                const int ib = w >> 1;
                bf16x8 bq[4];
#pragma unroll
                for (int k = 0; k < 4; ++k) bq[k] = frag_row(QIMG, RS128, ib * 16, k * 32, lane);
                const float mxi = fmaxf(m, sCM[ib * 16 + l15]);
#pragma unroll
                for (int t = 0; t < 2; ++t) { const int jb = (w & 1) * 2 + t; f32x4 acc = {0.f, 0.f, 0.f, 0.f};
#pragma unroll
                    for (int k = 0; k < 4; ++k) acc = MFMA16(frag_row(KIMG, RS128, jb * 16, k * 32, lane), bq[k], acc);
                    const int i = ib * 16 + l15;
#pragma unroll
                    for (int r = 0; r < 4; ++r) { const int j = jb * 16 + 4 * g4 + r; acc[r] = (j <= i) ? acc[r] * 0.08838834764831845f * __expf(sIGB[j] - mxi) : 0.f; }
                    tile_write(SM, RS64, ib * 16, jb * 16, lane, acc); }
            }
            for (int pc = tid; pc < 640; pc += NTHREADS) { const int j = pc / 10, o = pc % 10; const float f = __expf(sIGB[j] - mx63);
                float v[8]; unpack8(*(const LAS u32x4*)(VIMG + j * RS80 + o * 16), v);
#pragma unroll
                for (int q = 0; q < 8; ++q) v[q] *= f;
                *(LAS u32x4*)(VS + j * RS80 + o * 16) = pack8(v); }
            __syncthreads();
            if (s >= 4) {
                const int ib = w & 3, eh = w >> 2, i = ib * 16 + l15;
                const float mxi = fmaxf(m, sCM[i]), inter = __expf(m - mxi) * 0.08838834764831845f, floorv = __expf(-(sB[i] + mxi));
                bf16x8 bs[2], bq[4];
#pragma unroll
                for (int k = 0; k < 2; ++k) bs[k] = frag_row(SM, RS64, ib * 16, k * 32, lane);
#pragma unroll
                for (int k = 0; k < 4; ++k) bq[k] = frag_row(QIMG, RS128, ib * 16, k * 32, lane);
                f32x4 val[3];
#pragma unroll
                for (int t = 0; t < 3; ++t) { const int eb = t < 2 ? eh * 2 + t : 4; f32x4 a1 = {0.f, 0.f, 0.f, 0.f}, a2 = {0.f, 0.f, 0.f, 0.f};
#pragma unroll
                    for (int k = 0; k < 2; ++k) a1 = MFMA16(frag_tr(VIMG, RS80, eb * 16, k * 32, lane), bs[k], a1);
#pragma unroll
                    for (int k = 0; k < 4; ++k) a2 = MFMA16(frag_row(CT, RS128, eb * 16, k * 32, lane), bq[k], a2);
                    val[t] = a1 + a2 * inter; }
                const float den = __shfl(val[2][0], l15);
                const float dd = 1.f / fmaxf(fabsf(den), floorv);
                const int tl = dir ? 63 - i : i, row0 = chunk_row(b, dir, s);
#pragma unroll
                for (int t = 0; t < 2; ++t) { const int e0 = (eh * 2 + t) * 16 + 4 * g4; u32x2 o; o.x = pk2(val[t][0] * dd, val[t][1] * dd); o.y = pk2(val[t][2] * dd, val[t][3] * dd);
                    *(u32x2*)(Hs + (size_t)dir * ML * D + (size_t)(row0 + tl) * D + h * 256 + cq * 64 + e0) = o; }
            }
            {   bf16x8 ak[2];
#pragma unroll
                for (int k = 0; k < 2; ++k) ak[k] = frag_tr(KIMG, RS128, w * 16, k * 32, lane);
#pragma unroll
                for (int e = 0; e < 5; ++e) { st[e] = st[e] * cscale;
#pragma unroll
                    for (int k = 0; k < 2; ++k) st[e] = MFMA16(ak[k], frag_tr(VS, RS80, e * 16, k * 32, lane), st[e]); }
            }
            m = blast + mx63;
            __syncthreads();
#pragma unroll
            for (int e = 0; e < 5; ++e) tile_write(CT, RS128, e * 16, w * 16, lane, st[e]);
        }
    }
}

__device__ __forceinline__ void gdn_chunk_items(const Ctx& c, int item0, int item_stride, int n_items) {
    const bf16_t* F = (const bf16_t*)(c.ws + WS_F); bf16_t* P = (bf16_t*)(c.ws + WS_P);
    const float* GA = (const float*)(c.ws + WS_GA); const float* GB = (const float*)(c.ws + WS_GB);
    const int lane = c.lane, tid = c.tid, w = c.wave, g4 = lane >> 4, l15 = lane & 15;
    LAS unsigned char* KIMG = c.lds; LAS unsigned char* QIMG = c.lds + 17408; LAS unsigned char* VIMG = c.lds + 34816; LAS unsigned char* ST = c.lds + 44032;
    LAS unsigned char* WIMG = c.lds + 61440; LAS unsigned char* QKM = c.lds + 78848; LAS unsigned char* VNT = c.lds + 88064; LAS unsigned char* VNS = c.lds + 97280;
    LAS unsigned char* TW = c.lds + 106496; LAS unsigned char* TU = c.lds + 115712; LAS float* MF = (LAS float*)(c.lds + 124928); LAS float* TMP = (LAS float*)VNT;
    LAS float* sGC = (LAS float*)(c.lds + 142336); LAS float* sEG = sGC + 64; LAS float* sEL = sGC + 128; LAS float* sBT = sGC + 192; LAS float* sBG = sGC + 256;
    for (int item = item0; item < n_items; item += item_stride) {
        const int chain = item >> 1, eh = item & 1, b = chain >> 4, h = (chain >> 1) & 7, dir = chain & 1;
        f32x4 st[4];
#pragma unroll
        for (int e = 0; e < 4; ++e) st[e] = (f32x4){0.f, 0.f, 0.f, 0.f};
        u32x4 rk[2], rq[2], rv; float rg = 0.f, rb = 0.f;
        auto gload = [&](int s) {
            const int row0 = chunk_row(b, dir, s);
#pragma unroll
            for (int i = 0; i < 2; ++i) { const int pc = tid + i * 512, tk = pc >> 4, o = (pc & 15) * 8;
                rk[i] = *(const u32x4*)(F + (size_t)1 * MT * 1024 + (size_t)(row0 + tk) * 1024 + h * 128 + o);
                rq[i] = *(const u32x4*)(F + (size_t)0 * MT * 1024 + (size_t)(row0 + tk) * 1024 + h * 128 + o); }
            { const int tk = tid >> 3, o = (tid & 7) * 8; rv = *(const u32x4*)(F + (size_t)2 * MT * 1024 + (size_t)(row0 + tk) * 1024 + h * 128 + eh * 64 + o); }
            if (tid < 64) { rg = GA[(size_t)(row0 + tid) * 16 + dir * 8 + h]; rb = GB[(size_t)(row0 + tid) * 16 + dir * 8 + h]; }
        };
        __syncthreads();
        for (int i = tid; i < 64 * 34; i += NTHREADS) ((LAS u32x2*)ST)[i] = (u32x2){0u, 0u};
        gload(0);
#pragma unroll 1
        for (int s = 0; s < 68; ++s) {
#pragma unroll
            for (int i = 0; i < 2; ++i) { const int pc = tid + i * 512, tk = pc >> 4, o = pc & 15, ri = dir ? 63 - tk : tk;
                *(LAS u32x4*)(KIMG + ri * RS128 + o * 16) = rk[i]; *(LAS u32x4*)(QIMG + ri * RS128 + o * 16) = rq[i]; }
            { const int tk = tid >> 3, o = tid & 7, ri = dir ? 63 - tk : tk; *(LAS u32x4*)(VIMG + ri * RS64 + o * 16) = rv; }
            if (w == 0) {
                const int src = dir ? 63 - lane : lane;
                const float gg = __shfl(rg, src), bt = __shfl(rb, src);
                const float gc = wave_incl_scan_add(gg, lane), gl = __shfl(gc, 63), eg = __expf(gc);
                sGC[lane] = gc; sEG[lane] = eg; sEL[lane] = __expf(gl - gc); sBT[lane] = bt; sBG[lane] = bt * eg;
            }
            __syncthreads();
            if (s + 1 < 68) gload(s + 1);
            {   const int ib = w >> 1, i = ib * 16 + l15; const float gci = sGC[i], bti = sBT[i];
                bf16x8 bk[4], bq[4];
#pragma unroll
                for (int k = 0; k < 4; ++k) { bk[k] = frag_row(KIMG, RS128, ib * 16, k * 32, lane); bq[k] = frag_row(QIMG, RS128, ib * 16, k * 32, lane); }
#pragma unroll
                for (int t = 0; t < 2; ++t) { const int jb = (w & 1) * 2 + t; f32x4 a1 = {0.f, 0.f, 0.f, 0.f}, a2 = {0.f, 0.f, 0.f, 0.f};
#pragma unroll
                    for (int k = 0; k < 4; ++k) { const bf16x8 aj = frag_row(KIMG, RS128, jb * 16, k * 32, lane); a1 = MFMA16(aj, bk[k], a1); a2 = MFMA16(aj, bq[k], a2); }
                    f32x4 mv;
#pragma unroll
                    for (int r = 0; r < 4; ++r) { const int j = jb * 16 + 4 * g4 + r; const float dec = __expf(gci - sGC[j]);
                        mv[r] = (j < i) ? bti * a1[r] * dec : 0.f; a2[r] = (j <= i) ? a2[r] * dec : 0.f; }
                    *(LAS f32x4*)(MF + i * MS + jb * 16 + 4 * g4) = mv;
                    tile_write(QKM, RS64, ib * 16, jb * 16, lane, a2); }
            }
            __syncthreads();
            tri_inverse_64(MF, TMP, tid);
            {   const int i = tid >> 3, j8 = (tid & 7) * 8; float tw[8], tu[8];
#pragma unroll
                for (int q = 0; q < 8; ++q) { const float x = MF[i * MS + j8 + q]; tw[q] = x * sBG[j8 + q]; tu[q] = x * sBT[j8 + q]; }
                *(LAS u32x4*)(TW + i * RS64 + j8 * 2) = pack8(tw); *(LAS u32x4*)(TU + i * RS64 + j8 * 2) = pack8(tu); }
            __syncthreads();
            f32x4 ut[2];
            {   const int ib = w >> 1;
                bf16x8 au[2];
#pragma unroll
                for (int k = 0; k < 2; ++k) au[k] = frag_row(TU, RS64, ib * 16, k * 32, lane);
#pragma unroll
                for (int t = 0; t < 2; ++t) { const int eb = (w & 1) * 2 + t; ut[t] = (f32x4){0.f, 0.f, 0.f, 0.f};
#pragma unroll
                    for (int k = 0; k < 2; ++k) ut[t] = MFMA16(au[k], frag_tr(VIMG, RS64, eb * 16, k * 32, lane), ut[t]); }
                bf16x8 akt[2];
#pragma unroll
                for (int k = 0; k < 2; ++k) akt[k] = frag_tr(KIMG, RS128, w * 16, k * 32, lane);
#pragma unroll
                for (int i2 = 0; i2 < 4; ++i2) { f32x4 a = {0.f, 0.f, 0.f, 0.f};
#pragma unroll
                    for (int k = 0; k < 2; ++k) a = MFMA16(akt[k], frag_row(TW, RS64, i2 * 16, k * 32, lane), a);
                    tile_write(WIMG, RS128, i2 * 16, w * 16, lane, a); }
            }
            __syncthreads();
            {   const int ib = w >> 1;
                bf16x8 aw[4];
#pragma unroll
                for (int k = 0; k < 4; ++k) aw[k] = frag_row(WIMG, RS128, ib * 16, k * 32, lane);
#pragma unroll
                for (int t = 0; t < 2; ++t) { const int eb = (w & 1) * 2 + t; f32x4 a = {0.f, 0.f, 0.f, 0.f};
#pragma unroll
                    for (int k = 0; k < 4; ++k) a = MFMA16(aw[k], frag_row(ST, RS128, eb * 16, k * 32, lane), a);
                    f32x4 vn = ut[t] - a, vs;
#pragma unroll
                    for (int r = 0; r < 4; ++r) vs[r] = vn[r] * sEL[ib * 16 + 4 * g4 + r];
                    tile_write(VNT, RS64, eb * 16, ib * 16, lane, vn); tile_write(VNS, RS64, eb * 16, ib * 16, lane, vs); }
            }
            __syncthreads();
            {   const int eb = w >> 1, row0 = chunk_row(b, dir, s);
                bf16x8 as[4], av[2];
#pragma unroll
                for (int k = 0; k < 4; ++k) as[k] = frag_row(ST, RS128, eb * 16, k * 32, lane);
#pragma unroll
                for (int k = 0; k < 2; ++k) av[k] = frag_row(VNT, RS64, eb * 16, k * 32, lane);
#pragma unroll
                for (int t = 0; t < 2; ++t) { const int ib = (w & 1) * 2 + t, i = ib * 16 + l15; f32x4 a = {0.f, 0.f, 0.f, 0.f};
#pragma unroll
                    for (int k = 0; k < 4; ++k) a = MFMA16(as[k], frag_row(QIMG, RS128, ib * 16, k * 32, lane), a);
                    a = a * sEG[i];
#pragma unroll
                    for (int k = 0; k < 2; ++k) a = MFMA16(av[k], frag_row(QKM, RS64, ib * 16, k * 32, lane), a);
                    const int tl = dir ? 63 - i : i; u32x2 o; o.x = pk2(a[0], a[1]); o.y = pk2(a[2], a[3]);
                    *(u32x2*)(P + (size_t)(row0 + tl) * PW0 + (4 + dir) * 1024 + h * 128 + eh * 64 + eb * 16 + 4 * g4) = o; }
                const float al = __expf(sGC[63]);
                bf16x8 akt[2];
#pragma unroll
                for (int k = 0; k < 2; ++k) akt[k] = frag_tr(KIMG, RS128, w * 16, k * 32, lane);
#pragma unroll
                for (int e = 0; e < 4; ++e) { st[e] = st[e] * al;
#pragma unroll
                    for (int k = 0; k < 2; ++k) st[e] = MFMA16(akt[k], frag_row(VNS, RS64, e * 16, k * 32, lane), st[e]); }
            }
            __syncthreads();
#pragma unroll
            for (int e = 0; e < 4; ++e) tile_write(ST, RS128, e * 16, w * 16, lane, st[e]);
        }
    }
}

__device__ __forceinline__ void rwkv_chunk_items(const Ctx& c, int item0, int item_stride, int n_items, bf16_t* Ybase, long ydir_stride, int ystride) {
    const bf16_t* F = (const bf16_t*)(c.ws + WS_F); const bf16_t* P = (const bf16_t*)(c.ws + WS_P);
    const int lane = c.lane, tid = c.tid, w = c.wave, g4 = lane >> 4, l15 = lane & 15;
    LAS unsigned char* KKP = c.lds; LAS unsigned char* RP = c.lds + 9216; LAS unsigned char* KTD = c.lds + 18432; LAS unsigned char* KADN = c.lds + 27648;
    LAS unsigned char* VIMG = c.lds + 36864; LAS unsigned char* ST = c.lds + 46080; LAS unsigned char* ART = c.lds + 55296; LAS unsigned char* ARAN = c.lds + 64512;
    LAS unsigned char* TI = c.lds + 73728; LAS unsigned char* KTI = c.lds + 82944; LAS unsigned char* KAI = c.lds + 92160; LAS unsigned char* AKT = c.lds + 101376;
    LAS unsigned char* TMPVT = KTI; LAS unsigned char* WK = KAI; LAS unsigned char* UT = AKT;
    LAS float* MF = (LAS float*)(c.lds + 110592); LAS float* LP = MF; LAS float* TMP = (LAS float*)(c.lds + 128000); LAS float* sPC = (LAS float*)(c.lds + 132096);
    for (int item = item0; item < n_items; item += item_stride) {
        const int chain = item, b = chain >> 5, h = (chain >> 1) & 15, dir = chain & 1;
        f32x4 st[2] = {{0.f, 0.f, 0.f, 0.f}, {0.f, 0.f, 0.f, 0.f}};
        const int tk = tid >> 3, o8 = tid & 7, ri = dir ? 63 - tk : tk;
        float kav[8];
        { const f32x4 k0 = *(const f32x4*)(c.in[IN_KA] + h * 64 + o8 * 8), k1 = *(const f32x4*)(c.in[IN_KA] + h * 64 + o8 * 8 + 4);
          kav[0] = k0.x; kav[1] = k0.y; kav[2] = k0.z; kav[3] = k0.w; kav[4] = k1.x; kav[5] = k1.y; kav[6] = k1.z; kav[7] = k1.w; }
        u32x4 rr[5], rv;
        auto gload = [&](int s) {
            const int row0 = chunk_row(b, dir, s); const int o = o8 * 8;
            rr[0] = *(const u32x4*)(F + (size_t)3 * MT * 1024 + (size_t)(row0 + tk) * 1024 + h * 64 + o);
            rr[1] = *(const u32x4*)(F + (size_t)4 * MT * 1024 + (size_t)(row0 + tk) * 1024 + h * 64 + o);
            rr[2] = *(const u32x4*)(F + (size_t)5 * MT * 1024 + (size_t)(row0 + tk) * 1024 + h * 64 + o);
            rr[3] = *(const u32x4*)(P + (size_t)(row0 + tk) * PW0 + (0 + dir) * 1024 + h * 64 + o);
            rr[4] = *(const u32x4*)(P + (size_t)(row0 + tk) * PW0 + (2 + dir) * 1024 + h * 64 + o);
            rv = *(const u32x4*)(F + (size_t)6 * MT * 1024 + (size_t)(row0 + tk) * 1024 + h * 64 + o);
        };
        __syncthreads();
        for (int i = tid; i < 64 * 18; i += NTHREADS) ((LAS u32x2*)ST)[i] = (u32x2){0u, 0u};
        gload(0);
#pragma unroll 1
        for (int s = 0; s < 68; ++s) {
            float lwf[8]; unpack8(rr[3], lwf);
            *(LAS f32x4*)(LP + ri * 64 + o8 * 8) = (f32x4){lwf[0], lwf[1], lwf[2], lwf[3]}; *(LAS f32x4*)(LP + ri * 64 + o8 * 8 + 4) = (f32x4){lwf[4], lwf[5], lwf[6], lwf[7]};
            __syncthreads();
            {   const int k = tid & 63, seg = tid >> 6; float x[8]; float run = 0.f;
#pragma unroll
                for (int i = 0; i < 8; ++i) { run += LP[(seg * 8 + i) * 64 + k]; x[i] = run; }
                TMP[seg * 64 + k] = run;
                __syncthreads();
                float off = 0.f;
#pragma unroll
                for (int q = 0; q < 8; ++q) off += (q < seg) ? TMP[q * 64 + k] : 0.f;
#pragma unroll
                for (int i = 0; i < 8; ++i) LP[(seg * 8 + i) * 64 + k] = x[i] + off;
            }
            __syncthreads();
            {
                float rf[8], kkf[8], kbf[8], af[8], lp[8], lpm[8], lpc[8];
                unpack8(rr[0], rf); unpack8(rr[1], kkf); unpack8(rr[2], kbf); unpack8(rr[4], af);
#pragma unroll
                for (int q = 0; q < 8; ++q) { lp[q] = LP[ri * 64 + o8 * 8 + q]; lpm[q] = ri > 0 ? LP[(ri - 1) * 64 + o8 * 8 + q] : 0.f; lpc[q] = LP[63 * 64 + o8 * 8 + q]; }
                float i0[8], i1[8], i2[8], i3[8], i4[8], i5[8];
#pragma unroll
                for (int q = 0; q < 8; ++q) { const float kt = kbf[q] * (1.f + (af[q] - 1.f) * kav[q]), kka = kkf[q] * af[q];
                    const float ei = __expf(-lp[q]), ed = __expf(lpc[q] - lp[q]);
                    i0[q] = kkf[q] * __expf(lpm[q]); i1[q] = rf[q] * __expf(lp[q]); i2[q] = kt * ei; i3[q] = kka * ei; i4[q] = kt * ed; i5[q] = -kka * ed; }
                const int off = ri * RS64 + o8 * 16;
                *(LAS u32x4*)(KKP + off) = pack8(i0); *(LAS u32x4*)(RP + off) = pack8(i1); *(LAS u32x4*)(KTI + off) = pack8(i2); *(LAS u32x4*)(KAI + off) = pack8(i3);
                *(LAS u32x4*)(KTD + off) = pack8(i4); *(LAS u32x4*)(KADN + off) = pack8(i5); *(LAS u32x4*)(VIMG + off) = rv;
                if (ri == 63) {
#pragma unroll
                    for (int q = 0; q < 8; ++q) sPC[o8 * 8 + q] = __expf(lpc[q]); }
            }
            __syncthreads();
            if (s + 1 < 68) gload(s + 1);
            {   const int tb = w >> 1, t = tb * 16 + l15;
                bf16x8 bkk[2], brp[2];
#pragma unroll
                for (int k = 0; k < 2; ++k) { bkk[k] = frag_row(KKP, RS64, tb * 16, k * 32, lane); brp[k] = frag_row(RP, RS64, tb * 16, k * 32, lane); }
#pragma unroll
                for (int q = 0; q < 2; ++q) { const int sb = (w & 1) * 2 + q; f32x4 aka = {0.f, 0.f, 0.f, 0.f}, akt = aka, ara = aka, art = aka;
#pragma unroll
                    for (int k = 0; k < 2; ++k) { const bf16x8 fa = frag_row(KAI, RS64, sb * 16, k * 32, lane), ft = frag_row(KTI, RS64, sb * 16, k * 32, lane);
                        aka = MFMA16(fa, bkk[k], aka); akt = MFMA16(ft, bkk[k], akt); ara = MFMA16(fa, brp[k], ara); art = MFMA16(ft, brp[k], art); }
#pragma unroll
                    for (int r = 0; r < 4; ++r) { const int ss = sb * 16 + 4 * g4 + r;
                        aka[r] = ss < t ? aka[r] : 0.f; akt[r] = ss < t ? akt[r] : 0.f; ara[r] = ss <= t ? -ara[r] : 0.f; art[r] = ss <= t ? art[r] : 0.f; }
                    tile_write(AKT, RS64, tb * 16, sb * 16, lane, akt); tile_write(ARAN, RS64, tb * 16, sb * 16, lane, ara); tile_write(ART, RS64, tb * 16, sb * 16, lane, art);
                    *(LAS f32x4*)(MF + t * MS + sb * 16 + 4 * g4) = aka; }
            }
            __syncthreads();
            tri_inverse_64(MF, TMP, tid);
            {   const int i = tid >> 3, j8 = (tid & 7) * 8; float x[8];
#pragma unroll
                for (int q = 0; q < 8; ++q) x[q] = MF[i * MS + j8 + q];
                *(LAS u32x4*)(TI + i * RS64 + j8 * 2) = pack8(x); }
            __syncthreads();
            f32x4 y0[2], u0[2];
            {   const int hb = w >> 1;
                bf16x8 aa[2], akk[2], av[2];
#pragma unroll
                for (int k = 0; k < 2; ++k) { aa[k] = frag_row(AKT, RS64, hb * 16, k * 32, lane); akk[k] = frag_tr(KKP, RS64, hb * 16, k * 32, lane); av[k] = frag_tr(VIMG, RS64, hb * 16, k * 32, lane); }
#pragma unroll
                for (int q = 0; q < 2; ++q) { const int ob = (w & 1) * 2 + q; f32x4 a = {0.f, 0.f, 0.f, 0.f}, bq = a; y0[q] = a;
#pragma unroll
                    for (int k = 0; k < 2; ++k) { a = MFMA16(aa[k], frag_tr(VIMG, RS64, ob * 16, k * 32, lane), a);
                        const bf16x8 fti = frag_row(TI, RS64, ob * 16, k * 32, lane);
                        bq = MFMA16(akk[k], fti, bq);
                        y0[q] = MFMA16(av[k], frag_row(ART, RS64, ob * 16, k * 32, lane), y0[q]); }
                    tile_write(TMPVT, RS64, ob * 16, hb * 16, lane, a); tile_write(WK, RS64, ob * 16, hb * 16, lane, bq); }
            }
            __syncthreads();
            {   const int tb = w >> 1;
                bf16x8 at[2], awk[2];
#pragma unroll
                for (int k = 0; k < 2; ++k) { at[k] = frag_row(TI, RS64, tb * 16, k * 32, lane); awk[k] = frag_row(WK, RS64, tb * 16, k * 32, lane); }
#pragma unroll
                for (int q = 0; q < 2; ++q) { const int vb = (w & 1) * 2 + q; u0[q] = (f32x4){0.f, 0.f, 0.f, 0.f};
#pragma unroll
                    for (int k = 0; k < 2; ++k) { u0[q] = MFMA16(at[k], frag_row(TMPVT, RS64, vb * 16, k * 32, lane), u0[q]); u0[q] = MFMA16(awk[k], frag_row(ST, RS64, vb * 16, k * 32, lane), u0[q]); }
                }
            }
            {   const int tb = w >> 1;
#pragma unroll
                for (int q = 0; q < 2; ++q) tile_write(UT, RS64, ((w & 1) * 2 + q) * 16, tb * 16, lane, u0[q]); }
            __syncthreads();
            {   const int hb = w >> 1, row0 = chunk_row(b, dir, s);
                bf16x8 as[2], au[2], aktd[2], akad[2];
#pragma unroll
                for (int k = 0; k < 2; ++k) { as[k] = frag_row(ST, RS64, hb * 16, k * 32, lane); au[k] = frag_row(UT, RS64, hb * 16, k * 32, lane);
                    aktd[k] = frag_tr(KTD, RS64, hb * 16, k * 32, lane); akad[k] = frag_tr(KADN, RS64, hb * 16, k * 32, lane); }
#pragma unroll
                for (int q = 0; q < 2; ++q) { const int ob = (w & 1) * 2 + q; f32x4 a = y0[q];
#pragma unroll
                    for (int k = 0; k < 2; ++k) { a = MFMA16(as[k], frag_row(RP, RS64, ob * 16, k * 32, lane), a); a = MFMA16(au[k], frag_row(ARAN, RS64, ob * 16, k * 32, lane), a); }
                    const int t = ob * 16 + l15, tl = dir ? 63 - t : t; u32x2 o; o.x = pk2(a[0], a[1]); o.y = pk2(a[2], a[3]);
                    *(u32x2*)(Ybase + (long)dir * ydir_stride + (size_t)(row0 + tl) * ystride + h * 64 + hb * 16 + 4 * g4) = o;
#pragma unroll
                    for (int r = 0; r < 4; ++r) st[q][r] *= sPC[hb * 16 + 4 * g4 + r];
#pragma unroll
                    for (int k = 0; k < 2; ++k) { st[q] = MFMA16(aktd[k], frag_tr(VIMG, RS64, ob * 16, k * 32, lane), st[q]); st[q] = MFMA16(akad[k], frag_row(UT, RS64, ob * 16, k * 32, lane), st[q]); } }
            }
            __syncthreads();
            {   const int hb = w >> 1;
#pragma unroll
                for (int q = 0; q < 2; ++q) tile_write(ST, RS64, ((w & 1) * 2 + q) * 16, hb * 16, lane, st[q]); }
        }
    }
}

#ifndef USE_CHUNK_ML
#define USE_CHUNK_ML 1
#endif
#ifndef USE_CHUNK_GDN
#define USE_CHUNK_GDN 1
#endif
#ifndef USE_CHUNK_RWKV
#define USE_CHUNK_RWKV 1
#endif
struct Args { const float* in[32]; float* out; unsigned char* ws; int ph_lo, ph_hi; };
constexpr int NPHASE = 24;
__global__ void __launch_bounds__(NTHREADS, 2) fwd_kernel(Args args) {
    extern __shared__ __attribute__((aligned(16))) unsigned char lds_raw[];
    Ctx c;
    c.lds = (LAS unsigned char*)lds_raw;
    c.tid = threadIdx.x; c.lane = c.tid & 63; c.wave = __builtin_amdgcn_readfirstlane(c.tid >> 6);
    c.G = gridDim.x; c.wg = blockIdx.x; c.gw = c.wg * NWAVES + c.wave; c.NGW = c.G * NWAVES;
#pragma unroll
    for (int i = 0; i < 32; ++i) c.in[i] = args.in[i];
    c.out = args.out; c.ws = args.ws;
    const int lo = args.ph_lo, hi = args.ph_hi;
    volatile LAS unsigned* bst = (volatile LAS unsigned*)(c.lds + LDS_BAR_OFF);
    if (c.tid < 4) bst[c.tid] = 0u;
    __syncthreads();
    XcdBarrier bar; bar.bar = (unsigned*)(c.ws + WS_CTL); bar.x = 0; bar.st = bst;
    if (hi - lo > 1) bar = xcd_barrier_post((unsigned*)(c.ws + WS_CTL), bst);
#define IN(k) (lo <= (k) && (k) < hi)
#ifndef REPEAT_MASK
#define REPEAT_MASK 0u
#endif
#define REP(k) for (int _rep = 0; _rep < (((REPEAT_MASK >> (k)) & 1u) ? 2 : 1); ++_rep)
#define SEAM(k) do { if (IN(k) && IN((k) + 1)) xcd_barrier(bar); } while (0)
    float* MOD = (float*)(c.ws + WS_MOD);
    float* XC = (float*)(c.ws + WS_XC);
    bf16_t* HY = (bf16_t*)(c.ws + WS_HY); bf16_t* Pb = (bf16_t*)(c.ws + WS_P); float* TL = (float*)(c.ws + WS_TAIL);
    bf16_t* Win = (bf16_t*)(c.ws + WS_WIN); bf16_t* Wout = (bf16_t*)(c.ws + WS_WOUT); bf16_t* W13 = (bf16_t*)(c.ws + WS_W13); bf16_t* W2 = (bf16_t*)(c.ws + WS_W2);
    const float* X = c.in[IN_X]; const float* CX = c.in[IN_CTX];

    if (IN(0)) REP(0) { ada_phase(c); __syncthreads(); convert_weights(c, 0); lora_weight_phase(c); __syncthreads(); }
    SEAM(0);
    if (IN(1)) REP(1) norm_mod_phase(c, X, CX, c.in[IN_NORMW], MOD, 0, D, MT);
    SEAM(1);
    if (IN(2)) { pg8::Gemm g{HY, Win, MT, NIN0, D}; pg8::StaticOrder S; S.init(MT, NIN0, c.G, c.wg); EpiInProj E{Pb, PW0, PW0 / 256, TL, TW0};
        pg8::gemm_phase<EpiInProj, pg8::StaticOrder>(c.lds, g, S, E); }
    SEAM(2);
    if (IN(3)) REP(3) ab_feature_phase(c);
    SEAM(3);
    if (IN(4)) {
        int k256 = 256; asm volatile("" : "+s"(k256));
        { pg8::Gemm g{(const bf16_t*)(c.ws + WS_A1), (const bf16_t*)(c.ws + WS_WL), MT, 4096, k256}; pg8::StaticOrder S; S.init(MT, 4096, c.G, c.wg); EpiLora E{Pb, PW0, c.in[IN_W0], c.in[IN_A0]};
          pg8::gemm_phase<EpiLora, pg8::StaticOrder>(c.lds, g, S, E); }
        { pg8::Gemm g{(const bf16_t*)(c.ws + WS_A2), (const bf16_t*)(c.ws + WS_WG), MT, 1024, k256}; pg8::StaticOrder S; S.init(MT, 1024, c.G, c.wg); EpiBf16Plain E{(bf16_t*)(c.ws + WS_GOUT), 1024};
          pg8::gemm_phase<EpiBf16Plain, pg8::StaticOrder>(c.lds, g, S, E); } }
    SEAM(4);
    if (IN(5)) REP(5) {
        gdn_chunk_items(c, c.wg, c.G, 128);
        rwkv_chunk_items(c, (c.wg + c.G / 2) % c.G, c.G, 128, HY + 1024, -1024L, D); }
    SEAM(5);
    SEAM(6);
    if (IN(7)) REP(7) ab_output_phase(c);
    SEAM(7);
    if (IN(8)) { pg8::Gemm g{HY, Wout, MT, D, D}; pg8::StaticOrder S; S.init(MT, D, c.G, c.wg); EpiResid E{X, CX, c.out, XC, MOD + 2 * D};
        pg8::gemm_phase<EpiResid, pg8::StaticOrder>(c.lds, g, S, E); }
    SEAM(8);
    if (IN(9)) REP(9) norm_mod_phase(c, c.out, XC, c.in[IN_NORMW] + D, MOD, 3 * D, 4 * D, MT);
    SEAM(9);
    if (IN(10)) { pg8::Gemm g{HY, W13, MT, 2 * FF, D}; pg8::StaticOrder S; S.init(MT, 2 * FF, c.G, c.wg); EpiSwiGLU E{Pb, FF};
        pg8::gemm_phase<EpiSwiGLU, pg8::StaticOrder>(c.lds, g, S, E); }
    SEAM(10);
    if (IN(11)) { pg8::Gemm g{Pb, W2, MT, D, FF}; pg8::StaticOrder S; S.init(MT, D, c.G, c.wg); EpiResid E{c.out, XC, c.out, XC, MOD + 5 * D};
        pg8::gemm_phase<EpiResid, pg8::StaticOrder>(c.lds, g, S, E); }
    SEAM(11);
    if (IN(12)) REP(12) { convert_weights(c, 1); norm_mod_phase(c, c.out, XC, c.in[IN_NORMW] + 2 * D, MOD + 5 * MODW, 0, D, MT); }
    SEAM(12);
    if (IN(13)) { pg8::Gemm g{HY, Win, MT, NIN1, D}; pg8::StaticOrder S; S.init(MT, NIN1, c.G, c.wg); EpiInProj E{Pb, PW1, PW1 / 256, TL, TW1};
        pg8::gemm_phase<EpiInProj, pg8::StaticOrder>(c.lds, g, S, E); }
    SEAM(13);
    if (IN(14)) REP(14) ml_gate_phase(c);
    SEAM(14);
    if (IN(15)) REP(15) { if (USE_CHUNK_ML) mlstm_chunk_phase(c); else mlstm_scan_phase(c); }
    SEAM(15);
    if (IN(16)) REP(16) ml_output_phase(c);
    SEAM(16);
    if (IN(17)) { pg8::Gemm g{HY, Wout, ML, D, D}; pg8::StaticOrder S; S.init(ML, D, c.G, c.wg); EpiResid E{c.out, XC, c.out, XC, MOD + 5 * MODW + 2 * D};
        pg8::gemm_phase<EpiResid, pg8::StaticOrder>(c.lds, g, S, E); }
    SEAM(17);
    if (IN(18)) REP(18) norm_mod_phase(c, c.out, XC, c.in[IN_NORMW] + 3 * D, MOD + 5 * MODW, 3 * D, 4 * D, ML);
    SEAM(18);
    if (IN(19)) { pg8::Gemm g{HY, W13, ML, 2 * FF, D}; pg8::StaticOrder S; S.init(ML, 2 * FF, c.G, c.wg); EpiSwiGLU E{Pb, FF};
        pg8::gemm_phase<EpiSwiGLU, pg8::StaticOrder>(c.lds, g, S, E); }
    SEAM(19);
    if (IN(20)) { pg8::Gemm g{Pb, W2, ML, D, FF}; pg8::StaticOrder S; S.init(ML, D, c.G, c.wg); EpiResid E{c.out, XC, c.out, XC, MOD + 5 * MODW + 5 * D};
        pg8::gemm_phase<EpiResid, pg8::StaticOrder>(c.lds, g, S, E); }
    SEAM(20);
    if (IN(21)) final_norm_phase(c);
#undef IN
#undef SEAM
}

#ifndef N_LAUNCH_MODE
#define N_LAUNCH_MODE 1
#endif
extern "C" void kernel_launch(void* const* d_in, const int* in_sizes, int n_in, void* d_out, int out_size, void* d_ws, size_t ws_size, hipStream_t stream) {
    static int grid = 0;
    if (grid == 0) {
        if (n_in != 32 || out_size != ML * D || ws_size < WS_END) { fprintf(stderr, "kernel_launch: unexpected problem (n_in %d out %d ws %zu)\n", n_in, out_size, ws_size); grid = -1; return; }
        int dev = 0, cus = 0;
        if (hipGetDevice(&dev) != hipSuccess || hipDeviceGetAttribute(&cus, hipDeviceAttributeMultiprocessorCount, dev) != hipSuccess) { grid = -1; return; }
        if (hipFuncSetAttribute((const void*)fwd_kernel, hipFuncAttributeMaxDynamicSharedMemorySize, LDS_BYTES) != hipSuccess) { grid = -1; return; }
        int per_cu = 0;
        if (hipOccupancyMaxActiveBlocksPerMultiprocessor(&per_cu, (const void*)fwd_kernel, NTHREADS, LDS_BYTES) != hipSuccess || per_cu < 1) { fprintf(stderr, "kernel_launch: occupancy query says %d\n", per_cu); }
        (void)hipGetLastError();
        grid = cus;
    }
    if (grid < 0) return;
    (void)hipMemsetAsync((char*)d_ws + WS_CTL, 0, CTL_BYTES, stream);
    Args a{};
    for (int i = 0; i < 32; ++i) a.in[i] = (const float*)d_in[i];
    a.out = (float*)d_out; a.ws = (unsigned char*)d_ws;
#if N_LAUNCH_MODE == 1
    a.ph_lo = 0; a.ph_hi = NPHASE;
    hipLaunchKernelGGL(fwd_kernel, dim3(grid), dim3(NTHREADS), LDS_BYTES, stream, a);
#else
    for (int p = 0; p < 22; ++p) { a.ph_lo = p; a.ph_hi = p + 1; hipLaunchKernelGGL(fwd_kernel, dim3(grid), dim3(NTHREADS), LDS_BYTES, stream, a); }
#endif
}
```

```cpp
#include <hip/hip_runtime.h>
#include <cstdio>
#include <cstdint>
#define LAS __attribute__((address_space(3)))
#define GAS __attribute__((address_space(1)))
#define XB_TMO      128
#define XB_XCNT(j)  (256  + 64 * (j))
#define XB_XSUB(j)  (1280 + 64 * (j))
#define XB_XGEN(j)  (2304 + 64 * (j))
#define XB_TOP      3328
#define XB_TOPGEN   3392
#define XCD_BAR_WORDS 3456
#define XB_SPIN_CAP (1u << 20)

__device__ __forceinline__ unsigned xb_ld(unsigned* p)              { return __hip_atomic_load(p, __ATOMIC_RELAXED, __HIP_MEMORY_SCOPE_AGENT); }
__device__ __forceinline__ unsigned xb_add(unsigned* p, unsigned v) { return __hip_atomic_fetch_add(p, v, __ATOMIC_RELAXED, __HIP_MEMORY_SCOPE_AGENT); }
__device__ __forceinline__ unsigned xb_xcc_id() { return (unsigned)__builtin_amdgcn_s_getreg((3 << 11) | 20) & 0xFu; }
#define XB_SPIN(cond, bar) do { unsigned _sp = 0; while (cond) { __builtin_amdgcn_s_sleep(1); \
    if ((++_sp & 255u) == 0u) { if (xb_ld(&(bar)[XB_TMO])) break; if (_sp > XB_SPIN_CAP) { atomicAdd(&(bar)[XB_TMO], 1u); break; } } } } while (0)

struct XcdBarrier {
    unsigned* bar; unsigned x;
    volatile LAS unsigned* st;
};

__device__ __forceinline__ XcdBarrier xcd_barrier_post(unsigned* bar, volatile LAS unsigned* st) {
    XcdBarrier b; b.bar = bar; b.x = xb_xcc_id(); b.st = st;
    if (threadIdx.x == 0) (void)xb_add(&bar[XB_XCNT(b.x)], 1u);
    return b;
}
__device__ __forceinline__ void xcd_barrier_complete(unsigned* bar, unsigned x, unsigned& nloc, unsigned& nx) {
    const unsigned G = gridDim.x * gridDim.y * gridDim.z;
    unsigned sum, cnt, mine, sp = 0u;
    for (;;) {
        sum = 0u; cnt = 0u; mine = 0u;
#pragma unroll
        for (unsigned j = 0; j < 16; ++j) { const unsigned c = xb_ld(&bar[XB_XCNT(j)]); sum += c; cnt += (c > 0u) ? 1u : 0u; mine = (j == x) ? c : mine; }
        if (sum == G) break;
        __builtin_amdgcn_s_sleep(1);
        if ((++sp & 255u) == 0u) { if (xb_ld(&bar[XB_TMO])) break; if (sp > XB_SPIN_CAP) { atomicAdd(&bar[XB_TMO], 1u); break; } }
    }
    nloc = mine > 0u ? mine : 1u; nx = cnt > 0u ? cnt : 1u;
}

__device__ __forceinline__ void xcd_barrier(const XcdBarrier& b) {
    asm volatile("s_waitcnt vmcnt(0)" ::: "memory");
    __syncthreads();
    if (threadIdx.x == 0) {
        unsigned* bar = b.bar;
        __builtin_amdgcn_s_waitcnt(0);
        unsigned nloc = b.st[0], nx = b.st[1];
        if (nloc == 0u) { xcd_barrier_complete(bar, b.x, nloc, nx); b.st[0] = nloc; b.st[1] = nx; }
        const unsigned old = xb_add(&bar[XB_XSUB(b.x)], 1u);
        const unsigned gen = old / nloc;
        if (old + 1u == (gen + 1u) * nloc) {
            __builtin_amdgcn_fence(__ATOMIC_RELEASE, "agent");
            asm volatile("s_waitcnt vmcnt(0)" ::: "memory");
            const unsigned og = xb_add(&bar[XB_TOP], 1u);
            const unsigned tg = og / nx;
            if (og + 1u == (tg + 1u) * nx) xb_add(&bar[XB_TOPGEN], 1u);
            else XB_SPIN(xb_ld(&bar[XB_TOPGEN]) == tg, bar);
            __builtin_amdgcn_fence(__ATOMIC_ACQUIRE, "agent");
            xb_add(&bar[XB_XGEN(b.x)], 1u);
            asm volatile("s_waitcnt vmcnt(0)" ::: "memory");
        } else {
            XB_SPIN(xb_ld(&bar[XB_XGEN(b.x)]) == gen, bar);
            __builtin_amdgcn_fence(__ATOMIC_ACQUIRE, "agent");
            asm volatile("s_waitcnt vmcnt(0)" ::: "memory");
        }
    }
    __syncthreads();
}
#include <hip/hip_runtime.h>
namespace pg8 {
#define PG8_LAS __attribute__((address_space(3)))
typedef unsigned short bf16_t;
typedef short bf16x8 __attribute__((ext_vector_type(8)));
typedef float f32x4 __attribute__((ext_vector_type(4)));
typedef unsigned u32x4 __attribute__((ext_vector_type(4)));
constexpr int BM = 256, BK = 64, HALF = 128, HTB = HALF * BK * 2  , STAGE_BYTES = 8 * HTB, NXCD = 8, WGM = 8;

__host__ __device__ __forceinline__ int lds_byte(int r, int c) { const int st = (r >> 4) * 2 + (c >> 5), rr = r & 15, cc = c & 31, ob = rr * 64 + cc * 2; return st * 1024 + (ob ^ (((ob >> 9) & 1) << 5)); }
__host__ __device__ __forceinline__ void stage_rc(int b, int& R, int& C) { const int st = b / 1024, sb = b % 1024, swz = sb ^ (((sb >> 9) & 1) << 5); R = (st >> 1) * 16 + swz / 64; C = (st & 1) * 32 + (swz % 64) / 2; }
__host__ __device__ __forceinline__ int perm32(int rho) { const int n = rho >> 4, i = rho & 15; return 8 * (i >> 2) + 4 * n + (i & 3); }

struct Unit { int pm, pn; };
struct Gemm { const bf16_t* A; const bf16_t* Bt; int M, N, K; };

struct StaticOrder {
    int nM, nN, nwg, G, c;
    __host__ __device__ void init(int M, int N, int G_, int c_) { nM = M / BM; nN = N / BM; nwg = nM * nN; G = G_; c = c_; }
    __host__ __device__ bool next(int i, Unit& u) const {
        const long L = (long)i * G + c; if (L >= nwg) return false;
        int wgid = (int)L; { const int q = nwg / NXCD, r = nwg % NXCD, xcd = wgid % NXCD, off = wgid / NXCD; wgid = (xcd < r ? xcd * (q + 1) : r * (q + 1) + (xcd - r) * q) + off; }
        const int nig = WGM * nN, gid = wgid / nig, fm = gid * WGM, gsz = (nM - fm) < WGM ? (nM - fm) : WGM;
        u.pm = fm + ((wgid % nig) % gsz); u.pn = (wgid % nig) / gsz; return true;
    }
    __device__ __forceinline__ void a_ready(const Unit&) const {}
    __device__ __forceinline__ void done(const Unit&) const {}
};
template <class Epi, class Sched, bool ALIGN_EPI = false, bool SP2 = false>
__device__ __forceinline__ void gemm_phase(PG8_LAS unsigned char* lds, const Gemm g, const Sched& S, const Epi& E) {
    const int tid = threadIdx.x, wid = __builtin_amdgcn_readfirstlane(tid >> 6), lane = tid & 63, wr = wid >> 2, wc = wid & 3, fr = lane & 15, fq = lane >> 4;
    const int K = g.K, nt = K / BK;
    unsigned voffA[2], voffB[2];
#pragma unroll
    for (int i = 0; i < 2; ++i) { int R, C; stage_rc(tid * 16 + i * 8192, R, C); const int Rb = Epi::PERM ? ((R & ~31) + perm32(R & 31)) : R;
        voffA[i] = (unsigned)(R * K + C) * 2u; voffB[i] = (unsigned)(Rb * K + C) * 2u; }
    const size_t kstep = (size_t)(BK * 2);
    const size_t hstep = (size_t)HALF * K * 2;
    const size_t tstep = 2 * hstep;
    const unsigned ldsw = (unsigned)wid * 1024u;
    const int aoff = lds_byte(wr * 64 + fr, fq * 8), boff = lds_byte(wc * 32 + fr, fq * 8);
#define PG8_SA(b, h) (((b) * 2 + (h)) * HTB)
#define PG8_SB(b, h) ((4 + (b) * 2 + (h)) * HTB)
#define PG8_STAGE(bufoff, gbase, voff) do { _Pragma("unroll") for (int _i = 0; _i < 2; ++_i) \
        __builtin_amdgcn_global_load_lds((const unsigned*)((const char*)(gbase) + (voff)[_i]), (PG8_LAS unsigned*)(lds + (bufoff) + ldsw + _i * 8192), 16, 0, 0); } while (0)
#define PG8_LDA(dst, b, h) do { _Pragma("unroll") for (int m = 0; m < 4; ++m) _Pragma("unroll") for (int k = 0; k < 2; ++k) dst[m][k] = *(const PG8_LAS bf16x8*)(lds + PG8_SA(b, h) + aoff + m * 2048 + k * 1024); } while (0)
#define PG8_LDB(dst, b, h) do { _Pragma("unroll") for (int n = 0; n < 2; ++n) _Pragma("unroll") for (int k = 0; k < 2; ++k) dst[n][k] = *(const PG8_LAS bf16x8*)(lds + PG8_SB(b, h) + boff + n * 2048 + k * 1024); } while (0)
#define PG8_MMA(ai, bj, At, Bt) do { __builtin_amdgcn_s_setprio(1); _Pragma("unroll") for (int m = 0; m < 4; ++m) _Pragma("unroll") for (int n = 0; n < 2; ++n) _Pragma("unroll") for (int k = 0; k < 2; ++k) \
        acc[ai][bj][m][n] = __builtin_amdgcn_mfma_f32_16x16x32_bf16(Bt[n][k], At[m][k], acc[ai][bj][m][n], 0, 0, 0); __builtin_amdgcn_s_setprio(0); } while (0)
#define PG8_WAIT_V(n) asm volatile("s_waitcnt vmcnt(" #n ")" ::: "memory")
#define PG8_WAIT_L(n) asm volatile("s_waitcnt lgkmcnt(" #n ")" ::: "memory")
#define PG8_BAR __builtin_amdgcn_s_barrier()
#define PG8_SCHED __builtin_amdgcn_sched_barrier(0)
    Unit cur, nxt; int ui = 0;
    if (!S.next(0, cur)) return;
    f32x4 acc[2][2][4][2];
#pragma unroll
    for (int a = 0; a < 2; ++a)
#pragma unroll
        for (int b = 0; b < 2; ++b)
#pragma unroll
            for (int m = 0; m < 4; ++m)
#pragma unroll
                for (int n = 0; n < 2; ++n) acc[a][b][m][n] = (f32x4){0.f, 0.f, 0.f, 0.f};
    bf16x8 At[4][2], B0[2][2], B1[2][2];
    const char* cA = (const char*)g.A + (size_t)cur.pm * tstep; const char* cB = (const char*)g.Bt + (size_t)cur.pn * tstep;
    S.a_ready(cur);
    if constexpr (SP2) {
        PG8_STAGE(PG8_SB(0, 0), cB, voffB); PG8_STAGE(PG8_SB(0, 1), cB + hstep, voffB); PG8_STAGE(PG8_SA(0, 0), cA, voffA); PG8_STAGE(PG8_SA(0, 1), cA + hstep, voffA);
        if (wr == 1) PG8_BAR;
        PG8_WAIT_V(2); PG8_BAR;
        PG8_STAGE(PG8_SB(1, 0), cB + kstep, voffB); PG8_STAGE(PG8_SA(1, 0), cA + kstep, voffA); PG8_STAGE(PG8_SB(1, 1), cB + hstep + kstep, voffB);
        PG8_WAIT_V(6); PG8_BAR;
    } else {
        PG8_STAGE(PG8_SB(0, 0), cB, voffB); PG8_STAGE(PG8_SA(0, 0), cA, voffA); PG8_STAGE(PG8_SB(0, 1), cB + hstep, voffB); PG8_STAGE(PG8_SA(0, 1), cA + hstep, voffA);
        if (wr == 1) PG8_BAR;
        PG8_WAIT_V(4); PG8_BAR;
        PG8_STAGE(PG8_SB(1, 0), cB + kstep, voffB); PG8_STAGE(PG8_SA(1, 0), cA + kstep, voffA); PG8_STAGE(PG8_SB(1, 1), cB + hstep + kstep, voffB);
        PG8_WAIT_V(6); PG8_BAR;
    }
    for (;;) {
        const bool has_next = S.next(ui + 1, nxt);
        const char* nA = has_next ? (const char*)g.A + (size_t)nxt.pm * tstep : cA; const char* nB = has_next ? (const char*)g.Bt + (size_t)nxt.pn * tstep : cB;
        for (int t = 0; t < nt; t += 2) {
            const bool last = (t == nt - 2);
            const char* a1 = cA + (size_t)(t + 1) * kstep;
            const char* a2 = last ? nA : cA + (size_t)(t + 2) * kstep; const char* b2 = last ? nB : cB + (size_t)(t + 2) * kstep;
            const char* a3 = a2 + kstep; const char* b3 = b2 + kstep;
            if (last && has_next) S.a_ready(nxt);
            if constexpr (SP2) {
            PG8_LDB(B0, 0, 0); PG8_LDB(B1, 0, 1); PG8_SCHED; PG8_LDA(At, 0, 0); PG8_STAGE(PG8_SA(1, 1), a1 + hstep, voffA);
            PG8_WAIT_V(8); PG8_WAIT_L(0); PG8_BAR; PG8_MMA(0, 0, At, B0); PG8_MMA(0, 1, At, B1); PG8_BAR; PG8_SCHED;
            PG8_LDA(At, 0, 1); PG8_STAGE(PG8_SB(0, 0), b2, voffB); PG8_STAGE(PG8_SB(0, 1), b2 + hstep, voffB); PG8_STAGE(PG8_SA(0, 0), a2, voffA);
            PG8_WAIT_V(8); PG8_WAIT_L(0); PG8_BAR; PG8_MMA(1, 0, At, B0); PG8_MMA(1, 1, At, B1); PG8_BAR; PG8_SCHED;
            PG8_LDB(B0, 1, 0); PG8_LDB(B1, 1, 1); PG8_SCHED; PG8_LDA(At, 1, 0); PG8_STAGE(PG8_SA(0, 1), a2 + hstep, voffA);
            PG8_WAIT_V(8); PG8_WAIT_L(0); PG8_BAR; PG8_MMA(0, 0, At, B0); PG8_MMA(0, 1, At, B1); PG8_BAR; PG8_SCHED;
            PG8_LDA(At, 1, 1); PG8_STAGE(PG8_SB(1, 0), b3, voffB); PG8_STAGE(PG8_SB(1, 1), b3 + hstep, voffB); PG8_STAGE(PG8_SA(1, 0), a3, voffA);
            PG8_WAIT_V(8); PG8_WAIT_L(0); PG8_BAR; PG8_MMA(1, 0, At, B0); PG8_MMA(1, 1, At, B1); PG8_BAR; PG8_SCHED;
            } else {
            PG8_LDB(B0, 0, 0); PG8_SCHED; PG8_LDA(At, 0, 0); PG8_STAGE(PG8_SA(1, 1), a1 + hstep, voffA);
            PG8_WAIT_L(8); PG8_BAR; PG8_WAIT_L(0); PG8_MMA(0, 0, At, B0); PG8_BAR; PG8_SCHED;
            PG8_LDB(B1, 0, 1); PG8_STAGE(PG8_SB(0, 0), b2, voffB);
            PG8_BAR; PG8_WAIT_L(0); PG8_MMA(0, 1, At, B1); PG8_BAR;
            PG8_LDA(At, 0, 1); PG8_STAGE(PG8_SA(0, 0), a2, voffA);
            PG8_BAR; PG8_WAIT_L(0); PG8_MMA(1, 0, At, B0); PG8_BAR; PG8_SCHED;
            PG8_STAGE(PG8_SB(0, 1), b2 + hstep, voffB);
            PG8_WAIT_V(6); PG8_BAR; PG8_MMA(1, 1, At, B1); PG8_BAR;
            PG8_LDB(B0, 1, 0); PG8_SCHED; PG8_LDA(At, 1, 0); PG8_STAGE(PG8_SA(0, 1), a2 + hstep, voffA);
            PG8_WAIT_L(8); PG8_BAR; PG8_WAIT_L(0); PG8_MMA(0, 0, At, B0); PG8_BAR; PG8_SCHED;
            PG8_LDB(B1, 1, 1); PG8_STAGE(PG8_SB(1, 0), b3, voffB);
            PG8_BAR; PG8_WAIT_L(0); PG8_MMA(0, 1, At, B1); PG8_BAR;
            PG8_LDA(At, 1, 1); PG8_STAGE(PG8_SA(1, 0), a3, voffA);
            PG8_BAR; PG8_WAIT_L(0); PG8_MMA(1, 0, At, B0); PG8_BAR; PG8_SCHED;
            PG8_STAGE(PG8_SB(1, 1), b3 + hstep, voffB);
            PG8_WAIT_V(6); PG8_BAR; PG8_MMA(1, 1, At, B1); PG8_BAR;
            }
        }
        if constexpr (ALIGN_EPI) { if (wr == 0) PG8_BAR; }
        if constexpr (!Epi::AFTER_DRAIN) { E(acc, cur, wr, wc, fr, fq); S.done(cur); }
        if (!has_next) break;
#pragma unroll
        for (int a = 0; a < 2; ++a)
#pragma unroll
            for (int b = 0; b < 2; ++b)
#pragma unroll
                for (int m = 0; m < 4; ++m)
#pragma unroll
                    for (int n = 0; n < 2; ++n) acc[a][b][m][n] = (f32x4){0.f, 0.f, 0.f, 0.f};
        cur = nxt; cA = nA; cB = nB; ++ui;
        if constexpr (ALIGN_EPI) { if (wr == 1) PG8_BAR; }
    }
    PG8_WAIT_V(0);
    if constexpr (!ALIGN_EPI) { if (wr == 0) PG8_BAR; }
    PG8_BAR;
    if constexpr (Epi::AFTER_DRAIN) { E.fused(acc, cur, wr, wc, fr, fq, lds, wid, lane); S.done(cur); }
#undef PG8_SA
#undef PG8_SB
#undef PG8_STAGE
#undef PG8_LDA
#undef PG8_LDB
#undef PG8_MMA
#undef PG8_WAIT_V
#undef PG8_WAIT_L
#undef PG8_BAR
#undef PG8_SCHED
}
}

typedef unsigned short bf16_t;
typedef float f32x4 __attribute__((ext_vector_type(4)));
typedef float f32x2 __attribute__((ext_vector_type(2)));
typedef unsigned u32x4 __attribute__((ext_vector_type(4)));
typedef unsigned u32x2 __attribute__((ext_vector_type(2)));

constexpr int D = 2048, NB = 4, SEQ = 4096, CTXL = 256;
constexpr int ML = NB * SEQ;
constexpr int MC = NB * CTXL;
constexpr int MT = ML + MC;
constexpr int AB_IN = 7616, NIN0 = 7680, PW0 = 7168, TW0 = 512;
constexpr int C_INW = 6176, NIN1 = 6400, PW1 = 6144, TW1 = 256;
constexpr int FF = 5632;
constexpr int MODW = 6 * D;
constexpr int NTHREADS = 512, NWAVES = 8;

constexpr size_t MiB = 1u << 20;
constexpr size_t WS_CTL = 0, CTL_BYTES = 16384;
constexpr size_t WS_MOD = 1 * MiB;
constexpr size_t WS_GA = 2 * MiB, WS_GB = 4 * MiB;
constexpr size_t WS_XC = 6 * MiB;
constexpr size_t WS_HY = 14 * MiB;
constexpr size_t WS_TAIL = 82 * MiB;
constexpr size_t WS_WIN = 116 * MiB;
constexpr size_t WS_WOUT = 146 * MiB;
constexpr size_t WS_W13 = 154 * MiB;
constexpr size_t WS_W2 = 198 * MiB;
constexpr size_t WS_P = 220 * MiB;
constexpr size_t WS_F = 458 * MiB;
constexpr size_t FSLOT = (size_t)MT * 1024 * 2;
constexpr size_t WS_WL = 696 * MiB;
constexpr size_t WS_WG = 698 * MiB;
constexpr size_t WS_END = 700 * MiB;
constexpr size_t WS_A1 = WS_HY, WS_A2 = WS_HY + 16 * MiB;
constexpr size_t WS_GOUT = WS_TAIL;
static_assert(WS_F + 7 * FSLOT <= WS_END, "ws map");
static_assert(WS_HY + (size_t)MT * D * 2 <= WS_TAIL && WS_TAIL + (size_t)MT * TW0 * 4 <= WS_WIN && WS_W2 + (size_t)D * FF * 2 <= WS_P && WS_P + (size_t)MT * PW0 * 2 <= WS_F, "ws map");

constexpr int LDS_BYTES = 147456;
constexpr int LDS_BAR_OFF = LDS_BYTES - 64;

__device__ __forceinline__ float bflo(unsigned u) { return __builtin_bit_cast(float, u << 16); }
__device__ __forceinline__ float bfhi(unsigned u) { return __builtin_bit_cast(float, u & 0xffff0000u); }
__device__ __forceinline__ float bf1(bf16_t h) { return __builtin_bit_cast(float, (unsigned)h << 16); }
__device__ __forceinline__ unsigned f2bf(float f) { unsigned u = __builtin_bit_cast(unsigned, f); return (u + 0x7fffu + ((u >> 16) & 1u)) >> 16; }
__device__ __forceinline__ unsigned pk2(float lo, float hi) { return f2bf(lo) | (f2bf(hi) << 16); }
__device__ __forceinline__ float sigm(float x) { return 1.f / (1.f + expf(-x)); }
__device__ __forceinline__ float sigm_fast(float x) { return 1.f / (1.f + __expf(-x)); }
__device__ __forceinline__ float silu_fast(float x) { return x / (1.f + __expf(-x)); }
__device__ __forceinline__ float softplus_(float x) { return fmaxf(x, 0.f) + log1pf(expf(-fabsf(x))); }
__device__ __forceinline__ float logsigm_(float x) { return fminf(x, 0.f) - log1pf(expf(-fabsf(x))); }
template <int W> __device__ __forceinline__ float grp_sum(float v) {
#pragma unroll
    for (int o = 1; o < W; o <<= 1) v += __shfl_xor(v, o);
    return v;
}
__device__ __forceinline__ void unpack8(const u32x4 u, float (&f)[8]) {
    f[0] = bflo(u.x); f[1] = bfhi(u.x); f[2] = bflo(u.y); f[3] = bfhi(u.y); f[4] = bflo(u.z); f[5] = bfhi(u.z); f[6] = bflo(u.w); f[7] = bfhi(u.w);
}
__device__ __forceinline__ u32x4 pack8(const float (&f)[8]) { u32x4 o; o.x = pk2(f[0], f[1]); o.y = pk2(f[2], f[3]); o.z = pk2(f[4], f[5]); o.w = pk2(f[6], f[7]); return o; }

struct EpiInProj {
    static constexpr bool PERM = true, AFTER_DRAIN = false;
    bf16_t* P; int ldp; int nPt; float* T; int ldt;
    __device__ __forceinline__ void operator()(const pg8::f32x4 (&acc)[2][2][4][2], const pg8::Unit& u, int wr, int wc, int fr, int fq) const {
        const int row0 = u.pm * 256 + wr * 64 + fr;
        if (u.pn < nPt) {
            const int col0 = u.pn * 256 + wc * 32 + 8 * fq;
#pragma unroll
            for (int ai = 0; ai < 2; ++ai)
#pragma unroll
                for (int m = 0; m < 4; ++m) { bf16_t* rowp = P + (size_t)(row0 + ai * 128 + m * 16) * ldp + col0;
#pragma unroll
                    for (int bj = 0; bj < 2; ++bj) { const pg8::f32x4 v0 = acc[ai][bj][m][0], v1 = acc[ai][bj][m][1];
                        u32x4 o; o.x = pk2(v0[0], v0[1]); o.y = pk2(v0[2], v0[3]); o.z = pk2(v1[0], v1[1]); o.w = pk2(v1[2], v1[3]);
                        *(u32x4*)(rowp + bj * 128) = o; } }
        } else {
            const int col0 = (u.pn - nPt) * 256 + wc * 32 + 8 * fq;
#pragma unroll
            for (int ai = 0; ai < 2; ++ai)
#pragma unroll
                for (int m = 0; m < 4; ++m) { float* rowp = T + (size_t)(row0 + ai * 128 + m * 16) * ldt + col0;
#pragma unroll
                    for (int bj = 0; bj < 2; ++bj) { *(pg8::f32x4*)(rowp + bj * 128) = acc[ai][bj][m][0]; *(pg8::f32x4*)(rowp + bj * 128 + 4) = acc[ai][bj][m][1]; } }
        }
    }
};
struct EpiResid {
    static constexpr bool PERM = false, AFTER_DRAIN = false;
    const float* srcL; const float* srcC; float* dstL; float* dstC; const float* gate;
    __device__ __forceinline__ void operator()(const pg8::f32x4 (&acc)[2][2][4][2], const pg8::Unit& u, int wr, int wc, int fr, int fq) const {
        const bool lat = u.pm < 64;
        const int rowl = (lat ? u.pm : u.pm - 64) * 256 + wr * 64 + fr, col0 = u.pn * 256 + wc * 32 + 4 * fq;
        const float* src = lat ? srcL : srcC; float* dst = lat ? dstL : dstC;
        const float* g = gate + (size_t)(lat ? (u.pm >> 4) : 4) * MODW + col0;
        pg8::f32x4 gv[2][2];
#pragma unroll
        for (int bj = 0; bj < 2; ++bj)
#pragma unroll
            for (int n = 0; n < 2; ++n) gv[bj][n] = *(const pg8::f32x4*)(g + bj * 128 + n * 16);
#pragma unroll
        for (int ai = 0; ai < 2; ++ai)
#pragma unroll
            for (int m = 0; m < 4; ++m) { const size_t ro = (size_t)(rowl + ai * 128 + m * 16) * D + col0;
#pragma unroll
                for (int bj = 0; bj < 2; ++bj)
#pragma unroll
                    for (int n = 0; n < 2; ++n) { const pg8::f32x4 s = *(const pg8::f32x4*)(src + ro + bj * 128 + n * 16);
                        *(pg8::f32x4*)(dst + ro + bj * 128 + n * 16) = s + gv[bj][n] * acc[ai][bj][m][n]; } }
    }
};
struct EpiSwiGLU {
    static constexpr bool PERM = true, AFTER_DRAIN = false;
    bf16_t* H; int ldh;
    __device__ __forceinline__ void operator()(const pg8::f32x4 (&acc)[2][2][4][2], const pg8::Unit& u, int wr, int wc, int fr, int fq) const {
        const int row0 = u.pm * 256 + wr * 64 + fr, col0 = u.pn * 128 + wc * 32 + 8 * fq;
#pragma unroll
        for (int ai = 0; ai < 2; ++ai)
#pragma unroll
            for (int m = 0; m < 4; ++m) { float h[8];
#pragma unroll
                for (int n = 0; n < 2; ++n)
#pragma unroll
                    for (int j = 0; j < 4; ++j) h[n * 4 + j] = silu_fast(acc[ai][0][m][n][j]) * acc[ai][1][m][n][j];
                *(u32x4*)(H + (size_t)(row0 + ai * 128 + m * 16) * ldh + col0) = pack8(h); }
    }
};

struct EpiLora {
    static constexpr bool PERM = true, AFTER_DRAIN = false;
    bf16_t* P; int ldp; const float* w0; const float* a0;
    __device__ __forceinline__ void operator()(const pg8::f32x4 (&acc)[2][2][4][2], const pg8::Unit& u, int wr, int wc, int fr, int fq) const {
        const int row0 = u.pm * 256 + wr * 64 + fr, col0 = u.pn * 256 + wc * 32 + 8 * fq;
        const bool isw = u.pn < 8; const float* bp = isw ? w0 + col0 : a0 + (col0 - 2048); const float sc = isw ? -0.6065306597126334f : 1.f;
#pragma unroll
        for (int bj = 0; bj < 2; ++bj) {
            const pg8::f32x4 b0 = *(const pg8::f32x4*)(bp + bj * 128), b1 = *(const pg8::f32x4*)(bp + bj * 128 + 4);
#pragma unroll
            for (int ai = 0; ai < 2; ++ai)
#pragma unroll
                for (int m = 0; m < 4; ++m) { float h[8];
#pragma unroll
                    for (int j = 0; j < 4; ++j) { h[j] = sc * sigm_fast(acc[ai][bj][m][0][j] + b0[j]); h[4 + j] = sc * sigm_fast(acc[ai][bj][m][1][j] + b1[j]); }
                    *(u32x4*)(P + (size_t)(row0 + ai * 128 + m * 16) * ldp + col0 + bj * 128) = pack8(h); } }
    }
};
struct EpiBf16Plain {
    static constexpr bool PERM = true, AFTER_DRAIN = false;
    bf16_t* O; int ldo;
    __device__ __forceinline__ void operator()(const pg8::f32x4 (&acc)[2][2][4][2], const pg8::Unit& u, int wr, int wc, int fr, int fq) const {
        const int row0 = u.pm * 256 + wr * 64 + fr, col0 = u.pn * 256 + wc * 32 + 8 * fq;
#pragma unroll
        for (int ai = 0; ai < 2; ++ai)
#pragma unroll
            for (int m = 0; m < 4; ++m) { bf16_t* rowp = O + (size_t)(row0 + ai * 128 + m * 16) * ldo + col0;
#pragma unroll
                for (int bj = 0; bj < 2; ++bj) { const pg8::f32x4 v0 = acc[ai][bj][m][0], v1 = acc[ai][bj][m][1];
                    u32x4 o; o.x = pk2(v0[0], v0[1]); o.y = pk2(v0[2], v0[3]); o.z = pk2(v1[0], v1[1]); o.w = pk2(v1[2], v1[3]);
                    *(u32x4*)(rowp + bj * 128) = o; } }
    }
};

struct Ctx {
    LAS unsigned char* lds; int tid, lane, wave, G, wg, gw, NGW;
    const float* in[32]; float* out; unsigned char* ws;
};
#define IN_X 0
#define IN_C 1
#define IN_CTX 2
#define IN_CCTX 3
#define IN_ADAW 4
#define IN_ADAB 5
#define IN_NORMW 6
#define IN_ABWIN 7
#define IN_CONVW 8
#define IN_ALOG 9
#define IN_DTB 10
#define IN_GDNNW 11
#define IN_W0 12
#define IN_WUP 13
#define IN_A0 14
#define IN_AUP 15
#define IN_GUP 16
#define IN_KK 17
#define IN_KA 18
#define IN_RK 19
#define IN_LNW 20
#define IN_LNB 21
#define IN_ABWOUT 22
#define IN_MLWIN 23
#define IN_MLIB 24
#define IN_MLFB 25
#define IN_MLNW 26
#define IN_MLWOUT 27
#define IN_W1 28
#define IN_W3 29
#define IN_W2 30
#define IN_FNW 31

__device__ __forceinline__ void transpose_matrix(const Ctx& c, const float* W, int K, int N, int Npad, bf16_t* WT, int mode, LAS float* scr) {
    const int nblk = Npad / 64, items = (K / 64) * nblk, lane = c.lane;
#pragma unroll 1
    for (int it = c.gw; it < items; it += c.NGW) {
        const int kb = it / nblk, nb = it - kb * nblk, k0 = kb * 64, n0 = nb * 64;
        const int rr = lane >> 4, c4 = (lane & 15) * 4;
        f32x4 v[16];
        const bool inb = n0 + c4 < N;
#pragma unroll
        for (int i = 0; i < 16; ++i) v[i] = inb ? *(const f32x4*)(W + (size_t)(k0 + 4 * i + rr) * N + n0 + c4) : (f32x4){0.f, 0.f, 0.f, 0.f};
#pragma unroll
        for (int i = 0; i < 16; ++i) { LAS float* d = scr + (4 * i + rr) * 65 + c4; d[0] = v[i].x; d[1] = v[i].y; d[2] = v[i].z; d[3] = v[i].w; }
        asm volatile("s_waitcnt lgkmcnt(0)" ::: "memory");
        const int j = lane & 7;
#pragma unroll
        for (int q = 0; q < 8; ++q) { const int n = q * 8 + (lane >> 3); const LAS float* s = scr + (8 * j) * 65 + n;
            u32x4 o; o.x = pk2(s[0], s[65]); o.y = pk2(s[2 * 65], s[3 * 65]); o.z = pk2(s[4 * 65], s[5 * 65]); o.w = pk2(s[6 * 65], s[7 * 65]);
            const int ng = n0 + n, orow = mode == 0 ? ng : ((ng >> 7) * 256 + (ng & 127) + (mode == 2 ? 128 : 0));
            *(u32x4*)(WT + (size_t)orow * K + k0 + 8 * j) = o; }
        asm volatile("s_waitcnt lgkmcnt(0)" ::: "memory");
    }
}
__device__ __forceinline__ void convert_weights(const Ctx& c, int layer) {
    LAS float* scr = (LAS float*)c.lds + c.wave * (64 * 65);
    bf16_t* Win = (bf16_t*)(c.ws + WS_WIN); bf16_t* Wout = (bf16_t*)(c.ws + WS_WOUT); bf16_t* W13 = (bf16_t*)(c.ws + WS_W13); bf16_t* W2 = (bf16_t*)(c.ws + WS_W2);
    if (layer == 0) { transpose_matrix(c, c.in[IN_ABWIN], D, AB_IN, NIN0, Win, 0, scr); transpose_matrix(c, c.in[IN_ABWOUT], D, D, D, Wout, 0, scr); }
    else { transpose_matrix(c, c.in[IN_MLWIN], D, C_INW, NIN1, Win, 0, scr); transpose_matrix(c, c.in[IN_MLWOUT], D, D, D, Wout, 0, scr); }
    transpose_matrix(c, c.in[IN_W1] + (size_t)layer * D * FF, D, FF, FF, W13, 1, scr);
    transpose_matrix(c, c.in[IN_W3] + (size_t)layer * D * FF, D, FF, FF, W13, 2, scr);
    transpose_matrix(c, c.in[IN_W2] + (size_t)layer * FF * D, FF, D, D, W2, 0, scr);
}
__device__ __forceinline__ void lora_weight_phase(const Ctx& c) {
    bf16_t* Wl = (bf16_t*)(c.ws + WS_WL); bf16_t* Wg = (bf16_t*)(c.ws + WS_WG);
    for (int idx = c.wg * NTHREADS + c.tid; idx < 32 * 4096; idx += c.G * NTHREADS) {
        const int k8 = idx >> 12, n = idx & 4095, slot = n >> 10, ch = n & 1023; float v[8];
        const float* src = c.in[slot < 2 ? IN_WUP : IN_AUP] + (size_t)(slot & 1) * 64 * 1024 + ch;
#pragma unroll
        for (int q = 0; q < 8; ++q) { const int kk = k8 * 8 + q; v[q] = ((kk >> 6) == slot) ? src[(size_t)(kk & 63) * 1024] : 0.f; }
        *(u32x4*)(Wl + (size_t)n * 256 + k8 * 8) = pack8(v);
    }
    for (int idx = c.wg * NTHREADS + c.tid; idx < 32 * 1024; idx += c.G * NTHREADS) {
        const int k8 = idx >> 10, ch = idx & 1023; float v[8];
#pragma unroll
        for (int q = 0; q < 8; ++q) { const int kk = k8 * 8 + q; v[q] = kk < 160 ? c.in[IN_GUP][(size_t)kk * 1024 + ch] : 0.f; }
        *(u32x4*)(Wg + (size_t)ch * 256 + k8 * 8) = pack8(v);
    }
}
__device__ __forceinline__ void ada_phase(const Ctx& c) {
    LAS float* sc = (LAS float*)c.lds;
    LAS float* red = sc + 5 * D;
    for (int i = c.tid; i < 5 * D; i += NTHREADS) { const int b = i / D, k = i % D; const float v = b < 4 ? c.in[IN_C][b * D + k] : c.in[IN_CCTX][k]; sc[i] = v / (1.f + expf(-v)); }
    __syncthreads();
    float* MOD = (float*)(c.ws + WS_MOD);
    constexpr int UPL = MODW / 128;
    for (int u = c.wg; u < 2 * UPL; u += c.G) {
        const int layer = u / UPL, cb = (u % UPL) * 128;
        const float* wp = c.in[IN_ADAW] + (size_t)layer * D * MODW + cb + c.lane * 2;
        float acc[5][2];
#pragma unroll
        for (int b = 0; b < 5; ++b) acc[b][0] = acc[b][1] = 0.f;
        const int k0 = c.wave * 256;
#pragma unroll 16
        for (int k = k0; k < k0 + 256; ++k) { const f32x2 w = *(const f32x2*)(wp + (size_t)k * MODW);
#pragma unroll
            for (int b = 0; b < 5; ++b) { const float s = sc[b * D + k]; acc[b][0] += s * w.x; acc[b][1] += s * w.y; } }
#pragma unroll
        for (int b = 0; b < 5; ++b) { red[(c.wave * 5 + b) * 128 + c.lane * 2] = acc[b][0]; red[(c.wave * 5 + b) * 128 + c.lane * 2 + 1] = acc[b][1]; }
        __syncthreads();
        for (int i = c.tid; i < 640; i += NTHREADS) { const int b = i >> 7, l = i & 127; float s = 0.f;
#pragma unroll
            for (int w = 0; w < 8; ++w) s += red[(w * 5 + b) * 128 + l];
            MOD[(size_t)(layer * 5 + b) * MODW + cb + l] = s + c.in[IN_ADAB][layer * MODW + cb + l]; }
        __syncthreads();
    }
}
__device__ __forceinline__ void norm_mod_phase(const Ctx& c, const float* srcL, const float* srcC, const float* nw, const float* modl, int shift_off, int scale_off, int nrows) {
    bf16_t* H = (bf16_t*)(c.ws + WS_HY);
    for (int r = c.gw; r < nrows; r += c.NGW) {
        const float* xr = r < ML ? srcL + (size_t)r * D : srcC + (size_t)(r - ML) * D;
        const float* mr = modl + (size_t)(r < ML ? (r >> 12) : 4) * MODW;
        f32x4 v[8]; float ss = 0.f;
#pragma unroll
        for (int j = 0; j < 8; ++j) { v[j] = ((const f32x4*)xr)[c.lane + 64 * j]; ss += v[j].x * v[j].x + v[j].y * v[j].y + v[j].z * v[j].z + v[j].w * v[j].w; }
        ss = grp_sum<64>(ss);
        const float rstd = 1.f / sqrtf(ss * (1.f / D) + 1e-6f);
#pragma unroll
        for (int j = 0; j < 8; ++j) { const f32x4 w4 = ((const f32x4*)nw)[c.lane + 64 * j], s4 = ((const f32x4*)(mr + scale_off))[c.lane + 64 * j], h4 = ((const f32x4*)(mr + shift_off))[c.lane + 64 * j];
            const f32x4 y = v[j] * rstd * w4 * (s4 + 1.f) + h4;
            u32x2 o; o.x = pk2(y.x, y.y); o.y = pk2(y.z, y.w);
            ((u32x2*)(H + (size_t)r * D))[c.lane + 64 * j] = o; }
    }
}
__device__ __forceinline__ void final_norm_phase(const Ctx& c) {
    const float* nw = c.in[IN_FNW];
    for (int r = c.gw; r < ML; r += c.NGW) {
        f32x4* xr = (f32x4*)(c.out + (size_t)r * D);
        f32x4 v[8]; float ss = 0.f;
#pragma unroll
        for (int j = 0; j < 8; ++j) { v[j] = xr[c.lane + 64 * j]; ss += v[j].x * v[j].x + v[j].y * v[j].y + v[j].z * v[j].z + v[j].w * v[j].w; }
        ss = grp_sum<64>(ss);
        const float rstd = 1.f / sqrtf(ss * (1.f / D) + 1e-6f);
#pragma unroll
        for (int j = 0; j < 8; ++j) xr[c.lane + 64 * j] = v[j] * rstd * ((const f32x4*)nw)[c.lane + 64 * j];
    }
}

__device__ __forceinline__ void ab_feature_phase(const Ctx& c) {
    const bf16_t* P = (const bf16_t*)(c.ws + WS_P); const float* T = (const float*)(c.ws + WS_TAIL);
    bf16_t* F = (bf16_t*)(c.ws + WS_F);
    float* GA = (float*)(c.ws + WS_GA); float* GB = (float*)(c.ws + WS_GB);
    bf16_t* A1 = (bf16_t*)(c.ws + WS_A1); bf16_t* A2 = (bf16_t*)(c.ws + WS_A2);
    const float* cw = c.in[IN_CONVW];
    const int lane = c.lane;
    constexpr int NITEM = (MT / 8) * 12;
#pragma unroll 1
    for (int item = c.gw; item < NITEM; item += c.NGW) {
        const int st = item / 12, blk = item - st * 12, r0 = st * 8, ch = blk * 512 + lane * 8;
        const bool lat = r0 < ML;
        int rowbase, c0, ncols;
        int gr = 0;
        if (lat) { const int b = r0 >> 12, t0 = r0 & 4095; gr = t0 >> 6; c0 = t0 & 63; rowbase = b * 4096 + gr * 64; ncols = 64; }
        else { const int q = r0 - ML, b = q >> 8; c0 = q & 255; rowbase = ML + b * 256; ncols = 256; }
        float acc[8][8];
#pragma unroll
        for (int tt = 0; tt < 8; ++tt)
#pragma unroll
            for (int j = 0; j < 8; ++j) acc[tt][j] = 0.f;
#pragma unroll
        for (int dr = 0; dr < 3; ++dr) {
            const bool vr = lat ? (gr + dr - 1 >= 0 && gr + dr - 1 < 64) : (dr == 1);
            if (vr) {
                float w[3][8];
#pragma unroll
                for (int dc = 0; dc < 3; ++dc) { const f32x4 w0 = *(const f32x4*)(cw + (dr * 3 + dc) * 6144 + ch), w1 = *(const f32x4*)(cw + (dr * 3 + dc) * 6144 + ch + 4);
                    w[dc][0] = w0.x; w[dc][1] = w0.y; w[dc][2] = w0.z; w[dc][3] = w0.w; w[dc][4] = w1.x; w[dc][5] = w1.y; w[dc][6] = w1.z; w[dc][7] = w1.w; }
                const int rb = rowbase + (lat ? (dr - 1) * 64 : 0);
#pragma unroll
                for (int cc = 0; cc < 10; ++cc) {
                    const int col = c0 + cc - 1;
                    if (col >= 0 && col < ncols) {
                        float pf[8]; unpack8(*(const u32x4*)(P + (size_t)(rb + col) * PW0 + ch), pf);
#pragma unroll
                        for (int tt = 0; tt < 8; ++tt) { const int dc = cc - tt;
                            if (dc >= 0 && dc <= 2) {
#pragma unroll
                                for (int j = 0; j < 8; ++j) acc[tt][j] += pf[j] * w[dc][j]; } }
                    }
                }
            }
        }
        const int grp = blk >> 1, cl = (blk & 1) * 512 + lane * 8;
        f32x4 kk0 = {0.f, 0.f, 0.f, 0.f}, kk1 = kk0;
        if (grp == 4) { kk0 = *(const f32x4*)(c.in[IN_KK] + cl); kk1 = *(const f32x4*)(c.in[IN_KK] + cl + 4); }
#pragma unroll
        for (int tt = 0; tt < 8; ++tt) {
            const size_t r = (size_t)(r0 + tt);
            float cv[8];
#pragma unroll
            for (int j = 0; j < 8; ++j) cv[j] = acc[tt][j];
            if (grp < 3) {
                float ss = 0.f;
#pragma unroll
                for (int j = 0; j < 8; ++j) { cv[j] = cv[j] / (1.f + __expf(-cv[j])); ss += cv[j] * cv[j]; }
                if (grp < 2) { ss = grp_sum<16>(ss); const float sc = (1.f / sqrtf(ss + 1e-6f)) * (grp == 0 ? 0.08838834764831845f : 1.f);
#pragma unroll
                    for (int j = 0; j < 8; ++j) cv[j] *= sc; }
                *(u32x4*)(F + (size_t)grp * MT * 1024 + r * 1024 + cl) = pack8(cv);
            } else if (grp == 3) { *(u32x4*)(F + (size_t)3 * MT * 1024 + r * 1024 + cl) = pack8(cv);
            } else if (grp == 5) { *(u32x4*)(F + (size_t)6 * MT * 1024 + r * 1024 + cl) = pack8(cv);
            } else {
                *(u32x4*)(F + (size_t)5 * MT * 1024 + r * 1024 + cl) = pack8(cv);
                float t[8] = {cv[0] * kk0.x, cv[1] * kk0.y, cv[2] * kk0.z, cv[3] * kk0.w, cv[4] * kk1.x, cv[5] * kk1.y, cv[6] * kk1.z, cv[7] * kk1.w};
                float ss = 0.f;
#pragma unroll
                for (int j = 0; j < 8; ++j) ss += t[j] * t[j];
                ss = grp_sum<8>(ss); const float sc = 1.f / sqrtf(ss + 1e-6f);
#pragma unroll
                for (int j = 0; j < 8; ++j) t[j] *= sc;
                *(u32x4*)(F + (size_t)4 * MT * 1024 + r * 1024 + cl) = pack8(t);
            }
        }
        if (blk == 0) {
#pragma unroll 2
            for (int tt = 0; tt < 8; ++tt) {
                const size_t r = (size_t)(r0 + tt);
                const f32x4 t1 = *(const f32x4*)(T + r * TW0 + 32 + lane * 4);
                u32x2 o1; if (lane < 32) { o1.x = pk2(tanhf(t1.x), tanhf(t1.y)); o1.y = pk2(tanhf(t1.z), tanhf(t1.w)); } else { o1.x = pk2(t1.x, t1.y); o1.y = pk2(t1.z, t1.w); }
                *(u32x2*)(A1 + r * 256 + lane * 4) = o1;
                u32x2 o2 = {0u, 0u};
                if (lane < 40) { const f32x4 t2 = *(const f32x4*)(T + r * TW0 + 288 + lane * 4); o2.x = pk2(sigm(t2.x), sigm(t2.y)); o2.y = pk2(sigm(t2.z), sigm(t2.w)); }
                *(u32x2*)(A2 + r * 256 + lane * 4) = o2;
                if (lane < 16) {
                    const float g0 = T[r * TW0 + lane], g1 = T[r * TW0 + 16 + lane];
                    GA[r * 16 + lane] = -expf(c.in[IN_ALOG][lane]) * softplus_(g0 + c.in[IN_DTB][lane]);
                    GB[r * 16 + lane] = sigm(g1);
                }
            }
        }
    }
}
__device__ __forceinline__ void rw_lora_phase(const Ctx& c) {
    bf16_t* P = (bf16_t*)(c.ws + WS_P); const float* T = (const float*)(c.ws + WS_TAIL);
    LAS float* xin = (LAS float*)c.lds;
    const int tid = c.tid;
    for (int tile = c.wg; tile < MT / 16; tile += c.G) {
        const int r0 = tile * 16;
#pragma unroll 1
        for (int pass = 0; pass < 2; ++pass) {
            __syncthreads();
            for (int i = tid; i < 16 * 128; i += NTHREADS) { const int tk = i >> 7, j = i & 127; const float v = T[(size_t)(r0 + tk) * TW0 + 32 + pass * 128 + j]; xin[i] = pass == 0 ? tanhf(v) : v; }
            __syncthreads();
            const float* up = c.in[pass == 0 ? IN_WUP : IN_AUP];
            float acc[16][2][2];
#pragma unroll
            for (int tk = 0; tk < 16; ++tk) { acc[tk][0][0] = acc[tk][0][1] = acc[tk][1][0] = acc[tk][1][1] = 0.f; }
#pragma unroll 2
            for (int rr = 0; rr < 64; ++rr) {
                const float w00 = up[(size_t)rr * 1024 + tid], w01 = up[(size_t)rr * 1024 + tid + 512], w10 = up[(size_t)(64 + rr) * 1024 + tid], w11 = up[(size_t)(64 + rr) * 1024 + tid + 512];
#pragma unroll
                for (int tk = 0; tk < 16; ++tk) { const float x0 = xin[tk * 128 + rr], x1 = xin[tk * 128 + 64 + rr];
                    acc[tk][0][0] += x0 * w00; acc[tk][0][1] += x0 * w01; acc[tk][1][0] += x1 * w10; acc[tk][1][1] += x1 * w11; }
            }
            const float* bias = c.in[pass == 0 ? IN_W0 : IN_A0];
#pragma unroll
            for (int d = 0; d < 2; ++d)
#pragma unroll
                for (int j = 0; j < 2; ++j) { const int ch = tid + 512 * j; const float bz = bias[d * 1024 + ch];
#pragma unroll
                    for (int tk = 0; tk < 16; ++tk) { const float s = sigm(bz + acc[tk][d][j]);
                        P[(size_t)(r0 + tk) * PW0 + (pass * 2 + d) * 1024 + ch] = (bf16_t)f2bf(pass == 0 ? -0.6065306597126334f * s : s); } }
        }
    }
}
__device__ __forceinline__ int chunk_row(int b, int dir, int s) {
    if (s < 4) return ML + b * 256 + (dir == 0 ? s : 3 - s) * 64;
    return b * 4096 + (dir == 0 ? s - 4 : 67 - s) * 64;
}
__device__ __forceinline__ void gdn_scan_phase(const Ctx& c) {
    const bf16_t* F = (const bf16_t*)(c.ws + WS_F); bf16_t* P = (bf16_t*)(c.ws + WS_P);
    const float* GA = (const float*)(c.ws + WS_GA); const float* GB = (const float*)(c.ws + WS_GB);
    const int lane = c.lane, tid = c.tid, slab = lane & 15, cl = c.wave * 4 + (lane >> 4);
    for (int item = c.wg; item < 256; item += c.G) {
        const int chain = item >> 2, cq = item & 3, b = chain >> 4, h = (chain >> 1) & 7, dir = chain & 1;
        float S[8];
#pragma unroll
        for (int i = 0; i < 8; ++i) S[i] = 0.f;
        u32x4 rk[2], rq[2], rv; float rg = 0.f, rb = 0.f;
        auto gload = [&](int s) {
            const int row0 = chunk_row(b, dir, s);
#pragma unroll
            for (int i = 0; i < 2; ++i) { const int pc = tid + i * 512, tk = pc >> 4, o = (pc & 15) * 8;
                rk[i] = *(const u32x4*)(F + (size_t)1 * MT * 1024 + (size_t)(row0 + tk) * 1024 + h * 128 + o);
                rq[i] = *(const u32x4*)(F + (size_t)0 * MT * 1024 + (size_t)(row0 + tk) * 1024 + h * 128 + o); }
            if (tid < 256) { const int tk = tid >> 2, o = (tid & 3) * 8; rv = *(const u32x4*)(F + (size_t)2 * MT * 1024 + (size_t)(row0 + tk) * 1024 + h * 128 + cq * 32 + o); }
            if (tid < 64) { rg = GA[(size_t)(row0 + tid) * 16 + dir * 8 + h]; rb = GB[(size_t)(row0 + tid) * 16 + dir * 8 + h]; }
        };
        auto lstore = [&](int bufi) {
            LAS unsigned char* bp = c.lds + bufi * 40960;
#pragma unroll
            for (int i = 0; i < 2; ++i) { const int pc = tid + i * 512; *(LAS u32x4*)(bp + pc * 16) = rk[i]; *(LAS u32x4*)(bp + 16384 + pc * 16) = rq[i]; }
            if (tid < 256) *(LAS u32x4*)(bp + 32768 + tid * 16) = rv;
            if (tid < 64) { *(LAS float*)(bp + 36864 + tid * 4) = rg; *(LAS float*)(bp + 37120 + tid * 4) = rb; }
        };
        __syncthreads();
        gload(0); lstore(0);
        __syncthreads();
        LAS float* ost = (LAS float*)(c.lds + 81920);
#pragma unroll 1
        for (int s = 0; s < 68; ++s) {
            if (s + 1 < 68) gload(s + 1);
            const LAS unsigned char* bp = c.lds + (s & 1) * 40960;
#pragma unroll 2
            for (int j = 0; j < 64; ++j) {
                const int tl = dir == 0 ? j : 63 - j;
                float kf[8], qf[8];
                unpack8(*(const LAS u32x4*)(bp + tl * 256 + slab * 16), kf);
                unpack8(*(const LAS u32x4*)(bp + 16384 + tl * 256 + slab * 16), qf);
                const float vv = bf1(*(const LAS bf16_t*)(bp + 32768 + tl * 64 + cl * 2));
                const float a = __expf(*(const LAS float*)(bp + 36864 + tl * 4)), bt = *(const LAS float*)(bp + 37120 + tl * 4);
                float dot = 0.f;
#pragma unroll
                for (int i = 0; i < 8; ++i) dot += S[i] * kf[i];
                dot = grp_sum<16>(dot);
                const float dlt = bt * (vv - a * dot);
                float od = 0.f;
#pragma unroll
                for (int i = 0; i < 8; ++i) { S[i] = a * S[i] + kf[i] * dlt; od += S[i] * qf[i]; }
                od = grp_sum<16>(od);
                if (slab == 0) ost[tl * 32 + cl] = od;
            }
            __syncthreads();
            {
                const int row0 = chunk_row(b, dir, s), tk = tid >> 3, o = (tid & 7) * 4;
                const f32x4 v = *(const LAS f32x4*)(ost + tk * 32 + o);
                u32x2 w; w.x = pk2(v.x, v.y); w.y = pk2(v.z, v.w);
                *(u32x2*)(P + (size_t)(row0 + tk) * PW0 + (4 + dir) * 1024 + h * 128 + cq * 32 + o) = w;
            }
            if (s + 1 < 68) lstore((s + 1) & 1);
            __syncthreads();
        }
    }
}
__device__ __forceinline__ void rwkv_scan_phase(const Ctx& c) {
    const bf16_t* F = (const bf16_t*)(c.ws + WS_F); const bf16_t* P = (const bf16_t*)(c.ws + WS_P);
    bf16_t* Y = (bf16_t*)(c.ws + WS_F);
    const int lane = c.lane, tid = c.tid, slab = lane & 15, rl = c.wave * 4 + (lane >> 4);
    for (int item = c.wg; item < 256; item += c.G) {
        const int chain = item >> 1, rh = item & 1, b = chain >> 5, h = (chain >> 1) & 15, dir = chain & 1;
        float S[4] = {0.f, 0.f, 0.f, 0.f};
        const f32x4 ka = *(const f32x4*)(c.in[IN_KA] + h * 64 + slab * 4);
        u32x4 rr[5]; u32x4 rv;
        auto gload = [&](int s) {
            const int row0 = chunk_row(b, dir, s);
            const int tk = tid >> 3, o = (tid & 7) * 8;
            rr[0] = *(const u32x4*)(F + (size_t)3 * MT * 1024 + (size_t)(row0 + tk) * 1024 + h * 64 + o);
            rr[1] = *(const u32x4*)(F + (size_t)4 * MT * 1024 + (size_t)(row0 + tk) * 1024 + h * 64 + o);
            rr[2] = *(const u32x4*)(F + (size_t)5 * MT * 1024 + (size_t)(row0 + tk) * 1024 + h * 64 + o);
            rr[3] = *(const u32x4*)(P + (size_t)(row0 + tk) * PW0 + (0 + dir) * 1024 + h * 64 + o);
            rr[4] = *(const u32x4*)(P + (size_t)(row0 + tk) * PW0 + (2 + dir) * 1024 + h * 64 + o);
            if (tid < 256) { const int t2 = tid >> 2, o2 = (tid & 3) * 8; rv = *(const u32x4*)(F + (size_t)6 * MT * 1024 + (size_t)(row0 + t2) * 1024 + h * 64 + rh * 32 + o2); }
        };
        auto lstore = [&](int bufi) {
            LAS unsigned char* bp = c.lds + bufi * 45056;
#pragma unroll
            for (int q = 0; q < 5; ++q) *(LAS u32x4*)(bp + q * 8192 + tid * 16) = rr[q];
            if (tid < 256) *(LAS u32x4*)(bp + 40960 + tid * 16) = rv;
        };
        __syncthreads();
        gload(0); lstore(0);
        __syncthreads();
        LAS float* yst = (LAS float*)(c.lds + 90112);
#pragma unroll 1
        for (int s = 0; s < 68; ++s) {
            if (s + 1 < 68) gload(s + 1);
            const LAS unsigned char* bp = c.lds + (s & 1) * 45056;
#pragma unroll 2
            for (int j = 0; j < 64; ++j) {
                const int tl = dir == 0 ? j : 63 - j;
                const u32x2 ur = *(const LAS u32x2*)(bp + tl * 128 + slab * 8), ukk = *(const LAS u32x2*)(bp + 8192 + tl * 128 + slab * 8), ukb = *(const LAS u32x2*)(bp + 16384 + tl * 128 + slab * 8),
                            ulw = *(const LAS u32x2*)(bp + 24576 + tl * 128 + slab * 8), ua = *(const LAS u32x2*)(bp + 32768 + tl * 128 + slab * 8);
                const float vv = bf1(*(const LAS bf16_t*)(bp + 40960 + tl * 64 + rl * 2));
                const float rf[4] = {bflo(ur.x), bfhi(ur.x), bflo(ur.y), bfhi(ur.y)}, kkf[4] = {bflo(ukk.x), bfhi(ukk.x), bflo(ukk.y), bfhi(ukk.y)}, kbf[4] = {bflo(ukb.x), bfhi(ukb.x), bflo(ukb.y), bfhi(ukb.y)},
                            lwf[4] = {bflo(ulw.x), bfhi(ulw.x), bflo(ulw.y), bfhi(ulw.y)}, af[4] = {bflo(ua.x), bfhi(ua.x), bflo(ua.y), bfhi(ua.y)};
                float sk = 0.f;
#pragma unroll
                for (int i = 0; i < 4; ++i) sk += S[i] * kkf[i];
                sk = grp_sum<16>(sk);
                float y = 0.f;
#pragma unroll
                for (int i = 0; i < 4; ++i) { const float w = __expf(lwf[i]), kka = kkf[i] * af[i], kt = kbf[i] * (1.f + (af[i] - 1.f) * ka[i]);
                    S[i] = S[i] * w - sk * kka + vv * kt; y += S[i] * rf[i]; }
                y = grp_sum<16>(y);
                if (slab == 0) yst[tl * 32 + rl] = y;
            }
            __syncthreads();
            {   const int row0 = chunk_row(b, dir, s), tk = tid >> 3, o = (tid & 7) * 4;
                const f32x4 v = *(const LAS f32x4*)(yst + tk * 32 + o);
                u32x2 w; w.x = pk2(v.x, v.y); w.y = pk2(v.z, v.w);
                *(u32x2*)(Y + (size_t)dir * MT * 1024 + (size_t)(row0 + tk) * 1024 + h * 64 + rh * 32 + o) = w;
            }
            if (s + 1 < 68) lstore((s + 1) & 1);
            __syncthreads();
        }
    }
}
__device__ __forceinline__ void ab_output_phase(const Ctx& c) {
    const bf16_t* F = (const bf16_t*)(c.ws + WS_F); const bf16_t* P = (const bf16_t*)(c.ws + WS_P); const bf16_t* GO = (const bf16_t*)(c.ws + WS_GOUT);
    bf16_t* Yo = (bf16_t*)(c.ws + WS_HY);
    const int lane = c.lane;
#pragma unroll 1
    for (int r = c.gw; r < MT; r += c.NGW) {
        const size_t row = (size_t)r;
        u32x4 outw[4];
#pragma unroll
        for (int blk = 0; blk < 2; ++blk) {
            const int ch = blk * 512 + lane * 8;
            float yf[8], yb[8], rv[8], kb[8], vb[8], a0[8], a1[8], go[8];
            unpack8(*(const u32x4*)(Yo + row * D + 1024 + ch), yf); unpack8(*(const u32x4*)(Yo + row * D + ch), yb);
            unpack8(*(const u32x4*)(F + (size_t)3 * MT * 1024 + row * 1024 + ch), rv); unpack8(*(const u32x4*)(F + (size_t)5 * MT * 1024 + row * 1024 + ch), kb);
            unpack8(*(const u32x4*)(F + (size_t)6 * MT * 1024 + row * 1024 + ch), vb);
            unpack8(*(const u32x4*)(P + row * PW0 + 2048 + ch), a0); unpack8(*(const u32x4*)(P + row * PW0 + 3072 + ch), a1);
            unpack8(*(const u32x4*)(GO + row * 1024 + ch), go);
            const f32x4 ka0 = *(const f32x4*)(c.in[IN_KA] + ch), ka1 = *(const f32x4*)(c.in[IN_KA] + ch + 4), rk0 = *(const f32x4*)(c.in[IN_RK] + ch), rk1 = *(const f32x4*)(c.in[IN_RK] + ch + 4);
            const f32x4 lw0 = *(const f32x4*)(c.in[IN_LNW] + ch), lw1 = *(const f32x4*)(c.in[IN_LNW] + ch + 4), lb0 = *(const f32x4*)(c.in[IN_LNB] + ch), lb1 = *(const f32x4*)(c.in[IN_LNB] + ch + 4);
            const float ka[8] = {ka0.x, ka0.y, ka0.z, ka0.w, ka1.x, ka1.y, ka1.z, ka1.w}, rk[8] = {rk0.x, rk0.y, rk0.z, rk0.w, rk1.x, rk1.y, rk1.z, rk1.w};
            const float lnw[8] = {lw0.x, lw0.y, lw0.z, lw0.w, lw1.x, lw1.y, lw1.z, lw1.w}, lnb[8] = {lb0.x, lb0.y, lb0.z, lb0.w, lb1.x, lb1.y, lb1.z, lb1.w};
            float s = 0.f, bs = 0.f;
#pragma unroll
            for (int j = 0; j < 8; ++j) { yf[j] += yb[j]; s += yf[j]; bs += rv[j] * kb[j] * (2.f + (a0[j] + a1[j] - 2.f) * ka[j]) * rk[j]; }
            const float mu = grp_sum<8>(s) * (1.f / 64.f); bs = grp_sum<8>(bs);
            float vs = 0.f;
#pragma unroll
            for (int j = 0; j < 8; ++j) { yf[j] -= mu; vs += yf[j] * yf[j]; }
            const float rstd = 1.f / sqrtf(grp_sum<8>(vs) * (1.f / 64.f) + 64e-5f);
            float o[8];
#pragma unroll
            for (int j = 0; j < 8; ++j) o[j] = (yf[j] * rstd * lnw[j] + lnb[j] + bs * vb[j]) * go[j];
            outw[2 + blk] = pack8(o);
        }
#pragma unroll
        for (int blk = 0; blk < 2; ++blk) {
            const int ch = blk * 512 + lane * 8;
            float of[8], ob[8], z[8];
            unpack8(*(const u32x4*)(P + row * PW0 + 4096 + ch), of); unpack8(*(const u32x4*)(P + row * PW0 + 5120 + ch), ob); unpack8(*(const u32x4*)(P + row * PW0 + 6144 + ch), z);
            const f32x4 n0 = *(const f32x4*)(c.in[IN_GDNNW] + (ch & 127)), n1 = *(const f32x4*)(c.in[IN_GDNNW] + (ch & 127) + 4);
            const float nw[8] = {n0.x, n0.y, n0.z, n0.w, n1.x, n1.y, n1.z, n1.w};
            float ss = 0.f;
#pragma unroll
            for (int j = 0; j < 8; ++j) { of[j] += ob[j]; ss += of[j] * of[j]; }
            const float rstd = 1.f / sqrtf(grp_sum<16>(ss) * (1.f / 128.f) + 1e-6f);
            float o[8];
#pragma unroll
            for (int j = 0; j < 8; ++j) o[j] = of[j] * rstd * nw[j] * silu_fast(z[j]);
            outw[blk] = pack8(o);
        }
#pragma unroll
        for (int q = 0; q < 4; ++q) *(u32x4*)(Yo + row * D + q * 512 + lane * 8) = outw[q];
    }
}

__device__ __forceinline__ void ml_gate_phase(const Ctx& c) {
    const float* T = (const float*)(c.ws + WS_TAIL); float* GA = (float*)(c.ws + WS_GA); float* GB = (float*)(c.ws + WS_GB);
    for (size_t i = (size_t)c.wg * NTHREADS + c.tid; i < (size_t)MT * 16; i += (size_t)c.G * NTHREADS) {
        const size_t r = i >> 4; const int k = (int)(i & 15);
        const float gi = T[r * TW1 + k] + c.in[IN_MLIB][k], gf = T[r * TW1 + 16 + k] + c.in[IN_MLFB][k];
        GA[i] = 15.f * tanhf(gi * (1.f / 15.f));
        GB[i] = logsigm_(15.f * tanhf(gf * (1.f / 15.f)));
    }
}
__device__ __forceinline__ void mlstm_scan_phase(const Ctx& c) {
    const bf16_t* P = (const bf16_t*)(c.ws + WS_P); bf16_t* Hs = (bf16_t*)(c.ws + WS_F);
    const float* GA = (const float*)(c.ws + WS_GA); const float* GB = (const float*)(c.ws + WS_GB);
    const int lane = c.lane, tid = c.tid, slab = lane & 15, cp = c.wave * 4 + (lane >> 4);
    for (int item = c.wg; item < 256; item += c.G) {
        const int chain = item >> 2, cq = item & 3, b = chain >> 4, h = (chain >> 1) & 7, dir = chain & 1;
        float C[8][2], n[8]; float m = 0.f;
#pragma unroll
        for (int i = 0; i < 8; ++i) { C[i][0] = C[i][1] = 0.f; n[i] = 0.f; }
        u32x4 rk[2], rq[2], rv; float rg = 0.f, rb = 0.f;
        auto gload = [&](int s) {
            const int row0 = chunk_row(b, dir, s);
#pragma unroll
            for (int i = 0; i < 2; ++i) { const int pc = tid + i * 512, tk = pc >> 4, o = (pc & 15) * 8;
                rk[i] = *(const u32x4*)(P + (size_t)(row0 + tk) * PW1 + 1024 + h * 128 + o);
                rq[i] = *(const u32x4*)(P + (size_t)(row0 + tk) * PW1 + h * 128 + o); }
            { const int tk = tid >> 3, o = (tid & 7) * 8; rv = *(const u32x4*)(P + (size_t)(row0 + tk) * PW1 + 2048 + h * 256 + cq * 64 + o); }
            if (tid < 64) { rg = GA[(size_t)(row0 + tid) * 16 + dir * 8 + h]; rb = GB[(size_t)(row0 + tid) * 16 + dir * 8 + h]; }
        };
        auto lstore = [&](int bufi) {
            LAS unsigned char* bp = c.lds + bufi * 41472;
#pragma unroll
            for (int i = 0; i < 2; ++i) { const int pc = tid + i * 512; *(LAS u32x4*)(bp + pc * 16) = rk[i]; *(LAS u32x4*)(bp + 16384 + pc * 16) = rq[i]; }
            *(LAS u32x4*)(bp + 32768 + tid * 16) = rv;
            if (tid < 64) { *(LAS float*)(bp + 40960 + tid * 4) = rg; *(LAS float*)(bp + 41216 + tid * 4) = rb; }
        };
        __syncthreads();
        gload(0); lstore(0);
        __syncthreads();
        LAS float* hst = (LAS float*)(c.lds + 82944);
#pragma unroll 1
        for (int s = 0; s < 68; ++s) {
            if (s + 1 < 68) gload(s + 1);
            const LAS unsigned char* bp = c.lds + (s & 1) * 41472;
#pragma unroll 2
            for (int j = 0; j < 64; ++j) {
                const int tl = dir == 0 ? j : 63 - j;
                float kf[8], qf[8];
                unpack8(*(const LAS u32x4*)(bp + tl * 256 + slab * 16), kf);
                unpack8(*(const LAS u32x4*)(bp + 16384 + tl * 256 + slab * 16), qf);
                const unsigned uv = *(const LAS unsigned*)(bp + 32768 + tl * 128 + cp * 4);
                const float v0 = bflo(uv), v1 = bfhi(uv);
                const float ig = *(const LAS float*)(bp + 40960 + tl * 4), lf = *(const LAS float*)(bp + 41216 + tl * 4);
                const float mn = fmaxf(lf + m, ig), fs = __expf(lf + m - mn), is = __expf(ig - mn);
                m = mn;
                float n0 = 0.f, n1 = 0.f, dn = 0.f;
#pragma unroll
                for (int i = 0; i < 8; ++i) { const float ki = is * kf[i], qi = qf[i] * 0.08838834764831845f;
                    C[i][0] = fs * C[i][0] + ki * v0; C[i][1] = fs * C[i][1] + ki * v1; n[i] = fs * n[i] + ki;
                    n0 += C[i][0] * qi; n1 += C[i][1] * qi; dn += n[i] * qi; }
                n0 = grp_sum<16>(n0); n1 = grp_sum<16>(n1); dn = grp_sum<16>(dn);
                if (slab == 0) { const float dd = 1.f / fmaxf(fabsf(dn), __expf(-mn)); hst[tl * 64 + cp * 2] = n0 * dd; hst[tl * 64 + cp * 2 + 1] = n1 * dd; }
            }
            __syncthreads();
            if (s >= 4) {
                const int row0 = chunk_row(b, dir, s), tk = tid >> 3, o = (tid & 7) * 8;
                float v[8];
#pragma unroll
                for (int i = 0; i < 8; ++i) v[i] = hst[tk * 64 + o + i];
                *(u32x4*)(Hs + (size_t)dir * ML * D + (size_t)(row0 + tk) * D + h * 256 + cq * 64 + o) = pack8(v);
            }
            if (s + 1 < 68) lstore((s + 1) & 1);
            __syncthreads();
        }
    }
}
__device__ __forceinline__ void ml_output_phase(const Ctx& c) {
    const bf16_t* Hs = (const bf16_t*)(c.ws + WS_F); const bf16_t* P = (const bf16_t*)(c.ws + WS_P); bf16_t* Yo = (bf16_t*)(c.ws + WS_HY);
    const float* nw = c.in[IN_MLNW];
    for (int r = c.gw; r < ML; r += c.NGW) {
#pragma unroll
        for (int blk = 0; blk < 4; ++blk) {
            const int ch = blk * 512 + c.lane * 8;
            float a[8], bb[8], o[8];
            unpack8(*(const u32x4*)(Hs + (size_t)r * D + ch), a); unpack8(*(const u32x4*)(Hs + (size_t)ML * D + (size_t)r * D + ch), bb);
            unpack8(*(const u32x4*)(P + (size_t)r * PW1 + 4096 + ch), o);
            float ss = 0.f;
#pragma unroll
            for (int j = 0; j < 8; ++j) { a[j] += bb[j]; ss += a[j] * a[j]; }
            ss = grp_sum<32>(ss); const float rstd = 1.f / sqrtf(ss * (1.f / 256.f) + 1e-6f);
            const f32x4 w0 = *(const f32x4*)(nw + ch), w1 = *(const f32x4*)(nw + ch + 4);
            const float wv[8] = {w0.x, w0.y, w0.z, w0.w, w1.x, w1.y, w1.z, w1.w};
#pragma unroll
            for (int j = 0; j < 8; ++j) a[j] = a[j] * rstd * wv[j] * sigm_fast(o[j]);
            *(u32x4*)(Yo + (size_t)r * D + ch) = pack8(a);
        }
    }
}


typedef short bf16x8 __attribute__((ext_vector_type(8)));
typedef short s16x4 __attribute__((ext_vector_type(4)));
#define MFMA16(a, b, c) __builtin_amdgcn_mfma_f32_16x16x32_bf16((a), (b), (c), 0, 0, 0)
__device__ __forceinline__ bf16x8 frag_row(const LAS unsigned char* img, int RS, int r0, int k0, int lane) {
    return *(const LAS bf16x8*)(img + (r0 + (lane & 15)) * RS + (k0 + 8 * (lane >> 4)) * 2);
}
__device__ __forceinline__ bf16x8 frag_tr(const LAS unsigned char* img, int RS, int r0, int k0, int lane) {
    const int g = lane >> 4, q = (lane & 15) >> 2, p = lane & 3;
    LAS unsigned char* a = (LAS unsigned char*)img + (k0 + 8 * g + q) * RS + (r0 + 4 * p) * 2;
    const s16x4 lo = __builtin_amdgcn_ds_read_tr16_b64_v4i16((LAS s16x4*)a);
    const s16x4 hi = __builtin_amdgcn_ds_read_tr16_b64_v4i16((LAS s16x4*)(a + 4 * RS));
    bf16x8 r; r[0] = lo[0]; r[1] = lo[1]; r[2] = lo[2]; r[3] = lo[3]; r[4] = hi[0]; r[5] = hi[1]; r[6] = hi[2]; r[7] = hi[3];
    return r;
}
__device__ __forceinline__ void tile_write(LAS unsigned char* img, int RS, int n0, int m0, int lane, const f32x4 v) {
    u32x2 o; o.x = pk2(v[0], v[1]); o.y = pk2(v[2], v[3]);
    *(LAS u32x2*)(img + (n0 + (lane & 15)) * RS + (m0 + 4 * (lane >> 4)) * 2) = o;
}
constexpr int MS = 68;
__device__ __forceinline__ bf16x8 frag_pack(const f32x4 a, const f32x4 b) { u32x4 u; u.x = pk2(a[0], a[1]); u.y = pk2(a[2], a[3]); u.z = pk2(b[0], b[1]); u.w = pk2(b[2], b[3]); return __builtin_bit_cast(bf16x8, u); }
__device__ __forceinline__ void tri_inverse_64(LAS float* MF, LAS float* TMP, int tid) {
    (void)TMP;
    if (tid < 64) {
        const int lane = tid, g = lane >> 4, i = lane & 15;
        const f32x4 z4 = {0.f, 0.f, 0.f, 0.f};
        {   LAS float* base = MF + (g * 16) * MS + g * 16; float acc[16];
#pragma unroll
            for (int r = 0; r < 16; ++r) acc[r] = (r == i) ? 1.f : 0.f;
#pragma unroll
            for (int j = 0; j < 15; ++j) { const float xj = acc[j];
#pragma unroll
                for (int r = j + 1; r < 16; ++r) acc[r] -= base[r * MS + j] * xj; }
#pragma unroll
            for (int r = 0; r < 16; ++r) base[r * MS + i] = acc[r];
        }
#pragma unroll
        for (int h = 0; h < 2; ++h) {
            const int R0 = h ? 48 : 16, C0 = h ? 32 : 0;
            bf16x8 a1, b1;
            {   const LAS float* pa = MF + (R0 + i) * MS + C0 + 8 * (g & 1);
                const f32x4 x0 = *(const LAS f32x4*)pa, x1 = *(const LAS f32x4*)(pa + 4);
                f32x4 y0, y1;
#pragma unroll
                for (int j = 0; j < 4; ++j) { y0[j] = MF[(C0 + 8 * (g & 1) + j) * MS + C0 + i]; y1[j] = MF[(C0 + 8 * (g & 1) + 4 + j) * MS + C0 + i]; }
                a1 = g < 2 ? frag_pack(x0, x1) : frag_pack(z4, z4); b1 = g < 2 ? frag_pack(y0, y1) : frag_pack(z4, z4); }
            const f32x4 t = MFMA16(a1, b1, z4);
            const f32x4 xa = *(const LAS f32x4*)(MF + (R0 + i) * MS + R0 + 4 * g);
            const f32x4 x = MFMA16(frag_pack(xa, z4), frag_pack(t, z4), z4);
#pragma unroll
            for (int r = 0; r < 4; ++r) MF[(R0 + 4 * g + r) * MS + C0 + i] = -x[r];
        }
        {   bf16x8 a[2], b[2];
#pragma unroll
            for (int I = 0; I < 2; ++I) { const LAS float* pa = MF + (32 + 16 * I + i) * MS + 8 * g; a[I] = frag_pack(*(const LAS f32x4*)pa, *(const LAS f32x4*)(pa + 4)); }
#pragma unroll
            for (int J = 0; J < 2; ++J) { f32x4 y0, y1;
#pragma unroll
                for (int j = 0; j < 4; ++j) { y0[j] = MF[(8 * g + j) * MS + 16 * J + i]; y1[j] = MF[(8 * g + 4 + j) * MS + 16 * J + i]; }
                b[J] = frag_pack(y0, y1); }
            f32x4 t[2][2];
#pragma unroll
            for (int I = 0; I < 2; ++I)
#pragma unroll
                for (int J = 0; J < 2; ++J) t[I][J] = MFMA16(a[I], b[J], z4);
            bf16x8 a2[2];
#pragma unroll
            for (int I = 0; I < 2; ++I) { const LAS float* pa = MF + (32 + 16 * I + i) * MS + 32 + 4 * g; a2[I] = frag_pack(*(const LAS f32x4*)pa, *(const LAS f32x4*)(pa + 16)); }
#pragma unroll
            for (int I = 0; I < 2; ++I)
#pragma unroll
                for (int J = 0; J < 2; ++J) { const f32x4 x = MFMA16(a2[I], frag_pack(t[0][J], t[1][J]), z4);
#pragma unroll
                    for (int r = 0; r < 4; ++r) MF[(32 + 16 * I + 4 * g + r) * MS + 16 * J + i] = -x[r]; }
        }
    }
    __syncthreads();
}
__device__ __forceinline__ float wave_incl_scan_add(float x, int lane) {
#pragma unroll
    for (int o = 1; o < 64; o <<= 1) { const float t = __shfl_up(x, o); if (lane >= o) x += t; }
    return x;
}
__device__ __forceinline__ float wave_incl_scan_max(float x, int lane) {
#pragma unroll
    for (int o = 1; o < 64; o <<= 1) { const float t = __shfl_up(x, o); if (lane >= o) x = fmaxf(x, t); }
    return x;
}
constexpr int RS128 = 272, RS64 = 144, RS80 = 176;

__device__ __forceinline__ void mlstm_chunk_phase(const Ctx& c) {
    const bf16_t* P = (const bf16_t*)(c.ws + WS_P); bf16_t* Hs = (bf16_t*)(c.ws + WS_F);
    const float* GA = (const float*)(c.ws + WS_GA); const float* GB = (const float*)(c.ws + WS_GB);
    const int lane = c.lane, tid = c.tid, w = c.wave, g4 = lane >> 4, l15 = lane & 15;
    LAS unsigned char* KIMG = c.lds; LAS unsigned char* QIMG = c.lds + 17408; LAS unsigned char* VIMG = c.lds + 34816; LAS unsigned char* VS = c.lds + 46080;
    LAS unsigned char* SM = c.lds + 57344; LAS unsigned char* CT = c.lds + 66560;
    LAS float* sB = (LAS float*)(c.lds + 88320); LAS float* sCM = sB + 64; LAS float* sIGB = sB + 128;
    for (int item = c.wg; item < 256; item += c.G) {
        const int chain = item >> 2, cq = item & 3, b = chain >> 4, h = (chain >> 1) & 7, dir = chain & 1;
        f32x4 st[5];
#pragma unroll
        for (int e = 0; e < 5; ++e) st[e] = (f32x4){0.f, 0.f, 0.f, 0.f};
        float m = 0.f;
        u32x4 rk[2], rq[2], rv; float rg = 0.f, rb = 0.f;
        auto gload = [&](int s) {
            const int row0 = chunk_row(b, dir, s);
#pragma unroll
            for (int i = 0; i < 2; ++i) { const int pc = tid + i * 512, tk = pc >> 4, o = (pc & 15) * 8;
                rk[i] = *(const u32x4*)(P + (size_t)(row0 + tk) * PW1 + 1024 + h * 128 + o);
                rq[i] = *(const u32x4*)(P + (size_t)(row0 + tk) * PW1 + h * 128 + o); }
            { const int tk = tid >> 3, o = (tid & 7) * 8; rv = *(const u32x4*)(P + (size_t)(row0 + tk) * PW1 + 2048 + h * 256 + cq * 64 + o); }
            if (tid < 64) { rg = GA[(size_t)(row0 + tid) * 16 + dir * 8 + h]; rb = GB[(size_t)(row0 + tid) * 16 + dir * 8 + h]; }
        };
        __syncthreads();
        for (int i = tid; i < 80 * 34; i += NTHREADS) ((LAS u32x2*)CT)[i] = (u32x2){0u, 0u};
        gload(0);
#pragma unroll 1
        for (int s = 0; s < 68; ++s) {
#pragma unroll
            for (int i = 0; i < 2; ++i) { const int pc = tid + i * 512, tk = pc >> 4, o = pc & 15, ri = dir ? 63 - tk : tk;
                *(LAS u32x4*)(KIMG + ri * RS128 + o * 16) = rk[i]; *(LAS u32x4*)(QIMG + ri * RS128 + o * 16) = rq[i]; }
            { const int tk = tid >> 3, o = tid & 7, ri = dir ? 63 - tk : tk; *(LAS u32x4*)(VIMG + ri * RS80 + o * 16) = rv;
              if (o == 0) { *(LAS u32x4*)(VIMG + ri * RS80 + 128) = (u32x4){0x3F80u, 0u, 0u, 0u}; *(LAS u32x4*)(VIMG + ri * RS80 + 144) = (u32x4){0u, 0u, 0u, 0u}; } }
            if (w == 0) {
                const int src = dir ? 63 - lane : lane;
                const float ig = __shfl(rg, src), lf = __shfl(rb, src);
                const float bb = wave_incl_scan_add(lf, lane), igb = ig - bb, cm = wave_incl_scan_max(igb, lane);
                sB[lane] = bb; sCM[lane] = cm; sIGB[lane] = igb;
            }
            __syncthreads();
            if (s + 1 < 68) gload(s + 1);
            const float c63 = sCM[63], blast = sB[63], mx63 = fmaxf(m, c63);
            const float cscale = __expf(m - mx63);
            if (s >= 4) {
                const int ib = w >> 1;
                bf16x8 bq[4];
#pragma unroll
                for (int k = 0; k < 4; ++k) bq[k] = frag_row(QIMG, RS128, ib * 16, k * 32, lane);
                const float mxi = fmaxf(m, sCM[ib * 16 + l15]);
#pragma unroll
                for (int t = 0; t < 2; ++t) { const int jb = (w & 1) * 2 + t; f32x4 acc = {0.f, 0.f, 0.f, 0.f};
#pragma unroll
                    for (int k = 0; k < 4; ++k) acc = MFMA16(frag_row(KIMG, RS128, jb * 16, k * 32, lane), bq[k], acc);
                    const int i = ib * 16 + l15;
#pragma unroll
                    for (int r = 0; r < 4; ++r) { const int j = jb * 16 + 4 * g4 + r; acc[r] = (j <= i) ? acc[r] * 0.08838834764831845f * __expf(sIGB[j] - mxi) : 0.f; }
                    tile_write(SM, RS64, ib * 16, jb * 16, lane, acc); }
            }
            for (int pc = tid; pc < 640; pc += NTHREADS) { const int j = pc / 10, o = pc % 10; const float f = __expf(sIGB[j] - mx63);
                float v[8]; unpack8(*(const LAS u32x4*)(VIMG + j * RS80 + o * 16), v);
#pragma unroll
                for (int q = 0; q < 8; ++q) v[q] *= f;
                *(LAS u32x4*)(VS + j * RS80 + o * 16) = pack8(v); }
            __syncthreads();
            if (s >= 4) {
                const int ib = w & 3, eh = w >> 2, i = ib * 16 + l15;
                const float mxi = fmaxf(m, sCM[i]), inter = __expf(m - mxi) * 0.08838834764831845f, floorv = __expf(-(sB[i] + mxi));
                bf16x8 bs[2], bq[4];
#pragma unroll
                for (int k = 0; k < 2; ++k) bs[k] = frag_row(SM, RS64, ib * 16, k * 32, lane);
#pragma unroll
                for (int k = 0; k < 4; ++k) bq[k] = frag_row(QIMG, RS128, ib * 16, k * 32, lane);
                f32x4 val[3];
#pragma unroll
                for (int t = 0; t < 3; ++t) { const int eb = t < 2 ? eh * 2 + t : 4; f32x4 a1 = {0.f, 0.f, 0.f, 0.f}, a2 = {0.f, 0.f, 0.f, 0.f};
#pragma unroll
                    for (int k = 0; k < 2; ++k) a1 = MFMA16(frag_tr(VIMG, RS80, eb * 16, k * 32, lane), bs[k], a1);
#pragma unroll
                    for (int k = 0; k < 4; ++k) a2 = MFMA16(frag_row(CT, RS128, eb * 16, k * 32, lane), bq[k], a2);
                    val[t] = a1 + a2 * inter; }
                const float den = __shfl(val[2][0], l15);
                const float dd = 1.f / fmaxf(fabsf(den), floorv);
                const int tl = dir ? 63 - i : i, row0 = chunk_row(b, dir, s);
#pragma unroll
                for (int t = 0; t < 2; ++t) { const int e0 = (eh * 2 + t) * 16 + 4 * g4; u32x2 o; o.x = pk2(val[t][0] * dd, val[t][1] * dd); o.y = pk2(val[t][2] * dd, val[t][3] * dd);
                    *(u32x2*)(Hs + (size_t)dir * ML * D + (size_t)(row0 + tl) * D + h * 256 + cq * 64 + e0) = o; }
            }
            {   bf16x8 ak[2];
#pragma unroll
                for (int k = 0; k < 2; ++k) ak[k] = frag_tr(KIMG, RS128, w * 16, k * 32, lane);
#pragma unroll
                for (int e = 0; e < 5; ++e) { st[e] = st[e] * cscale;
#pragma unroll
                    for (int k = 0; k < 2; ++k) st[e] = MFMA16(ak[k], frag_tr(VS, RS80, e * 16, k * 32, lane), st[e]); }
            }
            m = blast + mx63;
            __syncthreads();
#pragma unroll
            for (int e = 0; e < 5; ++e) tile_write(CT, RS128, e * 16, w * 16, lane, st[e]);
        }
    }
}

__device__ __forceinline__ void gdn_chunk_items(const Ctx& c, int item0, int item_stride, int n_items) {
    const bf16_t* F = (const bf16_t*)(c.ws + WS_F); bf16_t* P = (bf16_t*)(c.ws + WS_P);
    const float* GA = (const float*)(c.ws + WS_GA); const float* GB = (const float*)(c.ws + WS_GB);
    const int lane = c.lane, tid = c.tid, w = c.wave, g4 = lane >> 4, l15 = lane & 15;
    LAS unsigned char* KIMG = c.lds; LAS unsigned char* QIMG = c.lds + 17408; LAS unsigned char* VIMG = c.lds + 34816; LAS unsigned char* ST = c.lds + 44032;
    LAS unsigned char* WIMG = c.lds + 61440; LAS unsigned char* QKM = c.lds + 78848; LAS unsigned char* VNT = c.lds + 88064; LAS unsigned char* VNS = c.lds + 97280;
    LAS unsigned char* TW = c.lds + 106496; LAS unsigned char* TU = c.lds + 115712; LAS float* MF = (LAS float*)(c.lds + 124928); LAS float* TMP = (LAS float*)VNT;
    LAS float* sGC = (LAS float*)(c.lds + 142336); LAS float* sEG = sGC + 64; LAS float* sEL = sGC + 128; LAS float* sBT = sGC + 192; LAS float* sBG = sGC + 256;
    for (int item = item0; item < n_items; item += item_stride) {
        const int chain = item >> 1, eh = item & 1, b = chain >> 4, h = (chain >> 1) & 7, dir = chain & 1;
        f32x4 st[4];
#pragma unroll
        for (int e = 0; e < 4; ++e) st[e] = (f32x4){0.f, 0.f, 0.f, 0.f};
        u32x4 rk[2], rq[2], rv; float rg = 0.f, rb = 0.f;
        auto gload = [&](int s) {
            const int row0 = chunk_row(b, dir, s);
#pragma unroll
            for (int i = 0; i < 2; ++i) { const int pc = tid + i * 512, tk = pc >> 4, o = (pc & 15) * 8;
                rk[i] = *(const u32x4*)(F + (size_t)1 * MT * 1024 + (size_t)(row0 + tk) * 1024 + h * 128 + o);
                rq[i] = *(const u32x4*)(F + (size_t)0 * MT * 1024 + (size_t)(row0 + tk) * 1024 + h * 128 + o); }
            { const int tk = tid >> 3, o = (tid & 7) * 8; rv = *(const u32x4*)(F + (size_t)2 * MT * 1024 + (size_t)(row0 + tk) * 1024 + h * 128 + eh * 64 + o); }
            if (tid < 64) { rg = GA[(size_t)(row0 + tid) * 16 + dir * 8 + h]; rb = GB[(size_t)(row0 + tid) * 16 + dir * 8 + h]; }
        };
        __syncthreads();
        for (int i = tid; i < 64 * 34; i += NTHREADS) ((LAS u32x2*)ST)[i] = (u32x2){0u, 0u};
        gload(0);
#pragma unroll 1
        for (int s = 0; s < 68; ++s) {
#pragma unroll
            for (int i = 0; i < 2; ++i) { const int pc = tid + i * 512, tk = pc >> 4, o = pc & 15, ri = dir ? 63 - tk : tk;
                *(LAS u32x4*)(KIMG + ri * RS128 + o * 16) = rk[i]; *(LAS u32x4*)(QIMG + ri * RS128 + o * 16) = rq[i]; }
            { const int tk = tid >> 3, o = tid & 7, ri = dir ? 63 - tk : tk; *(LAS u32x4*)(VIMG + ri * RS64 + o * 16) = rv; }
            if (w == 0) {
                const int src = dir ? 63 - lane : lane;
                const float gg = __shfl(rg, src), bt = __shfl(rb, src);
                const float gc = wave_incl_scan_add(gg, lane), gl = __shfl(gc, 63), eg = __expf(gc);
                sGC[lane] = gc; sEG[lane] = eg; sEL[lane] = __expf(gl - gc); sBT[lane] = bt; sBG[lane] = bt * eg;
            }
            __syncthreads();
            if (s + 1 < 68) gload(s + 1);
            {   const int ib = w >> 1, i = ib * 16 + l15; const float gci = sGC[i], bti = sBT[i];
                bf16x8 bk[4], bq[4];
#pragma unroll
                for (int k = 0; k < 4; ++k) { bk[k] = frag_row(KIMG, RS128, ib * 16, k * 32, lane); bq[k] = frag_row(QIMG, RS128, ib * 16, k * 32, lane); }
#pragma unroll
                for (int t = 0; t < 2; ++t) { const int jb = (w & 1) * 2 + t; f32x4 a1 = {0.f, 0.f, 0.f, 0.f}, a2 = {0.f, 0.f, 0.f, 0.f};
#pragma unroll
                    for (int k = 0; k < 4; ++k) { const bf16x8 aj = frag_row(KIMG, RS128, jb * 16, k * 32, lane); a1 = MFMA16(aj, bk[k], a1); a2 = MFMA16(aj, bq[k], a2); }
                    f32x4 mv;
#pragma unroll
                    for (int r = 0; r < 4; ++r) { const int j = jb * 16 + 4 * g4 + r; const float dec = __expf(gci - sGC[j]);
                        mv[r] = (j < i) ? bti * a1[r] * dec : 0.f; a2[r] = (j <= i) ? a2[r] * dec : 0.f; }
                    *(LAS f32x4*)(MF + i * MS + jb * 16 + 4 * g4) = mv;
                    tile_write(QKM, RS64, ib * 16, jb * 16, lane, a2); }
            }
            __syncthreads();
            tri_inverse_64(MF, TMP, tid);
            {   const int i = tid >> 3, j8 = (tid & 7) * 8; float tw[8], tu[8];
#pragma unroll
                for (int q = 0; q < 8; ++q) { const float x = MF[i * MS + j8 + q]; tw[q] = x * sBG[j8 + q]; tu[q] = x * sBT[j8 + q]; }
                *(LAS u32x4*)(TW + i * RS64 + j8 * 2) = pack8(tw); *(LAS u32x4*)(TU + i * RS64 + j8 * 2) = pack8(tu); }
            __syncthreads();
            f32x4 ut[2];
            {   const int ib = w >> 1;
                bf16x8 au[2];
#pragma unroll
                for (int k = 0; k < 2; ++k) au[k] = frag_row(TU, RS64, ib * 16, k * 32, lane);
#pragma unroll
                for (int t = 0; t < 2; ++t) { const int eb = (w & 1) * 2 + t; ut[t] = (f32x4){0.f, 0.f, 0.f, 0.f};
#pragma unroll
                    for (int k = 0; k < 2; ++k) ut[t] = MFMA16(au[k], frag_tr(VIMG, RS64, eb * 16, k * 32, lane), ut[t]); }
                bf16x8 akt[2];
#pragma unroll
                for (int k = 0; k < 2; ++k) akt[k] = frag_tr(KIMG, RS128, w * 16, k * 32, lane);
#pragma unroll
                for (int i2 = 0; i2 < 4; ++i2) { f32x4 a = {0.f, 0.f, 0.f, 0.f};
#pragma unroll
                    for (int k = 0; k < 2; ++k) a = MFMA16(akt[k], frag_row(TW, RS64, i2 * 16, k * 32, lane), a);
                    tile_write(WIMG, RS128, i2 * 16, w * 16, lane, a); }
            }
            __syncthreads();
            {   const int ib = w >> 1;
                bf16x8 aw[4];
#pragma unroll
                for (int k = 0; k < 4; ++k) aw[k] = frag_row(WIMG, RS128, ib * 16, k * 32, lane);
#pragma unroll
                for (int t = 0; t < 2; ++t) { const int eb = (w & 1) * 2 + t; f32x4 a = {0.f, 0.f, 0.f, 0.f};
#pragma unroll
                    for (int k = 0; k < 4; ++k) a = MFMA16(aw[k], frag_row(ST, RS128, eb * 16, k * 32, lane), a);
                    f32x4 vn = ut[t] - a, vs;
#pragma unroll
                    for (int r = 0; r < 4; ++r) vs[r] = vn[r] * sEL[ib * 16 + 4 * g4 + r];
                    tile_write(VNT, RS64, eb * 16, ib * 16, lane, vn); tile_write(VNS, RS64, eb * 16, ib * 16, lane, vs); }
            }
            __syncthreads();
            {   const int eb = w >> 1, row0 = chunk_row(b, dir, s);
                bf16x8 as[4], av[2];
#pragma unroll
                for (int k = 0; k < 4; ++k) as[k] = frag_row(ST, RS128, eb * 16, k * 32, lane);
#pragma unroll
                for (int k = 0; k < 2; ++k) av[k] = frag_row(VNT, RS64, eb * 16, k * 32, lane);
#pragma unroll
                for (int t = 0; t < 2; ++t) { const int ib = (w & 1) * 2 + t, i = ib * 16 + l15; f32x4 a = {0.f, 0.f, 0.f, 0.f};
#pragma unroll
                    for (int k = 0; k < 4; ++k) a = MFMA16(as[k], frag_row(QIMG, RS128, ib * 16, k * 32, lane), a);
                    a = a * sEG[i];
#pragma unroll
                    for (int k = 0; k < 2; ++k) a = MFMA16(av[k], frag_row(QKM, RS64, ib * 16, k * 32, lane), a);
                    const int tl = dir ? 63 - i : i; u32x2 o; o.x = pk2(a[0], a[1]); o.y = pk2(a[2], a[3]);
                    *(u32x2*)(P + (size_t)(row0 + tl) * PW0 + (4 + dir) * 1024 + h * 128 + eh * 64 + eb * 16 + 4 * g4) = o; }
                const float al = __expf(sGC[63]);
                bf16x8 akt[2];
#pragma unroll
                for (int k = 0; k < 2; ++k) akt[k] = frag_tr(KIMG, RS128, w * 16, k * 32, lane);
#pragma unroll
                for (int e = 0; e < 4; ++e) { st[e] = st[e] * al;
#pragma unroll
                    for (int k = 0; k < 2; ++k) st[e] = MFMA16(akt[k], frag_row(VNS, RS64, e * 16, k * 32, lane), st[e]); }
            }
            __syncthreads();
#pragma unroll
            for (int e = 0; e < 4; ++e) tile_write(ST, RS128, e * 16, w * 16, lane, st[e]);
        }
    }
}

__device__ __forceinline__ void rwkv_chunk_items(const Ctx& c, int item0, int item_stride, int n_items, bf16_t* Ybase, long ydir_stride, int ystride) {
    const bf16_t* F = (const bf16_t*)(c.ws + WS_F); const bf16_t* P = (const bf16_t*)(c.ws + WS_P);
    const int lane = c.lane, tid = c.tid, w = c.wave, g4 = lane >> 4, l15 = lane & 15;
    LAS unsigned char* KKP = c.lds; LAS unsigned char* RP = c.lds + 9216; LAS unsigned char* KTD = c.lds + 18432; LAS unsigned char* KADN = c.lds + 27648;
    LAS unsigned char* VIMG = c.lds + 36864; LAS unsigned char* ST = c.lds + 46080; LAS unsigned char* ART = c.lds + 55296; LAS unsigned char* ARAN = c.lds + 64512;
    LAS unsigned char* TI = c.lds + 73728; LAS unsigned char* KTI = c.lds + 82944; LAS unsigned char* KAI = c.lds + 92160; LAS unsigned char* AKT = c.lds + 101376;
    LAS unsigned char* TMPVT = KTI; LAS unsigned char* WK = KAI; LAS unsigned char* UT = AKT;
    LAS float* MF = (LAS float*)(c.lds + 110592); LAS float* LP = MF; LAS float* TMP = (LAS float*)(c.lds + 128000); LAS float* sPC = (LAS float*)(c.lds + 132096);
    for (int item = item0; item < n_items; item += item_stride) {
        const int chain = item, b = chain >> 5, h = (chain >> 1) & 15, dir = chain & 1;
        f32x4 st[2] = {{0.f, 0.f, 0.f, 0.f}, {0.f, 0.f, 0.f, 0.f}};
        const int tk = tid >> 3, o8 = tid & 7, ri = dir ? 63 - tk : tk;
        float kav[8];
        { const f32x4 k0 = *(const f32x4*)(c.in[IN_KA] + h * 64 + o8 * 8), k1 = *(const f32x4*)(c.in[IN_KA] + h * 64 + o8 * 8 + 4);
          kav[0] = k0.x; kav[1] = k0.y; kav[2] = k0.z; kav[3] = k0.w; kav[4] = k1.x; kav[5] = k1.y; kav[6] = k1.z; kav[7] = k1.w; }
        u32x4 rr[5], rv;
        auto gload = [&](int s) {
            const int row0 = chunk_row(b, dir, s); const int o = o8 * 8;
            rr[0] = *(const u32x4*)(F + (size_t)3 * MT * 1024 + (size_t)(row0 + tk) * 1024 + h * 64 + o);
            rr[1] = *(const u32x4*)(F + (size_t)4 * MT * 1024 + (size_t)(row0 + tk) * 1024 + h * 64 + o);
            rr[2] = *(const u32x4*)(F + (size_t)5 * MT * 1024 + (size_t)(row0 + tk) * 1024 + h * 64 + o);
            rr[3] = *(const u32x4*)(P + (size_t)(row0 + tk) * PW0 + (0 + dir) * 1024 + h * 64 + o);
            rr[4] = *(const u32x4*)(P + (size_t)(row0 + tk) * PW0 + (2 + dir) * 1024 + h * 64 + o);
            rv = *(const u32x4*)(F + (size_t)6 * MT * 1024 + (size_t)(row0 + tk) * 1024 + h * 64 + o);
        };
        __syncthreads();
        for (int i = tid; i < 64 * 18; i += NTHREADS) ((LAS u32x2*)ST)[i] = (u32x2){0u, 0u};
        gload(0);
#pragma unroll 1
        for (int s = 0; s < 68; ++s) {
            float lwf[8]; unpack8(rr[3], lwf);
            *(LAS f32x4*)(LP + ri * 64 + o8 * 8) = (f32x4){lwf[0], lwf[1], lwf[2], lwf[3]}; *(LAS f32x4*)(LP + ri * 64 + o8 * 8 + 4) = (f32x4){lwf[4], lwf[5], lwf[6], lwf[7]};
            __syncthreads();
            {   const int k = tid & 63, seg = tid >> 6; float x[8]; float run = 0.f;
#pragma unroll
                for (int i = 0; i < 8; ++i) { run += LP[(seg * 8 + i) * 64 + k]; x[i] = run; }
                TMP[seg * 64 + k] = run;
                __syncthreads();
                float off = 0.f;
#pragma unroll
                for (int q = 0; q < 8; ++q) off += (q < seg) ? TMP[q * 64 + k] : 0.f;
#pragma unroll
                for (int i = 0; i < 8; ++i) LP[(seg * 8 + i) * 64 + k] = x[i] + off;
            }
            __syncthreads();
            {
                float rf[8], kkf[8], kbf[8], af[8], lp[8], lpm[8], lpc[8];
                unpack8(rr[0], rf); unpack8(rr[1], kkf); unpack8(rr[2], kbf); unpack8(rr[4], af);
#pragma unroll
                for (int q = 0; q < 8; ++q) { lp[q] = LP[ri * 64 + o8 * 8 + q]; lpm[q] = ri > 0 ? LP[(ri - 1) * 64 + o8 * 8 + q] : 0.f; lpc[q] = LP[63 * 64 + o8 * 8 + q]; }
                float i0[8], i1[8], i2[8], i3[8], i4[8], i5[8];
#pragma unroll
                for (int q = 0; q < 8; ++q) { const float kt = kbf[q] * (1.f + (af[q] - 1.f) * kav[q]), kka = kkf[q] * af[q];
                    const float ei = __expf(-lp[q]), ed = __expf(lpc[q] - lp[q]);
                    i0[q] = kkf[q] * __expf(lpm[q]); i1[q] = rf[q] * __expf(lp[q]); i2[q] = kt * ei; i3[q] = kka * ei; i4[q] = kt * ed; i5[q] = -kka * ed; }
                const int off = ri * RS64 + o8 * 16;
                *(LAS u32x4*)(KKP + off) = pack8(i0); *(LAS u32x4*)(RP + off) = pack8(i1); *(LAS u32x4*)(KTI + off) = pack8(i2); *(LAS u32x4*)(KAI + off) = pack8(i3);
                *(LAS u32x4*)(KTD + off) = pack8(i4); *(LAS u32x4*)(KADN + off) = pack8(i5); *(LAS u32x4*)(VIMG + off) = rv;
                if (ri == 63) {
#pragma unroll
                    for (int q = 0; q < 8; ++q) sPC[o8 * 8 + q] = __expf(lpc[q]); }
            }
            __syncthreads();
            if (s + 1 < 68) gload(s + 1);
            {   const int tb = w >> 1, t = tb * 16 + l15;
                bf16x8 bkk[2], brp[2];
#pragma unroll
                for (int k = 0; k < 2; ++k) { bkk[k] = frag_row(KKP, RS64, tb * 16, k * 32, lane); brp[k] = frag_row(RP, RS64, tb * 16, k * 32, lane); }
#pragma unroll
                for (int q = 0; q < 2; ++q) { const int sb = (w & 1) * 2 + q; f32x4 aka = {0.f, 0.f, 0.f, 0.f}, akt = aka, ara = aka, art = aka;
#pragma unroll
                    for (int k = 0; k < 2; ++k) { const bf16x8 fa = frag_row(KAI, RS64, sb * 16, k * 32, lane), ft = frag_row(KTI, RS64, sb * 16, k * 32, lane);
                        aka = MFMA16(fa, bkk[k], aka); akt = MFMA16(ft, bkk[k], akt); ara = MFMA16(fa, brp[k], ara); art = MFMA16(ft, brp[k], art); }
#pragma unroll
                    for (int r = 0; r < 4; ++r) { const int ss = sb * 16 + 4 * g4 + r;
                        aka[r] = ss < t ? aka[r] : 0.f; akt[r] = ss < t ? akt[r] : 0.f; ara[r] = ss <= t ? -ara[r] : 0.f; art[r] = ss <= t ? art[r] : 0.f; }
                    tile_write(AKT, RS64, tb * 16, sb * 16, lane, akt); tile_write(ARAN, RS64, tb * 16, sb * 16, lane, ara); tile_write(ART, RS64, tb * 16, sb * 16, lane, art);
                    *(LAS f32x4*)(MF + t * MS + sb * 16 + 4 * g4) = aka; }
            }
            __syncthreads();
            tri_inverse_64(MF, TMP, tid);
            {   const int i = tid >> 3, j8 = (tid & 7) * 8; float x[8];
#pragma unroll
                for (int q = 0; q < 8; ++q) x[q] = MF[i * MS + j8 + q];
                *(LAS u32x4*)(TI + i * RS64 + j8 * 2) = pack8(x); }
            __syncthreads();
            f32x4 y0[2], u0[2];
            {   const int hb = w >> 1;
                bf16x8 aa[2], akk[2], av[2];
#pragma unroll
                for (int k = 0; k < 2; ++k) { aa[k] = frag_row(AKT, RS64, hb * 16, k * 32, lane); akk[k] = frag_tr(KKP, RS64, hb * 16, k * 32, lane); av[k] = frag_tr(VIMG, RS64, hb * 16, k * 32, lane); }
#pragma unroll
                for (int q = 0; q < 2; ++q) { const int ob = (w & 1) * 2 + q; f32x4 a = {0.f, 0.f, 0.f, 0.f}, bq = a; y0[q] = a;
#pragma unroll
                    for (int k = 0; k < 2; ++k) { a = MFMA16(aa[k], frag_tr(VIMG, RS64, ob * 16, k * 32, lane), a);
                        const bf16x8 fti = frag_row(TI, RS64, ob * 16, k * 32, lane);
                        bq = MFMA16(akk[k], fti, bq);
                        y0[q] = MFMA16(av[k], frag_row(ART, RS64, ob * 16, k * 32, lane), y0[q]); }
                    tile_write(TMPVT, RS64, ob * 16, hb * 16, lane, a); tile_write(WK, RS64, ob * 16, hb * 16, lane, bq); }
            }
            __syncthreads();
            {   const int tb = w >> 1;
                bf16x8 at[2], awk[2];
#pragma unroll
                for (int k = 0; k < 2; ++k) { at[k] = frag_row(TI, RS64, tb * 16, k * 32, lane); awk[k] = frag_row(WK, RS64, tb * 16, k * 32, lane); }
#pragma unroll
                for (int q = 0; q < 2; ++q) { const int vb = (w & 1) * 2 + q; u0[q] = (f32x4){0.f, 0.f, 0.f, 0.f};
#pragma unroll
                    for (int k = 0; k < 2; ++k) { u0[q] = MFMA16(at[k], frag_row(TMPVT, RS64, vb * 16, k * 32, lane), u0[q]); u0[q] = MFMA16(awk[k], frag_row(ST, RS64, vb * 16, k * 32, lane), u0[q]); }
                }
            }
            {   const int tb = w >> 1;
#pragma unroll
                for (int q = 0; q < 2; ++q) tile_write(UT, RS64, ((w & 1) * 2 + q) * 16, tb * 16, lane, u0[q]); }
            __syncthreads();
            {   const int hb = w >> 1, row0 = chunk_row(b, dir, s);
                bf16x8 as[2], au[2], aktd[2], akad[2];
#pragma unroll
                for (int k = 0; k < 2; ++k) { as[k] = frag_row(ST, RS64, hb * 16, k * 32, lane); au[k] = frag_row(UT, RS64, hb * 16, k * 32, lane);
                    aktd[k] = frag_tr(KTD, RS64, hb * 16, k * 32, lane); akad[k] = frag_tr(KADN, RS64, hb * 16, k * 32, lane); }
#pragma unroll
                for (int q = 0; q < 2; ++q) { const int ob = (w & 1) * 2 + q; f32x4 a = y0[q];
#pragma unroll
                    for (int k = 0; k < 2; ++k) { a = MFMA16(as[k], frag_row(RP, RS64, ob * 16, k * 32, lane), a); a = MFMA16(au[k], frag_row(ARAN, RS64, ob * 16, k * 32, lane), a); }
                    const int t = ob * 16 + l15, tl = dir ? 63 - t : t; u32x2 o; o.x = pk2(a[0], a[1]); o.y = pk2(a[2], a[3]);
                    *(u32x2*)(Ybase + (long)dir * ydir_stride + (size_t)(row0 + tl) * ystride + h * 64 + hb * 16 + 4 * g4) = o;
#pragma unroll
                    for (int r = 0; r < 4; ++r) st[q][r] *= sPC[hb * 16 + 4 * g4 + r];
#pragma unroll
                    for (int k = 0; k < 2; ++k) { st[q] = MFMA16(aktd[k], frag_tr(VIMG, RS64, ob * 16, k * 32, lane), st[q]); st[q] = MFMA16(akad[k], frag_row(UT, RS64, ob * 16, k * 32, lane), st[q]); } }
            }
            __syncthreads();
            {   const int hb = w >> 1;
#pragma unroll
                for (int q = 0; q < 2; ++q) tile_write(ST, RS64, ((w & 1) * 2 + q) * 16, hb * 16, lane, st[q]); }
        }
    }
}

#ifndef GEMM_ALIGN
#define GEMM_ALIGN true
#endif
#ifndef GEMM_SP2
#define GEMM_SP2 true
#endif
#ifndef USE_CHUNK_ML
#define USE_CHUNK_ML 1
#endif
#ifndef USE_CHUNK_GDN
#define USE_CHUNK_GDN 1
#endif
#ifndef USE_CHUNK_RWKV
#define USE_CHUNK_RWKV 1
#endif
struct Args { const float* in[32]; float* out; unsigned char* ws; int ph_lo, ph_hi; };
constexpr int NPHASE = 24;
__global__ void __launch_bounds__(NTHREADS, 2) fwd_kernel(Args args) {
    extern __shared__ __attribute__((aligned(16))) unsigned char lds_raw[];
    Ctx c;
    c.lds = (LAS unsigned char*)lds_raw;
    c.tid = threadIdx.x; c.lane = c.tid & 63; c.wave = __builtin_amdgcn_readfirstlane(c.tid >> 6);
    c.G = gridDim.x; c.wg = blockIdx.x; c.gw = c.wg * NWAVES + c.wave; c.NGW = c.G * NWAVES;
#pragma unroll
    for (int i = 0; i < 32; ++i) c.in[i] = args.in[i];
    c.out = args.out; c.ws = args.ws;
    const int lo = args.ph_lo, hi = args.ph_hi;
    volatile LAS unsigned* bst = (volatile LAS unsigned*)(c.lds + LDS_BAR_OFF);
    if (c.tid < 4) bst[c.tid] = 0u;
    __syncthreads();
    XcdBarrier bar; bar.bar = (unsigned*)(c.ws + WS_CTL); bar.x = 0; bar.st = bst;
    if (hi - lo > 1) bar = xcd_barrier_post((unsigned*)(c.ws + WS_CTL), bst);
#define IN(k) (lo <= (k) && (k) < hi)
#ifndef REPEAT_MASK
#define REPEAT_MASK 0u
#endif
#define REP(k) for (int _rep = 0; _rep < (((REPEAT_MASK >> (k)) & 1u) ? 2 : 1); ++_rep)
#define SEAM(k) do { if (IN(k) && IN((k) + 1)) xcd_barrier(bar); } while (0)
    float* MOD = (float*)(c.ws + WS_MOD);
    float* XC = (float*)(c.ws + WS_XC);
    bf16_t* HY = (bf16_t*)(c.ws + WS_HY); bf16_t* Pb = (bf16_t*)(c.ws + WS_P); float* TL = (float*)(c.ws + WS_TAIL);
    bf16_t* Win = (bf16_t*)(c.ws + WS_WIN); bf16_t* Wout = (bf16_t*)(c.ws + WS_WOUT); bf16_t* W13 = (bf16_t*)(c.ws + WS_W13); bf16_t* W2 = (bf16_t*)(c.ws + WS_W2);
    const float* X = c.in[IN_X]; const float* CX = c.in[IN_CTX];

    #ifndef SUBREP
#define SUBREP 0
#endif
    if (IN(0)) { for (int q = 0; q < ((SUBREP & 1) ? 2 : 1); ++q) { ada_phase(c); __syncthreads(); }
                 for (int q = 0; q < ((SUBREP & 2) ? 2 : 1); ++q) { convert_weights(c, 0); __syncthreads(); }
                 for (int q = 0; q < ((SUBREP & 4) ? 2 : 1); ++q) { lora_weight_phase(c); __syncthreads(); } }
    SEAM(0);
    if (IN(1)) REP(1) norm_mod_phase(c, X, CX, c.in[IN_NORMW], MOD, 0, D, MT);
    SEAM(1);
    if (IN(2)) { pg8::Gemm g{HY, Win, MT, NIN0, D}; pg8::StaticOrder S; S.init(MT, NIN0, c.G, c.wg); EpiInProj E{Pb, PW0, PW0 / 256, TL, TW0};
        pg8::gemm_phase<EpiInProj, pg8::StaticOrder, GEMM_ALIGN, GEMM_SP2>(c.lds, g, S, E); }
    SEAM(2);
    if (IN(3)) REP(3) ab_feature_phase(c);
    SEAM(3);
    if (IN(4)) {
        int k256 = 256; asm volatile("" : "+s"(k256));
        { pg8::Gemm g{(const bf16_t*)(c.ws + WS_A1), (const bf16_t*)(c.ws + WS_WL), MT, 4096, k256}; pg8::StaticOrder S; S.init(MT, 4096, c.G, c.wg); EpiLora E{Pb, PW0, c.in[IN_W0], c.in[IN_A0]};
          pg8::gemm_phase<EpiLora, pg8::StaticOrder, GEMM_ALIGN, GEMM_SP2>(c.lds, g, S, E); }
        { pg8::Gemm g{(const bf16_t*)(c.ws + WS_A2), (const bf16_t*)(c.ws + WS_WG), MT, 1024, k256}; pg8::StaticOrder S; S.init(MT, 1024, c.G, c.wg); EpiBf16Plain E{(bf16_t*)(c.ws + WS_GOUT), 1024};
          pg8::gemm_phase<EpiBf16Plain, pg8::StaticOrder, GEMM_ALIGN, GEMM_SP2>(c.lds, g, S, E); } }
    SEAM(4);
    if (IN(5)) REP(5) {
        gdn_chunk_items(c, c.wg, c.G, 128);
        rwkv_chunk_items(c, (c.wg + c.G / 2) % c.G, c.G, 128, HY + 1024, -1024L, D); }
    SEAM(5);
    SEAM(6);
    if (IN(7)) REP(7) ab_output_phase(c);
    SEAM(7);
    if (IN(8)) { pg8::Gemm g{HY, Wout, MT, D, D}; pg8::StaticOrder S; S.init(MT, D, c.G, c.wg); EpiResid E{X, CX, c.out, XC, MOD + 2 * D};
        pg8::gemm_phase<EpiResid, pg8::StaticOrder, GEMM_ALIGN, GEMM_SP2>(c.lds, g, S, E); }
    SEAM(8);
    if (IN(9)) REP(9) norm_mod_phase(c, c.out, XC, c.in[IN_NORMW] + D, MOD, 3 * D, 4 * D, MT);
    SEAM(9);
    if (IN(10)) { pg8::Gemm g{HY, W13, MT, 2 * FF, D}; pg8::StaticOrder S; S.init(MT, 2 * FF, c.G, c.wg); EpiSwiGLU E{Pb, FF};
        pg8::gemm_phase<EpiSwiGLU, pg8::StaticOrder, GEMM_ALIGN, GEMM_SP2>(c.lds, g, S, E); }
    SEAM(10);
    if (IN(11)) { pg8::Gemm g{Pb, W2, MT, D, FF}; pg8::StaticOrder S; S.init(MT, D, c.G, c.wg); EpiResid E{c.out, XC, c.out, XC, MOD + 5 * D};
        pg8::gemm_phase<EpiResid, pg8::StaticOrder, GEMM_ALIGN, GEMM_SP2>(c.lds, g, S, E); }
    SEAM(11);
    if (IN(12)) REP(12) { convert_weights(c, 1); norm_mod_phase(c, c.out, XC, c.in[IN_NORMW] + 2 * D, MOD + 5 * MODW, 0, D, MT); }
    SEAM(12);
    if (IN(13)) { pg8::Gemm g{HY, Win, MT, NIN1, D}; pg8::StaticOrder S; S.init(MT, NIN1, c.G, c.wg); EpiInProj E{Pb, PW1, PW1 / 256, TL, TW1};
        pg8::gemm_phase<EpiInProj, pg8::StaticOrder, GEMM_ALIGN, GEMM_SP2>(c.lds, g, S, E); }
    SEAM(13);
    if (IN(14)) REP(14) ml_gate_phase(c);
    SEAM(14);
    if (IN(15)) REP(15) { if (USE_CHUNK_ML) mlstm_chunk_phase(c); else mlstm_scan_phase(c); }
    SEAM(15);
    if (IN(16)) REP(16) ml_output_phase(c);
    SEAM(16);
    if (IN(17)) { pg8::Gemm g{HY, Wout, ML, D, D}; pg8::StaticOrder S; S.init(ML, D, c.G, c.wg); EpiResid E{c.out, XC, c.out, XC, MOD + 5 * MODW + 2 * D};
        pg8::gemm_phase<EpiResid, pg8::StaticOrder, GEMM_ALIGN, GEMM_SP2>(c.lds, g, S, E); }
    SEAM(17);
    if (IN(18)) REP(18) norm_mod_phase(c, c.out, XC, c.in[IN_NORMW] + 3 * D, MOD + 5 * MODW, 3 * D, 4 * D, ML);
    SEAM(18);
    if (IN(19)) { pg8::Gemm g{HY, W13, ML, 2 * FF, D}; pg8::StaticOrder S; S.init(ML, 2 * FF, c.G, c.wg); EpiSwiGLU E{Pb, FF};
        pg8::gemm_phase<EpiSwiGLU, pg8::StaticOrder, GEMM_ALIGN, GEMM_SP2>(c.lds, g, S, E); }
    SEAM(19);
    if (IN(20)) { pg8::Gemm g{Pb, W2, ML, D, FF}; pg8::StaticOrder S; S.init(ML, D, c.G, c.wg); EpiResid E{c.out, XC, c.out, XC, MOD + 5 * MODW + 5 * D};
        pg8::gemm_phase<EpiResid, pg8::StaticOrder, GEMM_ALIGN, GEMM_SP2>(c.lds, g, S, E); }
    SEAM(20);
    if (IN(21)) final_norm_phase(c);
#undef IN
#undef SEAM
}

#ifndef N_LAUNCH_MODE
#define N_LAUNCH_MODE 1
#endif
extern "C" void kernel_launch(void* const* d_in, const int* in_sizes, int n_in, void* d_out, int out_size, void* d_ws, size_t ws_size, hipStream_t stream) {
    static int grid = 0;
    if (grid == 0) {
        if (n_in != 32 || out_size != ML * D || ws_size < WS_END) { fprintf(stderr, "kernel_launch: unexpected problem (n_in %d out %d ws %zu)\n", n_in, out_size, ws_size); grid = -1; return; }
        int dev = 0, cus = 0;
        if (hipGetDevice(&dev) != hipSuccess || hipDeviceGetAttribute(&cus, hipDeviceAttributeMultiprocessorCount, dev) != hipSuccess) { grid = -1; return; }
        if (hipFuncSetAttribute((const void*)fwd_kernel, hipFuncAttributeMaxDynamicSharedMemorySize, LDS_BYTES) != hipSuccess) { grid = -1; return; }
        int per_cu = 0;
        if (hipOccupancyMaxActiveBlocksPerMultiprocessor(&per_cu, (const void*)fwd_kernel, NTHREADS, LDS_BYTES) != hipSuccess || per_cu < 1) { fprintf(stderr, "kernel_launch: occupancy query says %d\n", per_cu); }
        (void)hipGetLastError();
        grid = cus;
    }
    if (grid < 0) return;
    (void)hipMemsetAsync((char*)d_ws + WS_CTL, 0, CTL_BYTES, stream);
    Args a{};
    for (int i = 0; i < 32; ++i) a.in[i] = (const float*)d_in[i];
    a.out = (float*)d_out; a.ws = (unsigned char*)d_ws;
#if N_LAUNCH_MODE == 1
    a.ph_lo = 0; a.ph_hi = NPHASE;
    hipLaunchKernelGGL(fwd_kernel, dim3(grid), dim3(NTHREADS), LDS_BYTES, stream, a);
#else
    for (int p = 0; p < 22; ++p) { a.ph_lo = p; a.ph_hi = p + 1; hipLaunchKernelGGL(fwd_kernel, dim3(grid), dim3(NTHREADS), LDS_BYTES, stream, a); }
#endif
}
```

```cpp
#include <hip/hip_runtime.h>
#include <cstdio>
#include <cstdint>
#define LAS __attribute__((address_space(3)))
#define GAS __attribute__((address_space(1)))
#define XB_TMO      128
#define XB_XCNT(j)  (256  + 64 * (j))
#define XB_XSUB(j)  (1280 + 64 * (j))
#define XB_XGEN(j)  (2304 + 64 * (j))
#define XB_TOP      3328
#define XB_TOPGEN   3392
#define XCD_BAR_WORDS 3456
#define XB_SPIN_CAP (1u << 20)

__device__ __forceinline__ unsigned xb_ld(unsigned* p)              { return __hip_atomic_load(p, __ATOMIC_RELAXED, __HIP_MEMORY_SCOPE_AGENT); }
__device__ __forceinline__ unsigned xb_add(unsigned* p, unsigned v) { return __hip_atomic_fetch_add(p, v, __ATOMIC_RELAXED, __HIP_MEMORY_SCOPE_AGENT); }
__device__ __forceinline__ unsigned xb_xcc_id() { return (unsigned)__builtin_amdgcn_s_getreg((3 << 11) | 20) & 0xFu; }
#define XB_SPIN(cond, bar) do { unsigned _sp = 0; while (cond) { __builtin_amdgcn_s_sleep(1); \
    if ((++_sp & 255u) == 0u) { if (xb_ld(&(bar)[XB_TMO])) break; if (_sp > XB_SPIN_CAP) { atomicAdd(&(bar)[XB_TMO], 1u); break; } } } } while (0)

struct XcdBarrier {
    unsigned* bar; unsigned x;
    volatile LAS unsigned* st;
};

__device__ __forceinline__ XcdBarrier xcd_barrier_post(unsigned* bar, volatile LAS unsigned* st) {
    XcdBarrier b; b.bar = bar; b.x = xb_xcc_id(); b.st = st;
    if (threadIdx.x == 0) (void)xb_add(&bar[XB_XCNT(b.x)], 1u);
    return b;
}
__device__ __forceinline__ void xcd_barrier_complete(unsigned* bar, unsigned x, unsigned& nloc, unsigned& nx) {
    const unsigned G = gridDim.x * gridDim.y * gridDim.z;
    unsigned sum, cnt, mine, sp = 0u;
    for (;;) {
        sum = 0u; cnt = 0u; mine = 0u;
#pragma unroll
        for (unsigned j = 0; j < 16; ++j) { const unsigned c = xb_ld(&bar[XB_XCNT(j)]); sum += c; cnt += (c > 0u) ? 1u : 0u; mine = (j == x) ? c : mine; }
        if (sum == G) break;
        __builtin_amdgcn_s_sleep(1);
        if ((++sp & 255u) == 0u) { if (xb_ld(&bar[XB_TMO])) break; if (sp > XB_SPIN_CAP) { atomicAdd(&bar[XB_TMO], 1u); break; } }
    }
    nloc = mine > 0u ? mine : 1u; nx = cnt > 0u ? cnt : 1u;
}

__device__ __forceinline__ void xcd_barrier(const XcdBarrier& b) {
    asm volatile("s_waitcnt vmcnt(0)" ::: "memory");
    __syncthreads();
    if (threadIdx.x == 0) {
        unsigned* bar = b.bar;
        __builtin_amdgcn_s_waitcnt(0);
        unsigned nloc = b.st[0], nx = b.st[1];
        if (nloc == 0u) { xcd_barrier_complete(bar, b.x, nloc, nx); b.st[0] = nloc; b.st[1] = nx; }
        const unsigned old = xb_add(&bar[XB_XSUB(b.x)], 1u);
        const unsigned gen = old / nloc;
        if (old + 1u == (gen + 1u) * nloc) {
            __builtin_amdgcn_fence(__ATOMIC_RELEASE, "agent");
            asm volatile("s_waitcnt vmcnt(0)" ::: "memory");
            const unsigned og = xb_add(&bar[XB_TOP], 1u);
            const unsigned tg = og / nx;
            if (og + 1u == (tg + 1u) * nx) xb_add(&bar[XB_TOPGEN], 1u);
            else XB_SPIN(xb_ld(&bar[XB_TOPGEN]) == tg, bar);
            __builtin_amdgcn_fence(__ATOMIC_ACQUIRE, "agent");
            xb_add(&bar[XB_XGEN(b.x)], 1u);
            asm volatile("s_waitcnt vmcnt(0)" ::: "memory");
        } else {
            XB_SPIN(xb_ld(&bar[XB_XGEN(b.x)]) == gen, bar);
            __builtin_amdgcn_fence(__ATOMIC_ACQUIRE, "agent");
            asm volatile("s_waitcnt vmcnt(0)" ::: "memory");
        }
    }
    __syncthreads();
}
#include <hip/hip_runtime.h>
namespace pg8 {
#define PG8_LAS __attribute__((address_space(3)))
typedef unsigned short bf16_t;
typedef short bf16x8 __attribute__((ext_vector_type(8)));
typedef float f32x4 __attribute__((ext_vector_type(4)));
typedef unsigned u32x4 __attribute__((ext_vector_type(4)));
constexpr int BM = 256, BK = 64, HALF = 128, HTB = HALF * BK * 2  , STAGE_BYTES = 8 * HTB, NXCD = 8, WGM = 8;

__host__ __device__ __forceinline__ int lds_byte(int r, int c) { const int st = (r >> 4) * 2 + (c >> 5), rr = r & 15, cc = c & 31, ob = rr * 64 + cc * 2; return st * 1024 + (ob ^ (((ob >> 9) & 1) << 5)); }
__host__ __device__ __forceinline__ void stage_rc(int b, int& R, int& C) { const int st = b / 1024, sb = b % 1024, swz = sb ^ (((sb >> 9) & 1) << 5); R = (st >> 1) * 16 + swz / 64; C = (st & 1) * 32 + (swz % 64) / 2; }
__host__ __device__ __forceinline__ int perm32(int rho) { const int n = rho >> 4, i = rho & 15; return 8 * (i >> 2) + 4 * n + (i & 3); }

struct Unit { int pm, pn; };
struct Gemm { const bf16_t* A; const bf16_t* Bt; int M, N, K; };

struct StaticOrder {
    int nM, nN, nwg, G, c;
    __host__ __device__ void init(int M, int N, int G_, int c_) { nM = M / BM; nN = N / BM; nwg = nM * nN; G = G_; c = c_; }
    __host__ __device__ bool next(int i, Unit& u) const {
        const long L = (long)i * G + c; if (L >= nwg) return false;
        int wgid = (int)L; { const int q = nwg / NXCD, r = nwg % NXCD, xcd = wgid % NXCD, off = wgid / NXCD; wgid = (xcd < r ? xcd * (q + 1) : r * (q + 1) + (xcd - r) * q) + off; }
        const int nig = WGM * nN, gid = wgid / nig, fm = gid * WGM, gsz = (nM - fm) < WGM ? (nM - fm) : WGM;
        u.pm = fm + ((wgid % nig) % gsz); u.pn = (wgid % nig) / gsz; return true;
    }
    __device__ __forceinline__ void a_ready(const Unit&) const {}
    __device__ __forceinline__ void done(const Unit&) const {}
};
template <class Epi, class Sched, bool ALIGN_EPI = false, bool SP2 = false>
__device__ __forceinline__ void gemm_phase(PG8_LAS unsigned char* lds, const Gemm g, const Sched& S, const Epi& E) {
    const int tid = threadIdx.x, wid = __builtin_amdgcn_readfirstlane(tid >> 6), lane = tid & 63, wr = wid >> 2, wc = wid & 3, fr = lane & 15, fq = lane >> 4;
    const int K = g.K, nt = K / BK;
    unsigned voffA[2], voffB[2];
#pragma unroll
    for (int i = 0; i < 2; ++i) { int R, C; stage_rc(tid * 16 + i * 8192, R, C); const int Rb = Epi::PERM ? ((R & ~31) + perm32(R & 31)) : R;
        voffA[i] = (unsigned)(R * K + C) * 2u; voffB[i] = (unsigned)(Rb * K + C) * 2u; }
    const size_t kstep = (size_t)(BK * 2);
    const size_t hstep = (size_t)HALF * K * 2;
    const size_t tstep = 2 * hstep;
    const unsigned ldsw = (unsigned)wid * 1024u;
    const int aoff = lds_byte(wr * 64 + fr, fq * 8), boff = lds_byte(wc * 32 + fr, fq * 8);
#define PG8_SA(b, h) (((b) * 2 + (h)) * HTB)
#define PG8_SB(b, h) ((4 + (b) * 2 + (h)) * HTB)
#define PG8_STAGE(bufoff, gbase, voff) do { _Pragma("unroll") for (int _i = 0; _i < 2; ++_i) \
        __builtin_amdgcn_global_load_lds((const unsigned*)((const char*)(gbase) + (voff)[_i]), (PG8_LAS unsigned*)(lds + (bufoff) + ldsw + _i * 8192), 16, 0, 0); } while (0)
#define PG8_LDA(dst, b, h) do { _Pragma("unroll") for (int m = 0; m < 4; ++m) _Pragma("unroll") for (int k = 0; k < 2; ++k) dst[m][k] = *(const PG8_LAS bf16x8*)(lds + PG8_SA(b, h) + aoff + m * 2048 + k * 1024); } while (0)
#define PG8_LDB(dst, b, h) do { _Pragma("unroll") for (int n = 0; n < 2; ++n) _Pragma("unroll") for (int k = 0; k < 2; ++k) dst[n][k] = *(const PG8_LAS bf16x8*)(lds + PG8_SB(b, h) + boff + n * 2048 + k * 1024); } while (0)
#define PG8_MMA(ai, bj, At, Bt) do { __builtin_amdgcn_s_setprio(1); _Pragma("unroll") for (int m = 0; m < 4; ++m) _Pragma("unroll") for (int n = 0; n < 2; ++n) _Pragma("unroll") for (int k = 0; k < 2; ++k) \
        acc[ai][bj][m][n] = __builtin_amdgcn_mfma_f32_16x16x32_bf16(Bt[n][k], At[m][k], acc[ai][bj][m][n], 0, 0, 0); __builtin_amdgcn_s_setprio(0); } while (0)
#define PG8_WAIT_V(n) asm volatile("s_waitcnt vmcnt(" #n ")" ::: "memory")
#define PG8_WAIT_L(n) asm volatile("s_waitcnt lgkmcnt(" #n ")" ::: "memory")
#define PG8_BAR __builtin_amdgcn_s_barrier()
#define PG8_SCHED __builtin_amdgcn_sched_barrier(0)
    Unit cur, nxt; int ui = 0;
    if (!S.next(0, cur)) return;
    f32x4 acc[2][2][4][2];
#pragma unroll
    for (int a = 0; a < 2; ++a)
#pragma unroll
        for (int b = 0; b < 2; ++b)
#pragma unroll
            for (int m = 0; m < 4; ++m)
#pragma unroll
                for (int n = 0; n < 2; ++n) acc[a][b][m][n] = (f32x4){0.f, 0.f, 0.f, 0.f};
    bf16x8 At[4][2], B0[2][2], B1[2][2];
    const char* cA = (const char*)g.A + (size_t)cur.pm * tstep; const char* cB = (const char*)g.Bt + (size_t)cur.pn * tstep;
    S.a_ready(cur);
    if constexpr (SP2) {
        PG8_STAGE(PG8_SB(0, 0), cB, voffB); PG8_STAGE(PG8_SB(0, 1), cB + hstep, voffB); PG8_STAGE(PG8_SA(0, 0), cA, voffA); PG8_STAGE(PG8_SA(0, 1), cA + hstep, voffA);
        if (wr == 1) PG8_BAR;
        PG8_WAIT_V(2); PG8_BAR;
        PG8_STAGE(PG8_SB(1, 0), cB + kstep, voffB); PG8_STAGE(PG8_SA(1, 0), cA + kstep, voffA); PG8_STAGE(PG8_SB(1, 1), cB + hstep + kstep, voffB);
        PG8_WAIT_V(6); PG8_BAR;
    } else {
        PG8_STAGE(PG8_SB(0, 0), cB, voffB); PG8_STAGE(PG8_SA(0, 0), cA, voffA); PG8_STAGE(PG8_SB(0, 1), cB + hstep, voffB); PG8_STAGE(PG8_SA(0, 1), cA + hstep, voffA);
        if (wr == 1) PG8_BAR;
        PG8_WAIT_V(4); PG8_BAR;
        PG8_STAGE(PG8_SB(1, 0), cB + kstep, voffB); PG8_STAGE(PG8_SA(1, 0), cA + kstep, voffA); PG8_STAGE(PG8_SB(1, 1), cB + hstep + kstep, voffB);
        PG8_WAIT_V(6); PG8_BAR;
    }
    for (;;) {
        const bool has_next = S.next(ui + 1, nxt);
        const char* nA = has_next ? (const char*)g.A + (size_t)nxt.pm * tstep : cA; const char* nB = has_next ? (const char*)g.Bt + (size_t)nxt.pn * tstep : cB;
        for (int t = 0; t < nt; t += 2) {
            const bool last = (t == nt - 2);
            const char* a1 = cA + (size_t)(t + 1) * kstep;
            const char* a2 = last ? nA : cA + (size_t)(t + 2) * kstep; const char* b2 = last ? nB : cB + (size_t)(t + 2) * kstep;
            const char* a3 = a2 + kstep; const char* b3 = b2 + kstep;
            if (last && has_next) S.a_ready(nxt);
            if constexpr (SP2) {
            PG8_LDB(B0, 0, 0); PG8_LDB(B1, 0, 1); PG8_SCHED; PG8_LDA(At, 0, 0); PG8_STAGE(PG8_SA(1, 1), a1 + hstep, voffA);
            PG8_WAIT_V(8); PG8_WAIT_L(0); PG8_BAR; PG8_MMA(0, 0, At, B0); PG8_MMA(0, 1, At, B1); PG8_BAR; PG8_SCHED;
            PG8_LDA(At, 0, 1); PG8_STAGE(PG8_SB(0, 0), b2, voffB); PG8_STAGE(PG8_SB(0, 1), b2 + hstep, voffB); PG8_STAGE(PG8_SA(0, 0), a2, voffA);
            PG8_WAIT_V(8); PG8_WAIT_L(0); PG8_BAR; PG8_MMA(1, 0, At, B0); PG8_MMA(1, 1, At, B1); PG8_BAR; PG8_SCHED;
            PG8_LDB(B0, 1, 0); PG8_LDB(B1, 1, 1); PG8_SCHED; PG8_LDA(At, 1, 0); PG8_STAGE(PG8_SA(0, 1), a2 + hstep, voffA);
            PG8_WAIT_V(8); PG8_WAIT_L(0); PG8_BAR; PG8_MMA(0, 0, At, B0); PG8_MMA(0, 1, At, B1); PG8_BAR; PG8_SCHED;
            PG8_LDA(At, 1, 1); PG8_STAGE(PG8_SB(1, 0), b3, voffB); PG8_STAGE(PG8_SB(1, 1), b3 + hstep, voffB); PG8_STAGE(PG8_SA(1, 0), a3, voffA);
            PG8_WAIT_V(8); PG8_WAIT_L(0); PG8_BAR; PG8_MMA(1, 0, At, B0); PG8_MMA(1, 1, At, B1); PG8_BAR; PG8_SCHED;
            } else {
            PG8_LDB(B0, 0, 0); PG8_SCHED; PG8_LDA(At, 0, 0); PG8_STAGE(PG8_SA(1, 1), a1 + hstep, voffA);
            PG8_WAIT_L(8); PG8_BAR; PG8_WAIT_L(0); PG8_MMA(0, 0, At, B0); PG8_BAR; PG8_SCHED;
            PG8_LDB(B1, 0, 1); PG8_STAGE(PG8_SB(0, 0), b2, voffB);
            PG8_BAR; PG8_WAIT_L(0); PG8_MMA(0, 1, At, B1); PG8_BAR;
            PG8_LDA(At, 0, 1); PG8_STAGE(PG8_SA(0, 0), a2, voffA);
            PG8_BAR; PG8_WAIT_L(0); PG8_MMA(1, 0, At, B0); PG8_BAR; PG8_SCHED;
            PG8_STAGE(PG8_SB(0, 1), b2 + hstep, voffB);
            PG8_WAIT_V(6); PG8_BAR; PG8_MMA(1, 1, At, B1); PG8_BAR;
            PG8_LDB(B0, 1, 0); PG8_SCHED; PG8_LDA(At, 1, 0); PG8_STAGE(PG8_SA(0, 1), a2 + hstep, voffA);
            PG8_WAIT_L(8); PG8_BAR; PG8_WAIT_L(0); PG8_MMA(0, 0, At, B0); PG8_BAR; PG8_SCHED;
            PG8_LDB(B1, 1, 1); PG8_STAGE(PG8_SB(1, 0), b3, voffB);
            PG8_BAR; PG8_WAIT_L(0); PG8_MMA(0, 1, At, B1); PG8_BAR;
            PG8_LDA(At, 1, 1); PG8_STAGE(PG8_SA(1, 0), a3, voffA);
            PG8_BAR; PG8_WAIT_L(0); PG8_MMA(1, 0, At, B0); PG8_BAR; PG8_SCHED;
            PG8_STAGE(PG8_SB(1, 1), b3 + hstep, voffB);
            PG8_WAIT_V(6); PG8_BAR; PG8_MMA(1, 1, At, B1); PG8_BAR;
            }
        }
        if constexpr (ALIGN_EPI) { if (wr == 0) PG8_BAR; }
        if constexpr (!Epi::AFTER_DRAIN) { E(acc, cur, wr, wc, fr, fq); S.done(cur); }
        if (!has_next) break;
#pragma unroll
        for (int a = 0; a < 2; ++a)
#pragma unroll
            for (int b = 0; b < 2; ++b)
#pragma unroll
                for (int m = 0; m < 4; ++m)
#pragma unroll
                    for (int n = 0; n < 2; ++n) acc[a][b][m][n] = (f32x4){0.f, 0.f, 0.f, 0.f};
        cur = nxt; cA = nA; cB = nB; ++ui;
        if constexpr (ALIGN_EPI) { if (wr == 1) PG8_BAR; }
    }
    PG8_WAIT_V(0);
    if constexpr (!ALIGN_EPI) { if (wr == 0) PG8_BAR; }
    PG8_BAR;
    if constexpr (Epi::AFTER_DRAIN) { E.fused(acc, cur, wr, wc, fr, fq, lds, wid, lane); S.done(cur); }
#undef PG8_SA
#undef PG8_SB
#undef PG8_STAGE
#undef PG8_LDA
#undef PG8_LDB
#undef PG8_MMA
#undef PG8_WAIT_V
#undef PG8_WAIT_L
#undef PG8_BAR
#undef PG8_SCHED
}
}

typedef unsigned short bf16_t;
typedef float f32x4 __attribute__((ext_vector_type(4)));
typedef float f32x2 __attribute__((ext_vector_type(2)));
typedef unsigned u32x4 __attribute__((ext_vector_type(4)));
typedef unsigned u32x2 __attribute__((ext_vector_type(2)));

constexpr int D = 2048, NB = 4, SEQ = 4096, CTXL = 256;
constexpr int ML = NB * SEQ;
constexpr int MC = NB * CTXL;
constexpr int MT = ML + MC;
constexpr int AB_IN = 7616, NIN0 = 7680, PW0 = 7168, TW0 = 512;
constexpr int C_INW = 6176, NIN1 = 6400, PW1 = 6144, TW1 = 256;
constexpr int FF = 5632;
constexpr int MODW = 6 * D;
constexpr int NTHREADS = 512, NWAVES = 8;

constexpr size_t MiB = 1u << 20;
constexpr size_t WS_CTL = 0, CTL_BYTES = 16384;
constexpr size_t WS_MOD = 1 * MiB;
constexpr size_t WS_GA = 2 * MiB, WS_GB = 4 * MiB;
constexpr size_t WS_XC = 6 * MiB;
constexpr size_t WS_HY = 14 * MiB;
constexpr size_t WS_TAIL = 82 * MiB;
constexpr size_t WS_WIN = 116 * MiB;
constexpr size_t WS_WOUT = 146 * MiB;
constexpr size_t WS_W13 = 154 * MiB;
constexpr size_t WS_W2 = 198 * MiB;
constexpr size_t WS_P = 220 * MiB;
constexpr size_t WS_F = 458 * MiB;
constexpr size_t FSLOT = (size_t)MT * 1024 * 2;
constexpr size_t WS_WL = 696 * MiB;
constexpr size_t WS_WG = 698 * MiB;
constexpr size_t WS_END = 700 * MiB;
constexpr size_t WS_L1W = WS_F + 128 * MiB;
constexpr size_t WS_WIN1 = WS_L1W, WS_WOUT1 = WS_L1W + 26 * MiB, WS_W131 = WS_L1W + 34 * MiB, WS_W21 = WS_L1W + 78 * MiB;
static_assert(WS_W21 + (size_t)D * FF * 2 <= WS_WL && (size_t)2 * ML * D * 2 <= 128 * MiB, "layer-1 weight map");
constexpr size_t WS_A1 = WS_HY, WS_A2 = WS_HY + 16 * MiB;
constexpr size_t WS_GOUT = WS_TAIL;
static_assert(WS_F + 7 * FSLOT <= WS_END, "ws map");
static_assert(WS_HY + (size_t)MT * D * 2 <= WS_TAIL && WS_TAIL + (size_t)MT * TW0 * 4 <= WS_WIN && WS_W2 + (size_t)D * FF * 2 <= WS_P && WS_P + (size_t)MT * PW0 * 2 <= WS_F, "ws map");

constexpr int LDS_BYTES = 147456;
constexpr int LDS_BAR_OFF = LDS_BYTES - 64;

__device__ __forceinline__ float bflo(unsigned u) { return __builtin_bit_cast(float, u << 16); }
__device__ __forceinline__ float bfhi(unsigned u) { return __builtin_bit_cast(float, u & 0xffff0000u); }
__device__ __forceinline__ float bf1(bf16_t h) { return __builtin_bit_cast(float, (unsigned)h << 16); }
__device__ __forceinline__ unsigned f2bf(float f) { unsigned u = __builtin_bit_cast(unsigned, f); return (u + 0x7fffu + ((u >> 16) & 1u)) >> 16; }
__device__ __forceinline__ unsigned pk2(float lo, float hi) { return f2bf(lo) | (f2bf(hi) << 16); }
__device__ __forceinline__ float sigm(float x) { return 1.f / (1.f + expf(-x)); }
__device__ __forceinline__ float sigm_fast(float x) { return 1.f / (1.f + __expf(-x)); }
__device__ __forceinline__ float silu_fast(float x) { return x / (1.f + __expf(-x)); }
__device__ __forceinline__ float softplus_(float x) { return fmaxf(x, 0.f) + log1pf(expf(-fabsf(x))); }
__device__ __forceinline__ float logsigm_(float x) { return fminf(x, 0.f) - log1pf(expf(-fabsf(x))); }
template <int W> __device__ __forceinline__ float grp_sum(float v) {
#pragma unroll
    for (int o = 1; o < W; o <<= 1) v += __shfl_xor(v, o);
    return v;
}
__device__ __forceinline__ void unpack8(const u32x4 u, float (&f)[8]) {
    f[0] = bflo(u.x); f[1] = bfhi(u.x); f[2] = bflo(u.y); f[3] = bfhi(u.y); f[4] = bflo(u.z); f[5] = bfhi(u.z); f[6] = bflo(u.w); f[7] = bfhi(u.w);
}
__device__ __forceinline__ u32x4 pack8(const float (&f)[8]) { u32x4 o; o.x = pk2(f[0], f[1]); o.y = pk2(f[2], f[3]); o.z = pk2(f[4], f[5]); o.w = pk2(f[6], f[7]); return o; }

struct EpiInProj {
    static constexpr bool PERM = true, AFTER_DRAIN = false;
    bf16_t* P; int ldp; int nPt; float* T; int ldt;
    __device__ __forceinline__ void operator()(const pg8::f32x4 (&acc)[2][2][4][2], const pg8::Unit& u, int wr, int wc, int fr, int fq) const {
        const int row0 = u.pm * 256 + wr * 64 + fr;
        if (u.pn < nPt) {
            const int col0 = u.pn * 256 + wc * 32 + 8 * fq;
#pragma unroll
            for (int ai = 0; ai < 2; ++ai)
#pragma unroll
                for (int m = 0; m < 4; ++m) { bf16_t* rowp = P + (size_t)(row0 + ai * 128 + m * 16) * ldp + col0;
#pragma unroll
                    for (int bj = 0; bj < 2; ++bj) { const pg8::f32x4 v0 = acc[ai][bj][m][0], v1 = acc[ai][bj][m][1];
                        u32x4 o; o.x = pk2(v0[0], v0[1]); o.y = pk2(v0[2], v0[3]); o.z = pk2(v1[0], v1[1]); o.w = pk2(v1[2], v1[3]);
                        *(u32x4*)(rowp + bj * 128) = o; } }
        } else {
            const int col0 = (u.pn - nPt) * 256 + wc * 32 + 8 * fq;
#pragma unroll
            for (int ai = 0; ai < 2; ++ai)
#pragma unroll
                for (int m = 0; m < 4; ++m) { float* rowp = T + (size_t)(row0 + ai * 128 + m * 16) * ldt + col0;
#pragma unroll
                    for (int bj = 0; bj < 2; ++bj) { *(pg8::f32x4*)(rowp + bj * 128) = acc[ai][bj][m][0]; *(pg8::f32x4*)(rowp + bj * 128 + 4) = acc[ai][bj][m][1]; } }
        }
    }
};
struct EpiResid {
    static constexpr bool PERM = false, AFTER_DRAIN = false;
    const float* srcL; const float* srcC; float* dstL; float* dstC; const float* gate;
    __device__ __forceinline__ void operator()(const pg8::f32x4 (&acc)[2][2][4][2], const pg8::Unit& u, int wr, int wc, int fr, int fq) const {
        const bool lat = u.pm < 64;
        const int rowl = (lat ? u.pm : u.pm - 64) * 256 + wr * 64 + fr, col0 = u.pn * 256 + wc * 32 + 4 * fq;
        const float* src = lat ? srcL : srcC; float* dst = lat ? dstL : dstC;
        const float* g = gate + (size_t)(lat ? (u.pm >> 4) : 4) * MODW + col0;
        pg8::f32x4 gv[2][2];
#pragma unroll
        for (int bj = 0; bj < 2; ++bj)
#pragma unroll
            for (int n = 0; n < 2; ++n) gv[bj][n] = *(const pg8::f32x4*)(g + bj * 128 + n * 16);
#pragma unroll
        for (int ai = 0; ai < 2; ++ai)
#pragma unroll
            for (int m = 0; m < 4; ++m) { const size_t ro = (size_t)(rowl + ai * 128 + m * 16) * D + col0;
#pragma unroll
                for (int bj = 0; bj < 2; ++bj)
#pragma unroll
                    for (int n = 0; n < 2; ++n) { const pg8::f32x4 s = *(const pg8::f32x4*)(src + ro + bj * 128 + n * 16);
                        *(pg8::f32x4*)(dst + ro + bj * 128 + n * 16) = s + gv[bj][n] * acc[ai][bj][m][n]; } }
    }
};
struct EpiSwiGLU {
    static constexpr bool PERM = true, AFTER_DRAIN = false;
    bf16_t* H; int ldh;
    __device__ __forceinline__ void operator()(const pg8::f32x4 (&acc)[2][2][4][2], const pg8::Unit& u, int wr, int wc, int fr, int fq) const {
        const int row0 = u.pm * 256 + wr * 64 + fr, col0 = u.pn * 128 + wc * 32 + 8 * fq;
#pragma unroll
        for (int ai = 0; ai < 2; ++ai)
#pragma unroll
            for (int m = 0; m < 4; ++m) { float h[8];
#pragma unroll
                for (int n = 0; n < 2; ++n)
#pragma unroll
                    for (int j = 0; j < 4; ++j) h[n * 4 + j] = silu_fast(acc[ai][0][m][n][j]) * acc[ai][1][m][n][j];
                *(u32x4*)(H + (size_t)(row0 + ai * 128 + m * 16) * ldh + col0) = pack8(h); }
    }
};

struct EpiLora {
    static constexpr bool PERM = true, AFTER_DRAIN = false;
    bf16_t* P; int ldp; const float* w0; const float* a0;
    __device__ __forceinline__ void operator()(const pg8::f32x4 (&acc)[2][2][4][2], const pg8::Unit& u, int wr, int wc, int fr, int fq) const {
        const int row0 = u.pm * 256 + wr * 64 + fr, col0 = u.pn * 256 + wc * 32 + 8 * fq;
        const bool isw = u.pn < 8; const float* bp = isw ? w0 + col0 : a0 + (col0 - 2048); const float sc = isw ? -0.6065306597126334f : 1.f;
#pragma unroll
        for (int bj = 0; bj < 2; ++bj) {
            const pg8::f32x4 b0 = *(const pg8::f32x4*)(bp + bj * 128), b1 = *(const pg8::f32x4*)(bp + bj * 128 + 4);
#pragma unroll
            for (int ai = 0; ai < 2; ++ai)
#pragma unroll
                for (int m = 0; m < 4; ++m) { float h[8];
#pragma unroll
                    for (int j = 0; j < 4; ++j) { h[j] = sc * sigm_fast(acc[ai][bj][m][0][j] + b0[j]); h[4 + j] = sc * sigm_fast(acc[ai][bj][m][1][j] + b1[j]); }
                    *(u32x4*)(P + (size_t)(row0 + ai * 128 + m * 16) * ldp + col0 + bj * 128) = pack8(h); } }
    }
};
struct EpiBf16Plain {
    static constexpr bool PERM = true, AFTER_DRAIN = false;
    bf16_t* O; int ldo;
    __device__ __forceinline__ void operator()(const pg8::f32x4 (&acc)[2][2][4][2], const pg8::Unit& u, int wr, int wc, int fr, int fq) const {
        const int row0 = u.pm * 256 + wr * 64 + fr, col0 = u.pn * 256 + wc * 32 + 8 * fq;
#pragma unroll
        for (int ai = 0; ai < 2; ++ai)
#pragma unroll
            for (int m = 0; m < 4; ++m) { bf16_t* rowp = O + (size_t)(row0 + ai * 128 + m * 16) * ldo + col0;
#pragma unroll
                for (int bj = 0; bj < 2; ++bj) { const pg8::f32x4 v0 = acc[ai][bj][m][0], v1 = acc[ai][bj][m][1];
                    u32x4 o; o.x = pk2(v0[0], v0[1]); o.y = pk2(v0[2], v0[3]); o.z = pk2(v1[0], v1[1]); o.w = pk2(v1[2], v1[3]);
                    *(u32x4*)(rowp + bj * 128) = o; } }
    }
};

struct Ctx {
    LAS unsigned char* lds; int tid, lane, wave, G, wg, gw, NGW;
    const float* in[32]; float* out; unsigned char* ws;
};
#define IN_X 0
#define IN_C 1
#define IN_CTX 2
#define IN_CCTX 3
#define IN_ADAW 4
#define IN_ADAB 5
#define IN_NORMW 6
#define IN_ABWIN 7
#define IN_CONVW 8
#define IN_ALOG 9
#define IN_DTB 10
#define IN_GDNNW 11
#define IN_W0 12
#define IN_WUP 13
#define IN_A0 14
#define IN_AUP 15
#define IN_GUP 16
#define IN_KK 17
#define IN_KA 18
#define IN_RK 19
#define IN_LNW 20
#define IN_LNB 21
#define IN_ABWOUT 22
#define IN_MLWIN 23
#define IN_MLIB 24
#define IN_MLFB 25
#define IN_MLNW 26
#define IN_MLWOUT 27
#define IN_W1 28
#define IN_W3 29
#define IN_W2 30
#define IN_FNW 31

__device__ __forceinline__ void transpose_matrix(const Ctx& c, const float* W, int K, int N, int Npad, bf16_t* WT, int mode, LAS float* scr, int gw, int ngw) {
    const int nblk = Npad / 64, items = (K / 64) * nblk, lane = c.lane;
#pragma unroll 1
    for (int it = gw; it < items; it += ngw) {
        const int kb = it / nblk, nb = it - kb * nblk, k0 = kb * 64, n0 = nb * 64;
        const int rr = lane >> 4, c4 = (lane & 15) * 4;
        f32x4 v[16];
        const bool inb = n0 + c4 < N;
#pragma unroll
        for (int i = 0; i < 16; ++i) v[i] = inb ? *(const f32x4*)(W + (size_t)(k0 + 4 * i + rr) * N + n0 + c4) : (f32x4){0.f, 0.f, 0.f, 0.f};
#pragma unroll
        for (int i = 0; i < 16; ++i) { LAS float* d = scr + (4 * i + rr) * 65 + c4; d[0] = v[i].x; d[1] = v[i].y; d[2] = v[i].z; d[3] = v[i].w; }
        asm volatile("s_waitcnt lgkmcnt(0)" ::: "memory");
        const int j = lane & 7;
#pragma unroll
        for (int q = 0; q < 8; ++q) { const int n = q * 8 + (lane >> 3); const LAS float* s = scr + (8 * j) * 65 + n;
            u32x4 o; o.x = pk2(s[0], s[65]); o.y = pk2(s[2 * 65], s[3 * 65]); o.z = pk2(s[4 * 65], s[5 * 65]); o.w = pk2(s[6 * 65], s[7 * 65]);
            const int ng = n0 + n, orow = mode == 0 ? ng : ((ng >> 7) * 256 + (ng & 127) + (mode == 2 ? 128 : 0));
            *(u32x4*)(WT + (size_t)orow * K + k0 + 8 * j) = o; }
        asm volatile("s_waitcnt lgkmcnt(0)" ::: "memory");
    }
}
__device__ __forceinline__ void convert_weights(const Ctx& c, int layer, int wg0, int nwg) {
    if (c.wg < wg0 || c.wg >= wg0 + nwg) return;
    const int gw = (c.wg - wg0) * NWAVES + c.wave, ngw = nwg * NWAVES;
    LAS float* scr = (LAS float*)c.lds + c.wave * (64 * 65);
    if (layer == 0) {
        transpose_matrix(c, c.in[IN_ABWIN], D, AB_IN, NIN0, (bf16_t*)(c.ws + WS_WIN), 0, scr, gw, ngw); transpose_matrix(c, c.in[IN_ABWOUT], D, D, D, (bf16_t*)(c.ws + WS_WOUT), 0, scr, gw, ngw);
        transpose_matrix(c, c.in[IN_W1], D, FF, FF, (bf16_t*)(c.ws + WS_W13), 1, scr, gw, ngw); transpose_matrix(c, c.in[IN_W3], D, FF, FF, (bf16_t*)(c.ws + WS_W13), 2, scr, gw, ngw);
        transpose_matrix(c, c.in[IN_W2], FF, D, D, (bf16_t*)(c.ws + WS_W2), 0, scr, gw, ngw);
    } else {
        transpose_matrix(c, c.in[IN_MLWIN], D, C_INW, NIN1, (bf16_t*)(c.ws + WS_WIN1), 0, scr, gw, ngw); transpose_matrix(c, c.in[IN_MLWOUT], D, D, D, (bf16_t*)(c.ws + WS_WOUT1), 0, scr, gw, ngw);
        transpose_matrix(c, c.in[IN_W1] + (size_t)D * FF, D, FF, FF, (bf16_t*)(c.ws + WS_W131), 1, scr, gw, ngw); transpose_matrix(c, c.in[IN_W3] + (size_t)D * FF, D, FF, FF, (bf16_t*)(c.ws + WS_W131), 2, scr, gw, ngw);
        transpose_matrix(c, c.in[IN_W2] + (size_t)FF * D, FF, D, D, (bf16_t*)(c.ws + WS_W21), 0, scr, gw, ngw);
    }
}
__device__ __forceinline__ void lora_weight_phase(const Ctx& c) {
    bf16_t* Wl = (bf16_t*)(c.ws + WS_WL); bf16_t* Wg = (bf16_t*)(c.ws + WS_WG);
    for (int idx = c.wg * NTHREADS + c.tid; idx < 32 * 4096; idx += c.G * NTHREADS) {
        const int k8 = idx >> 12, n = idx & 4095, slot = n >> 10, ch = n & 1023; float v[8];
        const float* src = c.in[slot < 2 ? IN_WUP : IN_AUP] + (size_t)(slot & 1) * 64 * 1024 + ch;
#pragma unroll
        for (int q = 0; q < 8; ++q) { const int kk = k8 * 8 + q; v[q] = ((kk >> 6) == slot) ? src[(size_t)(kk & 63) * 1024] : 0.f; }
        *(u32x4*)(Wl + (size_t)n * 256 + k8 * 8) = pack8(v);
    }
    for (int idx = c.wg * NTHREADS + c.tid; idx < 32 * 1024; idx += c.G * NTHREADS) {
        const int k8 = idx >> 10, ch = idx & 1023; float v[8];
#pragma unroll
        for (int q = 0; q < 8; ++q) { const int kk = k8 * 8 + q; v[q] = kk < 160 ? c.in[IN_GUP][(size_t)kk * 1024 + ch] : 0.f; }
        *(u32x4*)(Wg + (size_t)ch * 256 + k8 * 8) = pack8(v);
    }
}
__device__ __forceinline__ void ada_phase(const Ctx& c, int layer_sel, int wg0, int nwg) {
    if (c.wg < wg0 || c.wg >= wg0 + nwg) return;
    LAS float* sc = (LAS float*)c.lds;
    LAS float* red = sc + 5 * D;
    for (int i = c.tid; i < 5 * D; i += NTHREADS) { const int b = i / D, k = i % D; const float v = b < 4 ? c.in[IN_C][b * D + k] : c.in[IN_CCTX][k]; sc[i] = v / (1.f + expf(-v)); }
    __syncthreads();
    float* MOD = (float*)(c.ws + WS_MOD);
    constexpr int UPL = MODW / 128;
    for (int u = c.wg - wg0; u < UPL; u += nwg) {
        const int layer = layer_sel, cb = u * 128;
        const float* wp = c.in[IN_ADAW] + (size_t)layer * D * MODW + cb + c.lane * 2;
        float acc[5][2];
#pragma unroll
        for (int b = 0; b < 5; ++b) acc[b][0] = acc[b][1] = 0.f;
        const int k0 = c.wave * 256;
#pragma unroll 16
        for (int k = k0; k < k0 + 256; ++k) { const f32x2 w = *(const f32x2*)(wp + (size_t)k * MODW);
#pragma unroll
            for (int b = 0; b < 5; ++b) { const float s = sc[b * D + k]; acc[b][0] += s * w.x; acc[b][1] += s * w.y; } }
#pragma unroll
        for (int b = 0; b < 5; ++b) { red[(c.wave * 5 + b) * 128 + c.lane * 2] = acc[b][0]; red[(c.wave * 5 + b) * 128 + c.lane * 2 + 1] = acc[b][1]; }
        __syncthreads();
        for (int i = c.tid; i < 640; i += NTHREADS) { const int b = i >> 7, l = i & 127; float s = 0.f;
#pragma unroll
            for (int w = 0; w < 8; ++w) s += red[(w * 5 + b) * 128 + l];
            MOD[(size_t)(layer * 5 + b) * MODW + cb + l] = s + c.in[IN_ADAB][layer * MODW + cb + l]; }
        __syncthreads();
    }
}
__device__ __forceinline__ void norm_mod_phase(const Ctx& c, const float* srcL, const float* srcC, const float* nw, const float* modl, int shift_off, int scale_off, int nrows) {
    bf16_t* H = (bf16_t*)(c.ws + WS_HY);
    for (int r = c.gw; r < nrows; r += c.NGW) {
        const float* xr = r < ML ? srcL + (size_t)r * D : srcC + (size_t)(r - ML) * D;
        const float* mr = modl + (size_t)(r < ML ? (r >> 12) : 4) * MODW;
        f32x4 v[8]; float ss = 0.f;
#pragma unroll
        for (int j = 0; j < 8; ++j) { v[j] = ((const f32x4*)xr)[c.lane + 64 * j]; ss += v[j].x * v[j].x + v[j].y * v[j].y + v[j].z * v[j].z + v[j].w * v[j].w; }
        ss = grp_sum<64>(ss);
        const float rstd = 1.f / sqrtf(ss * (1.f / D) + 1e-6f);
#pragma unroll
        for (int j = 0; j < 8; ++j) { const f32x4 w4 = ((const f32x4*)nw)[c.lane + 64 * j], s4 = ((const f32x4*)(mr + scale_off))[c.lane + 64 * j], h4 = ((const f32x4*)(mr + shift_off))[c.lane + 64 * j];
            const f32x4 y = v[j] * rstd * w4 * (s4 + 1.f) + h4;
            u32x2 o; o.x = pk2(y.x, y.y); o.y = pk2(y.z, y.w);
            ((u32x2*)(H + (size_t)r * D))[c.lane + 64 * j] = o; }
    }
}
__device__ __forceinline__ void final_norm_phase(const Ctx& c) {
    const float* nw = c.in[IN_FNW];
    for (int r = c.gw; r < ML; r += c.NGW) {
        f32x4* xr = (f32x4*)(c.out + (size_t)r * D);
        f32x4 v[8]; float ss = 0.f;
#pragma unroll
        for (int j = 0; j < 8; ++j) { v[j] = xr[c.lane + 64 * j]; ss += v[j].x * v[j].x + v[j].y * v[j].y + v[j].z * v[j].z + v[j].w * v[j].w; }
        ss = grp_sum<64>(ss);
        const float rstd = 1.f / sqrtf(ss * (1.f / D) + 1e-6f);
#pragma unroll
        for (int j = 0; j < 8; ++j) xr[c.lane + 64 * j] = v[j] * rstd * ((const f32x4*)nw)[c.lane + 64 * j];
    }
}

__device__ __forceinline__ void ab_feature_strips(const Ctx& c, int st_lo) {
    const bf16_t* P = (const bf16_t*)(c.ws + WS_P); const float* T = (const float*)(c.ws + WS_TAIL);
    bf16_t* F = (bf16_t*)(c.ws + WS_F);
    float* GA = (float*)(c.ws + WS_GA); float* GB = (float*)(c.ws + WS_GB);
    bf16_t* A1 = (bf16_t*)(c.ws + WS_A1); bf16_t* A2 = (bf16_t*)(c.ws + WS_A2);
    const float* cw = c.in[IN_CONVW];
    const int lane = c.lane;
    const int NITEM = (MT / 8 - st_lo) * 12;
#pragma unroll 1
    for (int item = c.gw; item < NITEM; item += c.NGW) {
        const int st = st_lo + item / 12, blk = item % 12, r0 = st * 8, ch = blk * 512 + lane * 8;
        const bool lat = r0 < ML;
        int rowbase, c0, ncols;
        int gr = 0;
        if (lat) { const int b = r0 >> 12, t0 = r0 & 4095; gr = t0 >> 6; c0 = t0 & 63; rowbase = b * 4096 + gr * 64; ncols = 64; }
        else { const int q = r0 - ML, b = q >> 8; c0 = q & 255; rowbase = ML + b * 256; ncols = 256; }
        float acc[8][8];
#pragma unroll
        for (int tt = 0; tt < 8; ++tt)
#pragma unroll
            for (int j = 0; j < 8; ++j) acc[tt][j] = 0.f;
#pragma unroll
        for (int dr = 0; dr < 3; ++dr) {
            const bool vr = lat ? (gr + dr - 1 >= 0 && gr + dr - 1 < 64) : (dr == 1);
            if (vr) {
                float w[3][8];
#pragma unroll
                for (int dc = 0; dc < 3; ++dc) { const f32x4 w0 = *(const f32x4*)(cw + (dr * 3 + dc) * 6144 + ch), w1 = *(const f32x4*)(cw + (dr * 3 + dc) * 6144 + ch + 4);
                    w[dc][0] = w0.x; w[dc][1] = w0.y; w[dc][2] = w0.z; w[dc][3] = w0.w; w[dc][4] = w1.x; w[dc][5] = w1.y; w[dc][6] = w1.z; w[dc][7] = w1.w; }
                const int rb = rowbase + (lat ? (dr - 1) * 64 : 0);
#pragma unroll
                for (int cc = 0; cc < 10; ++cc) {
                    const int col = c0 + cc - 1;
                    if (col >= 0 && col < ncols) {
                        float pf[8]; unpack8(*(const u32x4*)(P + (size_t)(rb + col) * PW0 + ch), pf);
#pragma unroll
                        for (int tt = 0; tt < 8; ++tt) { const int dc = cc - tt;
                            if (dc >= 0 && dc <= 2) {
#pragma unroll
                                for (int j = 0; j < 8; ++j) acc[tt][j] += pf[j] * w[dc][j]; } }
                    }
                }
            }
        }
        const int grp = blk >> 1, cl = (blk & 1) * 512 + lane * 8;
        f32x4 kk0 = {0.f, 0.f, 0.f, 0.f}, kk1 = kk0;
        if (grp == 4) { kk0 = *(const f32x4*)(c.in[IN_KK] + cl); kk1 = *(const f32x4*)(c.in[IN_KK] + cl + 4); }
#pragma unroll
        for (int tt = 0; tt < 8; ++tt) {
            const size_t r = (size_t)(r0 + tt);
            float cv[8];
#pragma unroll
            for (int j = 0; j < 8; ++j) cv[j] = acc[tt][j];
            if (grp < 3) {
                float ss = 0.f;
#pragma unroll
                for (int j = 0; j < 8; ++j) { cv[j] = cv[j] / (1.f + __expf(-cv[j])); ss += cv[j] * cv[j]; }
                if (grp < 2) { ss = grp_sum<16>(ss); const float sc = (1.f / sqrtf(ss + 1e-6f)) * (grp == 0 ? 0.08838834764831845f : 1.f);
#pragma unroll
                    for (int j = 0; j < 8; ++j) cv[j] *= sc; }
                *(u32x4*)(F + (size_t)grp * MT * 1024 + r * 1024 + cl) = pack8(cv);
            } else if (grp == 3) { *(u32x4*)(F + (size_t)3 * MT * 1024 + r * 1024 + cl) = pack8(cv);
            } else if (grp == 5) { *(u32x4*)(F + (size_t)6 * MT * 1024 + r * 1024 + cl) = pack8(cv);
            } else {
                *(u32x4*)(F + (size_t)5 * MT * 1024 + r * 1024 + cl) = pack8(cv);
                float t[8] = {cv[0] * kk0.x, cv[1] * kk0.y, cv[2] * kk0.z, cv[3] * kk0.w, cv[4] * kk1.x, cv[5] * kk1.y, cv[6] * kk1.z, cv[7] * kk1.w};
                float ss = 0.f;
#pragma unroll
                for (int j = 0; j < 8; ++j) ss += t[j] * t[j];
                ss = grp_sum<8>(ss); const float sc = 1.f / sqrtf(ss + 1e-6f);
#pragma unroll
                for (int j = 0; j < 8; ++j) t[j] *= sc;
                *(u32x4*)(F + (size_t)4 * MT * 1024 + r * 1024 + cl) = pack8(t);
            }
        }
        if (blk == 0) {
#pragma unroll 2
            for (int tt = 0; tt < 8; ++tt) {
                const size_t r = (size_t)(r0 + tt);
                const f32x4 t1 = *(const f32x4*)(T + r * TW0 + 32 + lane * 4);
                u32x2 o1; if (lane < 32) { o1.x = pk2(tanhf(t1.x), tanhf(t1.y)); o1.y = pk2(tanhf(t1.z), tanhf(t1.w)); } else { o1.x = pk2(t1.x, t1.y); o1.y = pk2(t1.z, t1.w); }
                *(u32x2*)(A1 + r * 256 + lane * 4) = o1;
                u32x2 o2 = {0u, 0u};
                if (lane < 40) { const f32x4 t2 = *(const f32x4*)(T + r * TW0 + 288 + lane * 4); o2.x = pk2(sigm(t2.x), sigm(t2.y)); o2.y = pk2(sigm(t2.z), sigm(t2.w)); }
                *(u32x2*)(A2 + r * 256 + lane * 4) = o2;
                if (lane < 16) {
                    const float g0 = T[r * TW0 + lane], g1 = T[r * TW0 + 16 + lane];
                    GA[r * 16 + lane] = -expf(c.in[IN_ALOG][lane]) * softplus_(g0 + c.in[IN_DTB][lane]);
                    GB[r * 16 + lane] = sigm(g1);
                }
            }
        }
    }
}
__device__ __forceinline__ void feat_post(bf16_t* F, size_t r, int grp, int cl, float (&cv)[8], const f32x4 kk0, const f32x4 kk1) {
    if (grp < 3) {
        float ss = 0.f;
#pragma unroll
        for (int j = 0; j < 8; ++j) { cv[j] = cv[j] / (1.f + __expf(-cv[j])); ss += cv[j] * cv[j]; }
        if (grp < 2) { ss = grp_sum<16>(ss); const float sc = (1.f / sqrtf(ss + 1e-6f)) * (grp == 0 ? 0.08838834764831845f : 1.f);
#pragma unroll
            for (int j = 0; j < 8; ++j) cv[j] *= sc; }
        *(u32x4*)(F + (size_t)grp * MT * 1024 + r * 1024 + cl) = pack8(cv);
    } else if (grp == 3) { *(u32x4*)(F + (size_t)3 * MT * 1024 + r * 1024 + cl) = pack8(cv);
    } else if (grp == 5) { *(u32x4*)(F + (size_t)6 * MT * 1024 + r * 1024 + cl) = pack8(cv);
    } else {
        *(u32x4*)(F + (size_t)5 * MT * 1024 + r * 1024 + cl) = pack8(cv);
        float t[8] = {cv[0] * kk0.x, cv[1] * kk0.y, cv[2] * kk0.z, cv[3] * kk0.w, cv[4] * kk1.x, cv[5] * kk1.y, cv[6] * kk1.z, cv[7] * kk1.w};
        float ss = 0.f;
#pragma unroll
        for (int j = 0; j < 8; ++j) ss += t[j] * t[j];
        ss = grp_sum<8>(ss); const float sc = 1.f / sqrtf(ss + 1e-6f);
#pragma unroll
        for (int j = 0; j < 8; ++j) t[j] *= sc;
        *(u32x4*)(F + (size_t)4 * MT * 1024 + r * 1024 + cl) = pack8(t);
    }
}
__device__ __forceinline__ void ab_feature_latent(const Ctx& c) {
    const bf16_t* P = (const bf16_t*)(c.ws + WS_P); bf16_t* F = (bf16_t*)(c.ws + WS_F);
    const float* cw = c.in[IN_CONVW];
    const int lane = c.lane;
#pragma unroll 1
    for (int item = c.gw; item < NB * 8 * 16 * 12; item += c.NGW) {
        const int blk = item % 12; int t = item / 12; const int cs = t & 15; t >>= 4; const int sg = t & 7, b = t >> 3;
        const int ch = blk * 512 + lane * 8, c0 = cs * 4, rf = sg * 8, grp = blk >> 1, cl = (blk & 1) * 512 + lane * 8;
        float w[9][8];
#pragma unroll
        for (int k = 0; k < 9; ++k) { const f32x4 w0 = *(const f32x4*)(cw + k * 6144 + ch), w1 = *(const f32x4*)(cw + k * 6144 + ch + 4);
            w[k][0] = w0.x; w[k][1] = w0.y; w[k][2] = w0.z; w[k][3] = w0.w; w[k][4] = w1.x; w[k][5] = w1.y; w[k][6] = w1.z; w[k][7] = w1.w; }
        f32x4 kk0 = {0.f, 0.f, 0.f, 0.f}, kk1 = kk0;
        if (grp == 4) { kk0 = *(const f32x4*)(c.in[IN_KK] + cl); kk1 = *(const f32x4*)(c.in[IN_KK] + cl + 4); }
        const bf16_t* Pb = P + (size_t)b * 4096 * PW0 + ch;
        u32x4 win[3][6];
        auto load_row = [&](int rr, u32x4 (&dst)[6]) {
            const bool vr = rr >= 0 && rr < 64;
#pragma unroll
            for (int cc = 0; cc < 6; ++cc) { const int col = c0 + cc - 1;
                dst[cc] = (vr && col >= 0 && col < 64) ? *(const u32x4*)(Pb + (size_t)(rr * 64 + col) * PW0) : (u32x4){0u, 0u, 0u, 0u}; }
        };
        load_row(rf - 1, win[0]); load_row(rf, win[1]);
#pragma unroll 1
        for (int ro = 0; ro < 8; ++ro) {
            const int r = rf + ro;
            load_row(r + 1, win[2]);
#pragma unroll
            for (int tt = 0; tt < 4; ++tt) {
                float cv[8];
#pragma unroll
                for (int j = 0; j < 8; ++j) cv[j] = 0.f;
#pragma unroll
                for (int dr = 0; dr < 3; ++dr)
#pragma unroll
                    for (int dc = 0; dc < 3; ++dc) { float pf[8]; unpack8(win[dr][tt + dc], pf);
#pragma unroll
                        for (int j = 0; j < 8; ++j) cv[j] += pf[j] * w[dr * 3 + dc][j]; }
                feat_post(F, (size_t)(b * 4096 + r * 64 + c0 + tt), grp, cl, cv, kk0, kk1);
            }
#pragma unroll
            for (int cc = 0; cc < 6; ++cc) { win[0][cc] = win[1][cc]; win[1][cc] = win[2][cc]; }
        }
    }
}
__device__ __forceinline__ void ab_gate_rows(const Ctx& c, int nrows) {
    const float* T = (const float*)(c.ws + WS_TAIL); float* GA = (float*)(c.ws + WS_GA); float* GB = (float*)(c.ws + WS_GB);
    bf16_t* A1 = (bf16_t*)(c.ws + WS_A1); bf16_t* A2 = (bf16_t*)(c.ws + WS_A2);
    const int lane = c.lane;
#pragma unroll 2
    for (int rr = c.gw; rr < nrows; rr += c.NGW) {
        const size_t r = (size_t)rr;
        const f32x4 t1 = *(const f32x4*)(T + r * TW0 + 32 + lane * 4);
        u32x2 o1; if (lane < 32) { o1.x = pk2(tanhf(t1.x), tanhf(t1.y)); o1.y = pk2(tanhf(t1.z), tanhf(t1.w)); } else { o1.x = pk2(t1.x, t1.y); o1.y = pk2(t1.z, t1.w); }
        *(u32x2*)(A1 + r * 256 + lane * 4) = o1;
        u32x2 o2 = {0u, 0u};
        if (lane < 40) { const f32x4 t2 = *(const f32x4*)(T + r * TW0 + 288 + lane * 4); o2.x = pk2(sigm(t2.x), sigm(t2.y)); o2.y = pk2(sigm(t2.z), sigm(t2.w)); }
        *(u32x2*)(A2 + r * 256 + lane * 4) = o2;
        if (lane < 16) {
            const float g0 = T[r * TW0 + lane], g1 = T[r * TW0 + 16 + lane];
            GA[r * 16 + lane] = -expf(c.in[IN_ALOG][lane]) * softplus_(g0 + c.in[IN_DTB][lane]);
            GB[r * 16 + lane] = sigm(g1);
        }
    }
}
__device__ __forceinline__ void ab_feature_phase(const Ctx& c) {
#ifndef FREP
#define FREP 0
#endif
    for (int q = 0; q < ((FREP & 1) ? 2 : 1); ++q) ab_feature_latent(c);
    for (int q = 0; q < ((FREP & 2) ? 2 : 1); ++q) ab_gate_rows(c, ML);
    for (int q = 0; q < ((FREP & 4) ? 2 : 1); ++q) ab_feature_strips(c, ML / 8);
}
__device__ __forceinline__ void rw_lora_phase(const Ctx& c) {
    bf16_t* P = (bf16_t*)(c.ws + WS_P); const float* T = (const float*)(c.ws + WS_TAIL);
    LAS float* xin = (LAS float*)c.lds;
    const int tid = c.tid;
    for (int tile = c.wg; tile < MT / 16; tile += c.G) {
        const int r0 = tile * 16;
#pragma unroll 1
        for (int pass = 0; pass < 2; ++pass) {
            __syncthreads();
            for (int i = tid; i < 16 * 128; i += NTHREADS) { const int tk = i >> 7, j = i & 127; const float v = T[(size_t)(r0 + tk) * TW0 + 32 + pass * 128 + j]; xin[i] = pass == 0 ? tanhf(v) : v; }
            __syncthreads();
            const float* up = c.in[pass == 0 ? IN_WUP : IN_AUP];
            float acc[16][2][2];
#pragma unroll
            for (int tk = 0; tk < 16; ++tk) { acc[tk][0][0] = acc[tk][0][1] = acc[tk][1][0] = acc[tk][1][1] = 0.f; }
#pragma unroll 2
            for (int rr = 0; rr < 64; ++rr) {
                const float w00 = up[(size_t)rr * 1024 + tid], w01 = up[(size_t)rr * 1024 + tid + 512], w10 = up[(size_t)(64 + rr) * 1024 + tid], w11 = up[(size_t)(64 + rr) * 1024 + tid + 512];
#pragma unroll
                for (int tk = 0; tk < 16; ++tk) { const float x0 = xin[tk * 128 + rr], x1 = xin[tk * 128 + 64 + rr];
                    acc[tk][0][0] += x0 * w00; acc[tk][0][1] += x0 * w01; acc[tk][1][0] += x1 * w10; acc[tk][1][1] += x1 * w11; }
            }
            const float* bias = c.in[pass == 0 ? IN_W0 : IN_A0];
#pragma unroll
            for (int d = 0; d < 2; ++d)
#pragma unroll
                for (int j = 0; j < 2; ++j) { const int ch = tid + 512 * j; const float bz = bias[d * 1024 + ch];
#pragma unroll
                    for (int tk = 0; tk < 16; ++tk) { const float s = sigm(bz + acc[tk][d][j]);
                        P[(size_t)(r0 + tk) * PW0 + (pass * 2 + d) * 1024 + ch] = (bf16_t)f2bf(pass == 0 ? -0.6065306597126334f * s : s); } }
        }
    }
}
__device__ __forceinline__ int chunk_row(int b, int dir, int s) {
    if (s < 4) return ML + b * 256 + (dir == 0 ? s : 3 - s) * 64;
    return b * 4096 + (dir == 0 ? s - 4 : 67 - s) * 64;
}
__device__ __forceinline__ void gdn_scan_phase(const Ctx& c) {
    const bf16_t* F = (const bf16_t*)(c.ws + WS_F); bf16_t* P = (bf16_t*)(c.ws + WS_P);
    const float* GA = (const float*)(c.ws + WS_GA); const float* GB = (const float*)(c.ws + WS_GB);
    const int lane = c.lane, tid = c.tid, slab = lane & 15, cl = c.wave * 4 + (lane >> 4);
    for (int item = c.wg; item < 256; item += c.G) {
        const int chain = item >> 2, cq = item & 3, b = chain >> 4, h = (chain >> 1) & 7, dir = chain & 1;
        float S[8];
#pragma unroll
        for (int i = 0; i < 8; ++i) S[i] = 0.f;
        u32x4 rk[2], rq[2], rv; float rg = 0.f, rb = 0.f;
        auto gload = [&](int s) {
            const int row0 = chunk_row(b, dir, s);
#pragma unroll
            for (int i = 0; i < 2; ++i) { const int pc = tid + i * 512, tk = pc >> 4, o = (pc & 15) * 8;
                rk[i] = *(const u32x4*)(F + (size_t)1 * MT * 1024 + (size_t)(row0 + tk) * 1024 + h * 128 + o);
                rq[i] = *(const u32x4*)(F + (size_t)0 * MT * 1024 + (size_t)(row0 + tk) * 1024 + h * 128 + o); }
            if (tid < 256) { const int tk = tid >> 2, o = (tid & 3) * 8; rv = *(const u32x4*)(F + (size_t)2 * MT * 1024 + (size_t)(row0 + tk) * 1024 + h * 128 + cq * 32 + o); }
            if (tid < 64) { rg = GA[(size_t)(row0 + tid) * 16 + dir * 8 + h]; rb = GB[(size_t)(row0 + tid) * 16 + dir * 8 + h]; }
        };
        auto lstore = [&](int bufi) {
            LAS unsigned char* bp = c.lds + bufi * 40960;
#pragma unroll
            for (int i = 0; i < 2; ++i) { const int pc = tid + i * 512; *(LAS u32x4*)(bp + pc * 16) = rk[i]; *(LAS u32x4*)(bp + 16384 + pc * 16) = rq[i]; }
            if (tid < 256) *(LAS u32x4*)(bp + 32768 + tid * 16) = rv;
            if (tid < 64) { *(LAS float*)(bp + 36864 + tid * 4) = rg; *(LAS float*)(bp + 37120 + tid * 4) = rb; }
        };
        __syncthreads();
        gload(0); lstore(0);
        __syncthreads();
        LAS float* ost = (LAS float*)(c.lds + 81920);
#pragma unroll 1
        for (int s = 0; s < 68; ++s) {
            if (s + 1 < 68) gload(s + 1);
            const LAS unsigned char* bp = c.lds + (s & 1) * 40960;
#pragma unroll 2
            for (int j = 0; j < 64; ++j) {
                const int tl = dir == 0 ? j : 63 - j;
                float kf[8], qf[8];
                unpack8(*(const LAS u32x4*)(bp + tl * 256 + slab * 16), kf);
                unpack8(*(const LAS u32x4*)(bp + 16384 + tl * 256 + slab * 16), qf);
                const float vv = bf1(*(const LAS bf16_t*)(bp + 32768 + tl * 64 + cl * 2));
                const float a = __expf(*(const LAS float*)(bp + 36864 + tl * 4)), bt = *(const LAS float*)(bp + 37120 + tl * 4);
                float dot = 0.f;
#pragma unroll
                for (int i = 0; i < 8; ++i) dot += S[i] * kf[i];
                dot = grp_sum<16>(dot);
                const float dlt = bt * (vv - a * dot);
                float od = 0.f;
#pragma unroll
                for (int i = 0; i < 8; ++i) { S[i] = a * S[i] + kf[i] * dlt; od += S[i] * qf[i]; }
                od = grp_sum<16>(od);
                if (slab == 0) ost[tl * 32 + cl] = od;
            }
            __syncthreads();
            {
                const int row0 = chunk_row(b, dir, s), tk = tid >> 3, o = (tid & 7) * 4;
                const f32x4 v = *(const LAS f32x4*)(ost + tk * 32 + o);
                u32x2 w; w.x = pk2(v.x, v.y); w.y = pk2(v.z, v.w);
                *(u32x2*)(P + (size_t)(row0 + tk) * PW0 + (4 + dir) * 1024 + h * 128 + cq * 32 + o) = w;
            }
            if (s + 1 < 68) lstore((s + 1) & 1);
            __syncthreads();
        }
    }
}
__device__ __forceinline__ void rwkv_scan_phase(const Ctx& c) {
    const bf16_t* F = (const bf16_t*)(c.ws + WS_F); const bf16_t* P = (const bf16_t*)(c.ws + WS_P);
    bf16_t* Y = (bf16_t*)(c.ws + WS_F);
    const int lane = c.lane, tid = c.tid, slab = lane & 15, rl = c.wave * 4 + (lane >> 4);
    for (int item = c.wg; item < 256; item += c.G) {
        const int chain = item >> 1, rh = item & 1, b = chain >> 5, h = (chain >> 1) & 15, dir = chain & 1;
        float S[4] = {0.f, 0.f, 0.f, 0.f};
        const f32x4 ka = *(const f32x4*)(c.in[IN_KA] + h * 64 + slab * 4);
        u32x4 rr[5]; u32x4 rv;
        auto gload = [&](int s) {
            const int row0 = chunk_row(b, dir, s);
            const int tk = tid >> 3, o = (tid & 7) * 8;
            rr[0] = *(const u32x4*)(F + (size_t)3 * MT * 1024 + (size_t)(row0 + tk) * 1024 + h * 64 + o);
            rr[1] = *(const u32x4*)(F + (size_t)4 * MT * 1024 + (size_t)(row0 + tk) * 1024 + h * 64 + o);
            rr[2] = *(const u32x4*)(F + (size_t)5 * MT * 1024 + (size_t)(row0 + tk) * 1024 + h * 64 + o);
            rr[3] = *(const u32x4*)(P + (size_t)(row0 + tk) * PW0 + (0 + dir) * 1024 + h * 64 + o);
            rr[4] = *(const u32x4*)(P + (size_t)(row0 + tk) * PW0 + (2 + dir) * 1024 + h * 64 + o);
            if (tid < 256) { const int t2 = tid >> 2, o2 = (tid & 3) * 8; rv = *(const u32x4*)(F + (size_t)6 * MT * 1024 + (size_t)(row0 + t2) * 1024 + h * 64 + rh * 32 + o2); }
        };
        auto lstore = [&](int bufi) {
            LAS unsigned char* bp = c.lds + bufi * 45056;
#pragma unroll
            for (int q = 0; q < 5; ++q) *(LAS u32x4*)(bp + q * 8192 + tid * 16) = rr[q];
            if (tid < 256) *(LAS u32x4*)(bp + 40960 + tid * 16) = rv;
        };
        __syncthreads();
        gload(0); lstore(0);
        __syncthreads();
        LAS float* yst = (LAS float*)(c.lds + 90112);
#pragma unroll 1
        for (int s = 0; s < 68; ++s) {
            if (s + 1 < 68) gload(s + 1);
            const LAS unsigned char* bp = c.lds + (s & 1) * 45056;
#pragma unroll 2
            for (int j = 0; j < 64; ++j) {
                const int tl = dir == 0 ? j : 63 - j;
                const u32x2 ur = *(const LAS u32x2*)(bp + tl * 128 + slab * 8), ukk = *(const LAS u32x2*)(bp + 8192 + tl * 128 + slab * 8), ukb = *(const LAS u32x2*)(bp + 16384 + tl * 128 + slab * 8),
                            ulw = *(const LAS u32x2*)(bp + 24576 + tl * 128 + slab * 8), ua = *(const LAS u32x2*)(bp + 32768 + tl * 128 + slab * 8);
                const float vv = bf1(*(const LAS bf16_t*)(bp + 40960 + tl * 64 + rl * 2));
                const float rf[4] = {bflo(ur.x), bfhi(ur.x), bflo(ur.y), bfhi(ur.y)}, kkf[4] = {bflo(ukk.x), bfhi(ukk.x), bflo(ukk.y), bfhi(ukk.y)}, kbf[4] = {bflo(ukb.x), bfhi(ukb.x), bflo(ukb.y), bfhi(ukb.y)},
                            lwf[4] = {bflo(ulw.x), bfhi(ulw.x), bflo(ulw.y), bfhi(ulw.y)}, af[4] = {bflo(ua.x), bfhi(ua.x), bflo(ua.y), bfhi(ua.y)};
                float sk = 0.f;
#pragma unroll
                for (int i = 0; i < 4; ++i) sk += S[i] * kkf[i];
                sk = grp_sum<16>(sk);
                float y = 0.f;
#pragma unroll
                for (int i = 0; i < 4; ++i) { const float w = __expf(lwf[i]), kka = kkf[i] * af[i], kt = kbf[i] * (1.f + (af[i] - 1.f) * ka[i]);
                    S[i] = S[i] * w - sk * kka + vv * kt; y += S[i] * rf[i]; }
                y = grp_sum<16>(y);
                if (slab == 0) yst[tl * 32 + rl] = y;
            }
            __syncthreads();
            {   const int row0 = chunk_row(b, dir, s), tk = tid >> 3, o = (tid & 7) * 4;
                const f32x4 v = *(const LAS f32x4*)(yst + tk * 32 + o);
                u32x2 w; w.x = pk2(v.x, v.y); w.y = pk2(v.z, v.w);
                *(u32x2*)(Y + (size_t)dir * MT * 1024 + (size_t)(row0 + tk) * 1024 + h * 64 + rh * 32 + o) = w;
            }
            if (s + 1 < 68) lstore((s + 1) & 1);
            __syncthreads();
        }
    }
}
__device__ __forceinline__ void ab_output_phase(const Ctx& c) {
    const bf16_t* F = (const bf16_t*)(c.ws + WS_F); const bf16_t* P = (const bf16_t*)(c.ws + WS_P); const bf16_t* GO = (const bf16_t*)(c.ws + WS_GOUT);
    bf16_t* Yo = (bf16_t*)(c.ws + WS_HY);
    const int lane = c.lane;
#pragma unroll 1
    for (int r = c.gw; r < MT; r += c.NGW) {
        const size_t row = (size_t)r;
        u32x4 outw[4];
#pragma unroll
        for (int blk = 0; blk < 2; ++blk) {
            const int ch = blk * 512 + lane * 8;
            float yf[8], yb[8], rv[8], kb[8], vb[8], a0[8], a1[8], go[8];
            unpack8(*(const u32x4*)(Yo + row * D + 1024 + ch), yf); unpack8(*(const u32x4*)(Yo + row * D + ch), yb);
            unpack8(*(const u32x4*)(F + (size_t)3 * MT * 1024 + row * 1024 + ch), rv); unpack8(*(const u32x4*)(F + (size_t)5 * MT * 1024 + row * 1024 + ch), kb);
            unpack8(*(const u32x4*)(F + (size_t)6 * MT * 1024 + row * 1024 + ch), vb);
            unpack8(*(const u32x4*)(P + row * PW0 + 2048 + ch), a0); unpack8(*(const u32x4*)(P + row * PW0 + 3072 + ch), a1);
            unpack8(*(const u32x4*)(GO + row * 1024 + ch), go);
            const f32x4 ka0 = *(const f32x4*)(c.in[IN_KA] + ch), ka1 = *(const f32x4*)(c.in[IN_KA] + ch + 4), rk0 = *(const f32x4*)(c.in[IN_RK] + ch), rk1 = *(const f32x4*)(c.in[IN_RK] + ch + 4);
            const f32x4 lw0 = *(const f32x4*)(c.in[IN_LNW] + ch), lw1 = *(const f32x4*)(c.in[IN_LNW] + ch + 4), lb0 = *(const f32x4*)(c.in[IN_LNB] + ch), lb1 = *(const f32x4*)(c.in[IN_LNB] + ch + 4);
            const float ka[8] = {ka0.x, ka0.y, ka0.z, ka0.w, ka1.x, ka1.y, ka1.z, ka1.w}, rk[8] = {rk0.x, rk0.y, rk0.z, rk0.w, rk1.x, rk1.y, rk1.z, rk1.w};
            const float lnw[8] = {lw0.x, lw0.y, lw0.z, lw0.w, lw1.x, lw1.y, lw1.z, lw1.w}, lnb[8] = {lb0.x, lb0.y, lb0.z, lb0.w, lb1.x, lb1.y, lb1.z, lb1.w};
            float s = 0.f, bs = 0.f;
#pragma unroll
            for (int j = 0; j < 8; ++j) { yf[j] += yb[j]; s += yf[j]; bs += rv[j] * kb[j] * (2.f + (a0[j] + a1[j] - 2.f) * ka[j]) * rk[j]; }
            const float mu = grp_sum<8>(s) * (1.f / 64.f); bs = grp_sum<8>(bs);
            float vs = 0.f;
#pragma unroll
            for (int j = 0; j < 8; ++j) { yf[j] -= mu; vs += yf[j] * yf[j]; }
            const float rstd = 1.f / sqrtf(grp_sum<8>(vs) * (1.f / 64.f) + 64e-5f);
            float o[8];
#pragma unroll
            for (int j = 0; j < 8; ++j) o[j] = (yf[j] * rstd * lnw[j] + lnb[j] + bs * vb[j]) * go[j];
            outw[2 + blk] = pack8(o);
        }
#pragma unroll
        for (int blk = 0; blk < 2; ++blk) {
            const int ch = blk * 512 + lane * 8;
            float of[8], ob[8], z[8];
            unpack8(*(const u32x4*)(P + row * PW0 + 4096 + ch), of); unpack8(*(const u32x4*)(P + row * PW0 + 5120 + ch), ob); unpack8(*(const u32x4*)(P + row * PW0 + 6144 + ch), z);
            const f32x4 n0 = *(const f32x4*)(c.in[IN_GDNNW] + (ch & 127)), n1 = *(const f32x4*)(c.in[IN_GDNNW] + (ch & 127) + 4);
            const float nw[8] = {n0.x, n0.y, n0.z, n0.w, n1.x, n1.y, n1.z, n1.w};
            float ss = 0.f;
#pragma unroll
            for (int j = 0; j < 8; ++j) { of[j] += ob[j]; ss += of[j] * of[j]; }
            const float rstd = 1.f / sqrtf(grp_sum<16>(ss) * (1.f / 128.f) + 1e-6f);
            float o[8];
#pragma unroll
            for (int j = 0; j < 8; ++j) o[j] = of[j] * rstd * nw[j] * silu_fast(z[j]);
            outw[blk] = pack8(o);
        }
#pragma unroll
        for (int q = 0; q < 4; ++q) *(u32x4*)(Yo + row * D + q * 512 + lane * 8) = outw[q];
    }
}

__device__ __forceinline__ void ml_gate_phase(const Ctx& c) {
    const float* T = (const float*)(c.ws + WS_TAIL); float* GA = (float*)(c.ws + WS_GA); float* GB = (float*)(c.ws + WS_GB);
    for (size_t i = (size_t)c.wg * NTHREADS + c.tid; i < (size_t)MT * 16; i += (size_t)c.G * NTHREADS) {
        const size_t r = i >> 4; const int k = (int)(i & 15);
        const float gi = T[r * TW1 + k] + c.in[IN_MLIB][k], gf = T[r * TW1 + 16 + k] + c.in[IN_MLFB][k];
        GA[i] = 15.f * tanhf(gi * (1.f / 15.f));
        GB[i] = logsigm_(15.f * tanhf(gf * (1.f / 15.f)));
    }
}
__device__ __forceinline__ void mlstm_scan_phase(const Ctx& c) {
    const bf16_t* P = (const bf16_t*)(c.ws + WS_P); bf16_t* Hs = (bf16_t*)(c.ws + WS_F);
    const float* GA = (const float*)(c.ws + WS_GA); const float* GB = (const float*)(c.ws + WS_GB);
    const int lane = c.lane, tid = c.tid, slab = lane & 15, cp = c.wave * 4 + (lane >> 4);
    for (int item = c.wg; item < 256; item += c.G) {
        const int chain = item >> 2, cq = item & 3, b = chain >> 4, h = (chain >> 1) & 7, dir = chain & 1;
        float C[8][2], n[8]; float m = 0.f;
#pragma unroll
        for (int i = 0; i < 8; ++i) { C[i][0] = C[i][1] = 0.f; n[i] = 0.f; }
        u32x4 rk[2], rq[2], rv; float rg = 0.f, rb = 0.f;
        auto gload = [&](int s) {
            const int row0 = chunk_row(b, dir, s);
#pragma unroll
            for (int i = 0; i < 2; ++i) { const int pc = tid + i * 512, tk = pc >> 4, o = (pc & 15) * 8;
                rk[i] = *(const u32x4*)(P + (size_t)(row0 + tk) * PW1 + 1024 + h * 128 + o);
                rq[i] = *(const u32x4*)(P + (size_t)(row0 + tk) * PW1 + h * 128 + o); }
            { const int tk = tid >> 3, o = (tid & 7) * 8; rv = *(const u32x4*)(P + (size_t)(row0 + tk) * PW1 + 2048 + h * 256 + cq * 64 + o); }
            if (tid < 64) { rg = GA[(size_t)(row0 + tid) * 16 + dir * 8 + h]; rb = GB[(size_t)(row0 + tid) * 16 + dir * 8 + h]; }
        };
        auto lstore = [&](int bufi) {
            LAS unsigned char* bp = c.lds + bufi * 41472;
#pragma unroll
            for (int i = 0; i < 2; ++i) { const int pc = tid + i * 512; *(LAS u32x4*)(bp + pc * 16) = rk[i]; *(LAS u32x4*)(bp + 16384 + pc * 16) = rq[i]; }
            *(LAS u32x4*)(bp + 32768 + tid * 16) = rv;
            if (tid < 64) { *(LAS float*)(bp + 40960 + tid * 4) = rg; *(LAS float*)(bp + 41216 + tid * 4) = rb; }
        };
        __syncthreads();
        gload(0); lstore(0);
        __syncthreads();
        LAS float* hst = (LAS float*)(c.lds + 82944);
#pragma unroll 1
        for (int s = 0; s < 68; ++s) {
            if (s + 1 < 68) gload(s + 1);
            const LAS unsigned char* bp = c.lds + (s & 1) * 41472;
#pragma unroll 2
            for (int j = 0; j < 64; ++j) {
                const int tl = dir == 0 ? j : 63 - j;
                float kf[8], qf[8];
                unpack8(*(const LAS u32x4*)(bp + tl * 256 + slab * 16), kf);
                unpack8(*(const LAS u32x4*)(bp + 16384 + tl * 256 + slab * 16), qf);
                const unsigned uv = *(const LAS unsigned*)(bp + 32768 + tl * 128 + cp * 4);
                const float v0 = bflo(uv), v1 = bfhi(uv);
                const float ig = *(const LAS float*)(bp + 40960 + tl * 4), lf = *(const LAS float*)(bp + 41216 + tl * 4);
                const float mn = fmaxf(lf + m, ig), fs = __expf(lf + m - mn), is = __expf(ig - mn);
                m = mn;
                float n0 = 0.f, n1 = 0.f, dn = 0.f;
#pragma unroll
                for (int i = 0; i < 8; ++i) { const float ki = is * kf[i], qi = qf[i] * 0.08838834764831845f;
                    C[i][0] = fs * C[i][0] + ki * v0; C[i][1] = fs * C[i][1] + ki * v1; n[i] = fs * n[i] + ki;
                    n0 += C[i][0] * qi; n1 += C[i][1] * qi; dn += n[i] * qi; }
                n0 = grp_sum<16>(n0); n1 = grp_sum<16>(n1); dn = grp_sum<16>(dn);
                if (slab == 0) { const float dd = 1.f / fmaxf(fabsf(dn), __expf(-mn)); hst[tl * 64 + cp * 2] = n0 * dd; hst[tl * 64 + cp * 2 + 1] = n1 * dd; }
            }
            __syncthreads();
            if (s >= 4) {
                const int row0 = chunk_row(b, dir, s), tk = tid >> 3, o = (tid & 7) * 8;
                float v[8];
#pragma unroll
                for (int i = 0; i < 8; ++i) v[i] = hst[tk * 64 + o + i];
                *(u32x4*)(Hs + (size_t)dir * ML * D + (size_t)(row0 + tk) * D + h * 256 + cq * 64 + o) = pack8(v);
            }
            if (s + 1 < 68) lstore((s + 1) & 1);
            __syncthreads();
        }
    }
}
__device__ __forceinline__ void ml_output_phase(const Ctx& c) {
    const bf16_t* Hs = (const bf16_t*)(c.ws + WS_F); const bf16_t* P = (const bf16_t*)(c.ws + WS_P); bf16_t* Yo = (bf16_t*)(c.ws + WS_HY);
    const float* nw = c.in[IN_MLNW];
    for (int r = c.gw; r < ML; r += c.NGW) {
#pragma unroll
        for (int blk = 0; blk < 4; ++blk) {
            const int ch = blk * 512 + c.lane * 8;
            float a[8], bb[8], o[8];
            unpack8(*(const u32x4*)(Hs + (size_t)r * D + ch), a); unpack8(*(const u32x4*)(Hs + (size_t)ML * D + (size_t)r * D + ch), bb);
            unpack8(*(const u32x4*)(P + (size_t)r * PW1 + 4096 + ch), o);
            float ss = 0.f;
#pragma unroll
            for (int j = 0; j < 8; ++j) { a[j] += bb[j]; ss += a[j] * a[j]; }
            ss = grp_sum<32>(ss); const float rstd = 1.f / sqrtf(ss * (1.f / 256.f) + 1e-6f);
            const f32x4 w0 = *(const f32x4*)(nw + ch), w1 = *(const f32x4*)(nw + ch + 4);
            const float wv[8] = {w0.x, w0.y, w0.z, w0.w, w1.x, w1.y, w1.z, w1.w};
#pragma unroll
            for (int j = 0; j < 8; ++j) a[j] = a[j] * rstd * wv[j] * sigm_fast(o[j]);
            *(u32x4*)(Yo + (size_t)r * D + ch) = pack8(a);
        }
    }
}


typedef short bf16x8 __attribute__((ext_vector_type(8)));
typedef short s16x4 __attribute__((ext_vector_type(4)));
#define MFMA16(a, b, c) __builtin_amdgcn_mfma_f32_16x16x32_bf16((a), (b), (c), 0, 0, 0)
__device__ __forceinline__ bf16x8 frag_row(const LAS unsigned char* img, int RS, int r0, int k0, int lane) {
    return *(const LAS bf16x8*)(img + (r0 + (lane & 15)) * RS + (k0 + 8 * (lane >> 4)) * 2);
}
__device__ __forceinline__ bf16x8 frag_tr(const LAS unsigned char* img, int RS, int r0, int k0, int lane) {
    const int g = lane >> 4, q = (lane & 15) >> 2, p = lane & 3;
    LAS unsigned char* a = (LAS unsigned char*)img + (k0 + 8 * g + q) * RS + (r0 + 4 * p) * 2;
    const s16x4 lo = __builtin_amdgcn_ds_read_tr16_b64_v4i16((LAS s16x4*)a);
    const s16x4 hi = __builtin_amdgcn_ds_read_tr16_b64_v4i16((LAS s16x4*)(a + 4 * RS));
    bf16x8 r; r[0] = lo[0]; r[1] = lo[1]; r[2] = lo[2]; r[3] = lo[3]; r[4] = hi[0]; r[5] = hi[1]; r[6] = hi[2]; r[7] = hi[3];
    return r;
}
__device__ __forceinline__ void tile_write(LAS unsigned char* img, int RS, int n0, int m0, int lane, const f32x4 v) {
    u32x2 o; o.x = pk2(v[0], v[1]); o.y = pk2(v[2], v[3]);
    *(LAS u32x2*)(img + (n0 + (lane & 15)) * RS + (m0 + 4 * (lane >> 4)) * 2) = o;
}
constexpr int MS = 68;
__device__ __forceinline__ bf16x8 frag_pack(const f32x4 a, const f32x4 b) { u32x4 u; u.x = pk2(a[0], a[1]); u.y = pk2(a[2], a[3]); u.z = pk2(b[0], b[1]); u.w = pk2(b[2], b[3]); return __builtin_bit_cast(bf16x8, u); }
__device__ __forceinline__ void tri_inverse_64(LAS float* MF, LAS float* TMP, int tid) {
    (void)TMP;
    if (tid < 64) {
        const int lane = tid, g = lane >> 4, i = lane & 15;
        const f32x4 z4 = {0.f, 0.f, 0.f, 0.f};
        {   LAS float* base = MF + (g * 16) * MS + g * 16; float acc[16];
#pragma unroll
            for (int r = 0; r < 16; ++r) acc[r] = (r == i) ? 1.f : 0.f;
#pragma unroll
            for (int j = 0; j < 15; ++j) { const float xj = acc[j];
#pragma unroll
                for (int r = j + 1; r < 16; ++r) acc[r] -= base[r * MS + j] * xj; }
#pragma unroll
            for (int r = 0; r < 16; ++r) base[r * MS + i] = acc[r];
        }
#pragma unroll
        for (int h = 0; h < 2; ++h) {
            const int R0 = h ? 48 : 16, C0 = h ? 32 : 0;
            bf16x8 a1, b1;
            {   const LAS float* pa = MF + (R0 + i) * MS + C0 + 8 * (g & 1);
                const f32x4 x0 = *(const LAS f32x4*)pa, x1 = *(const LAS f32x4*)(pa + 4);
                f32x4 y0, y1;
#pragma unroll
                for (int j = 0; j < 4; ++j) { y0[j] = MF[(C0 + 8 * (g & 1) + j) * MS + C0 + i]; y1[j] = MF[(C0 + 8 * (g & 1) + 4 + j) * MS + C0 + i]; }
                a1 = g < 2 ? frag_pack(x0, x1) : frag_pack(z4, z4); b1 = g < 2 ? frag_pack(y0, y1) : frag_pack(z4, z4); }
            const f32x4 t = MFMA16(a1, b1, z4);
            const f32x4 xa = *(const LAS f32x4*)(MF + (R0 + i) * MS + R0 + 4 * g);
            const f32x4 x = MFMA16(frag_pack(xa, z4), frag_pack(t, z4), z4);
#pragma unroll
            for (int r = 0; r < 4; ++r) MF[(R0 + 4 * g + r) * MS + C0 + i] = -x[r];
        }
        {   bf16x8 a[2], b[2];
#pragma unroll
            for (int I = 0; I < 2; ++I) { const LAS float* pa = MF + (32 + 16 * I + i) * MS + 8 * g; a[I] = frag_pack(*(const LAS f32x4*)pa, *(const LAS f32x4*)(pa + 4)); }
#pragma unroll
            for (int J = 0; J < 2; ++J) { f32x4 y0, y1;
#pragma unroll
                for (int j = 0; j < 4; ++j) { y0[j] = MF[(8 * g + j) * MS + 16 * J + i]; y1[j] = MF[(8 * g + 4 + j) * MS + 16 * J + i]; }
                b[J] = frag_pack(y0, y1); }
            f32x4 t[2][2];
#pragma unroll
            for (int I = 0; I < 2; ++I)
#pragma unroll
                for (int J = 0; J < 2; ++J) t[I][J] = MFMA16(a[I], b[J], z4);
            bf16x8 a2[2];
#pragma unroll
            for (int I = 0; I < 2; ++I) { const LAS float* pa = MF + (32 + 16 * I + i) * MS + 32 + 4 * g; a2[I] = frag_pack(*(const LAS f32x4*)pa, *(const LAS f32x4*)(pa + 16)); }
#pragma unroll
            for (int I = 0; I < 2; ++I)
#pragma unroll
                for (int J = 0; J < 2; ++J) { const f32x4 x = MFMA16(a2[I], frag_pack(t[0][J], t[1][J]), z4);
#pragma unroll
                    for (int r = 0; r < 4; ++r) MF[(32 + 16 * I + 4 * g + r) * MS + 16 * J + i] = -x[r]; }
        }
    }
    __syncthreads();
}
__device__ __forceinline__ float wave_incl_scan_add(float x, int lane) {
#pragma unroll
    for (int o = 1; o < 64; o <<= 1) { const float t = __shfl_up(x, o); if (lane >= o) x += t; }
    return x;
}
__device__ __forceinline__ float wave_incl_scan_max(float x, int lane) {
#pragma unroll
    for (int o = 1; o < 64; o <<= 1) { const float t = __shfl_up(x, o); if (lane >= o) x = fmaxf(x, t); }
    return x;
}
constexpr int RS128 = 272, RS64 = 144, RS80 = 176;

__device__ __forceinline__ void mlstm_chunk_phase(const Ctx& c) {
    const bf16_t* P = (const bf16_t*)(c.ws + WS_P); bf16_t* Hs = (bf16_t*)(c.ws + WS_F);
    const float* GA = (const float*)(c.ws + WS_GA); const float* GB = (const float*)(c.ws + WS_GB);
    const int lane = c.lane, tid = c.tid, w = c.wave, g4 = lane >> 4, l15 = lane & 15;
    LAS unsigned char* KIMG = c.lds; LAS unsigned char* QIMG = c.lds + 17408; LAS unsigned char* VIMG = c.lds + 34816; LAS unsigned char* VS = c.lds + 46080;
    LAS unsigned char* SM = c.lds + 57344; LAS unsigned char* CT = c.lds + 66560;
    LAS float* sB = (LAS float*)(c.lds + 88320); LAS float* sCM = sB + 64; LAS float* sIGB = sB + 128;
    for (int item = c.wg; item < 256; item += c.G) {
        const int chain = item >> 2, cq = item & 3, b = chain >> 4, h = (chain >> 1) & 7, dir = chain & 1;
        f32x4 st[5];
#pragma unroll
        for (int e = 0; e < 5; ++e) st[e] = (f32x4){0.f, 0.f, 0.f, 0.f};
        float m = 0.f;
        u32x4 rk[2], rq[2], rv; float rg = 0.f, rb = 0.f;
        auto gload = [&](int s) {
            const int row0 = chunk_row(b, dir, s);
#pragma unroll
            for (int i = 0; i < 2; ++i) { const int pc = tid + i * 512, tk = pc >> 4, o = (pc & 15) * 8;
                rk[i] = *(const u32x4*)(P + (size_t)(row0 + tk) * PW1 + 1024 + h * 128 + o);
                rq[i] = *(const u32x4*)(P + (size_t)(row0 + tk) * PW1 + h * 128 + o); }
            { const int tk = tid >> 3, o = (tid & 7) * 8; rv = *(const u32x4*)(P + (size_t)(row0 + tk) * PW1 + 2048 + h * 256 + cq * 64 + o); }
            if (tid < 64) { const float* tp = (const float*)(c.ws + WS_TAIL) + (size_t)(row0 + tid) * TW1 + dir * 8 + h;
                rg = 15.f * tanhf((tp[0] + c.in[IN_MLIB][dir * 8 + h]) * (1.f / 15.f)); rb = logsigm_(15.f * tanhf((tp[16] + c.in[IN_MLFB][dir * 8 + h]) * (1.f / 15.f))); }
        };
        __syncthreads();
        for (int i = tid; i < 80 * 34; i += NTHREADS) ((LAS u32x2*)CT)[i] = (u32x2){0u, 0u};
        gload(0);
#pragma unroll 1
        for (int s = 0; s < 68; ++s) {
#pragma unroll
            for (int i = 0; i < 2; ++i) { const int pc = tid + i * 512, tk = pc >> 4, o = pc & 15, ri = dir ? 63 - tk : tk;
                *(LAS u32x4*)(KIMG + ri * RS128 + o * 16) = rk[i]; *(LAS u32x4*)(QIMG + ri * RS128 + o * 16) = rq[i]; }
            { const int tk = tid >> 3, o = tid & 7, ri = dir ? 63 - tk : tk; *(LAS u32x4*)(VIMG + ri * RS80 + o * 16) = rv;
              if (o == 0) { *(LAS u32x4*)(VIMG + ri * RS80 + 128) = (u32x4){0x3F80u, 0u, 0u, 0u}; *(LAS u32x4*)(VIMG + ri * RS80 + 144) = (u32x4){0u, 0u, 0u, 0u}; } }
            if (w == 0) {
                const int src = dir ? 63 - lane : lane;
                const float ig = __shfl(rg, src), lf = __shfl(rb, src);
                const float bb = wave_incl_scan_add(lf, lane), igb = ig - bb, cm = wave_incl_scan_max(igb, lane);
                sB[lane] = bb; sCM[lane] = cm; sIGB[lane] = igb;
            }
            __syncthreads();
            if (s + 1 < 68) gload(s + 1);
            const float c63 = sCM[63], blast = sB[63], mx63 = fmaxf(m, c63);
            const float cscale = __expf(m - mx63);
            if (s >= 4) {
                const int ib = w >> 1;
                bf16x8 bq[4];
#pragma unroll
                for (int k = 0; k < 4; ++k) bq[k] = frag_row(QIMG, RS128, ib * 16, k * 32, lane);
                const float mxi = fmaxf(m, sCM[ib * 16 + l15]);
#pragma unroll
                for (int t = 0; t < 2; ++t) { const int jb = (w & 1) * 2 + t; f32x4 acc = {0.f, 0.f, 0.f, 0.f};
#pragma unroll
                    for (int k = 0; k < 4; ++k) acc = MFMA16(frag_row(KIMG, RS128, jb * 16, k * 32, lane), bq[k], acc);
                    const int i = ib * 16 + l15;
#pragma unroll
                    for (int r = 0; r < 4; ++r) { const int j = jb * 16 + 4 * g4 + r; acc[r] = (j <= i) ? acc[r] * 0.08838834764831845f * __expf(sIGB[j] - mxi) : 0.f; }
                    tile_write(SM, RS64, ib * 16, jb * 16, lane, acc); }
            }
            for (int pc = tid; pc < 640; pc += NTHREADS) { const int j = pc / 10, o = pc % 10; const float f = __expf(sIGB[j] - mx63);
                float v[8]; unpack8(*(const LAS u32x4*)(VIMG + j * RS80 + o * 16), v);
#pragma unroll
                for (int q = 0; q < 8; ++q) v[q] *= f;
                *(LAS u32x4*)(VS + j * RS80 + o * 16) = pack8(v); }
            __syncthreads();
            if (s >= 4) {
                const int ib = w & 3, eh = w >> 2, i = ib * 16 + l15;
                const float mxi = fmaxf(m, sCM[i]), inter = __expf(m - mxi) * 0.08838834764831845f, floorv = __expf(-(sB[i] + mxi));
                bf16x8 bs[2], bq[4];
#pragma unroll
                for (int k = 0; k < 2; ++k) bs[k] = frag_row(SM, RS64, ib * 16, k * 32, lane);
#pragma unroll
                for (int k = 0; k < 4; ++k) bq[k] = frag_row(QIMG, RS128, ib * 16, k * 32, lane);
                f32x4 val[3];
#pragma unroll
                for (int t = 0; t < 3; ++t) { const int eb = t < 2 ? eh * 2 + t : 4; f32x4 a1 = {0.f, 0.f, 0.f, 0.f}, a2 = {0.f, 0.f, 0.f, 0.f};
#pragma unroll
                    for (int k = 0; k < 2; ++k) a1 = MFMA16(frag_tr(VIMG, RS80, eb * 16, k * 32, lane), bs[k], a1);
#pragma unroll
                    for (int k = 0; k < 4; ++k) a2 = MFMA16(frag_row(CT, RS128, eb * 16, k * 32, lane), bq[k], a2);
                    val[t] = a1 + a2 * inter; }
                const float den = __shfl(val[2][0], l15);
                const float dd = 1.f / fmaxf(fabsf(den), floorv);
                const int tl = dir ? 63 - i : i, row0 = chunk_row(b, dir, s);
#pragma unroll
                for (int t = 0; t < 2; ++t) { const int e0 = (eh * 2 + t) * 16 + 4 * g4; u32x2 o; o.x = pk2(val[t][0] * dd, val[t][1] * dd); o.y = pk2(val[t][2] * dd, val[t][3] * dd);
                    *(u32x2*)(Hs + (size_t)dir * ML * D + (size_t)(row0 + tl) * D + h * 256 + cq * 64 + e0) = o; }
            }
            {   bf16x8 ak[2];
#pragma unroll
                for (int k = 0; k < 2; ++k) ak[k] = frag_tr(KIMG, RS128, w * 16, k * 32, lane);
#pragma unroll
                for (int e = 0; e < 5; ++e) { st[e] = st[e] * cscale;
#pragma unroll
                    for (int k = 0; k < 2; ++k) st[e] = MFMA16(ak[k], frag_tr(VS, RS80, e * 16, k * 32, lane), st[e]); }
            }
            m = blast + mx63;
            __syncthreads();
#pragma unroll
            for (int e = 0; e < 5; ++e) tile_write(CT, RS128, e * 16, w * 16, lane, st[e]);
        }
    }
}

__device__ __forceinline__ void gdn_chunk_items(const Ctx& c, int item0, int item_stride, int n_items) {
    const bf16_t* F = (const bf16_t*)(c.ws + WS_F); bf16_t* P = (bf16_t*)(c.ws + WS_P);
    const float* GA = (const float*)(c.ws + WS_GA); const float* GB = (const float*)(c.ws + WS_GB);
    const int lane = c.lane, tid = c.tid, w = c.wave, g4 = lane >> 4, l15 = lane & 15;
    LAS unsigned char* KIMG = c.lds; LAS unsigned char* QIMG = c.lds + 17408; LAS unsigned char* VIMG = c.lds + 34816; LAS unsigned char* ST = c.lds + 44032;
    LAS unsigned char* WIMG = c.lds + 61440; LAS unsigned char* QKM = c.lds + 78848; LAS unsigned char* VNT = c.lds + 88064; LAS unsigned char* VNS = c.lds + 97280;
    LAS unsigned char* TW = c.lds + 106496; LAS unsigned char* TU = c.lds + 115712; LAS float* MF = (LAS float*)(c.lds + 124928); LAS float* TMP = (LAS float*)VNT;
    LAS float* sGC = (LAS float*)(c.lds + 142336); LAS float* sEG = sGC + 64; LAS float* sEL = sGC + 128; LAS float* sBT = sGC + 192; LAS float* sBG = sGC + 256;
    for (int item = item0; item < n_items; item += item_stride) {
        const int chain = item >> 1, eh = item & 1, b = chain >> 4, h = (chain >> 1) & 7, dir = chain & 1;
        f32x4 st[4];
#pragma unroll
        for (int e = 0; e < 4; ++e) st[e] = (f32x4){0.f, 0.f, 0.f, 0.f};
        u32x4 rk[2], rq[2], rv; float rg = 0.f, rb = 0.f;
        auto gload = [&](int s) {
            const int row0 = chunk_row(b, dir, s);
#pragma unroll
            for (int i = 0; i < 2; ++i) { const int pc = tid + i * 512, tk = pc >> 4, o = (pc & 15) * 8;
                rk[i] = *(const u32x4*)(F + (size_t)1 * MT * 1024 + (size_t)(row0 + tk) * 1024 + h * 128 + o);
                rq[i] = *(const u32x4*)(F + (size_t)0 * MT * 1024 + (size_t)(row0 + tk) * 1024 + h * 128 + o); }
            { const int tk = tid >> 3, o = (tid & 7) * 8; rv = *(const u32x4*)(F + (size_t)2 * MT * 1024 + (size_t)(row0 + tk) * 1024 + h * 128 + eh * 64 + o); }
            if (tid < 64) { rg = GA[(size_t)(row0 + tid) * 16 + dir * 8 + h]; rb = GB[(size_t)(row0 + tid) * 16 + dir * 8 + h]; }
        };
        __syncthreads();
        for (int i = tid; i < 64 * 34; i += NTHREADS) ((LAS u32x2*)ST)[i] = (u32x2){0u, 0u};
        gload(0);
#pragma unroll 1
        for (int s = 0; s < 68; ++s) {
#pragma unroll
            for (int i = 0; i < 2; ++i) { const int pc = tid + i * 512, tk = pc >> 4, o = pc & 15, ri = dir ? 63 - tk : tk;
                *(LAS u32x4*)(KIMG + ri * RS128 + o * 16) = rk[i]; *(LAS u32x4*)(QIMG + ri * RS128 + o * 16) = rq[i]; }
            { const int tk = tid >> 3, o = tid & 7, ri = dir ? 63 - tk : tk; *(LAS u32x4*)(VIMG + ri * RS64 + o * 16) = rv; }
            if (w == 0) {
                const int src = dir ? 63 - lane : lane;
                const float gg = __shfl(rg, src), bt = __shfl(rb, src);
                const float gc = wave_incl_scan_add(gg, lane), gl = __shfl(gc, 63), eg = __expf(gc);
                sGC[lane] = gc; sEG[lane] = eg; sEL[lane] = __expf(gl - gc); sBT[lane] = bt; sBG[lane] = bt * eg;
            }
            __syncthreads();
            if (s + 1 < 68) gload(s + 1);
            {   const int ib = w >> 1, i = ib * 16 + l15; const float gci = sGC[i], bti = sBT[i];
                bf16x8 bk[4], bq[4];
#pragma unroll
                for (int k = 0; k < 4; ++k) { bk[k] = frag_row(KIMG, RS128, ib * 16, k * 32, lane); bq[k] = frag_row(QIMG, RS128, ib * 16, k * 32, lane); }
#pragma unroll
                for (int t = 0; t < 2; ++t) { const int jb = (w & 1) * 2 + t; f32x4 a1 = {0.f, 0.f, 0.f, 0.f}, a2 = {0.f, 0.f, 0.f, 0.f};
#pragma unroll
                    for (int k = 0; k < 4; ++k) { const bf16x8 aj = frag_row(KIMG, RS128, jb * 16, k * 32, lane); a1 = MFMA16(aj, bk[k], a1); a2 = MFMA16(aj, bq[k], a2); }
                    f32x4 mv;
#pragma unroll
                    for (int r = 0; r < 4; ++r) { const int j = jb * 16 + 4 * g4 + r; const float dec = __expf(gci - sGC[j]);
                        mv[r] = (j < i) ? bti * a1[r] * dec : 0.f; a2[r] = (j <= i) ? a2[r] * dec : 0.f; }
                    *(LAS f32x4*)(MF + i * MS + jb * 16 + 4 * g4) = mv;
                    tile_write(QKM, RS64, ib * 16, jb * 16, lane, a2); }
            }
            __syncthreads();
            tri_inverse_64(MF, TMP, tid);
            {   const int i = tid >> 3, j8 = (tid & 7) * 8; float tw[8], tu[8];
#pragma unroll
                for (int q = 0; q < 8; ++q) { const float x = MF[i * MS + j8 + q]; tw[q] = x * sBG[j8 + q]; tu[q] = x * sBT[j8 + q]; }
                *(LAS u32x4*)(TW + i * RS64 + j8 * 2) = pack8(tw); *(LAS u32x4*)(TU + i * RS64 + j8 * 2) = pack8(tu); }
            __syncthreads();
            f32x4 ut[2];
            {   const int ib = w >> 1;
                bf16x8 au[2];
#pragma unroll
                for (int k = 0; k < 2; ++k) au[k] = frag_row(TU, RS64, ib * 16, k * 32, lane);
#pragma unroll
                for (int t = 0; t < 2; ++t) { const int eb = (w & 1) * 2 + t; ut[t] = (f32x4){0.f, 0.f, 0.f, 0.f};
#pragma unroll
                    for (int k = 0; k < 2; ++k) ut[t] = MFMA16(au[k], frag_tr(VIMG, RS64, eb * 16, k * 32, lane), ut[t]); }
                bf16x8 akt[2];
#pragma unroll
                for (int k = 0; k < 2; ++k) akt[k] = frag_tr(KIMG, RS128, w * 16, k * 32, lane);
#pragma unroll
                for (int i2 = 0; i2 < 4; ++i2) { f32x4 a = {0.f, 0.f, 0.f, 0.f};
#pragma unroll
                    for (int k = 0; k < 2; ++k) a = MFMA16(akt[k], frag_row(TW, RS64, i2 * 16, k * 32, lane), a);
                    tile_write(WIMG, RS128, i2 * 16, w * 16, lane, a); }
            }
            __syncthreads();
            {   const int ib = w >> 1;
                bf16x8 aw[4];
#pragma unroll
                for (int k = 0; k < 4; ++k) aw[k] = frag_row(WIMG, RS128, ib * 16, k * 32, lane);
#pragma unroll
                for (int t = 0; t < 2; ++t) { const int eb = (w & 1) * 2 + t; f32x4 a = {0.f, 0.f, 0.f, 0.f};
#pragma unroll
                    for (int k = 0; k < 4; ++k) a = MFMA16(aw[k], frag_row(ST, RS128, eb * 16, k * 32, lane), a);
                    f32x4 vn = ut[t] - a, vs;
#pragma unroll
                    for (int r = 0; r < 4; ++r) vs[r] = vn[r] * sEL[ib * 16 + 4 * g4 + r];
                    tile_write(VNT, RS64, eb * 16, ib * 16, lane, vn); tile_write(VNS, RS64, eb * 16, ib * 16, lane, vs); }
            }
            __syncthreads();
            {   const int eb = w >> 1, row0 = chunk_row(b, dir, s);
                bf16x8 as[4], av[2];
#pragma unroll
                for (int k = 0; k < 4; ++k) as[k] = frag_row(ST, RS128, eb * 16, k * 32, lane);
#pragma unroll
                for (int k = 0; k < 2; ++k) av[k] = frag_row(VNT, RS64, eb * 16, k * 32, lane);
#pragma unroll
                for (int t = 0; t < 2; ++t) { const int ib = (w & 1) * 2 + t, i = ib * 16 + l15; f32x4 a = {0.f, 0.f, 0.f, 0.f};
#pragma unroll
                    for (int k = 0; k < 4; ++k) a = MFMA16(as[k], frag_row(QIMG, RS128, ib * 16, k * 32, lane), a);
                    a = a * sEG[i];
#pragma unroll
                    for (int k = 0; k < 2; ++k) a = MFMA16(av[k], frag_row(QKM, RS64, ib * 16, k * 32, lane), a);
                    const int tl = dir ? 63 - i : i; u32x2 o; o.x = pk2(a[0], a[1]); o.y = pk2(a[2], a[3]);
                    *(u32x2*)(P + (size_t)(row0 + tl) * PW0 + (4 + dir) * 1024 + h * 128 + eh * 64 + eb * 16 + 4 * g4) = o; }
                const float al = __expf(sGC[63]);
                bf16x8 akt[2];
#pragma unroll
                for (int k = 0; k < 2; ++k) akt[k] = frag_tr(KIMG, RS128, w * 16, k * 32, lane);
#pragma unroll
                for (int e = 0; e < 4; ++e) { st[e] = st[e] * al;
#pragma unroll
                    for (int k = 0; k < 2; ++k) st[e] = MFMA16(akt[k], frag_row(VNS, RS64, e * 16, k * 32, lane), st[e]); }
            }
            __syncthreads();
#pragma unroll
            for (int e = 0; e < 4; ++e) tile_write(ST, RS128, e * 16, w * 16, lane, st[e]);
        }
    }
}

__device__ __forceinline__ void rwkv_chunk_items(const Ctx& c, int item0, int item_stride, int n_items, bf16_t* Ybase, long ydir_stride, int ystride) {
    const bf16_t* F = (const bf16_t*)(c.ws + WS_F); const bf16_t* P = (const bf16_t*)(c.ws + WS_P);
    const int lane = c.lane, tid = c.tid, w = c.wave, g4 = lane >> 4, l15 = lane & 15;
    LAS unsigned char* KKP = c.lds; LAS unsigned char* RP = c.lds + 9216; LAS unsigned char* KTD = c.lds + 18432; LAS unsigned char* KADN = c.lds + 27648;
    LAS unsigned char* VIMG = c.lds + 36864; LAS unsigned char* ST = c.lds + 46080; LAS unsigned char* ART = c.lds + 55296; LAS unsigned char* ARAN = c.lds + 64512;
    LAS unsigned char* TI = c.lds + 73728; LAS unsigned char* KTI = c.lds + 82944; LAS unsigned char* KAI = c.lds + 92160; LAS unsigned char* AKT = c.lds + 101376;
    LAS unsigned char* TMPVT = KTI; LAS unsigned char* WK = KAI; LAS unsigned char* UT = AKT;
    LAS float* MF = (LAS float*)(c.lds + 110592); LAS float* LP = MF; LAS float* TMP = (LAS float*)(c.lds + 128000); LAS float* sPC = (LAS float*)(c.lds + 132096);
    for (int item = item0; item < n_items; item += item_stride) {
        const int chain = item, b = chain >> 5, h = (chain >> 1) & 15, dir = chain & 1;
        f32x4 st[2] = {{0.f, 0.f, 0.f, 0.f}, {0.f, 0.f, 0.f, 0.f}};
        const int tk = tid >> 3, o8 = tid & 7, ri = dir ? 63 - tk : tk;
        float kav[8];
        { const f32x4 k0 = *(const f32x4*)(c.in[IN_KA] + h * 64 + o8 * 8), k1 = *(const f32x4*)(c.in[IN_KA] + h * 64 + o8 * 8 + 4);
          kav[0] = k0.x; kav[1] = k0.y; kav[2] = k0.z; kav[3] = k0.w; kav[4] = k1.x; kav[5] = k1.y; kav[6] = k1.z; kav[7] = k1.w; }
        u32x4 rr[5], rv;
        auto gload = [&](int s) {
            const int row0 = chunk_row(b, dir, s); const int o = o8 * 8;
            rr[0] = *(const u32x4*)(F + (size_t)3 * MT * 1024 + (size_t)(row0 + tk) * 1024 + h * 64 + o);
            rr[1] = *(const u32x4*)(F + (size_t)4 * MT * 1024 + (size_t)(row0 + tk) * 1024 + h * 64 + o);
            rr[2] = *(const u32x4*)(F + (size_t)5 * MT * 1024 + (size_t)(row0 + tk) * 1024 + h * 64 + o);
            rr[3] = *(const u32x4*)(P + (size_t)(row0 + tk) * PW0 + (0 + dir) * 1024 + h * 64 + o);
            rr[4] = *(const u32x4*)(P + (size_t)(row0 + tk) * PW0 + (2 + dir) * 1024 + h * 64 + o);
            rv = *(const u32x4*)(F + (size_t)6 * MT * 1024 + (size_t)(row0 + tk) * 1024 + h * 64 + o);
        };
        __syncthreads();
        for (int i = tid; i < 64 * 18; i += NTHREADS) ((LAS u32x2*)ST)[i] = (u32x2){0u, 0u};
        gload(0);
#pragma unroll 1
        for (int s = 0; s < 68; ++s) {
            float lwf[8]; unpack8(rr[3], lwf);
            *(LAS f32x4*)(LP + ri * 64 + o8 * 8) = (f32x4){lwf[0], lwf[1], lwf[2], lwf[3]}; *(LAS f32x4*)(LP + ri * 64 + o8 * 8 + 4) = (f32x4){lwf[4], lwf[5], lwf[6], lwf[7]};
            __syncthreads();
            {   const int k = tid & 63, seg = tid >> 6; float x[8]; float run = 0.f;
#pragma unroll
                for (int i = 0; i < 8; ++i) { run += LP[(seg * 8 + i) * 64 + k]; x[i] = run; }
                TMP[seg * 64 + k] = run;
                __syncthreads();
                float off = 0.f;
#pragma unroll
                for (int q = 0; q < 8; ++q) off += (q < seg) ? TMP[q * 64 + k] : 0.f;
#pragma unroll
                for (int i = 0; i < 8; ++i) LP[(seg * 8 + i) * 64 + k] = x[i] + off;
            }
            __syncthreads();
            {
                float rf[8], kkf[8], kbf[8], af[8], lp[8], lpm[8], lpc[8];
                unpack8(rr[0], rf); unpack8(rr[1], kkf); unpack8(rr[2], kbf); unpack8(rr[4], af);
#pragma unroll
                for (int q = 0; q < 8; ++q) { lp[q] = LP[ri * 64 + o8 * 8 + q]; lpm[q] = ri > 0 ? LP[(ri - 1) * 64 + o8 * 8 + q] : 0.f; lpc[q] = LP[63 * 64 + o8 * 8 + q]; }
                float i0[8], i1[8], i2[8], i3[8], i4[8], i5[8];
#pragma unroll
                for (int q = 0; q < 8; ++q) { const float kt = kbf[q] * (1.f + (af[q] - 1.f) * kav[q]), kka = kkf[q] * af[q];
                    const float ei = __expf(-lp[q]), ed = __expf(lpc[q] - lp[q]);
                    i0[q] = kkf[q] * __expf(lpm[q]); i1[q] = rf[q] * __expf(lp[q]); i2[q] = kt * ei; i3[q] = kka * ei; i4[q] = kt * ed; i5[q] = -kka * ed; }
                const int off = ri * RS64 + o8 * 16;
                *(LAS u32x4*)(KKP + off) = pack8(i0); *(LAS u32x4*)(RP + off) = pack8(i1); *(LAS u32x4*)(KTI + off) = pack8(i2); *(LAS u32x4*)(KAI + off) = pack8(i3);
                *(LAS u32x4*)(KTD + off) = pack8(i4); *(LAS u32x4*)(KADN + off) = pack8(i5); *(LAS u32x4*)(VIMG + off) = rv;
                if (ri == 63) {
#pragma unroll
                    for (int q = 0; q < 8; ++q) sPC[o8 * 8 + q] = __expf(lpc[q]); }
            }
            __syncthreads();
            if (s + 1 < 68) gload(s + 1);
            {   const int tb = w >> 1, t = tb * 16 + l15;
                bf16x8 bkk[2], brp[2];
#pragma unroll
                for (int k = 0; k < 2; ++k) { bkk[k] = frag_row(KKP, RS64, tb * 16, k * 32, lane); brp[k] = frag_row(RP, RS64, tb * 16, k * 32, lane); }
#pragma unroll
                for (int q = 0; q < 2; ++q) { const int sb = (w & 1) * 2 + q; f32x4 aka = {0.f, 0.f, 0.f, 0.f}, akt = aka, ara = aka, art = aka;
#pragma unroll
                    for (int k = 0; k < 2; ++k) { const bf16x8 fa = frag_row(KAI, RS64, sb * 16, k * 32, lane), ft = frag_row(KTI, RS64, sb * 16, k * 32, lane);
                        aka = MFMA16(fa, bkk[k], aka); akt = MFMA16(ft, bkk[k], akt); ara = MFMA16(fa, brp[k], ara); art = MFMA16(ft, brp[k], art); }
#pragma unroll
                    for (int r = 0; r < 4; ++r) { const int ss = sb * 16 + 4 * g4 + r;
                        aka[r] = ss < t ? aka[r] : 0.f; akt[r] = ss < t ? akt[r] : 0.f; ara[r] = ss <= t ? -ara[r] : 0.f; art[r] = ss <= t ? art[r] : 0.f; }
                    tile_write(AKT, RS64, tb * 16, sb * 16, lane, akt); tile_write(ARAN, RS64, tb * 16, sb * 16, lane, ara); tile_write(ART, RS64, tb * 16, sb * 16, lane, art);
                    *(LAS f32x4*)(MF + t * MS + sb * 16 + 4 * g4) = aka; }
            }
            __syncthreads();
            tri_inverse_64(MF, TMP, tid);
            {   const int i = tid >> 3, j8 = (tid & 7) * 8; float x[8];
#pragma unroll
                for (int q = 0; q < 8; ++q) x[q] = MF[i * MS + j8 + q];
                *(LAS u32x4*)(TI + i * RS64 + j8 * 2) = pack8(x); }
            __syncthreads();
            f32x4 y0[2], u0[2];
            {   const int hb = w >> 1;
                bf16x8 aa[2], akk[2], av[2];
#pragma unroll
                for (int k = 0; k < 2; ++k) { aa[k] = frag_row(AKT, RS64, hb * 16, k * 32, lane); akk[k] = frag_tr(KKP, RS64, hb * 16, k * 32, lane); av[k] = frag_tr(VIMG, RS64, hb * 16, k * 32, lane); }
#pragma unroll
                for (int q = 0; q < 2; ++q) { const int ob = (w & 1) * 2 + q; f32x4 a = {0.f, 0.f, 0.f, 0.f}, bq = a; y0[q] = a;
#pragma unroll
                    for (int k = 0; k < 2; ++k) { a = MFMA16(aa[k], frag_tr(VIMG, RS64, ob * 16, k * 32, lane), a);
                        const bf16x8 fti = frag_row(TI, RS64, ob * 16, k * 32, lane);
                        bq = MFMA16(akk[k], fti, bq);
                        y0[q] = MFMA16(av[k], frag_row(ART, RS64, ob * 16, k * 32, lane), y0[q]); }
                    tile_write(TMPVT, RS64, ob * 16, hb * 16, lane, a); tile_write(WK, RS64, ob * 16, hb * 16, lane, bq); }
            }
            __syncthreads();
            {   const int tb = w >> 1;
                bf16x8 at[2], awk[2];
#pragma unroll
                for (int k = 0; k < 2; ++k) { at[k] = frag_row(TI, RS64, tb * 16, k * 32, lane); awk[k] = frag_row(WK, RS64, tb * 16, k * 32, lane); }
#pragma unroll
                for (int q = 0; q < 2; ++q) { const int vb = (w & 1) * 2 + q; u0[q] = (f32x4){0.f, 0.f, 0.f, 0.f};
#pragma unroll
                    for (int k = 0; k < 2; ++k) { u0[q] = MFMA16(at[k], frag_row(TMPVT, RS64, vb * 16, k * 32, lane), u0[q]); u0[q] = MFMA16(awk[k], frag_row(ST, RS64, vb * 16, k * 32, lane), u0[q]); }
                }
            }
            {   const int tb = w >> 1;
#pragma unroll
                for (int q = 0; q < 2; ++q) tile_write(UT, RS64, ((w & 1) * 2 + q) * 16, tb * 16, lane, u0[q]); }
            __syncthreads();
            {   const int hb = w >> 1, row0 = chunk_row(b, dir, s);
                bf16x8 as[2], au[2], aktd[2], akad[2];
#pragma unroll
                for (int k = 0; k < 2; ++k) { as[k] = frag_row(ST, RS64, hb * 16, k * 32, lane); au[k] = frag_row(UT, RS64, hb * 16, k * 32, lane);
                    aktd[k] = frag_tr(KTD, RS64, hb * 16, k * 32, lane); akad[k] = frag_tr(KADN, RS64, hb * 16, k * 32, lane); }
#pragma unroll
                for (int q = 0; q < 2; ++q) { const int ob = (w & 1) * 2 + q; f32x4 a = y0[q];
#pragma unroll
                    for (int k = 0; k < 2; ++k) { a = MFMA16(as[k], frag_row(RP, RS64, ob * 16, k * 32, lane), a); a = MFMA16(au[k], frag_row(ARAN, RS64, ob * 16, k * 32, lane), a); }
                    const int t = ob * 16 + l15, tl = dir ? 63 - t : t; u32x2 o; o.x = pk2(a[0], a[1]); o.y = pk2(a[2], a[3]);
                    *(u32x2*)(Ybase + (long)dir * ydir_stride + (size_t)(row0 + tl) * ystride + h * 64 + hb * 16 + 4 * g4) = o;
#pragma unroll
                    for (int r = 0; r < 4; ++r) st[q][r] *= sPC[hb * 16 + 4 * g4 + r];
#pragma unroll
                    for (int k = 0; k < 2; ++k) { st[q] = MFMA16(aktd[k], frag_tr(VIMG, RS64, ob * 16, k * 32, lane), st[q]); st[q] = MFMA16(akad[k], frag_row(UT, RS64, ob * 16, k * 32, lane), st[q]); } }
            }
            __syncthreads();
            {   const int hb = w >> 1;
#pragma unroll
                for (int q = 0; q < 2; ++q) tile_write(ST, RS64, ((w & 1) * 2 + q) * 16, hb * 16, lane, st[q]); }
        }
    }
}

#ifndef GEMM_ALIGN
#define GEMM_ALIGN true
#endif
#ifndef GEMM_SP2
#define GEMM_SP2 true
#endif
#ifndef USE_CHUNK_ML
#define USE_CHUNK_ML 1
#endif
#ifndef USE_CHUNK_GDN
#define USE_CHUNK_GDN 1
#endif
#ifndef USE_CHUNK_RWKV
#define USE_CHUNK_RWKV 1
#endif
struct Args { const float* in[32]; float* out; unsigned char* ws; int ph_lo, ph_hi; };
constexpr int NPHASE = 24;
__global__ void __launch_bounds__(NTHREADS, 2) fwd_kernel(Args args) {
    extern __shared__ __attribute__((aligned(16))) unsigned char lds_raw[];
    Ctx c;
    c.lds = (LAS unsigned char*)lds_raw;
    c.tid = threadIdx.x; c.lane = c.tid & 63; c.wave = __builtin_amdgcn_readfirstlane(c.tid >> 6);
    c.G = gridDim.x; c.wg = blockIdx.x; c.gw = c.wg * NWAVES + c.wave; c.NGW = c.G * NWAVES;
#pragma unroll
    for (int i = 0; i < 32; ++i) c.in[i] = args.in[i];
    c.out = args.out; c.ws = args.ws;
    const int lo = args.ph_lo, hi = args.ph_hi;
    volatile LAS unsigned* bst = (volatile LAS unsigned*)(c.lds + LDS_BAR_OFF);
    if (c.tid < 4) bst[c.tid] = 0u;
    __syncthreads();
    XcdBarrier bar; bar.bar = (unsigned*)(c.ws + WS_CTL); bar.x = 0; bar.st = bst;
    if (hi - lo > 1) bar = xcd_barrier_post((unsigned*)(c.ws + WS_CTL), bst);
#define IN(k) (lo <= (k) && (k) < hi)
#ifndef REPEAT_MASK
#define REPEAT_MASK 0u
#endif
#define REP(k) for (int _rep = 0; _rep < (((REPEAT_MASK >> (k)) & 1u) ? 2 : 1); ++_rep)
#define SEAM(k) do { if (IN(k) && IN((k) + 1)) xcd_barrier(bar); } while (0)
    float* MOD = (float*)(c.ws + WS_MOD);
    float* XC = (float*)(c.ws + WS_XC);
    bf16_t* HY = (bf16_t*)(c.ws + WS_HY); bf16_t* Pb = (bf16_t*)(c.ws + WS_P); float* TL = (float*)(c.ws + WS_TAIL);
    bf16_t* Win = (bf16_t*)(c.ws + WS_WIN); bf16_t* Wout = (bf16_t*)(c.ws + WS_WOUT); bf16_t* W13 = (bf16_t*)(c.ws + WS_W13); bf16_t* W2 = (bf16_t*)(c.ws + WS_W2);
    const float* X = c.in[IN_X]; const float* CX = c.in[IN_CTX];

    #ifndef SUBREP
#define SUBREP 0
#endif
    if (IN(0)) { ada_phase(c, 0, 0, c.G); __syncthreads(); convert_weights(c, 0, 0, c.G); lora_weight_phase(c); }
    SEAM(0);
    if (IN(1)) REP(1) norm_mod_phase(c, X, CX, c.in[IN_NORMW], MOD, 0, D, MT);
    SEAM(1);
    if (IN(2)) { pg8::Gemm g{HY, Win, MT, NIN0, D}; pg8::StaticOrder S; S.init(MT, NIN0, c.G, c.wg); EpiInProj E{Pb, PW0, PW0 / 256, TL, TW0};
        pg8::gemm_phase<EpiInProj, pg8::StaticOrder, GEMM_ALIGN, GEMM_SP2>(c.lds, g, S, E); }
    SEAM(2);
    if (IN(3)) REP(3) ab_feature_phase(c);
    SEAM(3);
    if (IN(4)) {
        int k256 = 256; asm volatile("" : "+s"(k256));
        { pg8::Gemm g{(const bf16_t*)(c.ws + WS_A1), (const bf16_t*)(c.ws + WS_WL), MT, 4096, k256}; pg8::StaticOrder S; S.init(MT, 4096, c.G, c.wg); EpiLora E{Pb, PW0, c.in[IN_W0], c.in[IN_A0]};
          pg8::gemm_phase<EpiLora, pg8::StaticOrder, GEMM_ALIGN, GEMM_SP2>(c.lds, g, S, E); }
        { pg8::Gemm g{(const bf16_t*)(c.ws + WS_A2), (const bf16_t*)(c.ws + WS_WG), MT, 1024, k256}; pg8::StaticOrder S; S.init(MT, 1024, c.G, c.wg); EpiBf16Plain E{(bf16_t*)(c.ws + WS_GOUT), 1024};
          pg8::gemm_phase<EpiBf16Plain, pg8::StaticOrder, GEMM_ALIGN, GEMM_SP2>(c.lds, g, S, E); } }
    SEAM(4);
    if (IN(5)) REP(5) {
        gdn_chunk_items(c, c.wg, c.G, 128);
        rwkv_chunk_items(c, (c.wg + c.G / 2) % c.G, c.G, 128, HY + 1024, -1024L, D); }
    SEAM(5);
    if (IN(7)) REP(7) ab_output_phase(c);
    SEAM(7);
    if (IN(8)) { pg8::Gemm g{HY, Wout, MT, D, D}; pg8::StaticOrder S; S.init(MT, D, c.G, c.wg); EpiResid E{X, CX, c.out, XC, MOD + 2 * D};
        pg8::gemm_phase<EpiResid, pg8::StaticOrder, GEMM_ALIGN, GEMM_SP2>(c.lds, g, S, E);
        __syncthreads(); const int nt3 = (MT / 256) * (D / 256) - 2 * c.G;
        if (nt3 > 0 && nt3 < c.G) ada_phase(c, 1, nt3, c.G - nt3); else ada_phase(c, 1, 0, c.G); }
    SEAM(8);
    if (IN(9)) REP(9) norm_mod_phase(c, c.out, XC, c.in[IN_NORMW] + D, MOD, 3 * D, 4 * D, MT);
    SEAM(9);
    if (IN(10)) { pg8::Gemm g{HY, W13, MT, 2 * FF, D}; pg8::StaticOrder S; S.init(MT, 2 * FF, c.G, c.wg); EpiSwiGLU E{Pb, FF};
        pg8::gemm_phase<EpiSwiGLU, pg8::StaticOrder, GEMM_ALIGN, GEMM_SP2>(c.lds, g, S, E); }
    SEAM(10);
    if (IN(11)) { pg8::Gemm g{Pb, W2, MT, D, FF}; pg8::StaticOrder S; S.init(MT, D, c.G, c.wg); EpiResid E{c.out, XC, c.out, XC, MOD + 5 * D};
        pg8::gemm_phase<EpiResid, pg8::StaticOrder, GEMM_ALIGN, GEMM_SP2>(c.lds, g, S, E);
        __syncthreads(); const int nt3 = (MT / 256) * (D / 256) - 2 * c.G;
        if (nt3 > 0 && nt3 < c.G) convert_weights(c, 1, nt3, c.G - nt3); else convert_weights(c, 1, 0, c.G); }
    SEAM(11);
    if (IN(12)) REP(12) { norm_mod_phase(c, c.out, XC, c.in[IN_NORMW] + 2 * D, MOD + 5 * MODW, 0, D, MT); }
    SEAM(12);
    if (IN(13)) { pg8::Gemm g{HY, (const bf16_t*)(c.ws + WS_WIN1), MT, NIN1, D}; pg8::StaticOrder S; S.init(MT, NIN1, c.G, c.wg); EpiInProj E{Pb, PW1, PW1 / 256, TL, TW1};
        pg8::gemm_phase<EpiInProj, pg8::StaticOrder, GEMM_ALIGN, GEMM_SP2>(c.lds, g, S, E); }
    SEAM(13);
    if (IN(15)) REP(15) { if (USE_CHUNK_ML) mlstm_chunk_phase(c); else mlstm_scan_phase(c); }
    SEAM(15);
    if (IN(16)) REP(16) ml_output_phase(c);
    SEAM(16);
    if (IN(17)) { pg8::Gemm g{HY, (const bf16_t*)(c.ws + WS_WOUT1), ML, D, D}; pg8::StaticOrder S; S.init(ML, D, c.G, c.wg); EpiResid E{c.out, XC, c.out, XC, MOD + 5 * MODW + 2 * D};
        pg8::gemm_phase<EpiResid, pg8::StaticOrder, GEMM_ALIGN, GEMM_SP2>(c.lds, g, S, E); }
    SEAM(17);
    if (IN(18)) REP(18) norm_mod_phase(c, c.out, XC, c.in[IN_NORMW] + 3 * D, MOD + 5 * MODW, 3 * D, 4 * D, ML);
    SEAM(18);
    if (IN(19)) { pg8::Gemm g{HY, (const bf16_t*)(c.ws + WS_W131), ML, 2 * FF, D}; pg8::StaticOrder S; S.init(ML, 2 * FF, c.G, c.wg); EpiSwiGLU E{Pb, FF};
        pg8::gemm_phase<EpiSwiGLU, pg8::StaticOrder, GEMM_ALIGN, GEMM_SP2>(c.lds, g, S, E); }
    SEAM(19);
    if (IN(20)) { pg8::Gemm g{Pb, (const bf16_t*)(c.ws + WS_W21), ML, D, FF}; pg8::StaticOrder S; S.init(ML, D, c.G, c.wg); EpiResid E{c.out, XC, c.out, XC, MOD + 5 * MODW + 5 * D};
        pg8::gemm_phase<EpiResid, pg8::StaticOrder, GEMM_ALIGN, GEMM_SP2>(c.lds, g, S, E); }
    SEAM(20);
    if (IN(21)) final_norm_phase(c);
#undef IN
#undef SEAM
}

#ifndef N_LAUNCH_MODE
#define N_LAUNCH_MODE 1
#endif
extern "C" void kernel_launch(void* const* d_in, const int* in_sizes, int n_in, void* d_out, int out_size, void* d_ws, size_t ws_size, hipStream_t stream) {
    static int grid = 0;
    if (grid == 0) {
        if (n_in != 32 || out_size != ML * D || ws_size < WS_END) { fprintf(stderr, "kernel_launch: unexpected problem (n_in %d out %d ws %zu)\n", n_in, out_size, ws_size); grid = -1; return; }
        int dev = 0, cus = 0;
        if (hipGetDevice(&dev) != hipSuccess || hipDeviceGetAttribute(&cus, hipDeviceAttributeMultiprocessorCount, dev) != hipSuccess) { grid = -1; return; }
        if (hipFuncSetAttribute((const void*)fwd_kernel, hipFuncAttributeMaxDynamicSharedMemorySize, LDS_BYTES) != hipSuccess) { grid = -1; return; }
        int per_cu = 0;
        if (hipOccupancyMaxActiveBlocksPerMultiprocessor(&per_cu, (const void*)fwd_kernel, NTHREADS, LDS_BYTES) != hipSuccess || per_cu < 1) { fprintf(stderr, "kernel_launch: occupancy query says %d\n", per_cu); }
        (void)hipGetLastError();
        grid = cus;
    }
    if (grid < 0) return;
    (void)hipMemsetAsync((char*)d_ws + WS_CTL, 0, CTL_BYTES, stream);
    Args a{};
    for (int i = 0; i < 32; ++i) a.in[i] = (const float*)d_in[i];
    a.out = (float*)d_out; a.ws = (unsigned char*)d_ws;
#if N_LAUNCH_MODE == 1
    a.ph_lo = 0; a.ph_hi = NPHASE;
    hipLaunchKernelGGL(fwd_kernel, dim3(grid), dim3(NTHREADS), LDS_BYTES, stream, a);
#else
    for (int p = 0; p < 22; ++p) { a.ph_lo = p; a.ph_hi = p + 1; hipLaunchKernelGGL(fwd_kernel, dim3(grid), dim3(NTHREADS), LDS_BYTES, stream, a); }
#endif
}
```

```cpp
#include <hip/hip_runtime.h>
#include <cstdio>
#include <cstdint>
#define LAS __attribute__((address_space(3)))
#define GAS __attribute__((address_space(1)))
#define XB_TMO      128
#define XB_XCNT(j)  (256  + 64 * (j))
#define XB_XSUB(j)  (1280 + 64 * (j))
#define XB_XGEN(j)  (2304 + 64 * (j))
#define XB_TOP      3328
#define XB_TOPGEN   3392
#define XCD_BAR_WORDS 3456
#define XB_SPIN_CAP (1u << 20)

__device__ __forceinline__ unsigned xb_ld(unsigned* p)              { return __hip_atomic_load(p, __ATOMIC_RELAXED, __HIP_MEMORY_SCOPE_AGENT); }
__device__ __forceinline__ unsigned xb_add(unsigned* p, unsigned v) { return __hip_atomic_fetch_add(p, v, __ATOMIC_RELAXED, __HIP_MEMORY_SCOPE_AGENT); }
__device__ __forceinline__ unsigned xb_xcc_id() { return (unsigned)__builtin_amdgcn_s_getreg((3 << 11) | 20) & 0xFu; }
#define XB_SPIN(cond, bar) do { unsigned _sp = 0; while (cond) { __builtin_amdgcn_s_sleep(1); \
    if ((++_sp & 255u) == 0u) { if (xb_ld(&(bar)[XB_TMO])) break; if (_sp > XB_SPIN_CAP) { atomicAdd(&(bar)[XB_TMO], 1u); break; } } } } while (0)

struct XcdBarrier {
    unsigned* bar; unsigned x;
    volatile LAS unsigned* st;
};

__device__ __forceinline__ XcdBarrier xcd_barrier_post(unsigned* bar, volatile LAS unsigned* st) {
    XcdBarrier b; b.bar = bar; b.x = xb_xcc_id(); b.st = st;
    if (threadIdx.x == 0) (void)xb_add(&bar[XB_XCNT(b.x)], 1u);
    return b;
}
__device__ __forceinline__ void xcd_barrier_complete(unsigned* bar, unsigned x, unsigned& nloc, unsigned& nx) {
    const unsigned G = gridDim.x * gridDim.y * gridDim.z;
    unsigned sum, cnt, mine, sp = 0u;
    for (;;) {
        sum = 0u; cnt = 0u; mine = 0u;
#pragma unroll
        for (unsigned j = 0; j < 16; ++j) { const unsigned c = xb_ld(&bar[XB_XCNT(j)]); sum += c; cnt += (c > 0u) ? 1u : 0u; mine = (j == x) ? c : mine; }
        if (sum == G) break;
        __builtin_amdgcn_s_sleep(1);
        if ((++sp & 255u) == 0u) { if (xb_ld(&bar[XB_TMO])) break; if (sp > XB_SPIN_CAP) { atomicAdd(&bar[XB_TMO], 1u); break; } }
    }
    nloc = mine > 0u ? mine : 1u; nx = cnt > 0u ? cnt : 1u;
}

__device__ __forceinline__ void xcd_barrier(const XcdBarrier& b) {
    asm volatile("s_waitcnt vmcnt(0)" ::: "memory");
    __syncthreads();
    if (threadIdx.x == 0) {
        unsigned* bar = b.bar;
        __builtin_amdgcn_s_waitcnt(0);
        unsigned nloc = b.st[0], nx = b.st[1];
        if (nloc == 0u) { xcd_barrier_complete(bar, b.x, nloc, nx); b.st[0] = nloc; b.st[1] = nx; }
        const unsigned old = xb_add(&bar[XB_XSUB(b.x)], 1u);
        const unsigned gen = old / nloc;
        if (old + 1u == (gen + 1u) * nloc) {
            __builtin_amdgcn_fence(__ATOMIC_RELEASE, "agent");
            asm volatile("s_waitcnt vmcnt(0)" ::: "memory");
            const unsigned og = xb_add(&bar[XB_TOP], 1u);
            const unsigned tg = og / nx;
            if (og + 1u == (tg + 1u) * nx) xb_add(&bar[XB_TOPGEN], 1u);
            else XB_SPIN(xb_ld(&bar[XB_TOPGEN]) == tg, bar);
            __builtin_amdgcn_fence(__ATOMIC_ACQUIRE, "agent");
            xb_add(&bar[XB_XGEN(b.x)], 1u);
            asm volatile("s_waitcnt vmcnt(0)" ::: "memory");
        } else {
            XB_SPIN(xb_ld(&bar[XB_XGEN(b.x)]) == gen, bar);
            __builtin_amdgcn_fence(__ATOMIC_ACQUIRE, "agent");
            asm volatile("s_waitcnt vmcnt(0)" ::: "memory");
        }
    }
    __syncthreads();
}
#include <hip/hip_runtime.h>
namespace pg8 {
#define PG8_LAS __attribute__((address_space(3)))
typedef unsigned short bf16_t;
typedef short bf16x8 __attribute__((ext_vector_type(8)));
typedef float f32x4 __attribute__((ext_vector_type(4)));
typedef unsigned u32x4 __attribute__((ext_vector_type(4)));
constexpr int BM = 256, BK = 64, HALF = 128, HTB = HALF * BK * 2  , STAGE_BYTES = 8 * HTB, NXCD = 8, WGM = 8;

__host__ __device__ __forceinline__ int lds_byte(int r, int c) { const int st = (r >> 4) * 2 + (c >> 5), rr = r & 15, cc = c & 31, ob = rr * 64 + cc * 2; return st * 1024 + (ob ^ (((ob >> 9) & 1) << 5)); }
__host__ __device__ __forceinline__ void stage_rc(int b, int& R, int& C) { const int st = b / 1024, sb = b % 1024, swz = sb ^ (((sb >> 9) & 1) << 5); R = (st >> 1) * 16 + swz / 64; C = (st & 1) * 32 + (swz % 64) / 2; }
__host__ __device__ __forceinline__ int perm32(int rho) { const int n = rho >> 4, i = rho & 15; return 8 * (i >> 2) + 4 * n + (i & 3); }

struct Unit { int pm, pn; };
struct Gemm { const bf16_t* A; const bf16_t* Bt; int M, N, K; };

struct StaticOrder {
    int nM, nN, nwg, G, c;
    __host__ __device__ void init(int M, int N, int G_, int c_) { nM = M / BM; nN = N / BM; nwg = nM * nN; G = G_; c = c_; }
    __host__ __device__ bool next(int i, Unit& u) const {
        const long L = (long)i * G + c; if (L >= nwg) return false;
        int wgid = (int)L; { const int q = nwg / NXCD, r = nwg % NXCD, xcd = wgid % NXCD, off = wgid / NXCD; wgid = (xcd < r ? xcd * (q + 1) : r * (q + 1) + (xcd - r) * q) + off; }
        const int nig = WGM * nN, gid = wgid / nig, fm = gid * WGM, gsz = (nM - fm) < WGM ? (nM - fm) : WGM;
        u.pm = fm + ((wgid % nig) % gsz); u.pn = (wgid % nig) / gsz; return true;
    }
    __device__ __forceinline__ void a_ready(const Unit&) const {}
    __device__ __forceinline__ void done(const Unit&) const {}
};
template <class Epi, class Sched, bool ALIGN_EPI = false, bool SP2 = false>
__device__ __forceinline__ void gemm_phase(PG8_LAS unsigned char* lds, const Gemm g, const Sched& S, const Epi& E) {
    const int tid = threadIdx.x, wid = __builtin_amdgcn_readfirstlane(tid >> 6), lane = tid & 63, wr = wid >> 2, wc = wid & 3, fr = lane & 15, fq = lane >> 4;
    const int K = g.K, nt = K / BK;
    unsigned voffA[2], voffB[2];
#pragma unroll
    for (int i = 0; i < 2; ++i) { int R, C; stage_rc(tid * 16 + i * 8192, R, C); const int Rb = Epi::PERM ? ((R & ~31) + perm32(R & 31)) : R;
        voffA[i] = (unsigned)(R * K + C) * 2u; voffB[i] = (unsigned)(Rb * K + C) * 2u; }
    const size_t kstep = (size_t)(BK * 2);
    const size_t hstep = (size_t)HALF * K * 2;
    const size_t tstep = 2 * hstep;
    const unsigned ldsw = (unsigned)wid * 1024u;
    const int aoff = lds_byte(wr * 64 + fr, fq * 8), boff = lds_byte(wc * 32 + fr, fq * 8);
#define PG8_SA(b, h) (((b) * 2 + (h)) * HTB)
#define PG8_SB(b, h) ((4 + (b) * 2 + (h)) * HTB)
#define PG8_STAGE(bufoff, gbase, voff) do { _Pragma("unroll") for (int _i = 0; _i < 2; ++_i) \
        __builtin_amdgcn_global_load_lds((const unsigned*)((const char*)(gbase) + (voff)[_i]), (PG8_LAS unsigned*)(lds + (bufoff) + ldsw + _i * 8192), 16, 0, 0); } while (0)
#define PG8_LDA(dst, b, h) do { _Pragma("unroll") for (int m = 0; m < 4; ++m) _Pragma("unroll") for (int k = 0; k < 2; ++k) dst[m][k] = *(const PG8_LAS bf16x8*)(lds + PG8_SA(b, h) + aoff + m * 2048 + k * 1024); } while (0)
#define PG8_LDB(dst, b, h) do { _Pragma("unroll") for (int n = 0; n < 2; ++n) _Pragma("unroll") for (int k = 0; k < 2; ++k) dst[n][k] = *(const PG8_LAS bf16x8*)(lds + PG8_SB(b, h) + boff + n * 2048 + k * 1024); } while (0)
#define PG8_MMA(ai, bj, At, Bt) do { __builtin_amdgcn_s_setprio(1); _Pragma("unroll") for (int m = 0; m < 4; ++m) _Pragma("unroll") for (int n = 0; n < 2; ++n) _Pragma("unroll") for (int k = 0; k < 2; ++k) \
        acc[ai][bj][m][n] = __builtin_amdgcn_mfma_f32_16x16x32_bf16(Bt[n][k], At[m][k], acc[ai][bj][m][n], 0, 0, 0); __builtin_amdgcn_s_setprio(0); } while (0)
#define PG8_WAIT_V(n) asm volatile("s_waitcnt vmcnt(" #n ")" ::: "memory")
#define PG8_WAIT_L(n) asm volatile("s_waitcnt lgkmcnt(" #n ")" ::: "memory")
#define PG8_BAR __builtin_amdgcn_s_barrier()
#define PG8_SCHED __builtin_amdgcn_sched_barrier(0)
    Unit cur, nxt; int ui = 0;
    if (!S.next(0, cur)) return;
    f32x4 acc[2][2][4][2];
#pragma unroll
    for (int a = 0; a < 2; ++a)
#pragma unroll
        for (int b = 0; b < 2; ++b)
#pragma unroll
            for (int m = 0; m < 4; ++m)
#pragma unroll
                for (int n = 0; n < 2; ++n) acc[a][b][m][n] = (f32x4){0.f, 0.f, 0.f, 0.f};
    bf16x8 At[4][2], B0[2][2], B1[2][2];
    const char* cA = (const char*)g.A + (size_t)cur.pm * tstep; const char* cB = (const char*)g.Bt + (size_t)cur.pn * tstep;
    S.a_ready(cur);
    if constexpr (SP2) {
        PG8_STAGE(PG8_SB(0, 0), cB, voffB); PG8_STAGE(PG8_SB(0, 1), cB + hstep, voffB); PG8_STAGE(PG8_SA(0, 0), cA, voffA); PG8_STAGE(PG8_SA(0, 1), cA + hstep, voffA);
        if (wr == 1) PG8_BAR;
        PG8_WAIT_V(2); PG8_BAR;
        PG8_STAGE(PG8_SB(1, 0), cB + kstep, voffB); PG8_STAGE(PG8_SA(1, 0), cA + kstep, voffA); PG8_STAGE(PG8_SB(1, 1), cB + hstep + kstep, voffB);
        PG8_WAIT_V(6); PG8_BAR;
    } else {
        PG8_STAGE(PG8_SB(0, 0), cB, voffB); PG8_STAGE(PG8_SA(0, 0), cA, voffA); PG8_STAGE(PG8_SB(0, 1), cB + hstep, voffB); PG8_STAGE(PG8_SA(0, 1), cA + hstep, voffA);
        if (wr == 1) PG8_BAR;
        PG8_WAIT_V(4); PG8_BAR;
        PG8_STAGE(PG8_SB(1, 0), cB + kstep, voffB); PG8_STAGE(PG8_SA(1, 0), cA + kstep, voffA); PG8_STAGE(PG8_SB(1, 1), cB + hstep + kstep, voffB);
        PG8_WAIT_V(6); PG8_BAR;
    }
    for (;;) {
        const bool has_next = S.next(ui + 1, nxt);
        const char* nA = has_next ? (const char*)g.A + (size_t)nxt.pm * tstep : cA; const char* nB = has_next ? (const char*)g.Bt + (size_t)nxt.pn * tstep : cB;
        for (int t = 0; t < nt; t += 2) {
            const bool last = (t == nt - 2);
            const char* a1 = cA + (size_t)(t + 1) * kstep;
            const char* a2 = last ? nA : cA + (size_t)(t + 2) * kstep; const char* b2 = last ? nB : cB + (size_t)(t + 2) * kstep;
            const char* a3 = a2 + kstep; const char* b3 = b2 + kstep;
            if (last && has_next) S.a_ready(nxt);
            if constexpr (SP2) {
            PG8_LDB(B0, 0, 0); PG8_LDB(B1, 0, 1); PG8_SCHED; PG8_LDA(At, 0, 0); PG8_STAGE(PG8_SA(1, 1), a1 + hstep, voffA);
            PG8_WAIT_V(8); PG8_WAIT_L(0); PG8_BAR; PG8_MMA(0, 0, At, B0); PG8_MMA(0, 1, At, B1); PG8_BAR; PG8_SCHED;
            PG8_LDA(At, 0, 1); PG8_STAGE(PG8_SB(0, 0), b2, voffB); PG8_STAGE(PG8_SB(0, 1), b2 + hstep, voffB); PG8_STAGE(PG8_SA(0, 0), a2, voffA);
            PG8_WAIT_V(8); PG8_WAIT_L(0); PG8_BAR; PG8_MMA(1, 0, At, B0); PG8_MMA(1, 1, At, B1); PG8_BAR; PG8_SCHED;
            PG8_LDB(B0, 1, 0); PG8_LDB(B1, 1, 1); PG8_SCHED; PG8_LDA(At, 1, 0); PG8_STAGE(PG8_SA(0, 1), a2 + hstep, voffA);
            PG8_WAIT_V(8); PG8_WAIT_L(0); PG8_BAR; PG8_MMA(0, 0, At, B0); PG8_MMA(0, 1, At, B1); PG8_BAR; PG8_SCHED;
            PG8_LDA(At, 1, 1); PG8_STAGE(PG8_SB(1, 0), b3, voffB); PG8_STAGE(PG8_SB(1, 1), b3 + hstep, voffB); PG8_STAGE(PG8_SA(1, 0), a3, voffA);
            PG8_WAIT_V(8); PG8_WAIT_L(0); PG8_BAR; PG8_MMA(1, 0, At, B0); PG8_MMA(1, 1, At, B1); PG8_BAR; PG8_SCHED;
            } else {
            PG8_LDB(B0, 0, 0); PG8_SCHED; PG8_LDA(At, 0, 0); PG8_STAGE(PG8_SA(1, 1), a1 + hstep, voffA);
            PG8_WAIT_L(8); PG8_BAR; PG8_WAIT_L(0); PG8_MMA(0, 0, At, B0); PG8_BAR; PG8_SCHED;
            PG8_LDB(B1, 0, 1); PG8_STAGE(PG8_SB(0, 0), b2, voffB);
            PG8_BAR; PG8_WAIT_L(0); PG8_MMA(0, 1, At, B1); PG8_BAR;
            PG8_LDA(At, 0, 1); PG8_STAGE(PG8_SA(0, 0), a2, voffA);
            PG8_BAR; PG8_WAIT_L(0); PG8_MMA(1, 0, At, B0); PG8_BAR; PG8_SCHED;
            PG8_STAGE(PG8_SB(0, 1), b2 + hstep, voffB);
            PG8_WAIT_V(6); PG8_BAR; PG8_MMA(1, 1, At, B1); PG8_BAR;
            PG8_LDB(B0, 1, 0); PG8_SCHED; PG8_LDA(At, 1, 0); PG8_STAGE(PG8_SA(0, 1), a2 + hstep, voffA);
            PG8_WAIT_L(8); PG8_BAR; PG8_WAIT_L(0); PG8_MMA(0, 0, At, B0); PG8_BAR; PG8_SCHED;
            PG8_LDB(B1, 1, 1); PG8_STAGE(PG8_SB(1, 0), b3, voffB);
            PG8_BAR; PG8_WAIT_L(0); PG8_MMA(0, 1, At, B1); PG8_BAR;
            PG8_LDA(At, 1, 1); PG8_STAGE(PG8_SA(1, 0), a3, voffA);
            PG8_BAR; PG8_WAIT_L(0); PG8_MMA(1, 0, At, B0); PG8_BAR; PG8_SCHED;
            PG8_STAGE(PG8_SB(1, 1), b3 + hstep, voffB);
            PG8_WAIT_V(6); PG8_BAR; PG8_MMA(1, 1, At, B1); PG8_BAR;
            }
        }
        if constexpr (ALIGN_EPI) { if (wr == 0) PG8_BAR; }
        if constexpr (!Epi::AFTER_DRAIN) { E(acc, cur, wr, wc, fr, fq); S.done(cur); }
        if (!has_next) break;
#pragma unroll
        for (int a = 0; a < 2; ++a)
#pragma unroll
            for (int b = 0; b < 2; ++b)
#pragma unroll
                for (int m = 0; m < 4; ++m)
#pragma unroll
                    for (int n = 0; n < 2; ++n) acc[a][b][m][n] = (f32x4){0.f, 0.f, 0.f, 0.f};
        cur = nxt; cA = nA; cB = nB; ++ui;
        if constexpr (ALIGN_EPI) { if (wr == 1) PG8_BAR; }
    }
    PG8_WAIT_V(0);
    if constexpr (!ALIGN_EPI) { if (wr == 0) PG8_BAR; }
    PG8_BAR;
    if constexpr (Epi::AFTER_DRAIN) { E.fused(acc, cur, wr, wc, fr, fq, lds, wid, lane); S.done(cur); }
#undef PG8_SA
#undef PG8_SB
#undef PG8_STAGE
#undef PG8_LDA
#undef PG8_LDB
#undef PG8_MMA
#undef PG8_WAIT_V
#undef PG8_WAIT_L
#undef PG8_BAR
#undef PG8_SCHED
}
}

typedef unsigned short bf16_t;
typedef float f32x4 __attribute__((ext_vector_type(4)));
typedef float f32x2 __attribute__((ext_vector_type(2)));
typedef unsigned u32x4 __attribute__((ext_vector_type(4)));
typedef unsigned u32x2 __attribute__((ext_vector_type(2)));

constexpr int D = 2048, NB = 4, SEQ = 4096, CTXL = 256;
constexpr int ML = NB * SEQ;
constexpr int MC = NB * CTXL;
constexpr int MT = ML + MC;
constexpr int AB_IN = 7616, NIN0 = 7680, PW0 = 7168, TW0 = 512;
constexpr int C_INW = 6176, NIN1 = 6400, PW1 = 6144, TW1 = 256;
constexpr int FF = 5632;
constexpr int MODW = 6 * D;
constexpr int NTHREADS = 512, NWAVES = 8;

constexpr size_t MiB = 1u << 20;
constexpr size_t WS_CTL = 0, CTL_BYTES = 16384;
constexpr size_t WS_MOD = 1 * MiB;
constexpr size_t WS_GA = 2 * MiB, WS_GB = 4 * MiB;
constexpr size_t WS_XC = 6 * MiB;
constexpr size_t WS_HY = 14 * MiB;
constexpr size_t WS_TAIL = 82 * MiB;
constexpr size_t WS_WIN = 116 * MiB;
constexpr size_t WS_WOUT = 146 * MiB;
constexpr size_t WS_W13 = 154 * MiB;
constexpr size_t WS_W2 = 198 * MiB;
constexpr size_t WS_P = 220 * MiB;
constexpr size_t WS_F = 458 * MiB;
constexpr size_t FSLOT = (size_t)MT * 1024 * 2;
constexpr size_t WS_WL = 696 * MiB;
constexpr size_t WS_WG = 698 * MiB;
constexpr size_t WS_END = 700 * MiB;
constexpr size_t WS_L1W = WS_F + 128 * MiB;
constexpr size_t WS_WIN1 = WS_L1W, WS_WOUT1 = WS_L1W + 26 * MiB, WS_W131 = WS_L1W + 34 * MiB, WS_W21 = WS_L1W + 78 * MiB;
static_assert(WS_W21 + (size_t)D * FF * 2 <= WS_WL && (size_t)2 * ML * D * 2 <= 128 * MiB, "layer-1 weight map");
constexpr size_t WS_DELTA = WS_F;
constexpr size_t WS_A1 = WS_HY, WS_A2 = WS_HY + 16 * MiB;
constexpr size_t WS_GOUT = WS_TAIL;
static_assert(WS_F + 7 * FSLOT <= WS_END, "ws map");
static_assert(WS_HY + (size_t)MT * D * 2 <= WS_TAIL && WS_TAIL + (size_t)MT * TW0 * 4 <= WS_WIN && WS_W2 + (size_t)D * FF * 2 <= WS_P && WS_P + (size_t)MT * PW0 * 2 <= WS_F, "ws map");

constexpr int LDS_BYTES = 147456;
constexpr int LDS_BAR_OFF = LDS_BYTES - 64;

__device__ __forceinline__ float bflo(unsigned u) { return __builtin_bit_cast(float, u << 16); }
__device__ __forceinline__ float bfhi(unsigned u) { return __builtin_bit_cast(float, u & 0xffff0000u); }
__device__ __forceinline__ float bf1(bf16_t h) { return __builtin_bit_cast(float, (unsigned)h << 16); }
__device__ __forceinline__ unsigned f2bf(float f) { unsigned u = __builtin_bit_cast(unsigned, f); return (u + 0x7fffu + ((u >> 16) & 1u)) >> 16; }
__device__ __forceinline__ unsigned pk2(float lo, float hi) { return f2bf(lo) | (f2bf(hi) << 16); }
__device__ __forceinline__ float sigm(float x) { return 1.f / (1.f + expf(-x)); }
__device__ __forceinline__ float sigm_fast(float x) { return 1.f / (1.f + __expf(-x)); }
__device__ __forceinline__ float silu_fast(float x) { return x / (1.f + __expf(-x)); }
__device__ __forceinline__ float softplus_(float x) { return fmaxf(x, 0.f) + log1pf(expf(-fabsf(x))); }
__device__ __forceinline__ float logsigm_(float x) { return fminf(x, 0.f) - log1pf(expf(-fabsf(x))); }
__device__ __forceinline__ float softcap15_fast(float x) { const float t = __expf(x * (2.f / 15.f)); return 15.f * (t - 1.f) / (t + 1.f); }
template <int W> __device__ __forceinline__ float grp_sum(float v) {
#pragma unroll
    for (int o = 1; o < W; o <<= 1) v += __shfl_xor(v, o);
    return v;
}
__device__ __forceinline__ void unpack8(const u32x4 u, float (&f)[8]) {
    f[0] = bflo(u.x); f[1] = bfhi(u.x); f[2] = bflo(u.y); f[3] = bfhi(u.y); f[4] = bflo(u.z); f[5] = bfhi(u.z); f[6] = bflo(u.w); f[7] = bfhi(u.w);
}
__device__ __forceinline__ u32x4 pack8(const float (&f)[8]) { u32x4 o; o.x = pk2(f[0], f[1]); o.y = pk2(f[2], f[3]); o.z = pk2(f[4], f[5]); o.w = pk2(f[6], f[7]); return o; }

struct EpiInProj {
    static constexpr bool PERM = true, AFTER_DRAIN = false;
    bf16_t* P; int ldp; int nPt; float* T; int ldt;
    __device__ __forceinline__ void operator()(const pg8::f32x4 (&acc)[2][2][4][2], const pg8::Unit& u, int wr, int wc, int fr, int fq) const {
        const int row0 = u.pm * 256 + wr * 64 + fr;
        if (u.pn < nPt) {
            const int col0 = u.pn * 256 + wc * 32 + 8 * fq;
#pragma unroll
            for (int ai = 0; ai < 2; ++ai)
#pragma unroll
                for (int m = 0; m < 4; ++m) { bf16_t* rowp = P + (size_t)(row0 + ai * 128 + m * 16) * ldp + col0;
#pragma unroll
                    for (int bj = 0; bj < 2; ++bj) { const pg8::f32x4 v0 = acc[ai][bj][m][0], v1 = acc[ai][bj][m][1];
                        u32x4 o; o.x = pk2(v0[0], v0[1]); o.y = pk2(v0[2], v0[3]); o.z = pk2(v1[0], v1[1]); o.w = pk2(v1[2], v1[3]);
                        *(u32x4*)(rowp + bj * 128) = o; } }
        } else {
            const int col0 = (u.pn - nPt) * 256 + wc * 32 + 8 * fq;
#pragma unroll
            for (int ai = 0; ai < 2; ++ai)
#pragma unroll
                for (int m = 0; m < 4; ++m) { float* rowp = T + (size_t)(row0 + ai * 128 + m * 16) * ldt + col0;
#pragma unroll
                    for (int bj = 0; bj < 2; ++bj) { *(pg8::f32x4*)(rowp + bj * 128) = acc[ai][bj][m][0]; *(pg8::f32x4*)(rowp + bj * 128 + 4) = acc[ai][bj][m][1]; } }
        }
    }
};
struct EpiResid {
    static constexpr bool PERM = false, AFTER_DRAIN = false;
    const float* srcL; const float* srcC; float* dstL; float* dstC; const float* gate;
    __device__ __forceinline__ void operator()(const pg8::f32x4 (&acc)[2][2][4][2], const pg8::Unit& u, int wr, int wc, int fr, int fq) const {
        const bool lat = u.pm < 64;
        const int rowl = (lat ? u.pm : u.pm - 64) * 256 + wr * 64 + fr, col0 = u.pn * 256 + wc * 32 + 4 * fq;
        const float* src = lat ? srcL : srcC; float* dst = lat ? dstL : dstC;
        const float* g = gate + (size_t)(lat ? (u.pm >> 4) : 4) * MODW + col0;
        pg8::f32x4 gv[2][2];
#pragma unroll
        for (int bj = 0; bj < 2; ++bj)
#pragma unroll
            for (int n = 0; n < 2; ++n) gv[bj][n] = *(const pg8::f32x4*)(g + bj * 128 + n * 16);
#pragma unroll
        for (int ai = 0; ai < 2; ++ai)
#pragma unroll
            for (int m = 0; m < 4; ++m) { const size_t ro = (size_t)(rowl + ai * 128 + m * 16) * D + col0;
#pragma unroll
                for (int bj = 0; bj < 2; ++bj)
#pragma unroll
                    for (int n = 0; n < 2; ++n) { const pg8::f32x4 s = *(const pg8::f32x4*)(src + ro + bj * 128 + n * 16);
                        *(pg8::f32x4*)(dst + ro + bj * 128 + n * 16) = s + gv[bj][n] * acc[ai][bj][m][n]; } }
    }
};
struct EpiSwiGLU {
    static constexpr bool PERM = true, AFTER_DRAIN = false;
    bf16_t* H; int ldh;
    __device__ __forceinline__ void operator()(const pg8::f32x4 (&acc)[2][2][4][2], const pg8::Unit& u, int wr, int wc, int fr, int fq) const {
        const int row0 = u.pm * 256 + wr * 64 + fr, col0 = u.pn * 128 + wc * 32 + 8 * fq;
#pragma unroll
        for (int ai = 0; ai < 2; ++ai)
#pragma unroll
            for (int m = 0; m < 4; ++m) { float h[8];
#pragma unroll
                for (int n = 0; n < 2; ++n)
#pragma unroll
                    for (int j = 0; j < 4; ++j) h[n * 4 + j] = silu_fast(acc[ai][0][m][n][j]) * acc[ai][1][m][n][j];
                *(u32x4*)(H + (size_t)(row0 + ai * 128 + m * 16) * ldh + col0) = pack8(h); }
    }
};

struct EpiLora {
    static constexpr bool PERM = true, AFTER_DRAIN = false;
    bf16_t* P; int ldp; const float* w0; const float* a0;
    __device__ __forceinline__ void operator()(const pg8::f32x4 (&acc)[2][2][4][2], const pg8::Unit& u, int wr, int wc, int fr, int fq) const {
        const int row0 = u.pm * 256 + wr * 64 + fr, col0 = u.pn * 256 + wc * 32 + 8 * fq;
        const bool isw = u.pn < 8; const float* bp = isw ? w0 + col0 : a0 + (col0 - 2048); const float sc = isw ? -0.6065306597126334f : 1.f;
#pragma unroll
        for (int bj = 0; bj < 2; ++bj) {
            const pg8::f32x4 b0 = *(const pg8::f32x4*)(bp + bj * 128), b1 = *(const pg8::f32x4*)(bp + bj * 128 + 4);
#pragma unroll
            for (int ai = 0; ai < 2; ++ai)
#pragma unroll
                for (int m = 0; m < 4; ++m) { float h[8];
#pragma unroll
                    for (int j = 0; j < 4; ++j) { h[j] = sc * sigm_fast(acc[ai][bj][m][0][j] + b0[j]); h[4 + j] = sc * sigm_fast(acc[ai][bj][m][1][j] + b1[j]); }
                    *(u32x4*)(P + (size_t)(row0 + ai * 128 + m * 16) * ldp + col0 + bj * 128) = pack8(h); } }
    }
};
struct EpiBf16Plain {
    static constexpr bool PERM = true, AFTER_DRAIN = false;
    bf16_t* O; int ldo;
    __device__ __forceinline__ void operator()(const pg8::f32x4 (&acc)[2][2][4][2], const pg8::Unit& u, int wr, int wc, int fr, int fq) const {
        const int row0 = u.pm * 256 + wr * 64 + fr, col0 = u.pn * 256 + wc * 32 + 8 * fq;
#pragma unroll
        for (int ai = 0; ai < 2; ++ai)
#pragma unroll
            for (int m = 0; m < 4; ++m) { bf16_t* rowp = O + (size_t)(row0 + ai * 128 + m * 16) * ldo + col0;
#pragma unroll
                for (int bj = 0; bj < 2; ++bj) { const pg8::f32x4 v0 = acc[ai][bj][m][0], v1 = acc[ai][bj][m][1];
                    u32x4 o; o.x = pk2(v0[0], v0[1]); o.y = pk2(v0[2], v0[3]); o.z = pk2(v1[0], v1[1]); o.w = pk2(v1[2], v1[3]);
                    *(u32x4*)(rowp + bj * 128) = o; } }
    }
};

struct EpiDelta {
    static constexpr bool PERM = true, AFTER_DRAIN = false;
    bf16_t* O; const float* gate;
    __device__ __forceinline__ void operator()(const pg8::f32x4 (&acc)[2][2][4][2], const pg8::Unit& u, int wr, int wc, int fr, int fq) const {
        const int row0 = u.pm * 256 + wr * 64 + fr, col0 = u.pn * 256 + wc * 32 + 8 * fq;
        const float* g = gate + (size_t)(u.pm < 64 ? (u.pm >> 4) : 4) * MODW + col0;
#pragma unroll
        for (int bj = 0; bj < 2; ++bj) {
            const pg8::f32x4 g0 = *(const pg8::f32x4*)(g + bj * 128), g1 = *(const pg8::f32x4*)(g + bj * 128 + 4);
#pragma unroll
            for (int ai = 0; ai < 2; ++ai)
#pragma unroll
                for (int m = 0; m < 4; ++m) { const pg8::f32x4 v0 = acc[ai][bj][m][0] * g0, v1 = acc[ai][bj][m][1] * g1;
                    u32x4 o; o.x = pk2(v0[0], v0[1]); o.y = pk2(v0[2], v0[3]); o.z = pk2(v1[0], v1[1]); o.w = pk2(v1[2], v1[3]);
                    *(u32x4*)(O + (size_t)(row0 + ai * 128 + m * 16) * D + col0 + bj * 128) = o; } }
    }
};

struct Ctx {
    LAS unsigned char* lds; int tid, lane, wave, G, wg, gw, NGW;
    const float* in[32]; float* out; unsigned char* ws;
};
#define IN_X 0
#define IN_C 1
#define IN_CTX 2
#define IN_CCTX 3
#define IN_ADAW 4
#define IN_ADAB 5
#define IN_NORMW 6
#define IN_ABWIN 7
#define IN_CONVW 8
#define IN_ALOG 9
#define IN_DTB 10
#define IN_GDNNW 11
#define IN_W0 12
#define IN_WUP 13
#define IN_A0 14
#define IN_AUP 15
#define IN_GUP 16
#define IN_KK 17
#define IN_KA 18
#define IN_RK 19
#define IN_LNW 20
#define IN_LNB 21
#define IN_ABWOUT 22
#define IN_MLWIN 23
#define IN_MLIB 24
#define IN_MLFB 25
#define IN_MLNW 26
#define IN_MLWOUT 27
#define IN_W1 28
#define IN_W3 29
#define IN_W2 30
#define IN_FNW 31

__device__ __forceinline__ void transpose_matrix(const Ctx& c, const float* W, int K, int N, int Npad, bf16_t* WT, int mode, LAS float* scr, int gw, int ngw) {
    const int nblk = Npad / 64, items = (K / 64) * nblk, lane = c.lane;
#pragma unroll 1
    for (int it = gw; it < items; it += ngw) {
        const int kb = it / nblk, nb = it - kb * nblk, k0 = kb * 64, n0 = nb * 64;
        const int rr = lane >> 4, c4 = (lane & 15) * 4;
        f32x4 v[16];
        const bool inb = n0 + c4 < N;
#pragma unroll
        for (int i = 0; i < 16; ++i) v[i] = inb ? *(const f32x4*)(W + (size_t)(k0 + 4 * i + rr) * N + n0 + c4) : (f32x4){0.f, 0.f, 0.f, 0.f};
#pragma unroll
        for (int i = 0; i < 16; ++i) { LAS float* d = scr + (4 * i + rr) * 65 + c4; d[0] = v[i].x; d[1] = v[i].y; d[2] = v[i].z; d[3] = v[i].w; }
        asm volatile("s_waitcnt lgkmcnt(0)" ::: "memory");
        const int j = lane & 7;
#pragma unroll
        for (int q = 0; q < 8; ++q) { const int n = q * 8 + (lane >> 3); const LAS float* s = scr + (8 * j) * 65 + n;
            u32x4 o; o.x = pk2(s[0], s[65]); o.y = pk2(s[2 * 65], s[3 * 65]); o.z = pk2(s[4 * 65], s[5 * 65]); o.w = pk2(s[6 * 65], s[7 * 65]);
            const int ng = n0 + n, orow = mode == 0 ? ng : ((ng >> 7) * 256 + (ng & 127) + (mode == 2 ? 128 : 0));
            *(u32x4*)(WT + (size_t)orow * K + k0 + 8 * j) = o; }
        asm volatile("s_waitcnt lgkmcnt(0)" ::: "memory");
    }
}
__device__ __forceinline__ void convert_weights(const Ctx& c, int layer, int wg0, int nwg) {
    if (c.wg < wg0 || c.wg >= wg0 + nwg) return;
    const int gw = (c.wg - wg0) * NWAVES + c.wave, ngw = nwg * NWAVES;
    LAS float* scr = (LAS float*)c.lds + c.wave * (64 * 65);
    if (layer == 0) {
        transpose_matrix(c, c.in[IN_ABWIN], D, AB_IN, NIN0, (bf16_t*)(c.ws + WS_WIN), 0, scr, gw, ngw); transpose_matrix(c, c.in[IN_ABWOUT], D, D, D, (bf16_t*)(c.ws + WS_WOUT), 0, scr, gw, ngw);
        transpose_matrix(c, c.in[IN_W1], D, FF, FF, (bf16_t*)(c.ws + WS_W13), 1, scr, gw, ngw); transpose_matrix(c, c.in[IN_W3], D, FF, FF, (bf16_t*)(c.ws + WS_W13), 2, scr, gw, ngw);
        transpose_matrix(c, c.in[IN_W2], FF, D, D, (bf16_t*)(c.ws + WS_W2), 0, scr, gw, ngw);
    } else {
        transpose_matrix(c, c.in[IN_MLWIN], D, C_INW, NIN1, (bf16_t*)(c.ws + WS_WIN1), 0, scr, gw, ngw); transpose_matrix(c, c.in[IN_MLWOUT], D, D, D, (bf16_t*)(c.ws + WS_WOUT1), 0, scr, gw, ngw);
        transpose_matrix(c, c.in[IN_W1] + (size_t)D * FF, D, FF, FF, (bf16_t*)(c.ws + WS_W131), 1, scr, gw, ngw); transpose_matrix(c, c.in[IN_W3] + (size_t)D * FF, D, FF, FF, (bf16_t*)(c.ws + WS_W131), 2, scr, gw, ngw);
        transpose_matrix(c, c.in[IN_W2] + (size_t)FF * D, FF, D, D, (bf16_t*)(c.ws + WS_W21), 0, scr, gw, ngw);
    }
}
__device__ __forceinline__ void lora_weight_phase(const Ctx& c) {
    bf16_t* Wl = (bf16_t*)(c.ws + WS_WL); bf16_t* Wg = (bf16_t*)(c.ws + WS_WG);
    for (int idx = c.wg * NTHREADS + c.tid; idx < 32 * 4096; idx += c.G * NTHREADS) {
        const int k8 = idx >> 12, n = idx & 4095, slot = n >> 10, ch = n & 1023; float v[8];
        const float* src = c.in[slot < 2 ? IN_WUP : IN_AUP] + (size_t)(slot & 1) * 64 * 1024 + ch;
#pragma unroll
        for (int q = 0; q < 8; ++q) { const int kk = k8 * 8 + q; v[q] = ((kk >> 6) == slot) ? src[(size_t)(kk & 63) * 1024] : 0.f; }
        *(u32x4*)(Wl + (size_t)n * 256 + k8 * 8) = pack8(v);
    }
    for (int idx = c.wg * NTHREADS + c.tid; idx < 32 * 1024; idx += c.G * NTHREADS) {
        const int k8 = idx >> 10, ch = idx & 1023; float v[8];
#pragma unroll
        for (int q = 0; q < 8; ++q) { const int kk = k8 * 8 + q; v[q] = kk < 160 ? c.in[IN_GUP][(size_t)kk * 1024 + ch] : 0.f; }
        *(u32x4*)(Wg + (size_t)ch * 256 + k8 * 8) = pack8(v);
    }
}
__device__ __forceinline__ void ada_phase(const Ctx& c, int layer_sel, int wg0, int nwg) {
    if (c.wg < wg0 || c.wg >= wg0 + nwg) return;
    LAS float* sc = (LAS float*)c.lds;
    LAS float* red = sc + 5 * D;
    for (int i = c.tid; i < 5 * D; i += NTHREADS) { const int b = i / D, k = i % D; const float v = b < 4 ? c.in[IN_C][b * D + k] : c.in[IN_CCTX][k]; sc[i] = v / (1.f + expf(-v)); }
    __syncthreads();
    float* MOD = (float*)(c.ws + WS_MOD);
    constexpr int UPL = MODW / 128;
    for (int u = c.wg - wg0; u < UPL; u += nwg) {
        const int layer = layer_sel, cb = u * 128;
        const float* wp = c.in[IN_ADAW] + (size_t)layer * D * MODW + cb + c.lane * 2;
        float acc[5][2];
#pragma unroll
        for (int b = 0; b < 5; ++b) acc[b][0] = acc[b][1] = 0.f;
        const int k0 = c.wave * 256;
#pragma unroll 16
        for (int k = k0; k < k0 + 256; ++k) { const f32x2 w = *(const f32x2*)(wp + (size_t)k * MODW);
#pragma unroll
            for (int b = 0; b < 5; ++b) { const float s = sc[b * D + k]; acc[b][0] += s * w.x; acc[b][1] += s * w.y; } }
#pragma unroll
        for (int b = 0; b < 5; ++b) { red[(c.wave * 5 + b) * 128 + c.lane * 2] = acc[b][0]; red[(c.wave * 5 + b) * 128 + c.lane * 2 + 1] = acc[b][1]; }
        __syncthreads();
        for (int i = c.tid; i < 640; i += NTHREADS) { const int b = i >> 7, l = i & 127; float s = 0.f;
#pragma unroll
            for (int w = 0; w < 8; ++w) s += red[(w * 5 + b) * 128 + l];
            MOD[(size_t)(layer * 5 + b) * MODW + cb + l] = s + c.in[IN_ADAB][layer * MODW + cb + l]; }
        __syncthreads();
    }
}
__device__ __forceinline__ void norm_mod_phase(const Ctx& c, const float* srcL, const float* srcC, const float* nw, const float* modl, int shift_off, int scale_off, int nrows,
                                               const bf16_t* DELTA = nullptr, float* dstL = nullptr, float* dstC = nullptr) {
    bf16_t* H = (bf16_t*)(c.ws + WS_HY);
    const int r_lo = (int)(((long)c.gw * nrows) / c.NGW), r_hi = (int)(((long)(c.gw + 1) * nrows) / c.NGW);
    f32x4 gn[8], sh[8]; int cur = -1;
#pragma unroll 1
    for (int r = r_lo; r < r_hi; ++r) {
        const float* xr = r < ML ? srcL + (size_t)r * D : srcC + (size_t)(r - ML) * D;
        const int mrow = r < ML ? (r >> 12) : 4;
        if (mrow != cur) { cur = mrow; const float* mr = modl + (size_t)mrow * MODW;
#pragma unroll
            for (int j = 0; j < 8; ++j) { gn[j] = ((const f32x4*)nw)[c.lane + 64 * j] * (((const f32x4*)(mr + scale_off))[c.lane + 64 * j] + 1.f); sh[j] = ((const f32x4*)(mr + shift_off))[c.lane + 64 * j]; } }
        f32x4 v[8]; float ss = 0.f;
        if (DELTA) { float* dr = r < ML ? dstL + (size_t)r * D : dstC + (size_t)(r - ML) * D;
#pragma unroll
            for (int j = 0; j < 8; ++j) { const u32x2 d = ((const u32x2*)(DELTA + (size_t)r * D))[c.lane + 64 * j]; f32x4 x = ((const f32x4*)xr)[c.lane + 64 * j];
                x.x += bflo(d.x); x.y += bfhi(d.x); x.z += bflo(d.y); x.w += bfhi(d.y); v[j] = x; ((f32x4*)dr)[c.lane + 64 * j] = x; ss += x.x * x.x + x.y * x.y + x.z * x.z + x.w * x.w; } }
        else {
#pragma unroll
            for (int j = 0; j < 8; ++j) { v[j] = ((const f32x4*)xr)[c.lane + 64 * j]; ss += v[j].x * v[j].x + v[j].y * v[j].y + v[j].z * v[j].z + v[j].w * v[j].w; } }
        ss = grp_sum<64>(ss);
        const float rstd = 1.f / sqrtf(ss * (1.f / D) + 1e-6f);
#pragma unroll
        for (int j = 0; j < 8; ++j) { const f32x4 y = v[j] * rstd * gn[j] + sh[j];
            u32x2 o; o.x = pk2(y.x, y.y); o.y = pk2(y.z, y.w);
            ((u32x2*)(H + (size_t)r * D))[c.lane + 64 * j] = o; }
    }
}
__device__ __forceinline__ void final_norm_phase(const Ctx& c) {
    const float* nw = c.in[IN_FNW];
    const float probe_scale = 1.f;
    const bf16_t* DELTA = (const bf16_t*)(c.ws + WS_DELTA);
    f32x4 w4[8];
#pragma unroll
    for (int j = 0; j < 8; ++j) w4[j] = ((const f32x4*)nw)[c.lane + 64 * j];
    const int r_lo = (int)(((long)c.gw * ML) / c.NGW), r_hi = (int)(((long)(c.gw + 1) * ML) / c.NGW);
#pragma unroll 1
    for (int r = r_lo; r < r_hi; ++r) {
        f32x4* xr = (f32x4*)(c.out + (size_t)r * D);
        f32x4 v[8]; float ss = 0.f;
#pragma unroll
        for (int j = 0; j < 8; ++j) { const u32x2 d = ((const u32x2*)(DELTA + (size_t)r * D))[c.lane + 64 * j]; f32x4 x = xr[c.lane + 64 * j];
            x.x += bflo(d.x); x.y += bfhi(d.x); x.z += bflo(d.y); x.w += bfhi(d.y); v[j] = x; ss += x.x * x.x + x.y * x.y + x.z * x.z + x.w * x.w; }
        ss = grp_sum<64>(ss);
        const float rstd = 1.f / sqrtf(ss * (1.f / D) + 1e-6f);
#pragma unroll
        for (int j = 0; j < 8; ++j) xr[c.lane + 64 * j] = v[j] * (rstd * probe_scale) * w4[j];
    }
}

__device__ __forceinline__ void ab_feature_strips(const Ctx& c, int st_lo) {
    const bf16_t* P = (const bf16_t*)(c.ws + WS_P); const float* T = (const float*)(c.ws + WS_TAIL);
    bf16_t* F = (bf16_t*)(c.ws + WS_F);
    float* GA = (float*)(c.ws + WS_GA); float* GB = (float*)(c.ws + WS_GB);
    bf16_t* A1 = (bf16_t*)(c.ws + WS_A1); bf16_t* A2 = (bf16_t*)(c.ws + WS_A2);
    const float* cw = c.in[IN_CONVW];
    const int lane = c.lane;
    const int NITEM = (MT / 8 - st_lo) * 12;
#pragma unroll 1
    for (int item = c.gw; item < NITEM; item += c.NGW) {
        const int st = st_lo + item / 12, blk = item % 12, r0 = st * 8, ch = blk * 512 + lane * 8;
        const bool lat = r0 < ML;
        int rowbase, c0, ncols;
        int gr = 0;
        if (lat) { const int b = r0 >> 12, t0 = r0 & 4095; gr = t0 >> 6; c0 = t0 & 63; rowbase = b * 4096 + gr * 64; ncols = 64; }
        else { const int q = r0 - ML, b = q >> 8; c0 = q & 255; rowbase = ML + b * 256; ncols = 256; }
        float acc[8][8];
#pragma unroll
        for (int tt = 0; tt < 8; ++tt)
#pragma unroll
            for (int j = 0; j < 8; ++j) acc[tt][j] = 0.f;
#pragma unroll
        for (int dr = 0; dr < 3; ++dr) {
            const bool vr = lat ? (gr + dr - 1 >= 0 && gr + dr - 1 < 64) : (dr == 1);
            if (vr) {
                float w[3][8];
#pragma unroll
                for (int dc = 0; dc < 3; ++dc) { const f32x4 w0 = *(const f32x4*)(cw + (dr * 3 + dc) * 6144 + ch), w1 = *(const f32x4*)(cw + (dr * 3 + dc) * 6144 + ch + 4);
                    w[dc][0] = w0.x; w[dc][1] = w0.y; w[dc][2] = w0.z; w[dc][3] = w0.w; w[dc][4] = w1.x; w[dc][5] = w1.y; w[dc][6] = w1.z; w[dc][7] = w1.w; }
                const int rb = rowbase + (lat ? (dr - 1) * 64 : 0);
#pragma unroll
                for (int cc = 0; cc < 10; ++cc) {
                    const int col = c0 + cc - 1;
                    if (col >= 0 && col < ncols) {
                        float pf[8]; unpack8(*(const u32x4*)(P + (size_t)(rb + col) * PW0 + ch), pf);
#pragma unroll
                        for (int tt = 0; tt < 8; ++tt) { const int dc = cc - tt;
                            if (dc >= 0 && dc <= 2) {
#pragma unroll
                                for (int j = 0; j < 8; ++j) acc[tt][j] += pf[j] * w[dc][j]; } }
                    }
                }
            }
        }
        const int grp = blk >> 1, cl = (blk & 1) * 512 + lane * 8;
        f32x4 kk0 = {0.f, 0.f, 0.f, 0.f}, kk1 = kk0;
        if (grp == 4) { kk0 = *(const f32x4*)(c.in[IN_KK] + cl); kk1 = *(const f32x4*)(c.in[IN_KK] + cl + 4); }
#pragma unroll
        for (int tt = 0; tt < 8; ++tt) {
            const size_t r = (size_t)(r0 + tt);
            float cv[8];
#pragma unroll
            for (int j = 0; j < 8; ++j) cv[j] = acc[tt][j];
            if (grp < 3) {
                float ss = 0.f;
#pragma unroll
                for (int j = 0; j < 8; ++j) { cv[j] = cv[j] / (1.f + __expf(-cv[j])); ss += cv[j] * cv[j]; }
                if (grp < 2) { ss = grp_sum<16>(ss); const float sc = (1.f / sqrtf(ss + 1e-6f)) * (grp == 0 ? 0.08838834764831845f : 1.f);
#pragma unroll
                    for (int j = 0; j < 8; ++j) cv[j] *= sc; }
                *(u32x4*)(F + (size_t)grp * MT * 1024 + r * 1024 + cl) = pack8(cv);
            } else if (grp == 3) { *(u32x4*)(F + (size_t)3 * MT * 1024 + r * 1024 + cl) = pack8(cv);
            } else if (grp == 5) { *(u32x4*)(F + (size_t)6 * MT * 1024 + r * 1024 + cl) = pack8(cv);
            } else {
                *(u32x4*)(F + (size_t)5 * MT * 1024 + r * 1024 + cl) = pack8(cv);
                float t[8] = {cv[0] * kk0.x, cv[1] * kk0.y, cv[2] * kk0.z, cv[3] * kk0.w, cv[4] * kk1.x, cv[5] * kk1.y, cv[6] * kk1.z, cv[7] * kk1.w};
                float ss = 0.f;
#pragma unroll
                for (int j = 0; j < 8; ++j) ss += t[j] * t[j];
                ss = grp_sum<8>(ss); const float sc = 1.f / sqrtf(ss + 1e-6f);
#pragma unroll
                for (int j = 0; j < 8; ++j) t[j] *= sc;
                *(u32x4*)(F + (size_t)4 * MT * 1024 + r * 1024 + cl) = pack8(t);
            }
        }
        if (blk == 0) {
#pragma unroll 2
            for (int tt = 0; tt < 8; ++tt) {
                const size_t r = (size_t)(r0 + tt);
                const f32x4 t1 = *(const f32x4*)(T + r * TW0 + 32 + lane * 4);
                u32x2 o1; if (lane < 32) { o1.x = pk2(tanhf(t1.x), tanhf(t1.y)); o1.y = pk2(tanhf(t1.z), tanhf(t1.w)); } else { o1.x = pk2(t1.x, t1.y); o1.y = pk2(t1.z, t1.w); }
                *(u32x2*)(A1 + r * 256 + lane * 4) = o1;
                u32x2 o2 = {0u, 0u};
                if (lane < 40) { const f32x4 t2 = *(const f32x4*)(T + r * TW0 + 288 + lane * 4); o2.x = pk2(sigm(t2.x), sigm(t2.y)); o2.y = pk2(sigm(t2.z), sigm(t2.w)); }
                *(u32x2*)(A2 + r * 256 + lane * 4) = o2;
                if (lane < 16) {
                    const float g0 = T[r * TW0 + lane], g1 = T[r * TW0 + 16 + lane];
                    GA[r * 16 + lane] = -expf(c.in[IN_ALOG][lane]) * softplus_(g0 + c.in[IN_DTB][lane]);
                    GB[r * 16 + lane] = sigm(g1);
                }
            }
        }
    }
}
__device__ __forceinline__ void feat_post(bf16_t* F, size_t r, int grp, int cl, float (&cv)[8], const f32x4 kk0, const f32x4 kk1) {
    if (grp < 3) {
        float ss = 0.f;
#pragma unroll
        for (int j = 0; j < 8; ++j) { cv[j] = cv[j] / (1.f + __expf(-cv[j])); ss += cv[j] * cv[j]; }
        if (grp < 2) { ss = grp_sum<16>(ss); const float sc = (1.f / sqrtf(ss + 1e-6f)) * (grp == 0 ? 0.08838834764831845f : 1.f);
#pragma unroll
            for (int j = 0; j < 8; ++j) cv[j] *= sc; }
        *(u32x4*)(F + (size_t)grp * MT * 1024 + r * 1024 + cl) = pack8(cv);
    } else if (grp == 3) { *(u32x4*)(F + (size_t)3 * MT * 1024 + r * 1024 + cl) = pack8(cv);
    } else if (grp == 5) { *(u32x4*)(F + (size_t)6 * MT * 1024 + r * 1024 + cl) = pack8(cv);
    } else {
        *(u32x4*)(F + (size_t)5 * MT * 1024 + r * 1024 + cl) = pack8(cv);
        float t[8] = {cv[0] * kk0.x, cv[1] * kk0.y, cv[2] * kk0.z, cv[3] * kk0.w, cv[4] * kk1.x, cv[5] * kk1.y, cv[6] * kk1.z, cv[7] * kk1.w};
        float ss = 0.f;
#pragma unroll
        for (int j = 0; j < 8; ++j) ss += t[j] * t[j];
        ss = grp_sum<8>(ss); const float sc = 1.f / sqrtf(ss + 1e-6f);
#pragma unroll
        for (int j = 0; j < 8; ++j) t[j] *= sc;
        *(u32x4*)(F + (size_t)4 * MT * 1024 + r * 1024 + cl) = pack8(t);
    }
}
__device__ __forceinline__ void ab_feature_latent(const Ctx& c) {
    const bf16_t* P = (const bf16_t*)(c.ws + WS_P); bf16_t* F = (bf16_t*)(c.ws + WS_F);
    const float* cw = c.in[IN_CONVW];
    const int lane = c.lane;
#pragma unroll 1
    for (int item = c.gw; item < NB * 8 * 16 * 12; item += c.NGW) {
        const int blk = item % 12; int t = item / 12; const int cs = t & 15; t >>= 4; const int sg = t & 7, b = t >> 3;
        const int ch = blk * 512 + lane * 8, c0 = cs * 4, rf = sg * 8, grp = blk >> 1, cl = (blk & 1) * 512 + lane * 8;
        float w[9][8];
#pragma unroll
        for (int k = 0; k < 9; ++k) { const f32x4 w0 = *(const f32x4*)(cw + k * 6144 + ch), w1 = *(const f32x4*)(cw + k * 6144 + ch + 4);
            w[k][0] = w0.x; w[k][1] = w0.y; w[k][2] = w0.z; w[k][3] = w0.w; w[k][4] = w1.x; w[k][5] = w1.y; w[k][6] = w1.z; w[k][7] = w1.w; }
        f32x4 kk0 = {0.f, 0.f, 0.f, 0.f}, kk1 = kk0;
        if (grp == 4) { kk0 = *(const f32x4*)(c.in[IN_KK] + cl); kk1 = *(const f32x4*)(c.in[IN_KK] + cl + 4); }
        const bf16_t* Pb = P + (size_t)b * 4096 * PW0 + ch;
        u32x4 win[3][6];
        auto load_row = [&](int rr, u32x4 (&dst)[6]) {
            const bool vr = rr >= 0 && rr < 64;
#pragma unroll
            for (int cc = 0; cc < 6; ++cc) { const int col = c0 + cc - 1;
                dst[cc] = (vr && col >= 0 && col < 64) ? *(const u32x4*)(Pb + (size_t)(rr * 64 + col) * PW0) : (u32x4){0u, 0u, 0u, 0u}; }
        };
        load_row(rf - 1, win[0]); load_row(rf, win[1]);
#pragma unroll 1
        for (int ro = 0; ro < 8; ++ro) {
            const int r = rf + ro;
            load_row(r + 1, win[2]);
#pragma unroll
            for (int tt = 0; tt < 4; ++tt) {
                float cv[8];
#pragma unroll
                for (int j = 0; j < 8; ++j) cv[j] = 0.f;
#pragma unroll
                for (int dr = 0; dr < 3; ++dr)
#pragma unroll
                    for (int dc = 0; dc < 3; ++dc) { float pf[8]; unpack8(win[dr][tt + dc], pf);
#pragma unroll
                        for (int j = 0; j < 8; ++j) cv[j] += pf[j] * w[dr * 3 + dc][j]; }
                feat_post(F, (size_t)(b * 4096 + r * 64 + c0 + tt), grp, cl, cv, kk0, kk1);
            }
#pragma unroll
            for (int cc = 0; cc < 6; ++cc) { win[0][cc] = win[1][cc]; win[1][cc] = win[2][cc]; }
        }
    }
}
__device__ __forceinline__ void ab_gate_rows(const Ctx& c, int nrows) {
    const float* T = (const float*)(c.ws + WS_TAIL); float* GA = (float*)(c.ws + WS_GA); float* GB = (float*)(c.ws + WS_GB);
    bf16_t* A1 = (bf16_t*)(c.ws + WS_A1); bf16_t* A2 = (bf16_t*)(c.ws + WS_A2);
    const int lane = c.lane;
#pragma unroll 2
    for (int rr = c.gw; rr < nrows; rr += c.NGW) {
        const size_t r = (size_t)rr;
        const f32x4 t1 = *(const f32x4*)(T + r * TW0 + 32 + lane * 4);
        u32x2 o1; if (lane < 32) { o1.x = pk2(tanhf(t1.x), tanhf(t1.y)); o1.y = pk2(tanhf(t1.z), tanhf(t1.w)); } else { o1.x = pk2(t1.x, t1.y); o1.y = pk2(t1.z, t1.w); }
        *(u32x2*)(A1 + r * 256 + lane * 4) = o1;
        u32x2 o2 = {0u, 0u};
        if (lane < 40) { const f32x4 t2 = *(const f32x4*)(T + r * TW0 + 288 + lane * 4); o2.x = pk2(sigm(t2.x), sigm(t2.y)); o2.y = pk2(sigm(t2.z), sigm(t2.w)); }
        *(u32x2*)(A2 + r * 256 + lane * 4) = o2;
        if (lane < 16) {
            const float g0 = T[r * TW0 + lane], g1 = T[r * TW0 + 16 + lane];
            GA[r * 16 + lane] = -expf(c.in[IN_ALOG][lane]) * softplus_(g0 + c.in[IN_DTB][lane]);
            GB[r * 16 + lane] = sigm(g1);
        }
    }
}
__device__ __forceinline__ void ab_feature_phase(const Ctx& c) {
#ifndef FREP
#define FREP 0
#endif
    for (int q = 0; q < ((FREP & 1) ? 2 : 1); ++q) ab_feature_latent(c);
    for (int q = 0; q < ((FREP & 2) ? 2 : 1); ++q) ab_gate_rows(c, ML);
    for (int q = 0; q < ((FREP & 4) ? 2 : 1); ++q) ab_feature_strips(c, ML / 8);
}
__device__ __forceinline__ void rw_lora_phase(const Ctx& c) {
    bf16_t* P = (bf16_t*)(c.ws + WS_P); const float* T = (const float*)(c.ws + WS_TAIL);
    LAS float* xin = (LAS float*)c.lds;
    const int tid = c.tid;
    for (int tile = c.wg; tile < MT / 16; tile += c.G) {
        const int r0 = tile * 16;
#pragma unroll 1
        for (int pass = 0; pass < 2; ++pass) {
            __syncthreads();
            for (int i = tid; i < 16 * 128; i += NTHREADS) { const int tk = i >> 7, j = i & 127; const float v = T[(size_t)(r0 + tk) * TW0 + 32 + pass * 128 + j]; xin[i] = pass == 0 ? tanhf(v) : v; }
            __syncthreads();
            const float* up = c.in[pass == 0 ? IN_WUP : IN_AUP];
            float acc[16][2][2];
#pragma unroll
            for (int tk = 0; tk < 16; ++tk) { acc[tk][0][0] = acc[tk][0][1] = acc[tk][1][0] = acc[tk][1][1] = 0.f; }
#pragma unroll 2
            for (int rr = 0; rr < 64; ++rr) {
                const float w00 = up[(size_t)rr * 1024 + tid], w01 = up[(size_t)rr * 1024 + tid + 512], w10 = up[(size_t)(64 + rr) * 1024 + tid], w11 = up[(size_t)(64 + rr) * 1024 + tid + 512];
#pragma unroll
                for (int tk = 0; tk < 16; ++tk) { const float x0 = xin[tk * 128 + rr], x1 = xin[tk * 128 + 64 + rr];
                    acc[tk][0][0] += x0 * w00; acc[tk][0][1] += x0 * w01; acc[tk][1][0] += x1 * w10; acc[tk][1][1] += x1 * w11; }
            }
            const float* bias = c.in[pass == 0 ? IN_W0 : IN_A0];
#pragma unroll
            for (int d = 0; d < 2; ++d)
#pragma unroll
                for (int j = 0; j < 2; ++j) { const int ch = tid + 512 * j; const float bz = bias[d * 1024 + ch];
#pragma unroll
                    for (int tk = 0; tk < 16; ++tk) { const float s = sigm(bz + acc[tk][d][j]);
                        P[(size_t)(r0 + tk) * PW0 + (pass * 2 + d) * 1024 + ch] = (bf16_t)f2bf(pass == 0 ? -0.6065306597126334f * s : s); } }
        }
    }
}
__device__ __forceinline__ int chunk_row(int b, int dir, int s) {
    if (s < 4) return ML + b * 256 + (dir == 0 ? s : 3 - s) * 64;
    return b * 4096 + (dir == 0 ? s - 4 : 67 - s) * 64;
}
__device__ __forceinline__ void gdn_scan_phase(const Ctx& c) {
    const bf16_t* F = (const bf16_t*)(c.ws + WS_F); bf16_t* P = (bf16_t*)(c.ws + WS_P);
    const float* GA = (const float*)(c.ws + WS_GA); const float* GB = (const float*)(c.ws + WS_GB);
    const int lane = c.lane, tid = c.tid, slab = lane & 15, cl = c.wave * 4 + (lane >> 4);
    for (int item = c.wg; item < 256; item += c.G) {
        const int chain = item >> 2, cq = item & 3, b = chain >> 4, h = (chain >> 1) & 7, dir = chain & 1;
        float S[8];
#pragma unroll
        for (int i = 0; i < 8; ++i) S[i] = 0.f;
        u32x4 rk[2], rq[2], rv; float rg = 0.f, rb = 0.f;
        auto gload = [&](int s) {
            const int row0 = chunk_row(b, dir, s);
#pragma unroll
            for (int i = 0; i < 2; ++i) { const int pc = tid + i * 512, tk = pc >> 4, o = (pc & 15) * 8;
                rk[i] = *(const u32x4*)(F + (size_t)1 * MT * 1024 + (size_t)(row0 + tk) * 1024 + h * 128 + o);
                rq[i] = *(const u32x4*)(F + (size_t)0 * MT * 1024 + (size_t)(row0 + tk) * 1024 + h * 128 + o); }
            if (tid < 256) { const int tk = tid >> 2, o = (tid & 3) * 8; rv = *(const u32x4*)(F + (size_t)2 * MT * 1024 + (size_t)(row0 + tk) * 1024 + h * 128 + cq * 32 + o); }
            if (tid < 64) { rg = GA[(size_t)(row0 + tid) * 16 + dir * 8 + h]; rb = GB[(size_t)(row0 + tid) * 16 + dir * 8 + h]; }
        };
        auto lstore = [&](int bufi) {
            LAS unsigned char* bp = c.lds + bufi * 40960;
#pragma unroll
            for (int i = 0; i < 2; ++i) { const int pc = tid + i * 512; *(LAS u32x4*)(bp + pc * 16) = rk[i]; *(LAS u32x4*)(bp + 16384 + pc * 16) = rq[i]; }
            if (tid < 256) *(LAS u32x4*)(bp + 32768 + tid * 16) = rv;
            if (tid < 64) { *(LAS float*)(bp + 36864 + tid * 4) = rg; *(LAS float*)(bp + 37120 + tid * 4) = rb; }
        };
        __syncthreads();
        gload(0); lstore(0);
        __syncthreads();
        LAS float* ost = (LAS float*)(c.lds + 81920);
#pragma unroll 1
        for (int s = 0; s < 68; ++s) {
            if (s + 1 < 68) gload(s + 1);
            const LAS unsigned char* bp = c.lds + (s & 1) * 40960;
#pragma unroll 2
            for (int j = 0; j < 64; ++j) {
                const int tl = dir == 0 ? j : 63 - j;
                float kf[8], qf[8];
                unpack8(*(const LAS u32x4*)(bp + tl * 256 + slab * 16), kf);
                unpack8(*(const LAS u32x4*)(bp + 16384 + tl * 256 + slab * 16), qf);
                const float vv = bf1(*(const LAS bf16_t*)(bp + 32768 + tl * 64 + cl * 2));
                const float a = __expf(*(const LAS float*)(bp + 36864 + tl * 4)), bt = *(const LAS float*)(bp + 37120 + tl * 4);
                float dot = 0.f;
#pragma unroll
                for (int i = 0; i < 8; ++i) dot += S[i] * kf[i];
                dot = grp_sum<16>(dot);
                const float dlt = bt * (vv - a * dot);
                float od = 0.f;
#pragma unroll
                for (int i = 0; i < 8; ++i) { S[i] = a * S[i] + kf[i] * dlt; od += S[i] * qf[i]; }
                od = grp_sum<16>(od);
                if (slab == 0) ost[tl * 32 + cl] = od;
            }
            __syncthreads();
            {
                const int row0 = chunk_row(b, dir, s), tk = tid >> 3, o = (tid & 7) * 4;
                const f32x4 v = *(const LAS f32x4*)(ost + tk * 32 + o);
                u32x2 w; w.x = pk2(v.x, v.y); w.y = pk2(v.z, v.w);
                *(u32x2*)(P + (size_t)(row0 + tk) * PW0 + (4 + dir) * 1024 + h * 128 + cq * 32 + o) = w;
            }
            if (s + 1 < 68) lstore((s + 1) & 1);
            __syncthreads();
        }
    }
}
__device__ __forceinline__ void rwkv_scan_phase(const Ctx& c) {
    const bf16_t* F = (const bf16_t*)(c.ws + WS_F); const bf16_t* P = (const bf16_t*)(c.ws + WS_P);
    bf16_t* Y = (bf16_t*)(c.ws + WS_F);
    const int lane = c.lane, tid = c.tid, slab = lane & 15, rl = c.wave * 4 + (lane >> 4);
    for (int item = c.wg; item < 256; item += c.G) {
        const int chain = item >> 1, rh = item & 1, b = chain >> 5, h = (chain >> 1) & 15, dir = chain & 1;
        float S[4] = {0.f, 0.f, 0.f, 0.f};
        const f32x4 ka = *(const f32x4*)(c.in[IN_KA] + h * 64 + slab * 4);
        u32x4 rr[5]; u32x4 rv;
        auto gload = [&](int s) {
            const int row0 = chunk_row(b, dir, s);
            const int tk = tid >> 3, o = (tid & 7) * 8;
            rr[0] = *(const u32x4*)(F + (size_t)3 * MT * 1024 + (size_t)(row0 + tk) * 1024 + h * 64 + o);
            rr[1] = *(const u32x4*)(F + (size_t)4 * MT * 1024 + (size_t)(row0 + tk) * 1024 + h * 64 + o);
            rr[2] = *(const u32x4*)(F + (size_t)5 * MT * 1024 + (size_t)(row0 + tk) * 1024 + h * 64 + o);
            rr[3] = *(const u32x4*)(P + (size_t)(row0 + tk) * PW0 + (0 + dir) * 1024 + h * 64 + o);
            rr[4] = *(const u32x4*)(P + (size_t)(row0 + tk) * PW0 + (2 + dir) * 1024 + h * 64 + o);
            if (tid < 256) { const int t2 = tid >> 2, o2 = (tid & 3) * 8; rv = *(const u32x4*)(F + (size_t)6 * MT * 1024 + (size_t)(row0 + t2) * 1024 + h * 64 + rh * 32 + o2); }
        };
        auto lstore = [&](int bufi) {
            LAS unsigned char* bp = c.lds + bufi * 45056;
#pragma unroll
            for (int q = 0; q < 5; ++q) *(LAS u32x4*)(bp + q * 8192 + tid * 16) = rr[q];
            if (tid < 256) *(LAS u32x4*)(bp + 40960 + tid * 16) = rv;
        };
        __syncthreads();
        gload(0); lstore(0);
        __syncthreads();
        LAS float* yst = (LAS float*)(c.lds + 90112);
#pragma unroll 1
        for (int s = 0; s < 68; ++s) {
            if (s + 1 < 68) gload(s + 1);
            const LAS unsigned char* bp = c.lds + (s & 1) * 45056;
#pragma unroll 2
            for (int j = 0; j < 64; ++j) {
                const int tl = dir == 0 ? j : 63 - j;
                const u32x2 ur = *(const LAS u32x2*)(bp + tl * 128 + slab * 8), ukk = *(const LAS u32x2*)(bp + 8192 + tl * 128 + slab * 8), ukb = *(const LAS u32x2*)(bp + 16384 + tl * 128 + slab * 8),
                            ulw = *(const LAS u32x2*)(bp + 24576 + tl * 128 + slab * 8), ua = *(const LAS u32x2*)(bp + 32768 + tl * 128 + slab * 8);
                const float vv = bf1(*(const LAS bf16_t*)(bp + 40960 + tl * 64 + rl * 2));
                const float rf[4] = {bflo(ur.x), bfhi(ur.x), bflo(ur.y), bfhi(ur.y)}, kkf[4] = {bflo(ukk.x), bfhi(ukk.x), bflo(ukk.y), bfhi(ukk.y)}, kbf[4] = {bflo(ukb.x), bfhi(ukb.x), bflo(ukb.y), bfhi(ukb.y)},
                            lwf[4] = {bflo(ulw.x), bfhi(ulw.x), bflo(ulw.y), bfhi(ulw.y)}, af[4] = {bflo(ua.x), bfhi(ua.x), bflo(ua.y), bfhi(ua.y)};
                float sk = 0.f;
#pragma unroll
                for (int i = 0; i < 4; ++i) sk += S[i] * kkf[i];
                sk = grp_sum<16>(sk);
                float y = 0.f;
#pragma unroll
                for (int i = 0; i < 4; ++i) { const float w = __expf(lwf[i]), kka = kkf[i] * af[i], kt = kbf[i] * (1.f + (af[i] - 1.f) * ka[i]);
                    S[i] = S[i] * w - sk * kka + vv * kt; y += S[i] * rf[i]; }
                y = grp_sum<16>(y);
                if (slab == 0) yst[tl * 32 + rl] = y;
            }
            __syncthreads();
            {   const int row0 = chunk_row(b, dir, s), tk = tid >> 3, o = (tid & 7) * 4;
                const f32x4 v = *(const LAS f32x4*)(yst + tk * 32 + o);
                u32x2 w; w.x = pk2(v.x, v.y); w.y = pk2(v.z, v.w);
                *(u32x2*)(Y + (size_t)dir * MT * 1024 + (size_t)(row0 + tk) * 1024 + h * 64 + rh * 32 + o) = w;
            }
            if (s + 1 < 68) lstore((s + 1) & 1);
            __syncthreads();
        }
    }
}
__device__ __forceinline__ void ab_output_phase(const Ctx& c) {
    const bf16_t* F = (const bf16_t*)(c.ws + WS_F); const bf16_t* P = (const bf16_t*)(c.ws + WS_P); const bf16_t* GO = (const bf16_t*)(c.ws + WS_GOUT);
    bf16_t* Yo = (bf16_t*)(c.ws + WS_HY);
    const int lane = c.lane;
#pragma unroll 1
    for (int r = c.gw; r < MT; r += c.NGW) {
        const size_t row = (size_t)r;
        u32x4 outw[4];
#pragma unroll
        for (int blk = 0; blk < 2; ++blk) {
            const int ch = blk * 512 + lane * 8;
            float yf[8], yb[8], rv[8], kb[8], vb[8], a0[8], a1[8], go[8];
            unpack8(*(const u32x4*)(Yo + row * D + 1024 + ch), yf); unpack8(*(const u32x4*)(Yo + row * D + ch), yb);
            unpack8(*(const u32x4*)(F + (size_t)3 * MT * 1024 + row * 1024 + ch), rv); unpack8(*(const u32x4*)(F + (size_t)5 * MT * 1024 + row * 1024 + ch), kb);
            unpack8(*(const u32x4*)(F + (size_t)6 * MT * 1024 + row * 1024 + ch), vb);
            unpack8(*(const u32x4*)(P + row * PW0 + 2048 + ch), a0); unpack8(*(const u32x4*)(P + row * PW0 + 3072 + ch), a1);
            unpack8(*(const u32x4*)(GO + row * 1024 + ch), go);
            const f32x4 ka0 = *(const f32x4*)(c.in[IN_KA] + ch), ka1 = *(const f32x4*)(c.in[IN_KA] + ch + 4), rk0 = *(const f32x4*)(c.in[IN_RK] + ch), rk1 = *(const f32x4*)(c.in[IN_RK] + ch + 4);
            const f32x4 lw0 = *(const f32x4*)(c.in[IN_LNW] + ch), lw1 = *(const f32x4*)(c.in[IN_LNW] + ch + 4), lb0 = *(const f32x4*)(c.in[IN_LNB] + ch), lb1 = *(const f32x4*)(c.in[IN_LNB] + ch + 4);
            const float ka[8] = {ka0.x, ka0.y, ka0.z, ka0.w, ka1.x, ka1.y, ka1.z, ka1.w}, rk[8] = {rk0.x, rk0.y, rk0.z, rk0.w, rk1.x, rk1.y, rk1.z, rk1.w};
            const float lnw[8] = {lw0.x, lw0.y, lw0.z, lw0.w, lw1.x, lw1.y, lw1.z, lw1.w}, lnb[8] = {lb0.x, lb0.y, lb0.z, lb0.w, lb1.x, lb1.y, lb1.z, lb1.w};
            float s = 0.f, bs = 0.f;
#pragma unroll
            for (int j = 0; j < 8; ++j) { yf[j] += yb[j]; s += yf[j]; bs += rv[j] * kb[j] * (2.f + (a0[j] + a1[j] - 2.f) * ka[j]) * rk[j]; }
            const float mu = grp_sum<8>(s) * (1.f / 64.f); bs = grp_sum<8>(bs);
            float vs = 0.f;
#pragma unroll
            for (int j = 0; j < 8; ++j) { yf[j] -= mu; vs += yf[j] * yf[j]; }
            const float rstd = 1.f / sqrtf(grp_sum<8>(vs) * (1.f / 64.f) + 64e-5f);
            float o[8];
#pragma unroll
            for (int j = 0; j < 8; ++j) o[j] = (yf[j] * rstd * lnw[j] + lnb[j] + bs * vb[j]) * go[j];
            outw[2 + blk] = pack8(o);
        }
#pragma unroll
        for (int blk = 0; blk < 2; ++blk) {
            const int ch = blk * 512 + lane * 8;
            float of[8], ob[8], z[8];
            unpack8(*(const u32x4*)(P + row * PW0 + 4096 + ch), of); unpack8(*(const u32x4*)(P + row * PW0 + 5120 + ch), ob); unpack8(*(const u32x4*)(P + row * PW0 + 6144 + ch), z);
            const f32x4 n0 = *(const f32x4*)(c.in[IN_GDNNW] + (ch & 127)), n1 = *(const f32x4*)(c.in[IN_GDNNW] + (ch & 127) + 4);
            const float nw[8] = {n0.x, n0.y, n0.z, n0.w, n1.x, n1.y, n1.z, n1.w};
            float ss = 0.f;
#pragma unroll
            for (int j = 0; j < 8; ++j) { of[j] += ob[j]; ss += of[j] * of[j]; }
            const float rstd = 1.f / sqrtf(grp_sum<16>(ss) * (1.f / 128.f) + 1e-6f);
            float o[8];
#pragma unroll
            for (int j = 0; j < 8; ++j) o[j] = of[j] * rstd * nw[j] * silu_fast(z[j]);
            outw[blk] = pack8(o);
        }
#pragma unroll
        for (int q = 0; q < 4; ++q) *(u32x4*)(Yo + row * D + q * 512 + lane * 8) = outw[q];
    }
}

__device__ __forceinline__ void ml_gate_phase(const Ctx& c) {
    const float* T = (const float*)(c.ws + WS_TAIL); float* GA = (float*)(c.ws + WS_GA); float* GB = (float*)(c.ws + WS_GB);
    for (size_t i = (size_t)c.wg * NTHREADS + c.tid; i < (size_t)MT * 16; i += (size_t)c.G * NTHREADS) {
        const size_t r = i >> 4; const int k = (int)(i & 15);
        const float gi = T[r * TW1 + k] + c.in[IN_MLIB][k], gf = T[r * TW1 + 16 + k] + c.in[IN_MLFB][k];
        GA[i] = 15.f * tanhf(gi * (1.f / 15.f));
        GB[i] = logsigm_(15.f * tanhf(gf * (1.f / 15.f)));
    }
}
__device__ __forceinline__ void mlstm_scan_phase(const Ctx& c) {
    const bf16_t* P = (const bf16_t*)(c.ws + WS_P); bf16_t* Hs = (bf16_t*)(c.ws + WS_F);
    const float* GA = (const float*)(c.ws + WS_GA); const float* GB = (const float*)(c.ws + WS_GB);
    const int lane = c.lane, tid = c.tid, slab = lane & 15, cp = c.wave * 4 + (lane >> 4);
    for (int item = c.wg; item < 256; item += c.G) {
        const int chain = item >> 2, cq = item & 3, b = chain >> 4, h = (chain >> 1) & 7, dir = chain & 1;
        float C[8][2], n[8]; float m = 0.f;
#pragma unroll
        for (int i = 0; i < 8; ++i) { C[i][0] = C[i][1] = 0.f; n[i] = 0.f; }
        u32x4 rk[2], rq[2], rv; float rg = 0.f, rb = 0.f;
        auto gload = [&](int s) {
            const int row0 = chunk_row(b, dir, s);
#pragma unroll
            for (int i = 0; i < 2; ++i) { const int pc = tid + i * 512, tk = pc >> 4, o = (pc & 15) * 8;
                rk[i] = *(const u32x4*)(P + (size_t)(row0 + tk) * PW1 + 1024 + h * 128 + o);
                rq[i] = *(const u32x4*)(P + (size_t)(row0 + tk) * PW1 + h * 128 + o); }
            { const int tk = tid >> 3, o = (tid & 7) * 8; rv = *(const u32x4*)(P + (size_t)(row0 + tk) * PW1 + 2048 + h * 256 + cq * 64 + o); }
            if (tid < 64) { rg = GA[(size_t)(row0 + tid) * 16 + dir * 8 + h]; rb = GB[(size_t)(row0 + tid) * 16 + dir * 8 + h]; }
        };
        auto lstore = [&](int bufi) {
            LAS unsigned char* bp = c.lds + bufi * 41472;
#pragma unroll
            for (int i = 0; i < 2; ++i) { const int pc = tid + i * 512; *(LAS u32x4*)(bp + pc * 16) = rk[i]; *(LAS u32x4*)(bp + 16384 + pc * 16) = rq[i]; }
            *(LAS u32x4*)(bp + 32768 + tid * 16) = rv;
            if (tid < 64) { *(LAS float*)(bp + 40960 + tid * 4) = rg; *(LAS float*)(bp + 41216 + tid * 4) = rb; }
        };
        __syncthreads();
        gload(0); lstore(0);
        __syncthreads();
        LAS float* hst = (LAS float*)(c.lds + 82944);
#pragma unroll 1
        for (int s = 0; s < 68; ++s) {
            if (s + 1 < 68) gload(s + 1);
            const LAS unsigned char* bp = c.lds + (s & 1) * 41472;
#pragma unroll 2
            for (int j = 0; j < 64; ++j) {
                const int tl = dir == 0 ? j : 63 - j;
                float kf[8], qf[8];
                unpack8(*(const LAS u32x4*)(bp + tl * 256 + slab * 16), kf);
                unpack8(*(const LAS u32x4*)(bp + 16384 + tl * 256 + slab * 16), qf);
                const unsigned uv = *(const LAS unsigned*)(bp + 32768 + tl * 128 + cp * 4);
                const float v0 = bflo(uv), v1 = bfhi(uv);
                const float ig = *(const LAS float*)(bp + 40960 + tl * 4), lf = *(const LAS float*)(bp + 41216 + tl * 4);
                const float mn = fmaxf(lf + m, ig), fs = __expf(lf + m - mn), is = __expf(ig - mn);
                m = mn;
                float n0 = 0.f, n1 = 0.f, dn = 0.f;
#pragma unroll
                for (int i = 0; i < 8; ++i) { const float ki = is * kf[i], qi = qf[i] * 0.08838834764831845f;
                    C[i][0] = fs * C[i][0] + ki * v0; C[i][1] = fs * C[i][1] + ki * v1; n[i] = fs * n[i] + ki;
                    n0 += C[i][0] * qi; n1 += C[i][1] * qi; dn += n[i] * qi; }
                n0 = grp_sum<16>(n0); n1 = grp_sum<16>(n1); dn = grp_sum<16>(dn);
                if (slab == 0) { const float dd = 1.f / fmaxf(fabsf(dn), __expf(-mn)); hst[tl * 64 + cp * 2] = n0 * dd; hst[tl * 64 + cp * 2 + 1] = n1 * dd; }
            }
            __syncthreads();
            if (s >= 4) {
                const int row0 = chunk_row(b, dir, s), tk = tid >> 3, o = (tid & 7) * 8;
                float v[8];
#pragma unroll
                for (int i = 0; i < 8; ++i) v[i] = hst[tk * 64 + o + i];
                *(u32x4*)(Hs + (size_t)dir * ML * D + (size_t)(row0 + tk) * D + h * 256 + cq * 64 + o) = pack8(v);
            }
            if (s + 1 < 68) lstore((s + 1) & 1);
            __syncthreads();
        }
    }
}
__device__ __forceinline__ void ml_output_phase(const Ctx& c) {
    const bf16_t* Hs = (const bf16_t*)(c.ws + WS_F); const bf16_t* P = (const bf16_t*)(c.ws + WS_P); bf16_t* Yo = (bf16_t*)(c.ws + WS_HY);
    const float* nw = c.in[IN_MLNW];
    for (int r = c.gw; r < ML; r += c.NGW) {
#pragma unroll
        for (int blk = 0; blk < 4; ++blk) {
            const int ch = blk * 512 + c.lane * 8;
            float a[8], bb[8], o[8];
            unpack8(*(const u32x4*)(Hs + (size_t)r * D + ch), a); unpack8(*(const u32x4*)(Hs + (size_t)ML * D + (size_t)r * D + ch), bb);
            unpack8(*(const u32x4*)(P + (size_t)r * PW1 + 4096 + ch), o);
            float ss = 0.f;
#pragma unroll
            for (int j = 0; j < 8; ++j) { a[j] += bb[j]; ss += a[j] * a[j]; }
            ss = grp_sum<32>(ss); const float rstd = 1.f / sqrtf(ss * (1.f / 256.f) + 1e-6f);
            const f32x4 w0 = *(const f32x4*)(nw + ch), w1 = *(const f32x4*)(nw + ch + 4);
            const float wv[8] = {w0.x, w0.y, w0.z, w0.w, w1.x, w1.y, w1.z, w1.w};
#pragma unroll
            for (int j = 0; j < 8; ++j) a[j] = a[j] * rstd * wv[j] * sigm_fast(o[j]);
            *(u32x4*)(Yo + (size_t)r * D + ch) = pack8(a);
        }
    }
}


typedef short bf16x8 __attribute__((ext_vector_type(8)));
typedef short s16x4 __attribute__((ext_vector_type(4)));
#define MFMA16(a, b, c) __builtin_amdgcn_mfma_f32_16x16x32_bf16((a), (b), (c), 0, 0, 0)
__device__ __forceinline__ bf16x8 frag_row(const LAS unsigned char* img, int RS, int r0, int k0, int lane) {
    return *(const LAS bf16x8*)(img + (r0 + (lane & 15)) * RS + (k0 + 8 * (lane >> 4)) * 2);
}
__device__ __forceinline__ bf16x8 frag_tr(const LAS unsigned char* img, int RS, int r0, int k0, int lane) {
    const int g = lane >> 4, q = (lane & 15) >> 2, p = lane & 3;
    LAS unsigned char* a = (LAS unsigned char*)img + (k0 + 8 * g + q) * RS + (r0 + 4 * p) * 2;
    const s16x4 lo = __builtin_amdgcn_ds_read_tr16_b64_v4i16((LAS s16x4*)a);
    const s16x4 hi = __builtin_amdgcn_ds_read_tr16_b64_v4i16((LAS s16x4*)(a + 4 * RS));
    bf16x8 r; r[0] = lo[0]; r[1] = lo[1]; r[2] = lo[2]; r[3] = lo[3]; r[4] = hi[0]; r[5] = hi[1]; r[6] = hi[2]; r[7] = hi[3];
    return r;
}
__device__ __forceinline__ void tile_write(LAS unsigned char* img, int RS, int n0, int m0, int lane, const f32x4 v) {
    u32x2 o; o.x = pk2(v[0], v[1]); o.y = pk2(v[2], v[3]);
    *(LAS u32x2*)(img + (n0 + (lane & 15)) * RS + (m0 + 4 * (lane >> 4)) * 2) = o;
}
constexpr int MS = 68;
__device__ __forceinline__ bf16x8 frag_pack(const f32x4 a, const f32x4 b) { u32x4 u; u.x = pk2(a[0], a[1]); u.y = pk2(a[2], a[3]); u.z = pk2(b[0], b[1]); u.w = pk2(b[2], b[3]); return __builtin_bit_cast(bf16x8, u); }
__device__ __forceinline__ void tri_inverse_wave0(LAS float* MF, int lane) {
    {
        const int g = lane >> 4, i = lane & 15;
        const f32x4 z4 = {0.f, 0.f, 0.f, 0.f};
        {   LAS float* base = MF + (g * 16) * MS + g * 16; float acc[16];
#pragma unroll
            for (int r = 0; r < 16; ++r) acc[r] = (r == i) ? 1.f : 0.f;
#pragma unroll
            for (int j = 0; j < 15; ++j) { const float xj = acc[j];
#pragma unroll
                for (int r = j + 1; r < 16; ++r) acc[r] -= base[r * MS + j] * xj; }
#pragma unroll
            for (int r = 0; r < 16; ++r) base[r * MS + i] = acc[r];
        }
#pragma unroll
        for (int h = 0; h < 2; ++h) {
            const int R0 = h ? 48 : 16, C0 = h ? 32 : 0;
            bf16x8 a1, b1;
            {   const LAS float* pa = MF + (R0 + i) * MS + C0 + 8 * (g & 1);
                const f32x4 x0 = *(const LAS f32x4*)pa, x1 = *(const LAS f32x4*)(pa + 4);
                f32x4 y0, y1;
#pragma unroll
                for (int j = 0; j < 4; ++j) { y0[j] = MF[(C0 + 8 * (g & 1) + j) * MS + C0 + i]; y1[j] = MF[(C0 + 8 * (g & 1) + 4 + j) * MS + C0 + i]; }
                a1 = g < 2 ? frag_pack(x0, x1) : frag_pack(z4, z4); b1 = g < 2 ? frag_pack(y0, y1) : frag_pack(z4, z4); }
            const f32x4 t = MFMA16(a1, b1, z4);
            const f32x4 xa = *(const LAS f32x4*)(MF + (R0 + i) * MS + R0 + 4 * g);
            const f32x4 x = MFMA16(frag_pack(xa, z4), frag_pack(t, z4), z4);
#pragma unroll
            for (int r = 0; r < 4; ++r) MF[(R0 + 4 * g + r) * MS + C0 + i] = -x[r];
        }
        {   bf16x8 a[2], b[2];
#pragma unroll
            for (int I = 0; I < 2; ++I) { const LAS float* pa = MF + (32 + 16 * I + i) * MS + 8 * g; a[I] = frag_pack(*(const LAS f32x4*)pa, *(const LAS f32x4*)(pa + 4)); }
#pragma unroll
            for (int J = 0; J < 2; ++J) { f32x4 y0, y1;
#pragma unroll
                for (int j = 0; j < 4; ++j) { y0[j] = MF[(8 * g + j) * MS + 16 * J + i]; y1[j] = MF[(8 * g + 4 + j) * MS + 16 * J + i]; }
                b[J] = frag_pack(y0, y1); }
            f32x4 t[2][2];
#pragma unroll
            for (int I = 0; I < 2; ++I)
#pragma unroll
                for (int J = 0; J < 2; ++J) t[I][J] = MFMA16(a[I], b[J], z4);
            bf16x8 a2[2];
#pragma unroll
            for (int I = 0; I < 2; ++I) { const LAS float* pa = MF + (32 + 16 * I + i) * MS + 32 + 4 * g; a2[I] = frag_pack(*(const LAS f32x4*)pa, *(const LAS f32x4*)(pa + 16)); }
#pragma unroll
            for (int I = 0; I < 2; ++I)
#pragma unroll
                for (int J = 0; J < 2; ++J) { const f32x4 x = MFMA16(a2[I], frag_pack(t[0][J], t[1][J]), z4);
#pragma unroll
                    for (int r = 0; r < 4; ++r) MF[(32 + 16 * I + 4 * g + r) * MS + 16 * J + i] = -x[r]; }
        }
    }
}
__device__ __forceinline__ void tri_inverse_64(LAS float* MF, LAS float* TMP, int tid) {
    (void)TMP;
    if (tid < 64) tri_inverse_wave0(MF, tid);
    __syncthreads();
}
#define DPP_F(old, src, ctrl, rmask) __builtin_bit_cast(float, __builtin_amdgcn_update_dpp(__builtin_bit_cast(int, (float)(old)), __builtin_bit_cast(int, (float)(src)), (ctrl), (rmask), 0xF, false))
__device__ __forceinline__ float wave_incl_scan_add(float x, int lane) {
    (void)lane;
    x += DPP_F(0.f, x, 0x111, 0xF); x += DPP_F(0.f, x, 0x112, 0xF); x += DPP_F(0.f, x, 0x114, 0xF); x += DPP_F(0.f, x, 0x118, 0xF);
    x += DPP_F(0.f, x, 0x142, 0xA); x += DPP_F(0.f, x, 0x143, 0xC);
    return x;
}
__device__ __forceinline__ float wave_incl_scan_max(float x, int lane) {
    (void)lane;
    const float ninf = -__builtin_inff();
    x = fmaxf(x, DPP_F(ninf, x, 0x111, 0xF)); x = fmaxf(x, DPP_F(ninf, x, 0x112, 0xF)); x = fmaxf(x, DPP_F(ninf, x, 0x114, 0xF)); x = fmaxf(x, DPP_F(ninf, x, 0x118, 0xF));
    x = fmaxf(x, DPP_F(ninf, x, 0x142, 0xA)); x = fmaxf(x, DPP_F(ninf, x, 0x143, 0xC));
    return x;
}
constexpr int RS128 = 272, RS64 = 144, RS80 = 176;

#ifdef PROBE_SCAN
#define TS_DECL unsigned tacc[14]; _Pragma("unroll") for (int _q = 0; _q < 14; ++_q) tacc[_q] = 0u; unsigned long long tlast = __builtin_amdgcn_s_memrealtime();
#define TS(k) do { if (tid == 0) { const unsigned long long _n = __builtin_amdgcn_s_memrealtime(); tacc[k] += (unsigned)(_n - tlast); tlast = _n; } } while (0)
#define TS_OUT(which) do { if (tid == 0 && item == 0 && PROBE_SCAN == (which)) { unsigned _sum = 0; _Pragma("unroll") for (int _q = 0; _q < 13; ++_q) { ((unsigned long long*)(c.ws + 14336))[40 + _q] = tacc[_q]; _sum += tacc[_q]; } ((unsigned long long*)(c.ws + 14336))[53] = _sum; } } while (0)
#else
#define TS_DECL
#define TS(k)
#define TS_OUT(which)
#endif
__device__ __forceinline__ void mlstm_chunk_phase(const Ctx& c) {
    const bf16_t* P = (const bf16_t*)(c.ws + WS_P); bf16_t* Hs = (bf16_t*)(c.ws + WS_F);
    const int lane = c.lane, tid = c.tid, w = c.wave, g4 = lane >> 4, l15 = lane & 15;
    LAS unsigned char* KIMG = c.lds; LAS unsigned char* QIMG = c.lds + 17408; LAS unsigned char* VIMG = c.lds + 34816; LAS unsigned char* VS = c.lds + 46080;
    LAS unsigned char* CT = c.lds + 66560;
    LAS float* sB = (LAS float*)(c.lds + 88320); LAS float* sCM = sB + 64; LAS float* sIGB = sB + 128;
    for (int item = c.wg; item < 256; item += c.G) {
        const int chain = item >> 2, cq = item & 3, b = chain >> 4, h = (chain >> 1) & 7, dir = chain & 1;
        f32x4 st[5];
#pragma unroll
        for (int e = 0; e < 5; ++e) st[e] = (f32x4){0.f, 0.f, 0.f, 0.f};
        float m = 0.f; const float ibias = c.in[IN_MLIB][dir * 8 + h], fbias = c.in[IN_MLFB][dir * 8 + h];
        u32x4 rk[2], rq[2], rv; float rg = 0.f, rb = 0.f;
        auto gload = [&](int s) {
            const int row0 = chunk_row(b, dir, s);
#pragma unroll
            for (int i = 0; i < 2; ++i) { const int pc = tid + i * 512, tk = pc >> 4, o = (pc & 15) * 8;
                rk[i] = *(const u32x4*)(P + (size_t)(row0 + tk) * PW1 + 1024 + h * 128 + o);
                rq[i] = *(const u32x4*)(P + (size_t)(row0 + tk) * PW1 + h * 128 + o); }
            { const int tk = tid >> 3, o = (tid & 7) * 8; rv = *(const u32x4*)(P + (size_t)(row0 + tk) * PW1 + 2048 + h * 256 + cq * 64 + o); }
            { const float* tp = (const float*)(c.ws + WS_TAIL) + (size_t)(row0 + lane) * TW1 + dir * 8 + h; rg = tp[0]; rb = tp[16]; }
        };
        __syncthreads();
        for (int i = tid; i < 80 * 34; i += NTHREADS) ((LAS u32x2*)CT)[i] = (u32x2){0u, 0u};
        gload(0);
        TS_DECL
#pragma unroll 1
        for (int s = 0; s < 68; ++s) {
            TS(0);
            const int src = dir ? 63 - lane : lane;
            const float ig = softcap15_fast(__shfl(rg, src) + ibias), xf = softcap15_fast(__shfl(rb, src) + fbias), lf = fminf(xf, 0.f) - __logf(1.f + __expf(-fabsf(xf)));
            const float bb = wave_incl_scan_add(lf, lane), igb = ig - bb, cm = wave_incl_scan_max(igb, lane);
            const float c63 = __builtin_bit_cast(float, __builtin_amdgcn_readlane(__builtin_bit_cast(int, cm), 63)), blast = __builtin_bit_cast(float, __builtin_amdgcn_readlane(__builtin_bit_cast(int, bb), 63));
            if (w == 0) { sB[lane] = bb; sCM[lane] = cm; sIGB[lane] = igb; }
#pragma unroll
            for (int i = 0; i < 2; ++i) { const int pc = tid + i * 512, tk = pc >> 4, o = pc & 15, ri = dir ? 63 - tk : tk;
                *(LAS u32x4*)(KIMG + ri * RS128 + o * 16) = rk[i]; *(LAS u32x4*)(QIMG + ri * RS128 + o * 16) = rq[i]; }
            { const int tk = tid >> 3, o = tid & 7, ri = dir ? 63 - tk : tk;
              const float f = __expf(__shfl(igb, ri) - c63);
              float v[8]; unpack8(rv, v);
              *(LAS u32x4*)(VIMG + ri * RS80 + o * 16) = rv;
#pragma unroll
              for (int q = 0; q < 8; ++q) v[q] *= f;
              *(LAS u32x4*)(VS + ri * RS80 + o * 16) = pack8(v);
              if (o == 0) { *(LAS u32x4*)(VIMG + ri * RS80 + 128) = (u32x4){0x3F80u, 0u, 0u, 0u}; *(LAS u32x4*)(VIMG + ri * RS80 + 144) = (u32x4){0u, 0u, 0u, 0u};
                            *(LAS u32x4*)(VS + ri * RS80 + 128) = (u32x4){f2bf(f), 0u, 0u, 0u}; *(LAS u32x4*)(VS + ri * RS80 + 144) = (u32x4){0u, 0u, 0u, 0u}; } }
            __syncthreads();
            TS(1);
            if (s + 1 < 68) gload(s + 1);
            const float mx63 = fmaxf(m, c63), cscale = __expf(m - mx63), s2 = __expf(c63 - mx63);
            if (s >= 4) {
                const int ib = w & 3, eh = w >> 2, i = ib * 16 + l15;
                const float mxi = fmaxf(m, sCM[i]), inter = __expf(m - mxi) * 0.08838834764831845f, floorv = __expf(-(sB[i] + mxi));
                bf16x8 bq[4];
#pragma unroll
                for (int k = 0; k < 4; ++k) bq[k] = frag_row(QIMG, RS128, ib * 16, k * 32, lane);
                f32x4 sm[4];
#pragma unroll
                for (int jt = 0; jt < 4; ++jt) { sm[jt] = (f32x4){0.f, 0.f, 0.f, 0.f};
                    if (jt <= ib) {
#pragma unroll
                        for (int k = 0; k < 4; ++k) sm[jt] = MFMA16(frag_row(KIMG, RS128, jt * 16, k * 32, lane), bq[k], sm[jt]);
                        const f32x4 igb4 = *(const LAS f32x4*)(sIGB + jt * 16 + 4 * g4);
#pragma unroll
                        for (int r = 0; r < 4; ++r) { const int j = jt * 16 + 4 * g4 + r; const float sv = sm[jt][r] * 0.08838834764831845f * __expf(igb4[r] - mxi); sm[jt][r] = (j <= i) ? sv : 0.f; } } }
                const bf16x8 bs0 = frag_pack(sm[0], sm[1]), bs1 = frag_pack(sm[2], sm[3]);
                f32x4 val[3];
#pragma unroll
                for (int t = 0; t < 3; ++t) { const int eb = t < 2 ? eh * 2 + t : 4; f32x4 a1 = {0.f, 0.f, 0.f, 0.f}, a2 = {0.f, 0.f, 0.f, 0.f};
                    {
                        const int q = (lane & 15) >> 2, pp = lane & 3;
                        LAS unsigned char* a = VIMG + (4 * g4 + q) * RS80 + (eb * 16 + 4 * pp) * 2;
                        const s16x4 l0 = __builtin_amdgcn_ds_read_tr16_b64_v4i16((LAS s16x4*)a), h0 = __builtin_amdgcn_ds_read_tr16_b64_v4i16((LAS s16x4*)(a + 16 * RS80));
                        const s16x4 l1 = __builtin_amdgcn_ds_read_tr16_b64_v4i16((LAS s16x4*)(a + 32 * RS80)), h1 = __builtin_amdgcn_ds_read_tr16_b64_v4i16((LAS s16x4*)(a + 48 * RS80));
                        bf16x8 av0, av1;
                        av0[0] = l0[0]; av0[1] = l0[1]; av0[2] = l0[2]; av0[3] = l0[3]; av0[4] = h0[0]; av0[5] = h0[1]; av0[6] = h0[2]; av0[7] = h0[3];
                        av1[0] = l1[0]; av1[1] = l1[1]; av1[2] = l1[2]; av1[3] = l1[3]; av1[4] = h1[0]; av1[5] = h1[1]; av1[6] = h1[2]; av1[7] = h1[3];
                        a1 = MFMA16(av0, bs0, a1);
                        if (ib >= 2) a1 = MFMA16(av1, bs1, a1); }
#pragma unroll
                    for (int k = 0; k < 4; ++k) a2 = MFMA16(frag_row(CT, RS128, eb * 16, k * 32, lane), bq[k], a2);
                    val[t] = a1 + a2 * inter; }
                const float den = __shfl(val[2][0], l15);
                const float dd = 1.f / fmaxf(fabsf(den), floorv);
                const int tl = dir ? 63 - i : i, row0 = chunk_row(b, dir, s);
#pragma unroll
                for (int t = 0; t < 2; ++t) { const int e0 = (eh * 2 + t) * 16 + 4 * g4; u32x2 o; o.x = pk2(val[t][0] * dd, val[t][1] * dd); o.y = pk2(val[t][2] * dd, val[t][3] * dd);
                    *(u32x2*)(Hs + (size_t)dir * ML * D + (size_t)(row0 + tl) * D + h * 256 + cq * 64 + e0) = o; }
            }
            TS(6);
            {   bf16x8 ak[2];
#pragma unroll
                for (int k = 0; k < 2; ++k) ak[k] = frag_tr(KIMG, RS128, w * 16, k * 32, lane);
#pragma unroll
                for (int e = 0; e < 5; ++e) { f32x4 t = {0.f, 0.f, 0.f, 0.f};
#pragma unroll
                    for (int k = 0; k < 2; ++k) t = MFMA16(ak[k], frag_tr(VS, RS80, e * 16, k * 32, lane), t);
                    st[e] = st[e] * cscale + t * s2; }
            }
            m = blast + mx63;
            TS(7);
            __syncthreads();
            TS(3);
#pragma unroll
            for (int e = 0; e < 5; ++e) tile_write(CT, RS128, e * 16, w * 16, lane, st[e]);
        }
        TS_OUT(3);
    }
}

__device__ __forceinline__ void gdn_chunk_items(const Ctx& c, int item0, int item_stride, int n_items) {
    const bf16_t* F = (const bf16_t*)(c.ws + WS_F); bf16_t* P = (bf16_t*)(c.ws + WS_P);
    const float* GA = (const float*)(c.ws + WS_GA); const float* GB = (const float*)(c.ws + WS_GB);
    const int lane = c.lane, tid = c.tid, w = c.wave, g4 = lane >> 4, l15 = lane & 15;
    LAS unsigned char* KIMG = c.lds; LAS unsigned char* QIMG = c.lds + 17408; LAS unsigned char* VIMG = c.lds + 34816; LAS unsigned char* ST = c.lds + 44032;
    LAS unsigned char* WIMG = c.lds + 61440; LAS unsigned char* QKM = c.lds + 78848; LAS unsigned char* VNT = c.lds + 88064; LAS unsigned char* VNS = c.lds + 97280;
    LAS unsigned char* TW = c.lds + 106496; LAS unsigned char* TU = c.lds + 115712; LAS float* MF = (LAS float*)(c.lds + 124928); LAS float* TMP = (LAS float*)VNT;
    LAS float* sGC = (LAS float*)(c.lds + 142336); LAS float* sEG = sGC + 64; LAS float* sEL = sGC + 128; LAS float* sBT = sGC + 192; LAS float* sBG = sGC + 256;
    for (int item = item0; item < n_items; item += item_stride) {
        const int chain = item >> 1, eh = item & 1, b = chain >> 4, h = (chain >> 1) & 7, dir = chain & 1;
        f32x4 st[4];
#pragma unroll
        for (int e = 0; e < 4; ++e) st[e] = (f32x4){0.f, 0.f, 0.f, 0.f};
        u32x4 rk[2], rq[2], rv; float rg = 0.f, rb = 0.f;
        auto gload = [&](int s) {
            const int row0 = chunk_row(b, dir, s);
#pragma unroll
            for (int i = 0; i < 2; ++i) { const int pc = tid + i * 512, tk = pc >> 4, o = (pc & 15) * 8;
                rk[i] = *(const u32x4*)(F + (size_t)1 * MT * 1024 + (size_t)(row0 + tk) * 1024 + h * 128 + o);
                rq[i] = *(const u32x4*)(F + (size_t)0 * MT * 1024 + (size_t)(row0 + tk) * 1024 + h * 128 + o); }
            { const int tk = tid >> 3, o = (tid & 7) * 8; rv = *(const u32x4*)(F + (size_t)2 * MT * 1024 + (size_t)(row0 + tk) * 1024 + h * 128 + eh * 64 + o); }
            if (tid < 64) { rg = GA[(size_t)(row0 + tid) * 16 + dir * 8 + h]; rb = GB[(size_t)(row0 + tid) * 16 + dir * 8 + h]; }
        };
        __syncthreads();
        for (int i = tid; i < 64 * 34; i += NTHREADS) ((LAS u32x2*)ST)[i] = (u32x2){0u, 0u};
        gload(0);
        TS_DECL
#pragma unroll 1
        for (int s = 0; s < 68; ++s) {
            TS(0);
#pragma unroll
            for (int i = 0; i < 2; ++i) { const int pc = tid + i * 512, tk = pc >> 4, o = pc & 15, ri = dir ? 63 - tk : tk;
                *(LAS u32x4*)(KIMG + ri * RS128 + o * 16) = rk[i]; *(LAS u32x4*)(QIMG + ri * RS128 + o * 16) = rq[i]; }
            { const int tk = tid >> 3, o = tid & 7, ri = dir ? 63 - tk : tk; *(LAS u32x4*)(VIMG + ri * RS64 + o * 16) = rv; }
            if (w == 0) {
                const int src = dir ? 63 - lane : lane;
                const float gg = __shfl(rg, src), bt = __shfl(rb, src);
                const float gc = wave_incl_scan_add(gg, lane), gl = __shfl(gc, 63), eg = __expf(gc);
                sGC[lane] = gc; sEG[lane] = eg; sEL[lane] = __expf(gl - gc); sBT[lane] = bt; sBG[lane] = bt * eg;
            }
            __syncthreads();
            TS(1);
            if (s + 1 < 68) gload(s + 1);
            {   const int ib = w >> 1, i = ib * 16 + l15; const float gci = sGC[i], bti = sBT[i];
                bf16x8 bk[4];
#pragma unroll
                for (int k = 0; k < 4; ++k) bk[k] = frag_row(KIMG, RS128, ib * 16, k * 32, lane);
#pragma unroll
                for (int t = 0; t < 2; ++t) { const int jb = (w & 1) * 2 + t; f32x4 a1 = {0.f, 0.f, 0.f, 0.f};
#pragma unroll
                    for (int k = 0; k < 4; ++k) a1 = MFMA16(frag_row(KIMG, RS128, jb * 16, k * 32, lane), bk[k], a1);
                    f32x4 mv;
                    const f32x4 gcj = *(const LAS f32x4*)(sGC + jb * 16 + 4 * g4);
#pragma unroll
                    for (int r = 0; r < 4; ++r) { const int j = jb * 16 + 4 * g4 + r; const float sv = bti * a1[r] * __expf(gci - gcj[r]); mv[r] = (j < i) ? sv : 0.f; }
                    *(LAS f32x4*)(MF + i * MS + jb * 16 + 4 * g4) = mv; }
            }
            __syncthreads();
            TS(2);
            if (w == 0) tri_inverse_wave0(MF, lane);
            else {
#pragma unroll 1
                for (int tile = w - 1; tile < 16; tile += 7) {
                    const int ib = tile >> 2, jb = tile & 3, i = ib * 16 + l15; const float gci = sGC[i];
                    f32x4 a2 = {0.f, 0.f, 0.f, 0.f};
#pragma unroll
                    for (int k = 0; k < 4; ++k) a2 = MFMA16(frag_row(KIMG, RS128, jb * 16, k * 32, lane), frag_row(QIMG, RS128, ib * 16, k * 32, lane), a2);
                    const f32x4 gcj = *(const LAS f32x4*)(sGC + jb * 16 + 4 * g4);
#pragma unroll
                    for (int r = 0; r < 4; ++r) { const int j = jb * 16 + 4 * g4 + r; const float sv = a2[r] * __expf(gci - gcj[r]); a2[r] = (j <= i) ? sv : 0.f; }
                    tile_write(QKM, RS64, ib * 16, jb * 16, lane, a2); }
            }
            __syncthreads();
            TS(3);
            {   const int i = tid >> 3, j8 = (tid & 7) * 8; float tw[8], tu[8];
#pragma unroll
                for (int q = 0; q < 8; ++q) { const float x = MF[i * MS + j8 + q]; tw[q] = x * sBG[j8 + q]; tu[q] = x * sBT[j8 + q]; }
                *(LAS u32x4*)(TW + i * RS64 + j8 * 2) = pack8(tw); *(LAS u32x4*)(TU + i * RS64 + j8 * 2) = pack8(tu); }
            __syncthreads();
            TS(4);
            f32x4 ut[2];
            {   const int ib = w >> 1;
                bf16x8 au[2];
#pragma unroll
                for (int k = 0; k < 2; ++k) au[k] = frag_row(TU, RS64, ib * 16, k * 32, lane);
#pragma unroll
                for (int t = 0; t < 2; ++t) { const int eb = (w & 1) * 2 + t; ut[t] = (f32x4){0.f, 0.f, 0.f, 0.f};
#pragma unroll
                    for (int k = 0; k < 2; ++k) ut[t] = MFMA16(au[k], frag_tr(VIMG, RS64, eb * 16, k * 32, lane), ut[t]); }
                bf16x8 akt[2];
#pragma unroll
                for (int k = 0; k < 2; ++k) akt[k] = frag_tr(KIMG, RS128, w * 16, k * 32, lane);
#pragma unroll
                for (int i2 = 0; i2 < 4; ++i2) { f32x4 a = {0.f, 0.f, 0.f, 0.f};
#pragma unroll
                    for (int k = 0; k < 2; ++k) a = MFMA16(akt[k], frag_row(TW, RS64, i2 * 16, k * 32, lane), a);
                    tile_write(WIMG, RS128, i2 * 16, w * 16, lane, a); }
            }
            __syncthreads();
            TS(5);
            {   const int ib = w >> 1;
                bf16x8 aw[4];
#pragma unroll
                for (int k = 0; k < 4; ++k) aw[k] = frag_row(WIMG, RS128, ib * 16, k * 32, lane);
#pragma unroll
                for (int t = 0; t < 2; ++t) { const int eb = (w & 1) * 2 + t; f32x4 a = {0.f, 0.f, 0.f, 0.f};
#pragma unroll
                    for (int k = 0; k < 4; ++k) a = MFMA16(aw[k], frag_row(ST, RS128, eb * 16, k * 32, lane), a);
                    f32x4 vn = ut[t] - a, vs;
                    { const f32x4 el4 = *(const LAS f32x4*)(sEL + ib * 16 + 4 * g4); vs = vn * el4; }
                    tile_write(VNT, RS64, eb * 16, ib * 16, lane, vn); tile_write(VNS, RS64, eb * 16, ib * 16, lane, vs); }
            }
            __syncthreads();
            TS(6);
            {   const int eb = w >> 1, row0 = chunk_row(b, dir, s);
                bf16x8 as[4], av[2];
#pragma unroll
                for (int k = 0; k < 4; ++k) as[k] = frag_row(ST, RS128, eb * 16, k * 32, lane);
#pragma unroll
                for (int k = 0; k < 2; ++k) av[k] = frag_row(VNT, RS64, eb * 16, k * 32, lane);
#pragma unroll
                for (int t = 0; t < 2; ++t) { const int ib = (w & 1) * 2 + t, i = ib * 16 + l15; f32x4 a = {0.f, 0.f, 0.f, 0.f};
#pragma unroll
                    for (int k = 0; k < 4; ++k) a = MFMA16(as[k], frag_row(QIMG, RS128, ib * 16, k * 32, lane), a);
                    a = a * sEG[i];
#pragma unroll
                    for (int k = 0; k < 2; ++k) a = MFMA16(av[k], frag_row(QKM, RS64, ib * 16, k * 32, lane), a);
                    const int tl = dir ? 63 - i : i; u32x2 o; o.x = pk2(a[0], a[1]); o.y = pk2(a[2], a[3]);
                    *(u32x2*)(P + (size_t)(row0 + tl) * PW0 + (4 + dir) * 1024 + h * 128 + eh * 64 + eb * 16 + 4 * g4) = o; }
                const float al = __expf(sGC[63]);
                bf16x8 akt[2];
#pragma unroll
                for (int k = 0; k < 2; ++k) akt[k] = frag_tr(KIMG, RS128, w * 16, k * 32, lane);
#pragma unroll
                for (int e = 0; e < 4; ++e) { st[e] = st[e] * al;
#pragma unroll
                    for (int k = 0; k < 2; ++k) st[e] = MFMA16(akt[k], frag_row(VNS, RS64, e * 16, k * 32, lane), st[e]); }
            }
            __syncthreads();
            TS(7);
#pragma unroll
            for (int e = 0; e < 4; ++e) tile_write(ST, RS128, e * 16, w * 16, lane, st[e]);
        }
        TS_OUT(1);
    }
}

__device__ __forceinline__ void rwkv_chunk_items(const Ctx& c, int item0, int item_stride, int n_items, bf16_t* Ybase, long ydir_stride, int ystride) {
    const bf16_t* F = (const bf16_t*)(c.ws + WS_F); const bf16_t* P = (const bf16_t*)(c.ws + WS_P);
    const int lane = c.lane, tid = c.tid, w = c.wave, g4 = lane >> 4, l15 = lane & 15;
    LAS unsigned char* KKP = c.lds; LAS unsigned char* RP = c.lds + 9216; LAS unsigned char* TMPVT = c.lds + 18432; LAS unsigned char* WK = c.lds + 27648;
    LAS unsigned char* VIMG = c.lds + 36864; LAS unsigned char* ST = c.lds + 46080; LAS unsigned char* ART = c.lds + 55296; LAS unsigned char* ARA = c.lds + 64512;
    LAS unsigned char* TI = c.lds + 73728; LAS unsigned char* KTI = c.lds + 82944; LAS unsigned char* KAI = c.lds + 92160; LAS unsigned char* AKT = c.lds + 101376;
    LAS unsigned char* UT = AKT;
    LAS float* MF = (LAS float*)(c.lds + 110592); LAS float* EP = MF; LAS float* TMP = (LAS float*)(c.lds + 128000); LAS float* sPC = (LAS float*)(c.lds + 132096);
    for (int item = item0; item < n_items; item += item_stride) {
        const int chain = item, b = chain >> 5, h = (chain >> 1) & 15, dir = chain & 1;
        f32x4 st[2] = {{0.f, 0.f, 0.f, 0.f}, {0.f, 0.f, 0.f, 0.f}};
        const int tk = tid >> 3, o8 = tid & 7, ri = dir ? 63 - tk : tk;
        float kav[8];
        { const f32x4 k0 = *(const f32x4*)(c.in[IN_KA] + h * 64 + o8 * 8), k1 = *(const f32x4*)(c.in[IN_KA] + h * 64 + o8 * 8 + 4);
          kav[0] = k0.x; kav[1] = k0.y; kav[2] = k0.z; kav[3] = k0.w; kav[4] = k1.x; kav[5] = k1.y; kav[6] = k1.z; kav[7] = k1.w; }
        u32x4 rr[5], rv;
        auto gload = [&](int s) {
            const int row0 = chunk_row(b, dir, s); const int o = o8 * 8;
            rr[0] = *(const u32x4*)(F + (size_t)3 * MT * 1024 + (size_t)(row0 + tk) * 1024 + h * 64 + o);
            rr[1] = *(const u32x4*)(F + (size_t)4 * MT * 1024 + (size_t)(row0 + tk) * 1024 + h * 64 + o);
            rr[2] = *(const u32x4*)(F + (size_t)5 * MT * 1024 + (size_t)(row0 + tk) * 1024 + h * 64 + o);
            rr[3] = *(const u32x4*)(P + (size_t)(row0 + tk) * PW0 + (0 + dir) * 1024 + h * 64 + o);
            rr[4] = *(const u32x4*)(P + (size_t)(row0 + tk) * PW0 + (2 + dir) * 1024 + h * 64 + o);
            rv = *(const u32x4*)(F + (size_t)6 * MT * 1024 + (size_t)(row0 + tk) * 1024 + h * 64 + o);
        };
        __syncthreads();
        for (int i = tid; i < 64 * 18; i += NTHREADS) ((LAS u32x2*)ST)[i] = (u32x2){0u, 0u};
        gload(0);
        TS_DECL
#pragma unroll 1
        for (int s = 0; s < 68; ++s) {
            TS(0);
            {   float lwf[8]; unpack8(rr[3], lwf);
                *(LAS f32x4*)(EP + ri * 64 + o8 * 8) = (f32x4){__expf(lwf[0]), __expf(lwf[1]), __expf(lwf[2]), __expf(lwf[3])};
                *(LAS f32x4*)(EP + ri * 64 + o8 * 8 + 4) = (f32x4){__expf(lwf[4]), __expf(lwf[5]), __expf(lwf[6]), __expf(lwf[7])}; }
            __syncthreads();
            TS(1);
            {   const int k = tid & 63, seg = tid >> 6; float x[8]; float run = 1.f;
#pragma unroll
                for (int i = 0; i < 8; ++i) { run *= EP[(seg * 8 + i) * 64 + k]; x[i] = run; }
                TMP[seg * 64 + k] = run;
                __syncthreads();
                float off = 1.f;
#pragma unroll
                for (int q = 0; q < 8; ++q) off *= (q < seg) ? TMP[q * 64 + k] : 1.f;
#pragma unroll
                for (int i = 0; i < 8; ++i) EP[(seg * 8 + i) * 64 + k] = x[i] * off;
            }
            __syncthreads();
            TS(2);
            {
                float rf[8], kkf[8], kbf[8], af[8];
                unpack8(rr[0], rf); unpack8(rr[1], kkf); unpack8(rr[2], kbf); unpack8(rr[4], af);
                const f32x4 e0 = *(const LAS f32x4*)(EP + ri * 64 + o8 * 8), e1 = *(const LAS f32x4*)(EP + ri * 64 + o8 * 8 + 4);
                const int rp = ri > 0 ? ri - 1 : 0;
                f32x4 m0 = *(const LAS f32x4*)(EP + rp * 64 + o8 * 8), m1 = *(const LAS f32x4*)(EP + rp * 64 + o8 * 8 + 4);
                if (ri == 0) { m0 = (f32x4){1.f, 1.f, 1.f, 1.f}; m1 = m0; }
                const float ee[8] = {e0.x, e0.y, e0.z, e0.w, e1.x, e1.y, e1.z, e1.w}, em[8] = {m0.x, m0.y, m0.z, m0.w, m1.x, m1.y, m1.z, m1.w};
                float i0[8], i1[8], i2[8], i3[8];
#pragma unroll
                for (int q = 0; q < 8; ++q) { const float kt = kbf[q] * (1.f + (af[q] - 1.f) * kav[q]), kka = kkf[q] * af[q], ei = __builtin_amdgcn_rcpf(ee[q]);
                    i0[q] = kkf[q] * em[q]; i1[q] = rf[q] * ee[q]; i2[q] = kt * ei; i3[q] = kka * ei; }
                const int off = ri * RS64 + o8 * 16;
                *(LAS u32x4*)(KKP + off) = pack8(i0); *(LAS u32x4*)(RP + off) = pack8(i1); *(LAS u32x4*)(KTI + off) = pack8(i2); *(LAS u32x4*)(KAI + off) = pack8(i3);
                *(LAS u32x4*)(VIMG + off) = rv;
                if (ri == 63) { *(LAS f32x4*)(sPC + o8 * 8) = e0; *(LAS f32x4*)(sPC + o8 * 8 + 4) = e1; }
            }
            __syncthreads();
            TS(3);
            if (s + 1 < 68) gload(s + 1);
            {   const int tb = w >> 1, t = tb * 16 + l15;
                bf16x8 bkk[2];
#pragma unroll
                for (int k = 0; k < 2; ++k) bkk[k] = frag_row(KKP, RS64, tb * 16, k * 32, lane);
#pragma unroll
                for (int q = 0; q < 2; ++q) { const int sb = (w & 1) * 2 + q; f32x4 aka = {0.f, 0.f, 0.f, 0.f};
#pragma unroll
                    for (int k = 0; k < 2; ++k) aka = MFMA16(frag_row(KAI, RS64, sb * 16, k * 32, lane), bkk[k], aka);
#pragma unroll
                    for (int r = 0; r < 4; ++r) { const int ss = sb * 16 + 4 * g4 + r; aka[r] = ss < t ? aka[r] : 0.f; }
                    *(LAS f32x4*)(MF + t * MS + sb * 16 + 4 * g4) = aka; }
            }
            __syncthreads();
            TS(4);
            if (w == 0) tri_inverse_wave0(MF, lane);
            else if (w <= 4) {
                const int tb = w - 1, t = tb * 16 + l15;
                bf16x8 bkk[2];
#pragma unroll
                for (int k = 0; k < 2; ++k) bkk[k] = frag_row(KKP, RS64, tb * 16, k * 32, lane);
#pragma unroll
                for (int sb = 0; sb < 4; ++sb) { f32x4 akt = {0.f, 0.f, 0.f, 0.f};
#pragma unroll
                    for (int k = 0; k < 2; ++k) akt = MFMA16(frag_row(KTI, RS64, sb * 16, k * 32, lane), bkk[k], akt);
#pragma unroll
                    for (int r = 0; r < 4; ++r) { const int ss = sb * 16 + 4 * g4 + r; akt[r] = ss < t ? akt[r] : 0.f; }
                    tile_write(AKT, RS64, tb * 16, sb * 16, lane, akt); }
                bf16x8 aa[2];
#pragma unroll
                for (int k = 0; k < 2; ++k) aa[k] = frag_row(AKT, RS64, tb * 16, k * 32, lane);
#pragma unroll
                for (int vb = 0; vb < 4; ++vb) { f32x4 a = {0.f, 0.f, 0.f, 0.f};
#pragma unroll
                    for (int k = 0; k < 2; ++k) a = MFMA16(aa[k], frag_tr(VIMG, RS64, vb * 16, k * 32, lane), a);
                    tile_write(TMPVT, RS64, vb * 16, tb * 16, lane, a); }
            } else {
#pragma unroll 1
                for (int tile = w - 5; tile < 32; tile += 3) {
                    const int kind = tile >> 4, tb = (tile >> 2) & 3, sb = tile & 3, t = tb * 16 + l15;
                    const LAS unsigned char* src = kind ? KTI : KAI; LAS unsigned char* dst = kind ? ART : ARA;
                    f32x4 a = {0.f, 0.f, 0.f, 0.f};
#pragma unroll
                    for (int k = 0; k < 2; ++k) a = MFMA16(frag_row(src, RS64, sb * 16, k * 32, lane), frag_row(RP, RS64, tb * 16, k * 32, lane), a);
#pragma unroll
                    for (int r = 0; r < 4; ++r) { const int ss = sb * 16 + 4 * g4 + r; a[r] = ss <= t ? a[r] : 0.f; }
                    tile_write(dst, RS64, tb * 16, sb * 16, lane, a); }
            }
            __syncthreads();
            TS(5);
            {   const int i = tid >> 3, j8 = (tid & 7) * 8; float x[8];
#pragma unroll
                for (int q = 0; q < 8; ++q) x[q] = MF[i * MS + j8 + q];
                *(LAS u32x4*)(TI + i * RS64 + j8 * 2) = pack8(x); }
            __syncthreads();
            TS(6);
            f32x4 y0[2], u0[2];
            {   const int hb = w >> 1;
                bf16x8 akk[2], av[2];
#pragma unroll
                for (int k = 0; k < 2; ++k) { akk[k] = frag_tr(KKP, RS64, hb * 16, k * 32, lane); av[k] = frag_tr(VIMG, RS64, hb * 16, k * 32, lane); }
#pragma unroll
                for (int q = 0; q < 2; ++q) { const int ob = (w & 1) * 2 + q; f32x4 bq = {0.f, 0.f, 0.f, 0.f}; y0[q] = bq;
#pragma unroll
                    for (int k = 0; k < 2; ++k) { bq = MFMA16(akk[k], frag_row(TI, RS64, ob * 16, k * 32, lane), bq);
                        y0[q] = MFMA16(av[k], frag_row(ART, RS64, ob * 16, k * 32, lane), y0[q]); }
                    tile_write(WK, RS64, ob * 16, hb * 16, lane, bq); }
            }
            __syncthreads();
            TS(7);
            {   const int tb = w >> 1;
                bf16x8 at[2], awk[2];
#pragma unroll
                for (int k = 0; k < 2; ++k) { at[k] = frag_row(TI, RS64, tb * 16, k * 32, lane); awk[k] = frag_row(WK, RS64, tb * 16, k * 32, lane); }
#pragma unroll
                for (int q = 0; q < 2; ++q) { const int vb = (w & 1) * 2 + q; u0[q] = (f32x4){0.f, 0.f, 0.f, 0.f};
#pragma unroll
                    for (int k = 0; k < 2; ++k) { u0[q] = MFMA16(at[k], frag_row(TMPVT, RS64, vb * 16, k * 32, lane), u0[q]); u0[q] = MFMA16(awk[k], frag_row(ST, RS64, vb * 16, k * 32, lane), u0[q]); }
                    tile_write(UT, RS64, vb * 16, tb * 16, lane, -u0[q]); }
            }
            __syncthreads();
            TS(8);
            {   const int hb = w >> 1, row0 = chunk_row(b, dir, s);
                bf16x8 as[2], au[2], akt[2], aka[2];
#pragma unroll
                for (int k = 0; k < 2; ++k) { as[k] = frag_row(ST, RS64, hb * 16, k * 32, lane); au[k] = frag_row(UT, RS64, hb * 16, k * 32, lane);
                    akt[k] = frag_tr(KTI, RS64, hb * 16, k * 32, lane); aka[k] = frag_tr(KAI, RS64, hb * 16, k * 32, lane); }
#pragma unroll
                for (int q = 0; q < 2; ++q) { const int ob = (w & 1) * 2 + q; f32x4 a = y0[q];
#pragma unroll
                    for (int k = 0; k < 2; ++k) { a = MFMA16(as[k], frag_row(RP, RS64, ob * 16, k * 32, lane), a); a = MFMA16(au[k], frag_row(ARA, RS64, ob * 16, k * 32, lane), a); }
                    const int t = ob * 16 + l15, tl = dir ? 63 - t : t; u32x2 o; o.x = pk2(a[0], a[1]); o.y = pk2(a[2], a[3]);
                    *(u32x2*)(Ybase + (long)dir * ydir_stride + (size_t)(row0 + tl) * ystride + h * 64 + hb * 16 + 4 * g4) = o;
#pragma unroll
                    for (int k = 0; k < 2; ++k) { st[q] = MFMA16(akt[k], frag_tr(VIMG, RS64, ob * 16, k * 32, lane), st[q]); st[q] = MFMA16(aka[k], frag_row(UT, RS64, ob * 16, k * 32, lane), st[q]); }
                    st[q] = st[q] * *(const LAS f32x4*)(sPC + hb * 16 + 4 * g4); }
            }
            __syncthreads();
            TS(9);
            {   const int hb = w >> 1;
#pragma unroll
                for (int q = 0; q < 2; ++q) tile_write(ST, RS64, ((w & 1) * 2 + q) * 16, hb * 16, lane, st[q]); }
        }
        TS_OUT(2);
    }
}

#ifndef GEMM_ALIGN
#define GEMM_ALIGN true
#endif
#ifndef GEMM_SP2
#define GEMM_SP2 true
#endif
#ifndef USE_CHUNK_ML
#define USE_CHUNK_ML 1
#endif
#ifndef USE_CHUNK_GDN
#define USE_CHUNK_GDN 1
#endif
#ifndef USE_CHUNK_RWKV
#define USE_CHUNK_RWKV 1
#endif
struct Args { const float* in[32]; float* out; unsigned char* ws; int ph_lo, ph_hi; };
constexpr int NPHASE = 24;
__global__ void __launch_bounds__(NTHREADS, 2) fwd_kernel(Args args) {
    extern __shared__ __attribute__((aligned(16))) unsigned char lds_raw[];
    Ctx c;
    c.lds = (LAS unsigned char*)lds_raw;
    c.tid = threadIdx.x; c.lane = c.tid & 63; c.wave = __builtin_amdgcn_readfirstlane(c.tid >> 6);
    c.G = gridDim.x; c.wg = blockIdx.x; c.gw = c.wg * NWAVES + c.wave; c.NGW = c.G * NWAVES;
#pragma unroll
    for (int i = 0; i < 32; ++i) c.in[i] = args.in[i];
    c.out = args.out; c.ws = args.ws;
    const int lo = args.ph_lo, hi = args.ph_hi;
    volatile LAS unsigned* bst = (volatile LAS unsigned*)(c.lds + LDS_BAR_OFF);
    if (c.tid < 4) bst[c.tid] = 0u;
    __syncthreads();
    XcdBarrier bar; bar.bar = (unsigned*)(c.ws + WS_CTL); bar.x = 0; bar.st = bst;
    if (hi - lo > 1) bar = xcd_barrier_post((unsigned*)(c.ws + WS_CTL), bst);
#define IN(k) (lo <= (k) && (k) < hi)
#ifndef REPEAT_MASK
#define REPEAT_MASK 0u
#endif
#define REP(k) for (int _rep = 0; _rep < (((REPEAT_MASK >> (k)) & 1u) ? 2 : 1); ++_rep)
#ifdef PROBE_PHASE
#define SEAM(k) do { if (IN(k) && IN((k) + 1)) xcd_barrier(bar); if (c.wg == 0 && c.tid == 0) ((unsigned long long*)(c.ws + 14336))[(k) + 1] = __builtin_amdgcn_s_memrealtime(); } while (0)
#else
#define SEAM(k) do { if (IN(k) && IN((k) + 1)) xcd_barrier(bar); } while (0)
#endif
    float* MOD = (float*)(c.ws + WS_MOD);
    float* XC = (float*)(c.ws + WS_XC);
    bf16_t* HY = (bf16_t*)(c.ws + WS_HY); bf16_t* Pb = (bf16_t*)(c.ws + WS_P); float* TL = (float*)(c.ws + WS_TAIL);
    bf16_t* Win = (bf16_t*)(c.ws + WS_WIN); bf16_t* Wout = (bf16_t*)(c.ws + WS_WOUT); bf16_t* W13 = (bf16_t*)(c.ws + WS_W13); bf16_t* W2 = (bf16_t*)(c.ws + WS_W2);
    const float* X = c.in[IN_X]; const float* CX = c.in[IN_CTX];

#ifdef PROBE_PHASE
    if (c.wg == 0 && c.tid == 0) ((unsigned long long*)(c.ws + 14336))[0] = __builtin_amdgcn_s_memrealtime();
#endif
    #ifndef SUBREP
#define SUBREP 0
#endif
    if (IN(0)) { ada_phase(c, 0, 0, c.G); __syncthreads(); convert_weights(c, 0, 0, c.G); lora_weight_phase(c); }
    SEAM(0);
    if (IN(1)) REP(1) norm_mod_phase(c, X, CX, c.in[IN_NORMW], MOD, 0, D, MT);
    SEAM(1);
    if (IN(2)) { pg8::Gemm g{HY, Win, MT, NIN0, D}; pg8::StaticOrder S; S.init(MT, NIN0, c.G, c.wg); EpiInProj E{Pb, PW0, PW0 / 256, TL, TW0};
        pg8::gemm_phase<EpiInProj, pg8::StaticOrder, GEMM_ALIGN, GEMM_SP2>(c.lds, g, S, E); }
    SEAM(2);
    if (IN(3)) REP(3) ab_feature_phase(c);
    SEAM(3);
    if (IN(4)) {
        int k256 = 256; asm volatile("" : "+s"(k256));
        { pg8::Gemm g{(const bf16_t*)(c.ws + WS_A1), (const bf16_t*)(c.ws + WS_WL), MT, 4096, k256}; pg8::StaticOrder S; S.init(MT, 4096, c.G, c.wg); EpiLora E{Pb, PW0, c.in[IN_W0], c.in[IN_A0]};
          pg8::gemm_phase<EpiLora, pg8::StaticOrder, GEMM_ALIGN, GEMM_SP2>(c.lds, g, S, E); }
        { pg8::Gemm g{(const bf16_t*)(c.ws + WS_A2), (const bf16_t*)(c.ws + WS_WG), MT, 1024, k256}; pg8::StaticOrder S; S.init(MT, 1024, c.G, c.wg); EpiBf16Plain E{(bf16_t*)(c.ws + WS_GOUT), 1024};
          pg8::gemm_phase<EpiBf16Plain, pg8::StaticOrder, GEMM_ALIGN, GEMM_SP2>(c.lds, g, S, E); } }
    SEAM(4);
    if (IN(5)) REP(5) {
        gdn_chunk_items(c, c.wg, c.G, 128);
        rwkv_chunk_items(c, (c.wg + c.G / 2) % c.G, c.G, 128, HY + 1024, -1024L, D); }
    SEAM(5);
    if (IN(7)) REP(7) ab_output_phase(c);
    SEAM(7);
    if (IN(8)) { pg8::Gemm g{HY, Wout, MT, D, D}; pg8::StaticOrder S; S.init(MT, D, c.G, c.wg); EpiDelta E{(bf16_t*)(c.ws + WS_DELTA), MOD + 2 * D};
        pg8::gemm_phase<EpiDelta, pg8::StaticOrder, GEMM_ALIGN, GEMM_SP2>(c.lds, g, S, E);
        __syncthreads(); const int nt3 = (MT / 256) * (D / 256) - 2 * c.G;
        if (nt3 > 0 && nt3 < c.G) ada_phase(c, 1, nt3, c.G - nt3); else ada_phase(c, 1, 0, c.G); }
    SEAM(8);
    if (IN(9)) norm_mod_phase(c, X, CX, c.in[IN_NORMW] + D, MOD, 3 * D, 4 * D, MT, (bf16_t*)(c.ws + WS_DELTA), c.out, XC);
    SEAM(9);
#ifdef SKEW_US
    if (IN(10) && (c.wg & 1)) { const unsigned long long t0 = __builtin_amdgcn_s_memrealtime(); while (__builtin_amdgcn_s_memrealtime() - t0 < (unsigned long long)(SKEW_US) * 100ull) __builtin_amdgcn_s_sleep(8); }
#endif
    if (IN(10)) { pg8::Gemm g{HY, W13, MT, 2 * FF, D}; pg8::StaticOrder S; S.init(MT, 2 * FF, c.G, c.wg); EpiSwiGLU E{Pb, FF};
        pg8::gemm_phase<EpiSwiGLU, pg8::StaticOrder, GEMM_ALIGN, GEMM_SP2>(c.lds, g, S, E); }
    SEAM(10);
    if (IN(11)) { pg8::Gemm g{Pb, W2, MT, D, FF}; pg8::StaticOrder S; S.init(MT, D, c.G, c.wg); EpiDelta E{(bf16_t*)(c.ws + WS_DELTA), MOD + 5 * D};
        pg8::gemm_phase<EpiDelta, pg8::StaticOrder, GEMM_ALIGN, GEMM_SP2>(c.lds, g, S, E);
        __syncthreads(); const int nt3 = (MT / 256) * (D / 256) - 2 * c.G;
        if (nt3 > 0 && nt3 < c.G) convert_weights(c, 1, nt3, c.G - nt3); else convert_weights(c, 1, 0, c.G); }
    SEAM(11);
    if (IN(12)) norm_mod_phase(c, c.out, XC, c.in[IN_NORMW] + 2 * D, MOD + 5 * MODW, 0, D, MT, (bf16_t*)(c.ws + WS_DELTA), c.out, XC);
    SEAM(12);
    if (IN(13)) { pg8::Gemm g{HY, (const bf16_t*)(c.ws + WS_WIN1), MT, NIN1, D}; pg8::StaticOrder S; S.init(MT, NIN1, c.G, c.wg); EpiInProj E{Pb, PW1, PW1 / 256, TL, TW1};
        pg8::gemm_phase<EpiInProj, pg8::StaticOrder, GEMM_ALIGN, GEMM_SP2>(c.lds, g, S, E); }
    SEAM(13);
    if (IN(15)) REP(15) { if (USE_CHUNK_ML) mlstm_chunk_phase(c); else mlstm_scan_phase(c); }
    SEAM(15);
    if (IN(16)) REP(16) ml_output_phase(c);
    SEAM(16);
    if (IN(17)) { pg8::Gemm g{HY, (const bf16_t*)(c.ws + WS_WOUT1), ML, D, D}; pg8::StaticOrder S; S.init(ML, D, c.G, c.wg); EpiDelta E{(bf16_t*)(c.ws + WS_DELTA), MOD + 5 * MODW + 2 * D};
        pg8::gemm_phase<EpiDelta, pg8::StaticOrder, GEMM_ALIGN, GEMM_SP2>(c.lds, g, S, E); }
    SEAM(17);
    if (IN(18)) norm_mod_phase(c, c.out, XC, c.in[IN_NORMW] + 3 * D, MOD + 5 * MODW, 3 * D, 4 * D, ML, (bf16_t*)(c.ws + WS_DELTA), c.out, XC);
    SEAM(18);
    if (IN(19)) { pg8::Gemm g{HY, (const bf16_t*)(c.ws + WS_W131), ML, 2 * FF, D}; pg8::StaticOrder S; S.init(ML, 2 * FF, c.G, c.wg); EpiSwiGLU E{Pb, FF};
        pg8::gemm_phase<EpiSwiGLU, pg8::StaticOrder, GEMM_ALIGN, GEMM_SP2>(c.lds, g, S, E); }
    SEAM(19);
    if (IN(20)) { pg8::Gemm g{Pb, (const bf16_t*)(c.ws + WS_W21), ML, D, FF}; pg8::StaticOrder S; S.init(ML, D, c.G, c.wg); EpiDelta E{(bf16_t*)(c.ws + WS_DELTA), MOD + 5 * MODW + 5 * D};
        pg8::gemm_phase<EpiDelta, pg8::StaticOrder, GEMM_ALIGN, GEMM_SP2>(c.lds, g, S, E); }
    SEAM(20);
    if (IN(21)) final_norm_phase(c);
#ifdef PROBE_PHASE
    if (c.wg == 0 && c.tid == 0) {
        const unsigned long long* tsp = (const unsigned long long*)(c.ws + 14336);
        #ifdef PROBE_SCAN
        const unsigned long long dt = tsp[40 + PROBE_STAGE], t0 = __builtin_amdgcn_s_memrealtime();
#else
        const unsigned long long dt = tsp[PROBE_B] - tsp[PROBE_A], t0 = __builtin_amdgcn_s_memrealtime();
#endif
        while (__builtin_amdgcn_s_memrealtime() - t0 < 4ull * dt) __builtin_amdgcn_s_sleep(16);
    }
#endif
#undef IN
#undef SEAM
}

#ifndef N_LAUNCH_MODE
#define N_LAUNCH_MODE 1
#endif
extern "C" void kernel_launch(void* const* d_in, const int* in_sizes, int n_in, void* d_out, int out_size, void* d_ws, size_t ws_size, hipStream_t stream) {
    static int grid = 0;
    if (grid == 0) {
        if (n_in != 32 || out_size != ML * D || ws_size < WS_END) { fprintf(stderr, "kernel_launch: unexpected problem (n_in %d out %d ws %zu)\n", n_in, out_size, ws_size); grid = -1; return; }
        int dev = 0, cus = 0;
        if (hipGetDevice(&dev) != hipSuccess || hipDeviceGetAttribute(&cus, hipDeviceAttributeMultiprocessorCount, dev) != hipSuccess) { grid = -1; return; }
        if (hipFuncSetAttribute((const void*)fwd_kernel, hipFuncAttributeMaxDynamicSharedMemorySize, LDS_BYTES) != hipSuccess) { grid = -1; return; }
        int per_cu = 0;
        if (hipOccupancyMaxActiveBlocksPerMultiprocessor(&per_cu, (const void*)fwd_kernel, NTHREADS, LDS_BYTES) != hipSuccess || per_cu < 1) { fprintf(stderr, "kernel_launch: occupancy query says %d\n", per_cu); }
        (void)hipGetLastError();
        grid = cus;
    }
    if (grid < 0) return;
    (void)hipMemsetAsync((char*)d_ws + WS_CTL, 0, CTL_BYTES, stream);
    Args a{};
    for (int i = 0; i < 32; ++i) a.in[i] = (const float*)d_in[i];
    a.out = (float*)d_out; a.ws = (unsigned char*)d_ws;
#if N_LAUNCH_MODE == 1
    a.ph_lo = 0; a.ph_hi = NPHASE;
    hipLaunchKernelGGL(fwd_kernel, dim3(grid), dim3(NTHREADS), LDS_BYTES, stream, a);
#else
    for (int p = 0; p < 22; ++p) { a.ph_lo = p; a.ph_hi = p + 1; hipLaunchKernelGGL(fwd_kernel, dim3(grid), dim3(NTHREADS), LDS_BYTES, stream, a); }
#endif
}
```

```cpp
#include <hip/hip_runtime.h>
#include <cstdio>
#include <cstdint>
#define LAS __attribute__((address_space(3)))
#define GAS __attribute__((address_space(1)))
#define XB_TMO      128
#define XB_XCNT(j)  (256  + 64 * (j))
#define XB_XSUB(j)  (1280 + 64 * (j))
#define XB_XGEN(j)  (2304 + 64 * (j))
#define XB_TOP      3328
#define XB_TOPGEN   3392
#define XCD_BAR_WORDS 3456
#define XB_SPIN_CAP (1u << 20)

__device__ __forceinline__ unsigned xb_ld(unsigned* p)              { return __hip_atomic_load(p, __ATOMIC_RELAXED, __HIP_MEMORY_SCOPE_AGENT); }
__device__ __forceinline__ unsigned xb_add(unsigned* p, unsigned v) { return __hip_atomic_fetch_add(p, v, __ATOMIC_RELAXED, __HIP_MEMORY_SCOPE_AGENT); }
__device__ __forceinline__ unsigned xb_xcc_id() { return (unsigned)__builtin_amdgcn_s_getreg((3 << 11) | 20) & 0xFu; }
#define XB_SPIN(cond, bar) do { unsigned _sp = 0; while (cond) { __builtin_amdgcn_s_sleep(1); \
    if ((++_sp & 255u) == 0u) { if (xb_ld(&(bar)[XB_TMO])) break; if (_sp > XB_SPIN_CAP) { atomicAdd(&(bar)[XB_TMO], 1u); break; } } } } while (0)

struct XcdBarrier {
    unsigned* bar; unsigned x;
    volatile LAS unsigned* st;
};

__device__ __forceinline__ XcdBarrier xcd_barrier_post(unsigned* bar, volatile LAS unsigned* st) {
    XcdBarrier b; b.bar = bar; b.x = xb_xcc_id(); b.st = st;
    if (threadIdx.x == 0) (void)xb_add(&bar[XB_XCNT(b.x)], 1u);
    return b;
}
__device__ __forceinline__ void xcd_barrier_complete(unsigned* bar, unsigned x, unsigned& nloc, unsigned& nx) {
    const unsigned G = gridDim.x * gridDim.y * gridDim.z;
    unsigned sum, cnt, mine, sp = 0u;
    for (;;) {
        sum = 0u; cnt = 0u; mine = 0u;
#pragma unroll
        for (unsigned j = 0; j < 16; ++j) { const unsigned c = xb_ld(&bar[XB_XCNT(j)]); sum += c; cnt += (c > 0u) ? 1u : 0u; mine = (j == x) ? c : mine; }
        if (sum == G) break;
        __builtin_amdgcn_s_sleep(1);
        if ((++sp & 255u) == 0u) { if (xb_ld(&bar[XB_TMO])) break; if (sp > XB_SPIN_CAP) { atomicAdd(&bar[XB_TMO], 1u); break; } }
    }
    nloc = mine > 0u ? mine : 1u; nx = cnt > 0u ? cnt : 1u;
}

__device__ __forceinline__ void xcd_barrier(const XcdBarrier& b) {
    asm volatile("s_waitcnt vmcnt(0)" ::: "memory");
    __syncthreads();
    if (threadIdx.x == 0) {
        unsigned* bar = b.bar;
        __builtin_amdgcn_s_waitcnt(0);
        unsigned nloc = b.st[0], nx = b.st[1];
        if (nloc == 0u) { xcd_barrier_complete(bar, b.x, nloc, nx); b.st[0] = nloc; b.st[1] = nx; }
        const unsigned old = xb_add(&bar[XB_XSUB(b.x)], 1u);
        const unsigned gen = old / nloc;
        if (old + 1u == (gen + 1u) * nloc) {
            __builtin_amdgcn_fence(__ATOMIC_RELEASE, "agent");
            asm volatile("s_waitcnt vmcnt(0)" ::: "memory");
            const unsigned og = xb_add(&bar[XB_TOP], 1u);
            const unsigned tg = og / nx;
            if (og + 1u == (tg + 1u) * nx) xb_add(&bar[XB_TOPGEN], 1u);
            else XB_SPIN(xb_ld(&bar[XB_TOPGEN]) == tg, bar);
            __builtin_amdgcn_fence(__ATOMIC_ACQUIRE, "agent");
            xb_add(&bar[XB_XGEN(b.x)], 1u);
            asm volatile("s_waitcnt vmcnt(0)" ::: "memory");
        } else {
            XB_SPIN(xb_ld(&bar[XB_XGEN(b.x)]) == gen, bar);
            __builtin_amdgcn_fence(__ATOMIC_ACQUIRE, "agent");
            asm volatile("s_waitcnt vmcnt(0)" ::: "memory");
        }
    }
    __syncthreads();
}
#include <hip/hip_runtime.h>
namespace pg8 {
#define PG8_LAS __attribute__((address_space(3)))
typedef unsigned short bf16_t;
typedef short bf16x8 __attribute__((ext_vector_type(8)));
typedef float f32x4 __attribute__((ext_vector_type(4)));
typedef unsigned u32x4 __attribute__((ext_vector_type(4)));
constexpr int BM = 256, BK = 64, HALF = 128, HTB = HALF * BK * 2  , STAGE_BYTES = 8 * HTB, NXCD = 8, WGM = 4;

__host__ __device__ __forceinline__ int lds_byte(int r, int c) { const int st = (r >> 4) * 2 + (c >> 5), rr = r & 15, cc = c & 31, ob = rr * 64 + cc * 2; return st * 1024 + (ob ^ (((ob >> 9) & 1) << 5)); }
__host__ __device__ __forceinline__ void stage_rc(int b, int& R, int& C) { const int st = b / 1024, sb = b % 1024, swz = sb ^ (((sb >> 9) & 1) << 5); R = (st >> 1) * 16 + swz / 64; C = (st & 1) * 32 + (swz % 64) / 2; }
__host__ __device__ __forceinline__ int perm32(int rho) { const int n = rho >> 4, i = rho & 15; return 8 * (i >> 2) + 4 * n + (i & 3); }

struct Unit { int pm, pn, ko; };
struct Gemm { const bf16_t* A; const bf16_t* Bt; int M, N, K, ld; };

struct StaticOrder {
    int nM, nN, nwg, G, c;
    __host__ __device__ void init(int M, int N, int G_, int c_) { nM = M / BM; nN = N / BM; nwg = nM * nN; G = G_; c = c_; }
    __host__ __device__ bool next(int i, Unit& u) const {
        const long L = (long)i * G + c; if (L >= nwg) return false;
        int wgid = (int)L; { const int q = nwg / NXCD, r = nwg % NXCD, xcd = wgid % NXCD, off = wgid / NXCD; wgid = (xcd < r ? xcd * (q + 1) : r * (q + 1) + (xcd - r) * q) + off; }
        const int nig = WGM * nN, gid = wgid / nig, fm = gid * WGM, gsz = (nM - fm) < WGM ? (nM - fm) : WGM;
        u.pm = fm + ((wgid % nig) % gsz); u.pn = (wgid % nig) / gsz; u.ko = 0; return true;
    }
    __device__ __forceinline__ void a_ready(const Unit&) const {}
    __device__ __forceinline__ void done(const Unit&) const {}
};
struct SplitOrder4 {
    int c, ksub;
    __device__ bool next(int i, Unit& u) const {
        if (i > 0 || c >= 128) return false;
        const int x = c & 7, y = c >> 3; u.ko = (x >> 1) * ksub; u.pm = (x & 1) * 2 + (y >> 3); u.pn = y & 7; return true;
    }
    __device__ __forceinline__ void a_ready(const Unit&) const {}
    __device__ __forceinline__ void done(const Unit&) const {}
};
template <class Epi, class Sched, bool ALIGN_EPI = false, bool SP2 = false>
__device__ __forceinline__ void gemm_phase(PG8_LAS unsigned char* lds, const Gemm g, const Sched& S, const Epi& E) {
    const int tid = threadIdx.x, wid = __builtin_amdgcn_readfirstlane(tid >> 6), lane = tid & 63, wr = wid >> 2, wc = wid & 3, fr = lane & 15, fq = lane >> 4;
    const int K = g.K, nt = K / BK, LD = g.ld ? g.ld : g.K;
    unsigned voffA[2], voffB[2];
#pragma unroll
    for (int i = 0; i < 2; ++i) { int R, C; stage_rc(tid * 16 + i * 8192, R, C); const int Rb = Epi::PERM ? ((R & ~31) + perm32(R & 31)) : R;
        voffA[i] = (unsigned)(R * LD + C) * 2u; voffB[i] = (unsigned)(Rb * LD + C) * 2u; }
    const size_t kstep = (size_t)(BK * 2);
    const size_t hstep = (size_t)HALF * LD * 2;
    const size_t tstep = 2 * hstep;
    const unsigned ldsw = (unsigned)wid * 1024u;
    const int aoff = lds_byte(wr * 64 + fr, fq * 8), boff = lds_byte(wc * 32 + fr, fq * 8);
#define PG8_SA(b, h) (((b) * 2 + (h)) * HTB)
#define PG8_SB(b, h) ((4 + (b) * 2 + (h)) * HTB)
#define PG8_STAGE(bufoff, gbase, voff) do { _Pragma("unroll") for (int _i = 0; _i < 2; ++_i) \
        __builtin_amdgcn_global_load_lds((const unsigned*)((const char*)(gbase) + (voff)[_i]), (PG8_LAS unsigned*)(lds + (bufoff) + ldsw + _i * 8192), 16, 0, 0); } while (0)
#define PG8_LDA(dst, b, h) do { _Pragma("unroll") for (int m = 0; m < 4; ++m) _Pragma("unroll") for (int k = 0; k < 2; ++k) dst[m][k] = *(const PG8_LAS bf16x8*)(lds + PG8_SA(b, h) + aoff + m * 2048 + k * 1024); } while (0)
#define PG8_LDB(dst, b, h) do { _Pragma("unroll") for (int n = 0; n < 2; ++n) _Pragma("unroll") for (int k = 0; k < 2; ++k) dst[n][k] = *(const PG8_LAS bf16x8*)(lds + PG8_SB(b, h) + boff + n * 2048 + k * 1024); } while (0)
#define PG8_MMA(ai, bj, At, Bt) do { __builtin_amdgcn_s_setprio(1); _Pragma("unroll") for (int m = 0; m < 4; ++m) _Pragma("unroll") for (int n = 0; n < 2; ++n) _Pragma("unroll") for (int k = 0; k < 2; ++k) \
        acc[ai][bj][m][n] = __builtin_amdgcn_mfma_f32_16x16x32_bf16(Bt[n][k], At[m][k], acc[ai][bj][m][n], 0, 0, 0); __builtin_amdgcn_s_setprio(0); } while (0)
#define PG8_WAIT_V(n) asm volatile("s_waitcnt vmcnt(" #n ")" ::: "memory")
#define PG8_WAIT_L(n) asm volatile("s_waitcnt lgkmcnt(" #n ")" ::: "memory")
#define PG8_BAR __builtin_amdgcn_s_barrier()
#define PG8_SCHED __builtin_amdgcn_sched_barrier(0)
    Unit cur, nxt; int ui = 0;
    if (!S.next(0, cur)) return;
    f32x4 acc[2][2][4][2];
#pragma unroll
    for (int a = 0; a < 2; ++a)
#pragma unroll
        for (int b = 0; b < 2; ++b)
#pragma unroll
            for (int m = 0; m < 4; ++m)
#pragma unroll
                for (int n = 0; n < 2; ++n) acc[a][b][m][n] = (f32x4){0.f, 0.f, 0.f, 0.f};
    bf16x8 At[4][2], B0[2][2], B1[2][2];
    const char* cA = (const char*)g.A + (size_t)cur.pm * tstep + (size_t)cur.ko * 2; const char* cB = (const char*)g.Bt + (size_t)cur.pn * tstep + (size_t)cur.ko * 2;
    S.a_ready(cur);
    if constexpr (SP2) {
        PG8_STAGE(PG8_SB(0, 0), cB, voffB); PG8_STAGE(PG8_SB(0, 1), cB + hstep, voffB); PG8_STAGE(PG8_SA(0, 0), cA, voffA); PG8_STAGE(PG8_SA(0, 1), cA + hstep, voffA);
        if (wr == 1) PG8_BAR;
        PG8_WAIT_V(2); PG8_BAR;
        PG8_STAGE(PG8_SB(1, 0), cB + kstep, voffB); PG8_STAGE(PG8_SA(1, 0), cA + kstep, voffA); PG8_STAGE(PG8_SB(1, 1), cB + hstep + kstep, voffB);
        PG8_WAIT_V(6); PG8_BAR;
    } else {
        PG8_STAGE(PG8_SB(0, 0), cB, voffB); PG8_STAGE(PG8_SA(0, 0), cA, voffA); PG8_STAGE(PG8_SB(0, 1), cB + hstep, voffB); PG8_STAGE(PG8_SA(0, 1), cA + hstep, voffA);
        if (wr == 1) PG8_BAR;
        PG8_WAIT_V(4); PG8_BAR;
        PG8_STAGE(PG8_SB(1, 0), cB + kstep, voffB); PG8_STAGE(PG8_SA(1, 0), cA + kstep, voffA); PG8_STAGE(PG8_SB(1, 1), cB + hstep + kstep, voffB);
        PG8_WAIT_V(6); PG8_BAR;
    }
    for (;;) {
        const bool has_next = S.next(ui + 1, nxt);
        const char* nA = has_next ? (const char*)g.A + (size_t)nxt.pm * tstep + (size_t)nxt.ko * 2 : cA; const char* nB = has_next ? (const char*)g.Bt + (size_t)nxt.pn * tstep + (size_t)nxt.ko * 2 : cB;
        for (int t = 0; t < nt; t += 2) {
            const bool last = (t == nt - 2);
            const char* a1 = cA + (size_t)(t + 1) * kstep;
            const char* a2 = last ? nA : cA + (size_t)(t + 2) * kstep; const char* b2 = last ? nB : cB + (size_t)(t + 2) * kstep;
            const char* a3 = a2 + kstep; const char* b3 = b2 + kstep;
            if (last && has_next) S.a_ready(nxt);
            if constexpr (SP2) {
            PG8_LDB(B0, 0, 0); PG8_LDB(B1, 0, 1); PG8_SCHED; PG8_LDA(At, 0, 0); PG8_STAGE(PG8_SA(1, 1), a1 + hstep, voffA);
            PG8_WAIT_V(8); PG8_WAIT_L(0); PG8_BAR; PG8_MMA(0, 0, At, B0); PG8_MMA(0, 1, At, B1); PG8_BAR; PG8_SCHED;
            PG8_LDA(At, 0, 1); PG8_STAGE(PG8_SB(0, 0), b2, voffB); PG8_STAGE(PG8_SB(0, 1), b2 + hstep, voffB); PG8_STAGE(PG8_SA(0, 0), a2, voffA);
            PG8_WAIT_V(8); PG8_WAIT_L(0); PG8_BAR; PG8_MMA(1, 0, At, B0); PG8_MMA(1, 1, At, B1); PG8_BAR; PG8_SCHED;
            PG8_LDB(B0, 1, 0); PG8_LDB(B1, 1, 1); PG8_SCHED; PG8_LDA(At, 1, 0); PG8_STAGE(PG8_SA(0, 1), a2 + hstep, voffA);
            PG8_WAIT_V(8); PG8_WAIT_L(0); PG8_BAR; PG8_MMA(0, 0, At, B0); PG8_MMA(0, 1, At, B1); PG8_BAR; PG8_SCHED;
            PG8_LDA(At, 1, 1); PG8_STAGE(PG8_SB(1, 0), b3, voffB); PG8_STAGE(PG8_SB(1, 1), b3 + hstep, voffB); PG8_STAGE(PG8_SA(1, 0), a3, voffA);
            PG8_WAIT_V(8); PG8_WAIT_L(0); PG8_BAR; PG8_MMA(1, 0, At, B0); PG8_MMA(1, 1, At, B1); PG8_BAR; PG8_SCHED;
            } else {
            PG8_LDB(B0, 0, 0); PG8_SCHED; PG8_LDA(At, 0, 0); PG8_STAGE(PG8_SA(1, 1), a1 + hstep, voffA);
            PG8_WAIT_L(8); PG8_BAR; PG8_WAIT_L(0); PG8_MMA(0, 0, At, B0); PG8_BAR; PG8_SCHED;
            PG8_LDB(B1, 0, 1); PG8_STAGE(PG8_SB(0, 0), b2, voffB);
            PG8_BAR; PG8_WAIT_L(0); PG8_MMA(0, 1, At, B1); PG8_BAR;
            PG8_LDA(At, 0, 1); PG8_STAGE(PG8_SA(0, 0), a2, voffA);
            PG8_BAR; PG8_WAIT_L(0); PG8_MMA(1, 0, At, B0); PG8_BAR; PG8_SCHED;
            PG8_STAGE(PG8_SB(0, 1), b2 + hstep, voffB);
            PG8_WAIT_V(6); PG8_BAR; PG8_MMA(1, 1, At, B1); PG8_BAR;
            PG8_LDB(B0, 1, 0); PG8_SCHED; PG8_LDA(At, 1, 0); PG8_STAGE(PG8_SA(0, 1), a2 + hstep, voffA);
            PG8_WAIT_L(8); PG8_BAR; PG8_WAIT_L(0); PG8_MMA(0, 0, At, B0); PG8_BAR; PG8_SCHED;
            PG8_LDB(B1, 1, 1); PG8_STAGE(PG8_SB(1, 0), b3, voffB);
            PG8_BAR; PG8_WAIT_L(0); PG8_MMA(0, 1, At, B1); PG8_BAR;
            PG8_LDA(At, 1, 1); PG8_STAGE(PG8_SA(1, 0), a3, voffA);
            PG8_BAR; PG8_WAIT_L(0); PG8_MMA(1, 0, At, B0); PG8_BAR; PG8_SCHED;
            PG8_STAGE(PG8_SB(1, 1), b3 + hstep, voffB);
            PG8_WAIT_V(6); PG8_BAR; PG8_MMA(1, 1, At, B1); PG8_BAR;
            }
        }
        if constexpr (ALIGN_EPI) { if (wr == 0) PG8_BAR; }
        if constexpr (!Epi::AFTER_DRAIN) { E(acc, cur, wr, wc, fr, fq); S.done(cur); }
        if (!has_next) break;
#pragma unroll
        for (int a = 0; a < 2; ++a)
#pragma unroll
            for (int b = 0; b < 2; ++b)
#pragma unroll
                for (int m = 0; m < 4; ++m)
#pragma unroll
                    for (int n = 0; n < 2; ++n) acc[a][b][m][n] = (f32x4){0.f, 0.f, 0.f, 0.f};
        cur = nxt; cA = nA; cB = nB; ++ui;
        if constexpr (ALIGN_EPI) { if (wr == 1) PG8_BAR; }
    }
    PG8_WAIT_V(0);
    if constexpr (!ALIGN_EPI) { if (wr == 0) PG8_BAR; }
    PG8_BAR;
    if constexpr (Epi::AFTER_DRAIN) { E.fused(acc, cur, wr, wc, fr, fq, lds, wid, lane); S.done(cur); }
#undef PG8_SA
#undef PG8_SB
#undef PG8_STAGE
#undef PG8_LDA
#undef PG8_LDB
#undef PG8_MMA
#undef PG8_WAIT_V
#undef PG8_WAIT_L
#undef PG8_BAR
#undef PG8_SCHED
}
}

typedef unsigned short bf16_t;
typedef float f32x4 __attribute__((ext_vector_type(4)));
typedef float f32x2 __attribute__((ext_vector_type(2)));
typedef unsigned u32x4 __attribute__((ext_vector_type(4)));
typedef unsigned u32x2 __attribute__((ext_vector_type(2)));

constexpr int D = 2048, NB = 4, SEQ = 4096, CTXL = 256;
constexpr int ML = NB * SEQ;
constexpr int MC = NB * CTXL;
constexpr int MT = ML + MC;
constexpr int AB_IN = 7616, NIN0 = 7680, PW0 = 7168, TW0 = 512;
constexpr int C_INW = 6176, NIN1 = 6400, PW1 = 6144, TW1 = 256;
constexpr int FF = 5632;
constexpr int MODW = 6 * D;
constexpr int NTHREADS = 512, NWAVES = 8;

constexpr size_t MiB = 1u << 20;
constexpr size_t WS_CTL = 0, CTL_BYTES = 16384;
constexpr size_t WS_MOD = 1 * MiB;
constexpr size_t WS_GA = 2 * MiB, WS_GB = 4 * MiB;
constexpr size_t WS_XC = 6 * MiB;
constexpr size_t WS_HY = 14 * MiB;
constexpr size_t WS_TAIL = 82 * MiB;
constexpr size_t WS_WIN = 116 * MiB;
constexpr size_t WS_WOUT = 146 * MiB;
constexpr size_t WS_W13 = 154 * MiB;
constexpr size_t WS_W2 = 198 * MiB;
constexpr size_t WS_P = 220 * MiB;
constexpr size_t WS_F = 458 * MiB;
constexpr size_t FSLOT = (size_t)MT * 1024 * 2;
constexpr size_t WS_WL = 696 * MiB;
constexpr size_t WS_WG = 698 * MiB;
constexpr size_t WS_END = 700 * MiB;
constexpr size_t WS_L1W = WS_F + 128 * MiB;
constexpr size_t WS_WIN1 = WS_L1W, WS_WOUT1 = WS_L1W + 26 * MiB, WS_W131 = WS_L1W + 34 * MiB, WS_W21 = WS_L1W + 78 * MiB;
static_assert(WS_W21 + (size_t)D * FF * 2 <= WS_WL && (size_t)2 * ML * D * 2 <= 128 * MiB, "layer-1 weight map");
constexpr size_t WS_DELTA = WS_F;
constexpr size_t WS_A1 = WS_HY, WS_A2 = WS_HY + 16 * MiB;
constexpr size_t WS_GOUT = WS_TAIL;
static_assert(WS_F + 7 * FSLOT <= WS_END, "ws map");
static_assert(WS_HY + (size_t)MT * D * 2 <= WS_TAIL && WS_TAIL + (size_t)MT * TW0 * 4 <= WS_WIN && WS_W2 + (size_t)D * FF * 2 <= WS_P && WS_P + (size_t)MT * PW0 * 2 <= WS_F, "ws map");

constexpr int LDS_BYTES = 147456;
constexpr int LDS_BAR_OFF = LDS_BYTES - 64;

__device__ __forceinline__ float bflo(unsigned u) { return __builtin_bit_cast(float, u << 16); }
__device__ __forceinline__ float bfhi(unsigned u) { return __builtin_bit_cast(float, u & 0xffff0000u); }
__device__ __forceinline__ float bf1(bf16_t h) { return __builtin_bit_cast(float, (unsigned)h << 16); }
typedef __bf16 bf16x2n __attribute__((ext_vector_type(2)));
__device__ __forceinline__ unsigned f2bf(float f) { return (unsigned)__builtin_bit_cast(unsigned short, (__bf16)f); }
__device__ __forceinline__ unsigned pk2(float lo, float hi) { const bf16x2n v = {(__bf16)lo, (__bf16)hi}; return __builtin_bit_cast(unsigned, v); }
__device__ __forceinline__ float sigm(float x) { return 1.f / (1.f + expf(-x)); }
__device__ __forceinline__ float sigm_fast(float x) { return __builtin_amdgcn_rcpf(1.f + __expf(-x)); }
__device__ __forceinline__ float silu_fast(float x) { return x / (1.f + __expf(-x)); }
__device__ __forceinline__ float softplus_(float x) { return fmaxf(x, 0.f) + log1pf(expf(-fabsf(x))); }
__device__ __forceinline__ float logsigm_(float x) { return fminf(x, 0.f) - log1pf(expf(-fabsf(x))); }
__device__ __forceinline__ float softcap15_fast(float x) { const float t = __expf(fminf(fmaxf(x, -90.f), 90.f) * (2.f / 15.f)); return 15.f * (t - 1.f) / (t + 1.f); }
template <int W> __device__ __forceinline__ float grp_sum(float v) {
#pragma unroll
    for (int o = 1; o < W; o <<= 1) v += __shfl_xor(v, o);
    return v;
}
__device__ __forceinline__ void unpack8(const u32x4 u, float (&f)[8]) {
    f[0] = bflo(u.x); f[1] = bfhi(u.x); f[2] = bflo(u.y); f[3] = bfhi(u.y); f[4] = bflo(u.z); f[5] = bfhi(u.z); f[6] = bflo(u.w); f[7] = bfhi(u.w);
}
__device__ __forceinline__ u32x4 pack8(const float (&f)[8]) { u32x4 o; o.x = pk2(f[0], f[1]); o.y = pk2(f[2], f[3]); o.z = pk2(f[4], f[5]); o.w = pk2(f[6], f[7]); return o; }

struct EpiInProj {
    static constexpr bool PERM = true, AFTER_DRAIN = false;
    bf16_t* P; int ldp; int nPt; float* T; int ldt;
    __device__ __forceinline__ void operator()(const pg8::f32x4 (&acc)[2][2][4][2], const pg8::Unit& u, int wr, int wc, int fr, int fq) const {
        const int row0 = u.pm * 256 + wr * 64 + fr;
        if (u.pn < nPt) {
            const int col0 = u.pn * 256 + wc * 32 + 8 * fq;
#pragma unroll
            for (int ai = 0; ai < 2; ++ai)
#pragma unroll
                for (int m = 0; m < 4; ++m) { bf16_t* rowp = P + (size_t)(row0 + ai * 128 + m * 16) * ldp + col0;
#pragma unroll
                    for (int bj = 0; bj < 2; ++bj) { const pg8::f32x4 v0 = acc[ai][bj][m][0], v1 = acc[ai][bj][m][1];
                        u32x4 o; o.x = pk2(v0[0], v0[1]); o.y = pk2(v0[2], v0[3]); o.z = pk2(v1[0], v1[1]); o.w = pk2(v1[2], v1[3]);
                        *(u32x4*)(rowp + bj * 128) = o; } }
        } else {
            const int col0 = (u.pn - nPt) * 256 + wc * 32 + 8 * fq;
#pragma unroll
            for (int ai = 0; ai < 2; ++ai)
#pragma unroll
                for (int m = 0; m < 4; ++m) { float* rowp = T + (size_t)(row0 + ai * 128 + m * 16) * ldt + col0;
#pragma unroll
                    for (int bj = 0; bj < 2; ++bj) { *(pg8::f32x4*)(rowp + bj * 128) = acc[ai][bj][m][0]; *(pg8::f32x4*)(rowp + bj * 128 + 4) = acc[ai][bj][m][1]; } }
        }
    }
};
struct EpiSwiGLU {
    static constexpr bool PERM = true, AFTER_DRAIN = false;
    bf16_t* H; int ldh;
    __device__ __forceinline__ void operator()(const pg8::f32x4 (&acc)[2][2][4][2], const pg8::Unit& u, int wr, int wc, int fr, int fq) const {
        const int row0 = u.pm * 256 + wr * 64 + fr, col0 = u.pn * 128 + wc * 32 + 8 * fq;
#pragma unroll
        for (int ai = 0; ai < 2; ++ai)
#pragma unroll
            for (int m = 0; m < 4; ++m) { float h[8];
#pragma unroll
                for (int n = 0; n < 2; ++n)
#pragma unroll
                    for (int j = 0; j < 4; ++j) { const float a1 = acc[ai][0][m][n][j]; h[n * 4 + j] = a1 * __builtin_amdgcn_rcpf(1.f + __expf(-a1)) * acc[ai][1][m][n][j]; }
                asm volatile("" ::: "memory");
                *(u32x4*)(H + (size_t)(row0 + ai * 128 + m * 16) * ldh + col0) = pack8(h); }
    }
};

struct EpiLora {
    static constexpr bool PERM = true, AFTER_DRAIN = false;
    bf16_t* P; int ldp; const float* w0; const float* a0;
    __device__ __forceinline__ void operator()(const pg8::f32x4 (&acc)[2][2][4][2], const pg8::Unit& u, int wr, int wc, int fr, int fq) const {
        const int row0 = u.pm * 256 + wr * 64 + fr, col0 = u.pn * 256 + wc * 32 + 8 * fq;
        const bool isw = u.pn < 8; const float* bp = isw ? w0 + col0 : a0 + (col0 - 2048); const float sc = isw ? -0.6065306597126334f : 1.f;
#pragma unroll
        for (int bj = 0; bj < 2; ++bj) {
            const pg8::f32x4 b0 = *(const pg8::f32x4*)(bp + bj * 128), b1 = *(const pg8::f32x4*)(bp + bj * 128 + 4);
#pragma unroll
            for (int ai = 0; ai < 2; ++ai)
#pragma unroll
                for (int m = 0; m < 4; ++m) { float h[8];
#pragma unroll
                    for (int j = 0; j < 4; ++j) { h[j] = sc * sigm_fast(acc[ai][bj][m][0][j] + b0[j]); h[4 + j] = sc * sigm_fast(acc[ai][bj][m][1][j] + b1[j]); }
                    *(u32x4*)(P + (size_t)(row0 + ai * 128 + m * 16) * ldp + col0 + bj * 128) = pack8(h); } }
    }
};
struct EpiBf16Plain {
    static constexpr bool PERM = true, AFTER_DRAIN = false;
    bf16_t* O; int ldo;
    __device__ __forceinline__ void operator()(const pg8::f32x4 (&acc)[2][2][4][2], const pg8::Unit& u, int wr, int wc, int fr, int fq) const {
        const int row0 = u.pm * 256 + wr * 64 + fr, col0 = u.pn * 256 + wc * 32 + 8 * fq;
#pragma unroll
        for (int ai = 0; ai < 2; ++ai)
#pragma unroll
            for (int m = 0; m < 4; ++m) { bf16_t* rowp = O + (size_t)(row0 + ai * 128 + m * 16) * ldo + col0;
#pragma unroll
                for (int bj = 0; bj < 2; ++bj) { const pg8::f32x4 v0 = acc[ai][bj][m][0], v1 = acc[ai][bj][m][1];
                    u32x4 o; o.x = pk2(v0[0], v0[1]); o.y = pk2(v0[2], v0[3]); o.z = pk2(v1[0], v1[1]); o.w = pk2(v1[2], v1[3]);
                    *(u32x4*)(rowp + bj * 128) = o; } }
    }
};

struct EpiDelta {
    static constexpr bool PERM = true, AFTER_DRAIN = false;
    bf16_t* O; const float* gate;
    __device__ __forceinline__ void operator()(const pg8::f32x4 (&acc)[2][2][4][2], const pg8::Unit& u, int wr, int wc, int fr, int fq) const {
        const int row0 = u.pm * 256 + wr * 64 + fr, col0 = u.pn * 256 + wc * 32 + 8 * fq;
        const float* g = gate + (size_t)(u.pm < 64 ? (u.pm >> 4) : 4) * MODW + col0;
#pragma unroll
        for (int bj = 0; bj < 2; ++bj) {
            const pg8::f32x4 g0 = *(const pg8::f32x4*)(g + bj * 128), g1 = *(const pg8::f32x4*)(g + bj * 128 + 4);
#pragma unroll
            for (int ai = 0; ai < 2; ++ai)
#pragma unroll
                for (int m = 0; m < 4; ++m) { const pg8::f32x4 v0 = acc[ai][bj][m][0] * g0, v1 = acc[ai][bj][m][1] * g1;
                    u32x4 o; o.x = pk2(v0[0], v0[1]); o.y = pk2(v0[2], v0[3]); o.z = pk2(v1[0], v1[1]); o.w = pk2(v1[2], v1[3]);
                    *(u32x4*)(O + (size_t)(row0 + ai * 128 + m * 16) * D + col0 + bj * 128) = o; } }
    }
};

template <bool SRCF32> struct EpiResid {
    static constexpr bool PERM = true, AFTER_DRAIN = false;
    static constexpr int PB = SRCF32 ? 2 : 4, NBAT = 16 / PB;
    const void* srcL; const void* srcC; bf16_t* dstL; bf16_t* dstC; const float* gate;
    struct Raw { pg8::f32x4 f[PB][2]; u32x4 b[PB]; };
    __device__ __forceinline__ void operator()(const pg8::f32x4 (&acc)[2][2][4][2], const pg8::Unit& u, int wr, int wc, int fr, int fq) const {
        const bool ctx = u.pm >= 64;
        const int row0 = (ctx ? u.pm - 64 : u.pm) * 256 + wr * 64 + fr, col0 = u.pn * 256 + wc * 32 + 8 * fq;
        const float* g = gate + (size_t)(ctx ? 4 : (u.pm >> 4)) * MODW + col0;
        const char* sb = (const char*)(ctx ? srcC : srcL); bf16_t* db = ctx ? dstC : dstL;
        pg8::f32x4 gv[2][2];
#pragma unroll
        for (int bj = 0; bj < 2; ++bj) { gv[bj][0] = *(const pg8::f32x4*)(g + bj * 128); gv[bj][1] = *(const pg8::f32x4*)(g + bj * 128 + 4); }
        auto ld = [&](Raw& w, int batch) {
#pragma unroll
            for (int i = 0; i < PB; ++i) { const int q = batch * PB + i, bj = q >> 3, ai = (q >> 2) & 1, m = q & 3;
                const size_t e = (size_t)(row0 + ai * 128 + m * 16) * D + col0 + bj * 128;
                if (SRCF32) { w.f[i][0] = *(const pg8::f32x4*)(sb + e * 4); w.f[i][1] = *(const pg8::f32x4*)(sb + e * 4 + 16); }
                else w.b[i] = *(const u32x4*)(sb + e * 2); }
        };
        auto use = [&](const Raw& w, int batch) {
#pragma unroll
            for (int i = 0; i < PB; ++i) { const int q = batch * PB + i, bj = q >> 3, ai = (q >> 2) & 1, m = q & 3;
                pg8::f32x4 x0, x1;
                if (SRCF32) { x0 = w.f[i][0]; x1 = w.f[i][1]; }
                else { x0 = (pg8::f32x4){bflo(w.b[i].x), bfhi(w.b[i].x), bflo(w.b[i].y), bfhi(w.b[i].y)}; x1 = (pg8::f32x4){bflo(w.b[i].z), bfhi(w.b[i].z), bflo(w.b[i].w), bfhi(w.b[i].w)}; }
                const pg8::f32x4 v0 = acc[ai][bj][m][0] * gv[bj][0] + x0, v1 = acc[ai][bj][m][1] * gv[bj][1] + x1;
                u32x4 o; o.x = pk2(v0[0], v0[1]); o.y = pk2(v0[2], v0[3]); o.z = pk2(v1[0], v1[1]); o.w = pk2(v1[2], v1[3]);
                *(u32x4*)(db + (size_t)(row0 + ai * 128 + m * 16) * D + col0 + bj * 128) = o; }
        };
        Raw wa, wb; ld(wa, 0);
#pragma unroll
        for (int b = 0; b < NBAT; b += 2) { ld(wb, b + 1); use(wa, b); if (b + 2 < NBAT) ld(wa, b + 2); use(wb, b + 1); }
    }
};
struct EpiDeltaPart {
    static constexpr bool PERM = true, AFTER_DRAIN = false;
    bf16_t* O; const float* gate; int ksub;
    __device__ __forceinline__ void operator()(const pg8::f32x4 (&acc)[2][2][4][2], const pg8::Unit& u, int wr, int wc, int fr, int fq) const {
        const int row0 = u.pm * 256 + wr * 64 + fr, col0 = u.pn * 256 + wc * 32 + 8 * fq;
        const float* g = gate + (size_t)4 * MODW + col0;
        bf16_t* Ob = O + (size_t)(u.ko / ksub) * MC * D;
#pragma unroll
        for (int bj = 0; bj < 2; ++bj) {
            const pg8::f32x4 g0 = *(const pg8::f32x4*)(g + bj * 128), g1 = *(const pg8::f32x4*)(g + bj * 128 + 4);
#pragma unroll
            for (int ai = 0; ai < 2; ++ai)
#pragma unroll
                for (int m = 0; m < 4; ++m) { const pg8::f32x4 v0 = acc[ai][bj][m][0] * g0, v1 = acc[ai][bj][m][1] * g1;
                    u32x4 o; o.x = pk2(v0[0], v0[1]); o.y = pk2(v0[2], v0[3]); o.z = pk2(v1[0], v1[1]); o.w = pk2(v1[2], v1[3]);
                    *(u32x4*)(Ob + (size_t)(row0 + ai * 128 + m * 16) * D + col0 + bj * 128) = o; } }
    }
};

struct Ctx {
    LAS unsigned char* lds; int tid, lane, wave, G, wg, gw, NGW;
    const float* in[32]; float* out; unsigned char* ws;
};
#define IN_X 0
#define IN_C 1
#define IN_CTX 2
#define IN_CCTX 3
#define IN_ADAW 4
#define IN_ADAB 5
#define IN_NORMW 6
#define IN_ABWIN 7
#define IN_CONVW 8
#define IN_ALOG 9
#define IN_DTB 10
#define IN_GDNNW 11
#define IN_W0 12
#define IN_WUP 13
#define IN_A0 14
#define IN_AUP 15
#define IN_GUP 16
#define IN_KK 17
#define IN_KA 18
#define IN_RK 19
#define IN_LNW 20
#define IN_LNB 21
#define IN_ABWOUT 22
#define IN_MLWIN 23
#define IN_MLIB 24
#define IN_MLFB 25
#define IN_MLNW 26
#define IN_MLWOUT 27
#define IN_W1 28
#define IN_W3 29
#define IN_W2 30
#define IN_FNW 31

__device__ __forceinline__ void transpose_matrix(const Ctx& c, const float* W, int K, int N, int Npad, bf16_t* WT, int mode, LAS float* scr, int gw, int ngw) {
    const int nblk = Npad / 64, items = (K / 64) * nblk, lane = c.lane;
    const int rr = lane >> 4, c4 = (lane & 15) * 4;
    auto load = [&](f32x4 (&v)[16], int it) {
        const int kb = it / nblk, nb = it - kb * nblk, k0 = kb * 64, n0 = nb * 64;
        const bool inb = n0 + c4 < N;
#pragma unroll
        for (int i = 0; i < 16; ++i) v[i] = inb ? *(const f32x4*)(W + (size_t)(k0 + 4 * i + rr) * N + n0 + c4) : (f32x4){0.f, 0.f, 0.f, 0.f};
    };
    auto process = [&](const f32x4 (&v)[16], int it) {
        const int kb = it / nblk, nb = it - kb * nblk, k0 = kb * 64, n0 = nb * 64;
#pragma unroll
        for (int i = 0; i < 16; ++i) { LAS float* d = scr + (4 * i + rr) * 65 + c4; d[0] = v[i].x; d[1] = v[i].y; d[2] = v[i].z; d[3] = v[i].w; }
        asm volatile("s_waitcnt lgkmcnt(0)" ::: "memory");
        const int j = lane & 7;
#pragma unroll
        for (int q = 0; q < 8; ++q) { const int n = q * 8 + (lane >> 3); const LAS float* s = scr + (8 * j) * 65 + n;
            u32x4 o; o.x = pk2(s[0], s[65]); o.y = pk2(s[2 * 65], s[3 * 65]); o.z = pk2(s[4 * 65], s[5 * 65]); o.w = pk2(s[6 * 65], s[7 * 65]);
            const int ng = n0 + n, orow = mode == 0 ? ng : ((ng >> 7) * 256 + (ng & 127) + (mode == 2 ? 128 : 0));
            *(u32x4*)(WT + (size_t)orow * K + k0 + 8 * j) = o; }
        asm volatile("s_waitcnt lgkmcnt(0)" ::: "memory");
    };
    f32x4 va[16], vb[16];
    int it = gw;
    if (it < items) load(va, it);
#pragma unroll 1
    for (; it < items; it += 2 * ngw) {
        const int it2 = it + ngw, it3 = it2 + ngw;
        if (it2 < items) load(vb, it2);
        process(va, it);
        if (it2 < items) { if (it3 < items) load(va, it3); process(vb, it2); }
    }
}
__device__ __forceinline__ void convert_weights(const Ctx& c, int layer, int wg0, int nwg, int mask = 15) {
    if (c.wg < wg0 || c.wg >= wg0 + nwg) return;
    const int gw = (c.wg - wg0) * NWAVES + c.wave, ngw = nwg * NWAVES;
    LAS float* scr = (LAS float*)c.lds + c.wave * (64 * 65);
    if (layer == 0) {
        if (mask & 1) transpose_matrix(c, c.in[IN_ABWIN], D, AB_IN, NIN0, (bf16_t*)(c.ws + WS_WIN), 0, scr, gw, ngw);
        if (mask & 2) transpose_matrix(c, c.in[IN_ABWOUT], D, D, D, (bf16_t*)(c.ws + WS_WOUT), 0, scr, gw, ngw);
        if (mask & 4) { transpose_matrix(c, c.in[IN_W1], D, FF, FF, (bf16_t*)(c.ws + WS_W13), 1, scr, gw, ngw); transpose_matrix(c, c.in[IN_W3], D, FF, FF, (bf16_t*)(c.ws + WS_W13), 2, scr, gw, ngw); }
        if (mask & 8) transpose_matrix(c, c.in[IN_W2], FF, D, D, (bf16_t*)(c.ws + WS_W2), 0, scr, gw, ngw);
    } else {
        if (mask & 1) transpose_matrix(c, c.in[IN_MLWIN], D, C_INW, NIN1, (bf16_t*)(c.ws + WS_WIN1), 0, scr, gw, ngw);
        if (mask & 2) transpose_matrix(c, c.in[IN_MLWOUT], D, D, D, (bf16_t*)(c.ws + WS_WOUT1), 0, scr, gw, ngw);
        if (mask & 4) transpose_matrix(c, c.in[IN_W1] + (size_t)D * FF, D, FF, FF, (bf16_t*)(c.ws + WS_W131), 1, scr, gw, ngw);
        if (mask & 16) transpose_matrix(c, c.in[IN_W3] + (size_t)D * FF, D, FF, FF, (bf16_t*)(c.ws + WS_W131), 2, scr, gw, ngw);
        if (mask & 8) transpose_matrix(c, c.in[IN_W2] + (size_t)FF * D, FF, D, D, (bf16_t*)(c.ws + WS_W21), 0, scr, gw, ngw);
    }
}
__device__ __forceinline__ void lora_weight_phase(const Ctx& c) {
    bf16_t* Wl = (bf16_t*)(c.ws + WS_WL); bf16_t* Wg = (bf16_t*)(c.ws + WS_WG);
    for (int idx = c.wg * NTHREADS + c.tid; idx < 32 * 4096; idx += c.G * NTHREADS) {
        const int k8 = idx >> 12, n = idx & 4095, slot = n >> 10, ch = n & 1023; float v[8];
        const float* src = c.in[slot < 2 ? IN_WUP : IN_AUP] + (size_t)(slot & 1) * 64 * 1024 + ch;
#pragma unroll
        for (int q = 0; q < 8; ++q) { const int kk = k8 * 8 + q; v[q] = ((kk >> 6) == slot) ? src[(size_t)(kk & 63) * 1024] : 0.f; }
        *(u32x4*)(Wl + (size_t)n * 256 + k8 * 8) = pack8(v);
    }
    for (int idx = c.wg * NTHREADS + c.tid; idx < 32 * 1024; idx += c.G * NTHREADS) {
        const int k8 = idx >> 10, ch = idx & 1023; float v[8];
#pragma unroll
        for (int q = 0; q < 8; ++q) { const int kk = k8 * 8 + q; v[q] = kk < 160 ? c.in[IN_GUP][(size_t)kk * 1024 + ch] : 0.f; }
        *(u32x4*)(Wg + (size_t)ch * 256 + k8 * 8) = pack8(v);
    }
}
__device__ __forceinline__ void ada_phase(const Ctx& c, int layer_sel, int wg0, int nwg) {
    if (c.wg < wg0 || c.wg >= wg0 + nwg) return;
    LAS float* sc = (LAS float*)c.lds;
    LAS float* red = sc + 5 * D;
    for (int i = c.tid; i < 5 * D; i += NTHREADS) { const int b = i / D, k = i % D; const float v = b < 4 ? c.in[IN_C][b * D + k] : c.in[IN_CCTX][k]; sc[i] = v / (1.f + expf(-v)); }
    __syncthreads();
    float* MOD = (float*)(c.ws + WS_MOD);
    constexpr int UPL = MODW / 128;
    for (int u = c.wg - wg0; u < UPL; u += nwg) {
        const int layer = layer_sel, cb = u * 128;
        const float* wp = c.in[IN_ADAW] + (size_t)layer * D * MODW + cb + c.lane * 2;
        float acc[5][2];
#pragma unroll
        for (int b = 0; b < 5; ++b) acc[b][0] = acc[b][1] = 0.f;
        const int k0 = c.wave * 256;
#pragma unroll 16
        for (int k = k0; k < k0 + 256; ++k) { const f32x2 w = *(const f32x2*)(wp + (size_t)k * MODW);
#pragma unroll
            for (int b = 0; b < 5; ++b) { const float s = sc[b * D + k]; acc[b][0] += s * w.x; acc[b][1] += s * w.y; } }
#pragma unroll
        for (int b = 0; b < 5; ++b) { red[(c.wave * 5 + b) * 128 + c.lane * 2] = acc[b][0]; red[(c.wave * 5 + b) * 128 + c.lane * 2 + 1] = acc[b][1]; }
        __syncthreads();
        for (int i = c.tid; i < 640; i += NTHREADS) { const int b = i >> 7, l = i & 127; float s = 0.f;
#pragma unroll
            for (int w = 0; w < 8; ++w) s += red[(w * 5 + b) * 128 + l];
            MOD[(size_t)(layer * 5 + b) * MODW + cb + l] = s + c.in[IN_ADAB][layer * MODW + cb + l]; }
        __syncthreads();
    }
}
template <bool SRCBF> struct NormSrc { typedef f32x4 type; };
template <> struct NormSrc<true> { typedef u32x2 type; };
template <bool SRCBF> struct NormRaw { typename NormSrc<SRCBF>::type x[8]; u32x2 d[8]; };
__device__ __forceinline__ f32x4 norm_unpack(const f32x4 v) { return v; }
__device__ __forceinline__ f32x4 norm_unpack(const u32x2 s) { f32x4 x; x.x = bflo(s.x); x.y = bfhi(s.x); x.z = bflo(s.y); x.w = bfhi(s.y); return x; }
template <bool SRCBF, bool DEEP = false>
__device__ __forceinline__ void norm_mod_phase(const Ctx& c, const void* srcL, const void* srcC, const float* nw, const float* modl, int shift_off, int scale_off, int nrows,
                                               const bf16_t* DELTA = nullptr, bf16_t* dstL = nullptr, bf16_t* dstC = nullptr, const bf16_t* PD = nullptr) {
    typedef typename NormSrc<SRCBF>::type src_t;
    bf16_t* H = (bf16_t*)(c.ws + WS_HY);
    const int r_lo = (int)(((long)c.gw * nrows) / c.NGW), r_hi = (int)(((long)(c.gw + 1) * nrows) / c.NGW);
    f32x4 gn[8], sh[8]; int cur = -1;
    auto load = [&](NormRaw<SRCBF>& w, int r) {
        const size_t ro = r < ML ? (size_t)r * D : (size_t)(r - ML) * D;
        const src_t* xp = (const src_t*)((const char*)(r < ML ? srcL : srcC) + ro * (SRCBF ? 2 : 4));
#pragma unroll
        for (int j = 0; j < 8; ++j) w.x[j] = xp[c.lane + 64 * j];
        if (DELTA || (PD && r >= ML)) {
            if (PD && r >= ML) {
#pragma unroll
                for (int j = 0; j < 8; ++j) { f32x4 s = {0.f, 0.f, 0.f, 0.f};
#pragma unroll
                    for (int q = 0; q < 4; ++q) { const u32x2 d = ((const u32x2*)(PD + (size_t)q * MC * D + ro))[c.lane + 64 * j]; s.x += bflo(d.x); s.y += bfhi(d.x); s.z += bflo(d.y); s.w += bfhi(d.y); }
                    w.d[j].x = pk2(s.x, s.y); w.d[j].y = pk2(s.z, s.w); }
            } else {
#pragma unroll
                for (int j = 0; j < 8; ++j) w.d[j] = ((const u32x2*)(DELTA + (size_t)r * D))[c.lane + 64 * j]; } }
    };
    auto process = [&](const NormRaw<SRCBF>& w, int r) {
        const size_t ro = r < ML ? (size_t)r * D : (size_t)(r - ML) * D;
        const int mrow = r < ML ? (r >> 12) : 4;
        if (mrow != cur) { cur = mrow; const float* mr = modl + (size_t)mrow * MODW;
#pragma unroll
            for (int j = 0; j < 8; ++j) { gn[j] = ((const f32x4*)nw)[c.lane + 64 * j] * (((const f32x4*)(mr + scale_off))[c.lane + 64 * j] + 1.f); sh[j] = ((const f32x4*)(mr + shift_off))[c.lane + 64 * j]; } }
        f32x4 v[8]; float ss = 0.f;
        if (DELTA || (PD && r >= ML)) { bf16_t* dr = (r < ML ? dstL : dstC) + ro;
#pragma unroll
            for (int j = 0; j < 8; ++j) { const u32x2 d = w.d[j]; f32x4 x = norm_unpack(w.x[j]);
                x.x += bflo(d.x); x.y += bfhi(d.x); x.z += bflo(d.y); x.w += bfhi(d.y); v[j] = x;
                u32x2 o; o.x = pk2(x.x, x.y); o.y = pk2(x.z, x.w); ((u32x2*)dr)[c.lane + 64 * j] = o; ss += x.x * x.x + x.y * x.y + x.z * x.z + x.w * x.w; } }
        else {
#pragma unroll
            for (int j = 0; j < 8; ++j) { v[j] = norm_unpack(w.x[j]); ss += v[j].x * v[j].x + v[j].y * v[j].y + v[j].z * v[j].z + v[j].w * v[j].w; } }
        ss = grp_sum<64>(ss);
        const float rstd = 1.f / sqrtf(ss * (1.f / D) + 1e-6f);
#pragma unroll
        for (int j = 0; j < 8; ++j) { const f32x4 y = v[j] * rstd * gn[j] + sh[j];
            u32x2 o; o.x = pk2(y.x, y.y); o.y = pk2(y.z, y.w);
            ((u32x2*)(H + (size_t)r * D))[c.lane + 64 * j] = o; }
    };
    if (SRCBF && DEEP) {
        NormRaw<SRCBF> w0, w1, w2, w3;
        if (r_lo < r_hi) load(w0, r_lo);
        if (r_lo + 1 < r_hi) load(w1, r_lo + 1);
        if (r_lo + 2 < r_hi) load(w2, r_lo + 2);
#pragma unroll 1
        for (int r = r_lo; r < r_hi; r += 4) {
            if (r + 3 < r_hi) load(w3, r + 3);
            process(w0, r);
            if (r + 1 < r_hi) { if (r + 4 < r_hi) load(w0, r + 4); process(w1, r + 1); }
            if (r + 2 < r_hi) { if (r + 5 < r_hi) load(w1, r + 5); process(w2, r + 2); }
            if (r + 3 < r_hi) { if (r + 6 < r_hi) load(w2, r + 6); process(w3, r + 3); }
        }
    } else if (SRCBF) {
        NormRaw<SRCBF> wa, wb;
        if (r_lo < r_hi) load(wa, r_lo);
#pragma unroll 1
        for (int r = r_lo; r < r_hi; r += 2) {
            if (r + 1 < r_hi) load(wb, r + 1);
            process(wa, r);
            if (r + 1 < r_hi) { if (r + 2 < r_hi) load(wa, r + 2); process(wb, r + 1); }
        }
    } else {
#pragma unroll 1
        for (int r = r_lo; r < r_hi; ++r) { NormRaw<SRCBF> wa; load(wa, r); process(wa, r); }
    }
}
__device__ __forceinline__ void final_norm_phase(const Ctx& c, const bf16_t* RES) {
    const float* nw = c.in[IN_FNW];
    f32x4 w4[8];
#pragma unroll
    for (int j = 0; j < 8; ++j) w4[j] = ((const f32x4*)nw)[c.lane + 64 * j];
    const int r_lo = (int)(((long)c.gw * ML) / c.NGW), r_hi = (int)(((long)(c.gw + 1) * ML) / c.NGW);
    auto load = [&](u32x2 (&w)[8], int r) {
#pragma unroll
        for (int j = 0; j < 8; ++j) w[j] = ((const u32x2*)(RES + (size_t)r * D))[c.lane + 64 * j];
    };
    auto process = [&](const u32x2 (&w)[8], int r) {
        f32x4* xr = (f32x4*)(c.out + (size_t)r * D);
        f32x4 v[8]; float ss = 0.f;
#pragma unroll
        for (int j = 0; j < 8; ++j) { const f32x4 x = norm_unpack(w[j]); v[j] = x; ss += x.x * x.x + x.y * x.y + x.z * x.z + x.w * x.w; }
        ss = grp_sum<64>(ss);
        const float rstd = 1.f / sqrtf(ss * (1.f / D) + 1e-6f);
#pragma unroll
        for (int j = 0; j < 8; ++j) xr[c.lane + 64 * j] = v[j] * rstd * w4[j];
    };
    u32x2 w0[8], w1[8], w2[8], w3[8];
    if (r_lo < r_hi) load(w0, r_lo);
    if (r_lo + 1 < r_hi) load(w1, r_lo + 1);
    if (r_lo + 2 < r_hi) load(w2, r_lo + 2);
#pragma unroll 1
    for (int r = r_lo; r < r_hi; r += 4) {
        if (r + 3 < r_hi) load(w3, r + 3);
        process(w0, r);
        if (r + 1 < r_hi) { if (r + 4 < r_hi) load(w0, r + 4); process(w1, r + 1); }
        if (r + 2 < r_hi) { if (r + 5 < r_hi) load(w1, r + 5); process(w2, r + 2); }
        if (r + 3 < r_hi) { if (r + 6 < r_hi) load(w2, r + 6); process(w3, r + 3); }
    }
}

__device__ __forceinline__ void ab_feature_strips(const Ctx& c, int st_lo) {
    const bf16_t* P = (const bf16_t*)(c.ws + WS_P); const float* T = (const float*)(c.ws + WS_TAIL);
    bf16_t* F = (bf16_t*)(c.ws + WS_F);
    float* GA = (float*)(c.ws + WS_GA); float* GB = (float*)(c.ws + WS_GB);
    bf16_t* A1 = (bf16_t*)(c.ws + WS_A1); bf16_t* A2 = (bf16_t*)(c.ws + WS_A2);
    const float* cw = c.in[IN_CONVW];
    const int lane = c.lane;
    const int NITEM = (MT / 8 - st_lo) * 12;
#pragma unroll 1
    for (int item = c.gw; item < NITEM; item += c.NGW) {
        const int st = st_lo + item / 12, blk = item % 12, r0 = st * 8, ch = blk * 512 + lane * 8;
        const bool lat = r0 < ML;
        int rowbase, c0, ncols;
        int gr = 0;
        if (lat) { const int b = r0 >> 12, t0 = r0 & 4095; gr = t0 >> 6; c0 = t0 & 63; rowbase = b * 4096 + gr * 64; ncols = 64; }
        else { const int q = r0 - ML, b = q >> 8; c0 = q & 255; rowbase = ML + b * 256; ncols = 256; }
        float acc[8][8];
#pragma unroll
        for (int tt = 0; tt < 8; ++tt)
#pragma unroll
            for (int j = 0; j < 8; ++j) acc[tt][j] = 0.f;
#pragma unroll
        for (int dr = 0; dr < 3; ++dr) {
            const bool vr = lat ? (gr + dr - 1 >= 0 && gr + dr - 1 < 64) : (dr == 1);
            if (vr) {
                float w[3][8];
#pragma unroll
                for (int dc = 0; dc < 3; ++dc) { const f32x4 w0 = *(const f32x4*)(cw + (dr * 3 + dc) * 6144 + ch), w1 = *(const f32x4*)(cw + (dr * 3 + dc) * 6144 + ch + 4);
                    w[dc][0] = w0.x; w[dc][1] = w0.y; w[dc][2] = w0.z; w[dc][3] = w0.w; w[dc][4] = w1.x; w[dc][5] = w1.y; w[dc][6] = w1.z; w[dc][7] = w1.w; }
                const int rb = rowbase + (lat ? (dr - 1) * 64 : 0);
#pragma unroll
                for (int cc = 0; cc < 10; ++cc) {
                    const int col = c0 + cc - 1;
                    if (col >= 0 && col < ncols) {
                        float pf[8]; unpack8(*(const u32x4*)(P + (size_t)(rb + col) * PW0 + ch), pf);
#pragma unroll
                        for (int tt = 0; tt < 8; ++tt) { const int dc = cc - tt;
                            if (dc >= 0 && dc <= 2) {
#pragma unroll
                                for (int j = 0; j < 8; ++j) acc[tt][j] += pf[j] * w[dc][j]; } }
                    }
                }
            }
        }
        const int grp = blk >> 1, cl = (blk & 1) * 512 + lane * 8;
        f32x4 kk0 = {0.f, 0.f, 0.f, 0.f}, kk1 = kk0;
        if (grp == 4) { kk0 = *(const f32x4*)(c.in[IN_KK] + cl); kk1 = *(const f32x4*)(c.in[IN_KK] + cl + 4); }
#pragma unroll
        for (int tt = 0; tt < 8; ++tt) {
            const size_t r = (size_t)(r0 + tt);
            float cv[8];
#pragma unroll
            for (int j = 0; j < 8; ++j) cv[j] = acc[tt][j];
            if (grp < 3) {
                float ss = 0.f;
#pragma unroll
                for (int j = 0; j < 8; ++j) { cv[j] = cv[j] / (1.f + __expf(-cv[j])); ss += cv[j] * cv[j]; }
                if (grp < 2) { ss = grp_sum<16>(ss); const float sc = (1.f / sqrtf(ss + 1e-6f)) * (grp == 0 ? 0.08838834764831845f : 1.f);
#pragma unroll
                    for (int j = 0; j < 8; ++j) cv[j] *= sc; }
                *(u32x4*)(F + (size_t)grp * MT * 1024 + r * 1024 + cl) = pack8(cv);
            } else if (grp == 3) { *(u32x4*)(F + (size_t)3 * MT * 1024 + r * 1024 + cl) = pack8(cv);
            } else if (grp == 5) { *(u32x4*)(F + (size_t)6 * MT * 1024 + r * 1024 + cl) = pack8(cv);
            } else {
                *(u32x4*)(F + (size_t)5 * MT * 1024 + r * 1024 + cl) = pack8(cv);
                float t[8] = {cv[0] * kk0.x, cv[1] * kk0.y, cv[2] * kk0.z, cv[3] * kk0.w, cv[4] * kk1.x, cv[5] * kk1.y, cv[6] * kk1.z, cv[7] * kk1.w};
                float ss = 0.f;
#pragma unroll
                for (int j = 0; j < 8; ++j) ss += t[j] * t[j];
                ss = grp_sum<8>(ss); const float sc = 1.f / sqrtf(ss + 1e-6f);
#pragma unroll
                for (int j = 0; j < 8; ++j) t[j] *= sc;
                *(u32x4*)(F + (size_t)4 * MT * 1024 + r * 1024 + cl) = pack8(t);
            }
        }
        if (blk == 0) {
#pragma unroll 2
            for (int tt = 0; tt < 8; ++tt) {
                const size_t r = (size_t)(r0 + tt);
                const f32x4 t1 = *(const f32x4*)(T + r * TW0 + 32 + lane * 4);
                u32x2 o1; if (lane < 32) { o1.x = pk2(tanhf(t1.x), tanhf(t1.y)); o1.y = pk2(tanhf(t1.z), tanhf(t1.w)); } else { o1.x = pk2(t1.x, t1.y); o1.y = pk2(t1.z, t1.w); }
                *(u32x2*)(A1 + r * 256 + lane * 4) = o1;
                u32x2 o2 = {0u, 0u};
                if (lane < 40) { const f32x4 t2 = *(const f32x4*)(T + r * TW0 + 288 + lane * 4); o2.x = pk2(sigm(t2.x), sigm(t2.y)); o2.y = pk2(sigm(t2.z), sigm(t2.w)); }
                *(u32x2*)(A2 + r * 256 + lane * 4) = o2;
                if (lane < 16) {
                    const float g0 = T[r * TW0 + lane], g1 = T[r * TW0 + 16 + lane];
                    GA[r * 16 + lane] = -expf(c.in[IN_ALOG][lane]) * softplus_(g0 + c.in[IN_DTB][lane]);
                    GB[r * 16 + lane] = sigm(g1);
                }
            }
        }
    }
}
__device__ __forceinline__ void feat_post(bf16_t* F, size_t r, int grp, int cl, float (&cv)[8], const f32x4 kk0, const f32x4 kk1) {
    if (grp < 3) {
        float ss = 0.f;
#pragma unroll
        for (int j = 0; j < 8; ++j) { cv[j] = cv[j] / (1.f + __expf(-cv[j])); ss += cv[j] * cv[j]; }
        if (grp < 2) { ss = grp_sum<16>(ss); const float sc = (1.f / sqrtf(ss + 1e-6f)) * (grp == 0 ? 0.08838834764831845f : 1.f);
#pragma unroll
            for (int j = 0; j < 8; ++j) cv[j] *= sc; }
        *(u32x4*)(F + (size_t)grp * MT * 1024 + r * 1024 + cl) = pack8(cv);
    } else if (grp == 3) { *(u32x4*)(F + (size_t)3 * MT * 1024 + r * 1024 + cl) = pack8(cv);
    } else if (grp == 5) { *(u32x4*)(F + (size_t)6 * MT * 1024 + r * 1024 + cl) = pack8(cv);
    } else {
        *(u32x4*)(F + (size_t)5 * MT * 1024 + r * 1024 + cl) = pack8(cv);
        float t[8] = {cv[0] * kk0.x, cv[1] * kk0.y, cv[2] * kk0.z, cv[3] * kk0.w, cv[4] * kk1.x, cv[5] * kk1.y, cv[6] * kk1.z, cv[7] * kk1.w};
        float ss = 0.f;
#pragma unroll
        for (int j = 0; j < 8; ++j) ss += t[j] * t[j];
        ss = grp_sum<8>(ss); const float sc = 1.f / sqrtf(ss + 1e-6f);
#pragma unroll
        for (int j = 0; j < 8; ++j) t[j] *= sc;
        *(u32x4*)(F + (size_t)4 * MT * 1024 + r * 1024 + cl) = pack8(t);
    }
}
__device__ __forceinline__ void ab_feature_latent(const Ctx& c) {
    const bf16_t* P = (const bf16_t*)(c.ws + WS_P); bf16_t* F = (bf16_t*)(c.ws + WS_F);
    const float* cw = c.in[IN_CONVW];
    const int lane = c.lane;
#pragma unroll 1
    for (int item = c.gw; item < NB * 8 * 16 * 12; item += c.NGW) {
        const int blk = item % 12; int t = item / 12; const int cs = t & 15; t >>= 4; const int sg = t & 7, b = t >> 3;
        const int ch = blk * 512 + lane * 8, c0 = cs * 4, rf = sg * 8, grp = blk >> 1, cl = (blk & 1) * 512 + lane * 8;
        float w[9][8];
#pragma unroll
        for (int k = 0; k < 9; ++k) { const f32x4 w0 = *(const f32x4*)(cw + k * 6144 + ch), w1 = *(const f32x4*)(cw + k * 6144 + ch + 4);
            w[k][0] = w0.x; w[k][1] = w0.y; w[k][2] = w0.z; w[k][3] = w0.w; w[k][4] = w1.x; w[k][5] = w1.y; w[k][6] = w1.z; w[k][7] = w1.w; }
        f32x4 kk0 = {0.f, 0.f, 0.f, 0.f}, kk1 = kk0;
        if (grp == 4) { kk0 = *(const f32x4*)(c.in[IN_KK] + cl); kk1 = *(const f32x4*)(c.in[IN_KK] + cl + 4); }
        const bf16_t* Pb = P + (size_t)b * 4096 * PW0 + ch;
        u32x4 win[3][6];
        auto load_row = [&](int rr, u32x4 (&dst)[6]) {
            const bool vr = rr >= 0 && rr < 64;
#pragma unroll
            for (int cc = 0; cc < 6; ++cc) { const int col = c0 + cc - 1;
                dst[cc] = (vr && col >= 0 && col < 64) ? *(const u32x4*)(Pb + (size_t)(rr * 64 + col) * PW0) : (u32x4){0u, 0u, 0u, 0u}; }
        };
        load_row(rf - 1, win[0]); load_row(rf, win[1]);
#pragma unroll 1
        for (int ro = 0; ro < 8; ++ro) {
            const int r = rf + ro;
            load_row(r + 1, win[2]);
#pragma unroll
            for (int tt = 0; tt < 4; ++tt) {
                float cv[8];
#pragma unroll
                for (int j = 0; j < 8; ++j) cv[j] = 0.f;
#pragma unroll
                for (int dr = 0; dr < 3; ++dr)
#pragma unroll
                    for (int dc = 0; dc < 3; ++dc) { float pf[8]; unpack8(win[dr][tt + dc], pf);
#pragma unroll
                        for (int j = 0; j < 8; ++j) cv[j] += pf[j] * w[dr * 3 + dc][j]; }
                feat_post(F, (size_t)(b * 4096 + r * 64 + c0 + tt), grp, cl, cv, kk0, kk1);
            }
#pragma unroll
            for (int cc = 0; cc < 6; ++cc) { win[0][cc] = win[1][cc]; win[1][cc] = win[2][cc]; }
        }
    }
}
__device__ __forceinline__ void ab_gate_rows(const Ctx& c, int nrows) {
    const float* T = (const float*)(c.ws + WS_TAIL); float* GA = (float*)(c.ws + WS_GA); float* GB = (float*)(c.ws + WS_GB);
    bf16_t* A1 = (bf16_t*)(c.ws + WS_A1); bf16_t* A2 = (bf16_t*)(c.ws + WS_A2);
    const int lane = c.lane;
#pragma unroll 2
    for (int rr = c.gw; rr < nrows; rr += c.NGW) {
        const size_t r = (size_t)rr;
        const f32x4 t1 = *(const f32x4*)(T + r * TW0 + 32 + lane * 4);
        u32x2 o1; if (lane < 32) { o1.x = pk2(tanhf(t1.x), tanhf(t1.y)); o1.y = pk2(tanhf(t1.z), tanhf(t1.w)); } else { o1.x = pk2(t1.x, t1.y); o1.y = pk2(t1.z, t1.w); }
        *(u32x2*)(A1 + r * 256 + lane * 4) = o1;
        u32x2 o2 = {0u, 0u};
        if (lane < 40) { const f32x4 t2 = *(const f32x4*)(T + r * TW0 + 288 + lane * 4); o2.x = pk2(sigm(t2.x), sigm(t2.y)); o2.y = pk2(sigm(t2.z), sigm(t2.w)); }
        *(u32x2*)(A2 + r * 256 + lane * 4) = o2;
        if (lane < 16) {
            const float g0 = T[r * TW0 + lane], g1 = T[r * TW0 + 16 + lane];
            GA[r * 16 + lane] = -expf(c.in[IN_ALOG][lane]) * softplus_(g0 + c.in[IN_DTB][lane]);
            GB[r * 16 + lane] = sigm(g1);
        }
    }
}
__device__ __forceinline__ void ab_feature_phase(const Ctx& c) {
    ab_feature_latent(c);
    ab_gate_rows(c, ML);
    ab_feature_strips(c, ML / 8);
}
__device__ __forceinline__ int chunk_row(int b, int dir, int s) {
    if (s < 4) return ML + b * 256 + (dir == 0 ? s : 3 - s) * 64;
    return b * 4096 + (dir == 0 ? s - 4 : 67 - s) * 64;
}
__device__ __forceinline__ void ab_output_phase(const Ctx& c) {
    const bf16_t* F = (const bf16_t*)(c.ws + WS_F); const bf16_t* P = (const bf16_t*)(c.ws + WS_P); const bf16_t* GO = (const bf16_t*)(c.ws + WS_GOUT);
    bf16_t* Yo = (bf16_t*)(c.ws + WS_HY);
    const int lane = c.lane;
#pragma unroll 1
    for (int r = c.gw; r < MT; r += c.NGW) {
        const size_t row = (size_t)r;
        u32x4 outw[4];
#pragma unroll
        for (int blk = 0; blk < 2; ++blk) {
            const int ch = blk * 512 + lane * 8;
            float yf[8], yb[8], rv[8], kb[8], vb[8], a0[8], a1[8], go[8];
            unpack8(*(const u32x4*)(Yo + row * D + 1024 + ch), yf); unpack8(*(const u32x4*)(Yo + row * D + ch), yb);
            unpack8(*(const u32x4*)(F + (size_t)3 * MT * 1024 + row * 1024 + ch), rv); unpack8(*(const u32x4*)(F + (size_t)5 * MT * 1024 + row * 1024 + ch), kb);
            unpack8(*(const u32x4*)(F + (size_t)6 * MT * 1024 + row * 1024 + ch), vb);
            unpack8(*(const u32x4*)(P + row * PW0 + 2048 + ch), a0); unpack8(*(const u32x4*)(P + row * PW0 + 3072 + ch), a1);
            unpack8(*(const u32x4*)(GO + row * 1024 + ch), go);
            const f32x4 ka0 = *(const f32x4*)(c.in[IN_KA] + ch), ka1 = *(const f32x4*)(c.in[IN_KA] + ch + 4), rk0 = *(const f32x4*)(c.in[IN_RK] + ch), rk1 = *(const f32x4*)(c.in[IN_RK] + ch + 4);
            const f32x4 lw0 = *(const f32x4*)(c.in[IN_LNW] + ch), lw1 = *(const f32x4*)(c.in[IN_LNW] + ch + 4), lb0 = *(const f32x4*)(c.in[IN_LNB] + ch), lb1 = *(const f32x4*)(c.in[IN_LNB] + ch + 4);
            const float ka[8] = {ka0.x, ka0.y, ka0.z, ka0.w, ka1.x, ka1.y, ka1.z, ka1.w}, rk[8] = {rk0.x, rk0.y, rk0.z, rk0.w, rk1.x, rk1.y, rk1.z, rk1.w};
            const float lnw[8] = {lw0.x, lw0.y, lw0.z, lw0.w, lw1.x, lw1.y, lw1.z, lw1.w}, lnb[8] = {lb0.x, lb0.y, lb0.z, lb0.w, lb1.x, lb1.y, lb1.z, lb1.w};
            float s = 0.f, bs = 0.f;
#pragma unroll
            for (int j = 0; j < 8; ++j) { yf[j] += yb[j]; s += yf[j]; bs += rv[j] * kb[j] * (2.f + (a0[j] + a1[j] - 2.f) * ka[j]) * rk[j]; }
            const float mu = grp_sum<8>(s) * (1.f / 64.f); bs = grp_sum<8>(bs);
            float vs = 0.f;
#pragma unroll
            for (int j = 0; j < 8; ++j) { yf[j] -= mu; vs += yf[j] * yf[j]; }
            const float rstd = 1.f / sqrtf(grp_sum<8>(vs) * (1.f / 64.f) + 64e-5f);
            float o[8];
#pragma unroll
            for (int j = 0; j < 8; ++j) o[j] = (yf[j] * rstd * lnw[j] + lnb[j] + bs * vb[j]) * go[j];
            outw[2 + blk] = pack8(o);
        }
#pragma unroll
        for (int blk = 0; blk < 2; ++blk) {
            const int ch = blk * 512 + lane * 8;
            float of[8], ob[8], z[8];
            unpack8(*(const u32x4*)(P + row * PW0 + 4096 + ch), of); unpack8(*(const u32x4*)(P + row * PW0 + 5120 + ch), ob); unpack8(*(const u32x4*)(P + row * PW0 + 6144 + ch), z);
            const f32x4 n0 = *(const f32x4*)(c.in[IN_GDNNW] + (ch & 127)), n1 = *(const f32x4*)(c.in[IN_GDNNW] + (ch & 127) + 4);
            const float nw[8] = {n0.x, n0.y, n0.z, n0.w, n1.x, n1.y, n1.z, n1.w};
            float ss = 0.f;
#pragma unroll
            for (int j = 0; j < 8; ++j) { of[j] += ob[j]; ss += of[j] * of[j]; }
            const float rstd = 1.f / sqrtf(grp_sum<16>(ss) * (1.f / 128.f) + 1e-6f);
            float o[8];
#pragma unroll
            for (int j = 0; j < 8; ++j) o[j] = of[j] * rstd * nw[j] * silu_fast(z[j]);
            outw[blk] = pack8(o);
        }
#pragma unroll
        for (int q = 0; q < 4; ++q) *(u32x4*)(Yo + row * D + q * 512 + lane * 8) = outw[q];
    }
}

__device__ __forceinline__ void ml_output_phase(const Ctx& c) {
    const bf16_t* Hs = (const bf16_t*)(c.ws + WS_F); const bf16_t* P = (const bf16_t*)(c.ws + WS_P); bf16_t* Yo = (bf16_t*)(c.ws + WS_HY);
    const float* nw = c.in[IN_MLNW];
    for (int r = c.gw; r < ML; r += c.NGW) {
#pragma unroll
        for (int blk = 0; blk < 4; ++blk) {
            const int ch = blk * 512 + c.lane * 8;
            float a[8], bb[8], o[8];
            unpack8(*(const u32x4*)(Hs + (size_t)r * D + ch), a); unpack8(*(const u32x4*)(Hs + (size_t)ML * D + (size_t)r * D + ch), bb);
            unpack8(*(const u32x4*)(P + (size_t)r * PW1 + 4096 + ch), o);
            float ss = 0.f;
#pragma unroll
            for (int j = 0; j < 8; ++j) { a[j] += bb[j]; ss += a[j] * a[j]; }
            ss = grp_sum<32>(ss); const float rstd = 1.f / sqrtf(ss * (1.f / 256.f) + 1e-6f);
            const f32x4 w0 = *(const f32x4*)(nw + ch), w1 = *(const f32x4*)(nw + ch + 4);
            const float wv[8] = {w0.x, w0.y, w0.z, w0.w, w1.x, w1.y, w1.z, w1.w};
#pragma unroll
            for (int j = 0; j < 8; ++j) a[j] = a[j] * rstd * wv[j] * sigm_fast(o[j]);
            *(u32x4*)(Yo + (size_t)r * D + ch) = pack8(a);
        }
    }
}


typedef short bf16x8 __attribute__((ext_vector_type(8)));
typedef short s16x4 __attribute__((ext_vector_type(4)));
#define MFMA16(a, b, c) __builtin_amdgcn_mfma_f32_16x16x32_bf16((a), (b), (c), 0, 0, 0)
__device__ __forceinline__ bf16x8 frag_row(const LAS unsigned char* img, int RS, int r0, int k0, int lane) {
    return *(const LAS bf16x8*)(img + (r0 + (lane & 15)) * RS + (k0 + 8 * (lane >> 4)) * 2);
}
__device__ __forceinline__ bf16x8 frag_tr(const LAS unsigned char* img, int RS, int r0, int k0, int lane) {
    const int g = lane >> 4, q = (lane & 15) >> 2, p = lane & 3;
    LAS unsigned char* a = (LAS unsigned char*)img + (k0 + 8 * g + q) * RS + (r0 + 4 * p) * 2;
    const s16x4 lo = __builtin_amdgcn_ds_read_tr16_b64_v4i16((LAS s16x4*)a);
    const s16x4 hi = __builtin_amdgcn_ds_read_tr16_b64_v4i16((LAS s16x4*)(a + 4 * RS));
    bf16x8 r; r[0] = lo[0]; r[1] = lo[1]; r[2] = lo[2]; r[3] = lo[3]; r[4] = hi[0]; r[5] = hi[1]; r[6] = hi[2]; r[7] = hi[3];
    return r;
}
__device__ __forceinline__ void tile_write(LAS unsigned char* img, int RS, int n0, int m0, int lane, const f32x4 v) {
    u32x2 o; o.x = pk2(v[0], v[1]); o.y = pk2(v[2], v[3]);
    *(LAS u32x2*)(img + (n0 + (lane & 15)) * RS + (m0 + 4 * (lane >> 4)) * 2) = o;
}
constexpr int MS = 68;
__device__ __forceinline__ bf16x8 frag_pack(const f32x4 a, const f32x4 b) { u32x4 u; u.x = pk2(a[0], a[1]); u.y = pk2(a[2], a[3]); u.z = pk2(b[0], b[1]); u.w = pk2(b[2], b[3]); return __builtin_bit_cast(bf16x8, u); }
__device__ __forceinline__ void tri_inverse_wave0(LAS float* MF, int lane) {
    {
        const int g = lane >> 4, i = lane & 15;
        const f32x4 z4 = {0.f, 0.f, 0.f, 0.f};
        {   LAS float* base = MF + (g * 16) * MS + g * 16; float acc[16];
#pragma unroll
            for (int r = 0; r < 16; ++r) acc[r] = (r == i) ? 1.f : 0.f;
#pragma unroll
            for (int j = 0; j < 15; ++j) { const float xj = acc[j];
#pragma unroll
                for (int r = j + 1; r < 16; ++r) acc[r] -= base[r * MS + j] * xj; }
#pragma unroll
            for (int r = 0; r < 16; ++r) base[r * MS + i] = acc[r];
        }
#pragma unroll
        for (int h = 0; h < 2; ++h) {
            const int R0 = h ? 48 : 16, C0 = h ? 32 : 0;
            bf16x8 a1, b1;
            {   const LAS float* pa = MF + (R0 + i) * MS + C0 + 8 * (g & 1);
                const f32x4 x0 = *(const LAS f32x4*)pa, x1 = *(const LAS f32x4*)(pa + 4);
                f32x4 y0, y1;
#pragma unroll
                for (int j = 0; j < 4; ++j) { y0[j] = MF[(C0 + 8 * (g & 1) + j) * MS + C0 + i]; y1[j] = MF[(C0 + 8 * (g & 1) + 4 + j) * MS + C0 + i]; }
                a1 = g < 2 ? frag_pack(x0, x1) : frag_pack(z4, z4); b1 = g < 2 ? frag_pack(y0, y1) : frag_pack(z4, z4); }
            const f32x4 t = MFMA16(a1, b1, z4);
            const f32x4 xa = *(const LAS f32x4*)(MF + (R0 + i) * MS + R0 + 4 * g);
            const f32x4 x = MFMA16(frag_pack(xa, z4), frag_pack(t, z4), z4);
#pragma unroll
            for (int r = 0; r < 4; ++r) MF[(R0 + 4 * g + r) * MS + C0 + i] = -x[r];
        }
        {   bf16x8 a[2], b[2];
#pragma unroll
            for (int I = 0; I < 2; ++I) { const LAS float* pa = MF + (32 + 16 * I + i) * MS + 8 * g; a[I] = frag_pack(*(const LAS f32x4*)pa, *(const LAS f32x4*)(pa + 4)); }
#pragma unroll
            for (int J = 0; J < 2; ++J) { f32x4 y0, y1;
#pragma unroll
                for (int j = 0; j < 4; ++j) { y0[j] = MF[(8 * g + j) * MS + 16 * J + i]; y1[j] = MF[(8 * g + 4 + j) * MS + 16 * J + i]; }
                b[J] = frag_pack(y0, y1); }
            f32x4 t[2][2];
#pragma unroll
            for (int I = 0; I < 2; ++I)
#pragma unroll
                for (int J = 0; J < 2; ++J) t[I][J] = MFMA16(a[I], b[J], z4);
            bf16x8 a2[2];
#pragma unroll
            for (int I = 0; I < 2; ++I) { const LAS float* pa = MF + (32 + 16 * I + i) * MS + 32 + 4 * g; a2[I] = frag_pack(*(const LAS f32x4*)pa, *(const LAS f32x4*)(pa + 16)); }
#pragma unroll
            for (int I = 0; I < 2; ++I)
#pragma unroll
                for (int J = 0; J < 2; ++J) { const f32x4 x = MFMA16(a2[I], frag_pack(t[0][J], t[1][J]), z4);
#pragma unroll
                    for (int r = 0; r < 4; ++r) MF[(32 + 16 * I + 4 * g + r) * MS + 16 * J + i] = -x[r]; }
        }
    }
}
__device__ __forceinline__ void tri_inverse_64(LAS float* MF, LAS float* TMP, int tid) {
    (void)TMP;
    if (tid < 64) tri_inverse_wave0(MF, tid);
    __syncthreads();
}
#define DPP_F(old, src, ctrl, rmask) __builtin_bit_cast(float, __builtin_amdgcn_update_dpp(__builtin_bit_cast(int, (float)(old)), __builtin_bit_cast(int, (float)(src)), (ctrl), (rmask), 0xF, false))
__device__ __forceinline__ float wave_incl_scan_add(float x, int lane) {
    (void)lane;
    x += DPP_F(0.f, x, 0x111, 0xF); x += DPP_F(0.f, x, 0x112, 0xF); x += DPP_F(0.f, x, 0x114, 0xF); x += DPP_F(0.f, x, 0x118, 0xF);
    x += DPP_F(0.f, x, 0x142, 0xA); x += DPP_F(0.f, x, 0x143, 0xC);
    return x;
}
__device__ __forceinline__ float wave_incl_scan_max(float x, int lane) {
    (void)lane;
    const float ninf = -__builtin_inff();
    x = fmaxf(x, DPP_F(ninf, x, 0x111, 0xF)); x = fmaxf(x, DPP_F(ninf, x, 0x112, 0xF)); x = fmaxf(x, DPP_F(ninf, x, 0x114, 0xF)); x = fmaxf(x, DPP_F(ninf, x, 0x118, 0xF));
    x = fmaxf(x, DPP_F(ninf, x, 0x142, 0xA)); x = fmaxf(x, DPP_F(ninf, x, 0x143, 0xC));
    return x;
}
constexpr int RS128 = 272, RS64 = 144, RS80 = 176;

__device__ __forceinline__ void mlstm_chunk_phase(const Ctx& c) {
    const bf16_t* P = (const bf16_t*)(c.ws + WS_P); bf16_t* Hs = (bf16_t*)(c.ws + WS_F);
    const float* GA = (const float*)(c.ws + WS_GA); const float* GB = (const float*)(c.ws + WS_GB);
    const int lane = c.lane, tid = c.tid, w = c.wave, g4 = lane >> 4, l15 = lane & 15;
    LAS unsigned char* KIMG = c.lds; LAS unsigned char* QIMG = c.lds + 17408; LAS unsigned char* VIMG = c.lds + 34816; LAS unsigned char* VS = c.lds + 46080;
    LAS unsigned char* SM = c.lds + 57344; LAS unsigned char* CT = c.lds + 66560;
    LAS float* sB = (LAS float*)(c.lds + 88320); LAS float* sCM = sB + 64; LAS float* sIGB = sB + 128;
    for (int item = c.wg; item < 256; item += c.G) {
        const int chain = item >> 2, cq = item & 3, b = chain >> 4, h = (chain >> 1) & 7, dir = chain & 1;
        f32x4 st[5];
#pragma unroll
        for (int e = 0; e < 5; ++e) st[e] = (f32x4){0.f, 0.f, 0.f, 0.f};
        float m = 0.f; const float ibias = c.in[IN_MLIB][dir * 8 + h], fbias = c.in[IN_MLFB][dir * 8 + h];
        u32x4 rk[2], rq[2], rv; float rg = 0.f, rb = 0.f;
        auto gload = [&](int s) {
            const int row0 = chunk_row(b, dir, s);
#pragma unroll
            for (int i = 0; i < 2; ++i) { const int pc = tid + i * 512, tk = pc >> 4, o = (pc & 15) * 8;
                rk[i] = *(const u32x4*)(P + (size_t)(row0 + tk) * PW1 + 1024 + h * 128 + o);
                rq[i] = *(const u32x4*)(P + (size_t)(row0 + tk) * PW1 + h * 128 + o); }
            { const int tk = tid >> 3, o = (tid & 7) * 8; rv = *(const u32x4*)(P + (size_t)(row0 + tk) * PW1 + 2048 + h * 256 + cq * 64 + o); }
            if (tid < 64) { const float* tp = (const float*)(c.ws + WS_TAIL) + (size_t)(row0 + tid) * TW1 + dir * 8 + h; rg = tp[0]; rb = tp[16]; }
        };
        __syncthreads();
        for (int i = tid; i < 80 * 34; i += NTHREADS) ((LAS u32x2*)CT)[i] = (u32x2){0u, 0u};
        gload(0);
#pragma unroll 1
        for (int s = 0; s < 68; ++s) {
#pragma unroll
            for (int i = 0; i < 2; ++i) { const int pc = tid + i * 512, tk = pc >> 4, o = pc & 15, ri = dir ? 63 - tk : tk;
                *(LAS u32x4*)(KIMG + ri * RS128 + o * 16) = rk[i]; *(LAS u32x4*)(QIMG + ri * RS128 + o * 16) = rq[i]; }
            { const int tk = tid >> 3, o = tid & 7, ri = dir ? 63 - tk : tk; *(LAS u32x4*)(VIMG + ri * RS80 + o * 16) = rv;
              if (o == 0) { *(LAS u32x4*)(VIMG + ri * RS80 + 128) = (u32x4){0x3F80u, 0u, 0u, 0u}; *(LAS u32x4*)(VIMG + ri * RS80 + 144) = (u32x4){0u, 0u, 0u, 0u}; } }
            if (w == 0) {
                const int src = dir ? 63 - lane : lane;
                const float ig = softcap15_fast(__shfl(rg, src) + ibias), xf = softcap15_fast(__shfl(rb, src) + fbias), lf = fminf(xf, 0.f) - __logf(1.f + __expf(-fabsf(xf)));
                const float bb = wave_incl_scan_add(lf, lane), igb = ig - bb, cm = wave_incl_scan_max(igb, lane);
                sB[lane] = bb; sCM[lane] = cm; sIGB[lane] = igb;
            }
            __syncthreads();
            if (s + 1 < 68) gload(s + 1);
            const float c63 = sCM[63], blast = sB[63], mx63 = fmaxf(m, c63);
            const float cscale = __expf(m - mx63);
            if (s >= 4) {
                const int ib = w >> 1;
                bf16x8 bq[4];
#pragma unroll
                for (int k = 0; k < 4; ++k) bq[k] = frag_row(QIMG, RS128, ib * 16, k * 32, lane);
                const float mxi = fmaxf(m, sCM[ib * 16 + l15]);
#pragma unroll
                for (int t = 0; t < 2; ++t) { const int jb = (w & 1) * 2 + t; f32x4 acc = {0.f, 0.f, 0.f, 0.f};
#pragma unroll
                    for (int k = 0; k < 4; ++k) acc = MFMA16(frag_row(KIMG, RS128, jb * 16, k * 32, lane), bq[k], acc);
                    const int i = ib * 16 + l15; const f32x4 igb4 = *(const LAS f32x4*)(sIGB + jb * 16 + 4 * g4);
#pragma unroll
                    for (int r = 0; r < 4; ++r) { const int j = jb * 16 + 4 * g4 + r; const float sv = acc[r] * 0.08838834764831845f * __expf(igb4[r] - mxi); acc[r] = (j <= i) ? sv : 0.f; }
                    tile_write(SM, RS64, ib * 16, jb * 16, lane, acc); }
            }
            for (int pc = tid; pc < 640; pc += NTHREADS) { const int j = pc / 10, o = pc % 10; const float f = __expf(sIGB[j] - mx63);
                float v[8]; unpack8(*(const LAS u32x4*)(VIMG + j * RS80 + o * 16), v);
#pragma unroll
                for (int q = 0; q < 8; ++q) v[q] *= f;
                *(LAS u32x4*)(VS + j * RS80 + o * 16) = pack8(v); }
            __syncthreads();
            if (s >= 4) {
                const int ib = w & 3, eh = w >> 2, i = ib * 16 + l15;
                const float mxi = fmaxf(m, sCM[i]), inter = __expf(m - mxi) * 0.08838834764831845f, floorv = __expf(-(sB[i] + mxi));
                bf16x8 bs[2], bq[4];
#pragma unroll
                for (int k = 0; k < 2; ++k) bs[k] = frag_row(SM, RS64, ib * 16, k * 32, lane);
#pragma unroll
                for (int k = 0; k < 4; ++k) bq[k] = frag_row(QIMG, RS128, ib * 16, k * 32, lane);
                f32x4 val[3];
#pragma unroll
                for (int t = 0; t < 3; ++t) { const int eb = t < 2 ? eh * 2 + t : 4; f32x4 a1 = {0.f, 0.f, 0.f, 0.f}, a2 = {0.f, 0.f, 0.f, 0.f};
#pragma unroll
                    for (int k = 0; k < 2; ++k) a1 = MFMA16(frag_tr(VIMG, RS80, eb * 16, k * 32, lane), bs[k], a1);
#pragma unroll
                    for (int k = 0; k < 4; ++k) a2 = MFMA16(frag_row(CT, RS128, eb * 16, k * 32, lane), bq[k], a2);
                    val[t] = a1 + a2 * inter; }
                const float den = __shfl(val[2][0], l15);
                const float dd = 1.f / fmaxf(fabsf(den), floorv);
                const int tl = dir ? 63 - i : i, row0 = chunk_row(b, dir, s);
#pragma unroll
                for (int t = 0; t < 2; ++t) { const int e0 = (eh * 2 + t) * 16 + 4 * g4; u32x2 o; o.x = pk2(val[t][0] * dd, val[t][1] * dd); o.y = pk2(val[t][2] * dd, val[t][3] * dd);
                    *(u32x2*)(Hs + (size_t)dir * ML * D + (size_t)(row0 + tl) * D + h * 256 + cq * 64 + e0) = o; }
            }
            {   bf16x8 ak[2];
#pragma unroll
                for (int k = 0; k < 2; ++k) ak[k] = frag_tr(KIMG, RS128, w * 16, k * 32, lane);
#pragma unroll
                for (int e = 0; e < 5; ++e) { st[e] = st[e] * cscale;
#pragma unroll
                    for (int k = 0; k < 2; ++k) st[e] = MFMA16(ak[k], frag_tr(VS, RS80, e * 16, k * 32, lane), st[e]); }
            }
            m = blast + mx63;
            __syncthreads();
#pragma unroll
            for (int e = 0; e < 5; ++e) tile_write(CT, RS128, e * 16, w * 16, lane, st[e]);
        }
    }
}

__device__ __forceinline__ void gdn_chunk_items(const Ctx& c, int item0, int item_stride, int n_items) {
    const bf16_t* F = (const bf16_t*)(c.ws + WS_F); bf16_t* P = (bf16_t*)(c.ws + WS_P);
    const float* GA = (const float*)(c.ws + WS_GA); const float* GB = (const float*)(c.ws + WS_GB);
    const int lane = c.lane, tid = c.tid, w = c.wave, g4 = lane >> 4, l15 = lane & 15;
    LAS unsigned char* KIMG = c.lds; LAS unsigned char* QIMG = c.lds + 17408; LAS unsigned char* VIMG = c.lds + 34816; LAS unsigned char* ST = c.lds + 44032;
    LAS unsigned char* WIMG = c.lds + 61440; LAS unsigned char* QKM = c.lds + 78848; LAS unsigned char* VNT = c.lds + 88064; LAS unsigned char* VNS = c.lds + 97280;
    LAS unsigned char* TW = c.lds + 106496; LAS unsigned char* TU = c.lds + 115712; LAS float* MF = (LAS float*)(c.lds + 124928); LAS float* TMP = (LAS float*)VNT;
    LAS float* sGC = (LAS float*)(c.lds + 142336); LAS float* sEG = sGC + 64; LAS float* sEL = sGC + 128; LAS float* sBT = sGC + 192; LAS float* sBG = sGC + 256;
    for (int item = item0; item < n_items; item += item_stride) {
        const int chain = item >> 1, eh = item & 1, b = chain >> 4, h = (chain >> 1) & 7, dir = chain & 1;
        f32x4 st[4];
#pragma unroll
        for (int e = 0; e < 4; ++e) st[e] = (f32x4){0.f, 0.f, 0.f, 0.f};
        u32x4 rk[2], rq[2], rv; float rg = 0.f, rb = 0.f;
        auto gload = [&](int s) {
            const int row0 = chunk_row(b, dir, s);
#pragma unroll
            for (int i = 0; i < 2; ++i) { const int pc = tid + i * 512, tk = pc >> 4, o = (pc & 15) * 8;
                rk[i] = *(const u32x4*)(F + (size_t)1 * MT * 1024 + (size_t)(row0 + tk) * 1024 + h * 128 + o);
                rq[i] = *(const u32x4*)(F + (size_t)0 * MT * 1024 + (size_t)(row0 + tk) * 1024 + h * 128 + o); }
            { const int tk = tid >> 3, o = (tid & 7) * 8; rv = *(const u32x4*)(F + (size_t)2 * MT * 1024 + (size_t)(row0 + tk) * 1024 + h * 128 + eh * 64 + o); }
            if (tid < 64) { rg = GA[(size_t)(row0 + tid) * 16 + dir * 8 + h]; rb = GB[(size_t)(row0 + tid) * 16 + dir * 8 + h]; }
        };
        __syncthreads();
        for (int i = tid; i < 64 * 34; i += NTHREADS) ((LAS u32x2*)ST)[i] = (u32x2){0u, 0u};
        gload(0);
#pragma unroll 1
        for (int s = 0; s < 68; ++s) {
#pragma unroll
            for (int i = 0; i < 2; ++i) { const int pc = tid + i * 512, tk = pc >> 4, o = pc & 15, ri = dir ? 63 - tk : tk;
                *(LAS u32x4*)(KIMG + ri * RS128 + o * 16) = rk[i]; *(LAS u32x4*)(QIMG + ri * RS128 + o * 16) = rq[i]; }
            { const int tk = tid >> 3, o = tid & 7, ri = dir ? 63 - tk : tk; *(LAS u32x4*)(VIMG + ri * RS64 + o * 16) = rv; }
            if (w == 0) {
                const int src = dir ? 63 - lane : lane;
                const float gg = __shfl(rg, src), bt = __shfl(rb, src);
                const float gc = wave_incl_scan_add(gg, lane), gl = __shfl(gc, 63), eg = __expf(gc);
                sGC[lane] = gc; sEG[lane] = eg; sEL[lane] = __expf(gl - gc); sBT[lane] = bt; sBG[lane] = bt * eg;
            }
            __syncthreads();
            if (s + 1 < 68) gload(s + 1);
            {   const int ib = w >> 1, i = ib * 16 + l15; const float gci = sGC[i], bti = sBT[i];
                bf16x8 bk[4];
#pragma unroll
                for (int k = 0; k < 4; ++k) bk[k] = frag_row(KIMG, RS128, ib * 16, k * 32, lane);
#pragma unroll
                for (int t = 0; t < 2; ++t) { const int jb = (w & 1) * 2 + t; f32x4 a1 = {0.f, 0.f, 0.f, 0.f};
#pragma unroll
                    for (int k = 0; k < 4; ++k) a1 = MFMA16(frag_row(KIMG, RS128, jb * 16, k * 32, lane), bk[k], a1);
                    f32x4 mv;
                    const f32x4 gcj = *(const LAS f32x4*)(sGC + jb * 16 + 4 * g4);
#pragma unroll
                    for (int r = 0; r < 4; ++r) { const int j = jb * 16 + 4 * g4 + r; const float sv = bti * a1[r] * __expf(gci - gcj[r]); mv[r] = (j < i) ? sv : 0.f; }
                    *(LAS f32x4*)(MF + i * MS + jb * 16 + 4 * g4) = mv; }
            }
            __syncthreads();
            if (w == 0) tri_inverse_wave0(MF, lane);
            else {
#pragma unroll 1
                for (int tile = w - 1; tile < 16; tile += 7) {
                    const int ib = tile >> 2, jb = tile & 3, i = ib * 16 + l15; const float gci = sGC[i];
                    f32x4 a2 = {0.f, 0.f, 0.f, 0.f};
#pragma unroll
                    for (int k = 0; k < 4; ++k) a2 = MFMA16(frag_row(KIMG, RS128, jb * 16, k * 32, lane), frag_row(QIMG, RS128, ib * 16, k * 32, lane), a2);
                    const f32x4 gcj = *(const LAS f32x4*)(sGC + jb * 16 + 4 * g4);
#pragma unroll
                    for (int r = 0; r < 4; ++r) { const int j = jb * 16 + 4 * g4 + r; const float sv = a2[r] * __expf(gci - gcj[r]); a2[r] = (j <= i) ? sv : 0.f; }
                    tile_write(QKM, RS64, ib * 16, jb * 16, lane, a2); }
            }
            __syncthreads();
            {   const int i = tid >> 3, j8 = (tid & 7) * 8; float tw[8], tu[8];
#pragma unroll
                for (int q = 0; q < 8; ++q) { const float x = MF[i * MS + j8 + q]; tw[q] = x * sBG[j8 + q]; tu[q] = x * sBT[j8 + q]; }
                *(LAS u32x4*)(TW + i * RS64 + j8 * 2) = pack8(tw); *(LAS u32x4*)(TU + i * RS64 + j8 * 2) = pack8(tu); }
            __syncthreads();
            f32x4 ut[2];
            {   const int ib = w >> 1;
                bf16x8 au[2];
#pragma unroll
                for (int k = 0; k < 2; ++k) au[k] = frag_row(TU, RS64, ib * 16, k * 32, lane);
#pragma unroll
                for (int t = 0; t < 2; ++t) { const int eb = (w & 1) * 2 + t; ut[t] = (f32x4){0.f, 0.f, 0.f, 0.f};
#pragma unroll
                    for (int k = 0; k < 2; ++k) ut[t] = MFMA16(au[k], frag_tr(VIMG, RS64, eb * 16, k * 32, lane), ut[t]); }
                bf16x8 akt[2];
#pragma unroll
                for (int k = 0; k < 2; ++k) akt[k] = frag_tr(KIMG, RS128, w * 16, k * 32, lane);
#pragma unroll
                for (int i2 = 0; i2 < 4; ++i2) { f32x4 a = {0.f, 0.f, 0.f, 0.f};
#pragma unroll
                    for (int k = 0; k < 2; ++k) a = MFMA16(akt[k], frag_row(TW, RS64, i2 * 16, k * 32, lane), a);
                    tile_write(WIMG, RS128, i2 * 16, w * 16, lane, a); }
            }
            __syncthreads();
            {   const int ib = w >> 1;
                bf16x8 aw[4];
#pragma unroll
                for (int k = 0; k < 4; ++k) aw[k] = frag_row(WIMG, RS128, ib * 16, k * 32, lane);
#pragma unroll
                for (int t = 0; t < 2; ++t) { const int eb = (w & 1) * 2 + t; f32x4 a = {0.f, 0.f, 0.f, 0.f};
#pragma unroll
                    for (int k = 0; k < 4; ++k) a = MFMA16(aw[k], frag_row(ST, RS128, eb * 16, k * 32, lane), a);
                    f32x4 vn = ut[t] - a, vs;
                    { const f32x4 el4 = *(const LAS f32x4*)(sEL + ib * 16 + 4 * g4); vs = vn * el4; }
                    tile_write(VNT, RS64, eb * 16, ib * 16, lane, vn); tile_write(VNS, RS64, eb * 16, ib * 16, lane, vs); }
            }
            __syncthreads();
            {   const int eb = w >> 1, row0 = chunk_row(b, dir, s);
                bf16x8 as[4], av[2];
#pragma unroll
                for (int k = 0; k < 4; ++k) as[k] = frag_row(ST, RS128, eb * 16, k * 32, lane);
#pragma unroll
                for (int k = 0; k < 2; ++k) av[k] = frag_row(VNT, RS64, eb * 16, k * 32, lane);
#pragma unroll
                for (int t = 0; t < 2; ++t) { const int ib = (w & 1) * 2 + t, i = ib * 16 + l15; f32x4 a = {0.f, 0.f, 0.f, 0.f};
#pragma unroll
                    for (int k = 0; k < 4; ++k) a = MFMA16(as[k], frag_row(QIMG, RS128, ib * 16, k * 32, lane), a);
                    a = a * sEG[i];
#pragma unroll
                    for (int k = 0; k < 2; ++k) a = MFMA16(av[k], frag_row(QKM, RS64, ib * 16, k * 32, lane), a);
                    const int tl = dir ? 63 - i : i; u32x2 o; o.x = pk2(a[0], a[1]); o.y = pk2(a[2], a[3]);
                    *(u32x2*)(P + (size_t)(row0 + tl) * PW0 + (4 + dir) * 1024 + h * 128 + eh * 64 + eb * 16 + 4 * g4) = o; }
                const float al = __expf(sGC[63]);
                bf16x8 akt[2];
#pragma unroll
                for (int k = 0; k < 2; ++k) akt[k] = frag_tr(KIMG, RS128, w * 16, k * 32, lane);
#pragma unroll
                for (int e = 0; e < 4; ++e) { st[e] = st[e] * al;
#pragma unroll
                    for (int k = 0; k < 2; ++k) st[e] = MFMA16(akt[k], frag_row(VNS, RS64, e * 16, k * 32, lane), st[e]); }
            }
            __syncthreads();
#pragma unroll
            for (int e = 0; e < 4; ++e) tile_write(ST, RS128, e * 16, w * 16, lane, st[e]);
        }
    }
}

__device__ __forceinline__ void rwkv_chunk_items(const Ctx& c, int item0, int item_stride, int n_items, bf16_t* Ybase, long ydir_stride, int ystride) {
    const bf16_t* F = (const bf16_t*)(c.ws + WS_F); const bf16_t* P = (const bf16_t*)(c.ws + WS_P);
    const int lane = c.lane, tid = c.tid, w = c.wave, g4 = lane >> 4, l15 = lane & 15;
    LAS unsigned char* KKP = c.lds; LAS unsigned char* RP = c.lds + 9216; LAS unsigned char* TMPVT = c.lds + 18432; LAS unsigned char* WK = c.lds + 27648;
    LAS unsigned char* VIMG = c.lds + 36864; LAS unsigned char* ST = c.lds + 46080; LAS unsigned char* ART = c.lds + 55296; LAS unsigned char* ARA = c.lds + 64512;
    LAS unsigned char* TI = c.lds + 73728; LAS unsigned char* KTI = c.lds + 82944; LAS unsigned char* KAI = c.lds + 92160; LAS unsigned char* AKT = c.lds + 101376;
    LAS unsigned char* UT = AKT;
    LAS float* MF = (LAS float*)(c.lds + 110592); LAS float* EP = (LAS float*)(c.lds + 128000); LAS float* TMP = (LAS float*)(c.lds + 144384); LAS float* sPC = (LAS float*)(c.lds + 146432);
    for (int item = item0; item < n_items; item += item_stride) {
        const int chain = item, b = chain >> 5, h = (chain >> 1) & 15, dir = chain & 1;
        f32x4 st[2] = {{0.f, 0.f, 0.f, 0.f}, {0.f, 0.f, 0.f, 0.f}};
        const int tk = tid >> 3, o8 = tid & 7, ri = dir ? 63 - tk : tk;
        float kav[8];
        { const f32x4 k0 = *(const f32x4*)(c.in[IN_KA] + h * 64 + o8 * 8), k1 = *(const f32x4*)(c.in[IN_KA] + h * 64 + o8 * 8 + 4);
          kav[0] = k0.x; kav[1] = k0.y; kav[2] = k0.z; kav[3] = k0.w; kav[4] = k1.x; kav[5] = k1.y; kav[6] = k1.z; kav[7] = k1.w; }
        u32x4 rr[5], rv;
        auto gload = [&](int s) {
            const int row0 = chunk_row(b, dir, s); const int o = o8 * 8;
            rr[0] = *(const u32x4*)(F + (size_t)3 * MT * 1024 + (size_t)(row0 + tk) * 1024 + h * 64 + o);
            rr[1] = *(const u32x4*)(F + (size_t)4 * MT * 1024 + (size_t)(row0 + tk) * 1024 + h * 64 + o);
            rr[2] = *(const u32x4*)(F + (size_t)5 * MT * 1024 + (size_t)(row0 + tk) * 1024 + h * 64 + o);
            rr[3] = *(const u32x4*)(P + (size_t)(row0 + tk) * PW0 + (0 + dir) * 1024 + h * 64 + o);
            rr[4] = *(const u32x4*)(P + (size_t)(row0 + tk) * PW0 + (2 + dir) * 1024 + h * 64 + o);
            rv = *(const u32x4*)(F + (size_t)6 * MT * 1024 + (size_t)(row0 + tk) * 1024 + h * 64 + o);
        };
        __syncthreads();
        for (int i = tid; i < 64 * 18; i += NTHREADS) ((LAS u32x2*)ST)[i] = (u32x2){0u, 0u};
        gload(0);
        float cx[8];
        auto cum_a = [&]() { float lwf[8]; unpack8(rr[3], lwf);
            *(LAS f32x4*)(EP + ri * 64 + o8 * 8) = (f32x4){__expf(lwf[0]), __expf(lwf[1]), __expf(lwf[2]), __expf(lwf[3])};
            *(LAS f32x4*)(EP + ri * 64 + o8 * 8 + 4) = (f32x4){__expf(lwf[4]), __expf(lwf[5]), __expf(lwf[6]), __expf(lwf[7])}; };
        auto cum_b = [&]() { const int k = tid & 63, seg = tid >> 6; float run = 1.f;
#pragma unroll
            for (int i = 0; i < 8; ++i) { run *= EP[(seg * 8 + i) * 64 + k]; cx[i] = run; }
            TMP[seg * 64 + k] = run; };
        auto cum_c = [&]() { const int k = tid & 63, seg = tid >> 6; float off = 1.f;
#pragma unroll
            for (int q = 0; q < 8; ++q) off *= (q < seg) ? TMP[q * 64 + k] : 1.f;
#pragma unroll
            for (int i = 0; i < 8; ++i) EP[(seg * 8 + i) * 64 + k] = cx[i] * off; };
        cum_a(); __syncthreads(); cum_b(); __syncthreads(); cum_c(); __syncthreads();
#pragma unroll 1
        for (int s = 0; s < 68; ++s) {
            {
                float rf[8], kkf[8], kbf[8], af[8];
                unpack8(rr[0], rf); unpack8(rr[1], kkf); unpack8(rr[2], kbf); unpack8(rr[4], af);
                const f32x4 e0 = *(const LAS f32x4*)(EP + ri * 64 + o8 * 8), e1 = *(const LAS f32x4*)(EP + ri * 64 + o8 * 8 + 4);
                const int rp = ri > 0 ? ri - 1 : 0;
                f32x4 m0 = *(const LAS f32x4*)(EP + rp * 64 + o8 * 8), m1 = *(const LAS f32x4*)(EP + rp * 64 + o8 * 8 + 4);
                if (ri == 0) { m0 = (f32x4){1.f, 1.f, 1.f, 1.f}; m1 = m0; }
                const float ee[8] = {e0.x, e0.y, e0.z, e0.w, e1.x, e1.y, e1.z, e1.w}, em[8] = {m0.x, m0.y, m0.z, m0.w, m1.x, m1.y, m1.z, m1.w};
                float i0[8], i1[8], i2[8], i3[8];
#pragma unroll
                for (int q = 0; q < 8; ++q) { const float kt = kbf[q] * (1.f + (af[q] - 1.f) * kav[q]), kka = kkf[q] * af[q], ei = __builtin_amdgcn_rcpf(ee[q]);
                    i0[q] = kkf[q] * em[q]; i1[q] = rf[q] * ee[q]; i2[q] = kt * ei; i3[q] = kka * ei; }
                const int off = ri * RS64 + o8 * 16;
                *(LAS u32x4*)(KKP + off) = pack8(i0); *(LAS u32x4*)(RP + off) = pack8(i1); *(LAS u32x4*)(KTI + off) = pack8(i2); *(LAS u32x4*)(KAI + off) = pack8(i3);
                *(LAS u32x4*)(VIMG + off) = rv;
                if (ri == 63) { *(LAS f32x4*)(sPC + o8 * 8) = e0; *(LAS f32x4*)(sPC + o8 * 8 + 4) = e1; }
            }
            __syncthreads();
            if (s + 1 < 68) gload(s + 1);
            {   const int tb = w >> 1, t = tb * 16 + l15;
                bf16x8 bkk[2];
#pragma unroll
                for (int k = 0; k < 2; ++k) bkk[k] = frag_row(KKP, RS64, tb * 16, k * 32, lane);
#pragma unroll
                for (int q = 0; q < 2; ++q) { const int sb = (w & 1) * 2 + q; f32x4 aka = {0.f, 0.f, 0.f, 0.f};
#pragma unroll
                    for (int k = 0; k < 2; ++k) aka = MFMA16(frag_row(KAI, RS64, sb * 16, k * 32, lane), bkk[k], aka);
#pragma unroll
                    for (int r = 0; r < 4; ++r) { const int ss = sb * 16 + 4 * g4 + r; aka[r] = ss < t ? aka[r] : 0.f; }
                    *(LAS f32x4*)(MF + t * MS + sb * 16 + 4 * g4) = aka; }
            }
            __syncthreads();
            if (w == 0) tri_inverse_wave0(MF, lane);
            else if (w <= 4) {
                const int tb = w - 1, t = tb * 16 + l15;
                bf16x8 bkk[2];
#pragma unroll
                for (int k = 0; k < 2; ++k) bkk[k] = frag_row(KKP, RS64, tb * 16, k * 32, lane);
#pragma unroll
                for (int sb = 0; sb < 4; ++sb) { f32x4 akt = {0.f, 0.f, 0.f, 0.f};
#pragma unroll
                    for (int k = 0; k < 2; ++k) akt = MFMA16(frag_row(KTI, RS64, sb * 16, k * 32, lane), bkk[k], akt);
#pragma unroll
                    for (int r = 0; r < 4; ++r) { const int ss = sb * 16 + 4 * g4 + r; akt[r] = ss < t ? akt[r] : 0.f; }
                    tile_write(AKT, RS64, tb * 16, sb * 16, lane, akt); }
                bf16x8 aa[2];
#pragma unroll
                for (int k = 0; k < 2; ++k) aa[k] = frag_row(AKT, RS64, tb * 16, k * 32, lane);
#pragma unroll
                for (int vb = 0; vb < 4; ++vb) { f32x4 a = {0.f, 0.f, 0.f, 0.f};
#pragma unroll
                    for (int k = 0; k < 2; ++k) a = MFMA16(aa[k], frag_tr(VIMG, RS64, vb * 16, k * 32, lane), a);
                    tile_write(TMPVT, RS64, vb * 16, tb * 16, lane, a); }
            } else {
#pragma unroll 1
                for (int tile = w - 5; tile < 32; tile += 3) {
                    const int kind = tile >> 4, tb = (tile >> 2) & 3, sb = tile & 3, t = tb * 16 + l15;
                    const LAS unsigned char* src = kind ? KTI : KAI; LAS unsigned char* dst = kind ? ART : ARA;
                    f32x4 a = {0.f, 0.f, 0.f, 0.f};
#pragma unroll
                    for (int k = 0; k < 2; ++k) a = MFMA16(frag_row(src, RS64, sb * 16, k * 32, lane), frag_row(RP, RS64, tb * 16, k * 32, lane), a);
#pragma unroll
                    for (int r = 0; r < 4; ++r) { const int ss = sb * 16 + 4 * g4 + r; a[r] = ss <= t ? a[r] : 0.f; }
                    tile_write(dst, RS64, tb * 16, sb * 16, lane, a); }
            }
            __syncthreads();
            {   const int i = tid >> 3, j8 = (tid & 7) * 8; float x[8];
#pragma unroll
                for (int q = 0; q < 8; ++q) x[q] = MF[i * MS + j8 + q];
                *(LAS u32x4*)(TI + i * RS64 + j8 * 2) = pack8(x); }
            if (s + 1 < 68) cum_a();
            __syncthreads();
            if (s + 1 < 68) cum_b();
            f32x4 y0[2], u0[2];
            {   const int hb = w >> 1;
                bf16x8 akk[2], av[2];
#pragma unroll
                for (int k = 0; k < 2; ++k) { akk[k] = frag_tr(KKP, RS64, hb * 16, k * 32, lane); av[k] = frag_tr(VIMG, RS64, hb * 16, k * 32, lane); }
#pragma unroll
                for (int q = 0; q < 2; ++q) { const int ob = (w & 1) * 2 + q; f32x4 bq = {0.f, 0.f, 0.f, 0.f}; y0[q] = bq;
#pragma unroll
                    for (int k = 0; k < 2; ++k) { bq = MFMA16(akk[k], frag_row(TI, RS64, ob * 16, k * 32, lane), bq);
                        y0[q] = MFMA16(av[k], frag_row(ART, RS64, ob * 16, k * 32, lane), y0[q]); }
                    tile_write(WK, RS64, ob * 16, hb * 16, lane, bq); }
            }
            __syncthreads();
            if (s + 1 < 68) cum_c();
            {   const int tb = w >> 1;
                bf16x8 at[2], awk[2];
#pragma unroll
                for (int k = 0; k < 2; ++k) { at[k] = frag_row(TI, RS64, tb * 16, k * 32, lane); awk[k] = frag_row(WK, RS64, tb * 16, k * 32, lane); }
#pragma unroll
                for (int q = 0; q < 2; ++q) { const int vb = (w & 1) * 2 + q; u0[q] = (f32x4){0.f, 0.f, 0.f, 0.f};
#pragma unroll
                    for (int k = 0; k < 2; ++k) { u0[q] = MFMA16(at[k], frag_row(TMPVT, RS64, vb * 16, k * 32, lane), u0[q]); u0[q] = MFMA16(awk[k], frag_row(ST, RS64, vb * 16, k * 32, lane), u0[q]); }
                    tile_write(UT, RS64, vb * 16, tb * 16, lane, -u0[q]); }
            }
            __syncthreads();
            {   const int hb = w >> 1, row0 = chunk_row(b, dir, s);
                bf16x8 as[2], au[2], akt[2], aka[2];
#pragma unroll
                for (int k = 0; k < 2; ++k) { as[k] = frag_row(ST, RS64, hb * 16, k * 32, lane); au[k] = frag_row(UT, RS64, hb * 16, k * 32, lane);
                    akt[k] = frag_tr(KTI, RS64, hb * 16, k * 32, lane); aka[k] = frag_tr(KAI, RS64, hb * 16, k * 32, lane); }
#pragma unroll
                for (int q = 0; q < 2; ++q) { const int ob = (w & 1) * 2 + q; f32x4 a = y0[q];
#pragma unroll
                    for (int k = 0; k < 2; ++k) { a = MFMA16(as[k], frag_row(RP, RS64, ob * 16, k * 32, lane), a); a = MFMA16(au[k], frag_row(ARA, RS64, ob * 16, k * 32, lane), a); }
                    const int t = ob * 16 + l15, tl = dir ? 63 - t : t; u32x2 o; o.x = pk2(a[0], a[1]); o.y = pk2(a[2], a[3]);
                    *(u32x2*)(Ybase + (long)dir * ydir_stride + (size_t)(row0 + tl) * ystride + h * 64 + hb * 16 + 4 * g4) = o;
#pragma unroll
                    for (int k = 0; k < 2; ++k) { st[q] = MFMA16(akt[k], frag_tr(VIMG, RS64, ob * 16, k * 32, lane), st[q]); st[q] = MFMA16(aka[k], frag_row(UT, RS64, ob * 16, k * 32, lane), st[q]); }
                    st[q] = st[q] * *(const LAS f32x4*)(sPC + hb * 16 + 4 * g4); }
            }
            __syncthreads();
            {   const int hb = w >> 1;
#pragma unroll
                for (int q = 0; q < 2; ++q) tile_write(ST, RS64, ((w & 1) * 2 + q) * 16, hb * 16, lane, st[q]); }
        }
    }
}

#ifndef GEMM_ALIGN
#define GEMM_ALIGN true
#endif
#ifndef GEMM_SP2
#define GEMM_SP2 true
#endif
struct Args { const float* in[32]; float* out; unsigned char* ws; int ph_lo, ph_hi; };
constexpr int NPHASE = 24;
__global__ void __launch_bounds__(NTHREADS, 2) fwd_kernel(Args args) {
    extern __shared__ __attribute__((aligned(16))) unsigned char lds_raw[];
    Ctx c;
    c.lds = (LAS unsigned char*)lds_raw;
    c.tid = threadIdx.x; c.lane = c.tid & 63; c.wave = __builtin_amdgcn_readfirstlane(c.tid >> 6);
    c.G = gridDim.x; c.wg = blockIdx.x; c.gw = c.wg * NWAVES + c.wave; c.NGW = c.G * NWAVES;
#pragma unroll
    for (int i = 0; i < 32; ++i) c.in[i] = args.in[i];
    c.out = args.out; c.ws = args.ws;
    const int lo = args.ph_lo, hi = args.ph_hi;
    volatile LAS unsigned* bst = (volatile LAS unsigned*)(c.lds + LDS_BAR_OFF);
    if (c.tid < 4) bst[c.tid] = 0u;
    __syncthreads();
    XcdBarrier bar; bar.bar = (unsigned*)(c.ws + WS_CTL); bar.x = 0; bar.st = bst;
    if (hi - lo > 1) bar = xcd_barrier_post((unsigned*)(c.ws + WS_CTL), bst);
#define IN(k) (lo <= (k) && (k) < hi)
#define SEAM(k) do { if (IN(k) && IN((k) + 1)) xcd_barrier(bar); } while (0)
    float* MOD = (float*)(c.ws + WS_MOD);
    float* XC = (float*)(c.ws + WS_XC);
    bf16_t* HY = (bf16_t*)(c.ws + WS_HY); bf16_t* Pb = (bf16_t*)(c.ws + WS_P); float* TL = (float*)(c.ws + WS_TAIL);
    bf16_t* Win = (bf16_t*)(c.ws + WS_WIN); bf16_t* Wout = (bf16_t*)(c.ws + WS_WOUT); bf16_t* W13 = (bf16_t*)(c.ws + WS_W13); bf16_t* W2 = (bf16_t*)(c.ws + WS_W2);
    const float* X = c.in[IN_X]; const float* CX = c.in[IN_CTX];

    const bool split11 = (c.G == 256);
    #ifndef SUBREP
#define SUBREP 0
#endif
    if (IN(0)) { ada_phase(c, 0, 0, c.G); __syncthreads(); convert_weights(c, 0, 0, c.G, split11 ? 1 : 3); lora_weight_phase(c); }
    SEAM(0);
    bf16_t* RA = (bf16_t*)c.out; bf16_t* RB = (bf16_t*)(c.ws + WS_WIN); bf16_t* RC = (bf16_t*)XC;
    if (IN(1)) norm_mod_phase<false>(c, X, CX, c.in[IN_NORMW], MOD, 0, D, MT);
    SEAM(1);
    if (IN(2)) { pg8::Gemm g{HY, Win, MT, NIN0, D}; pg8::StaticOrder S; S.init(MT, NIN0, c.G, c.wg); EpiInProj E{Pb, PW0, PW0 / 256, TL, TW0};
        pg8::gemm_phase<EpiInProj, pg8::StaticOrder, GEMM_ALIGN, GEMM_SP2>(c.lds, g, S, E); }
    SEAM(2);
    if (IN(3)) ab_feature_phase(c);
    SEAM(3);
    if (IN(4)) {
        int k256 = 256; asm volatile("" : "+s"(k256));
        { pg8::Gemm g{(const bf16_t*)(c.ws + WS_A1), (const bf16_t*)(c.ws + WS_WL), MT, 4096, k256}; pg8::StaticOrder S; S.init(MT, 4096, c.G, c.wg); EpiLora E{Pb, PW0, c.in[IN_W0], c.in[IN_A0]};
          pg8::gemm_phase<EpiLora, pg8::StaticOrder, GEMM_ALIGN, GEMM_SP2>(c.lds, g, S, E); }
        { pg8::Gemm g{(const bf16_t*)(c.ws + WS_A2), (const bf16_t*)(c.ws + WS_WG), MT, 1024, k256}; pg8::StaticOrder S; S.init(MT, 1024, c.G, split11 ? (c.wg + c.G / 2) % c.G : c.wg); EpiBf16Plain E{(bf16_t*)(c.ws + WS_GOUT), 1024};
          pg8::gemm_phase<EpiBf16Plain, pg8::StaticOrder, GEMM_ALIGN, GEMM_SP2>(c.lds, g, S, E);
          if (split11) { __syncthreads(); convert_weights(c, 0, 144, 112, 2); } } }
    SEAM(4);
    if (IN(5)) {
        gdn_chunk_items(c, c.wg, c.G, 128);
        rwkv_chunk_items(c, (c.wg + c.G / 2) % c.G, c.G, 128, HY + 1024, -1024L, D);
        if (split11) { __syncthreads(); convert_weights(c, 0, 0, 128, 12); } }
    SEAM(5);
    if (IN(7)) ab_output_phase(c);
    SEAM(7);
    if (IN(8)) { pg8::Gemm g{HY, Wout, MT, D, D}; pg8::StaticOrder S; S.init(MT, D, c.G, c.wg); EpiResid<true> E{X, CX, RA, RC, MOD + 2 * D};
        pg8::gemm_phase<EpiResid<true>, pg8::StaticOrder, GEMM_ALIGN, GEMM_SP2>(c.lds, g, S, E);
        __syncthreads(); const int nt3 = (MT / 256) * (D / 256) - 2 * c.G;
        if (split11) convert_weights(c, 1, nt3, c.G - nt3, 3 | 16);
        else if (nt3 > 0 && nt3 < c.G) convert_weights(c, 0, nt3, c.G - nt3, 4); else convert_weights(c, 0, 0, c.G, 4); }
    SEAM(8);
    if (IN(9)) norm_mod_phase<true, true>(c, RA, RC, c.in[IN_NORMW] + D, MOD, 3 * D, 4 * D, MT);
    SEAM(9);
    if (IN(10)) { pg8::Gemm g{HY, W13, MT, 2 * FF, D}; pg8::StaticOrder S; S.init(MT, 2 * FF, c.G, c.wg); EpiSwiGLU E{Pb, FF};
        pg8::gemm_phase<EpiSwiGLU, pg8::StaticOrder, GEMM_ALIGN, GEMM_SP2>(c.lds, g, S, E);
        __syncthreads(); const int nlast = ((MT / 256) * (2 * FF / 256)) % c.G;
        if (split11) convert_weights(c, 1, nlast, c.G - nlast, 8);
        else if (nlast > 0) convert_weights(c, 0, nlast, c.G - nlast, 8); else convert_weights(c, 0, 0, c.G, 8); }
    SEAM(10);
    bf16_t* PD = (bf16_t*)(c.ws + WS_F + 72 * MiB);
    if (IN(11)) {
        if (split11) {
            { pg8::Gemm g{Pb, W2, ML, D, FF}; pg8::StaticOrder S; S.init(ML, D, c.G, c.wg); EpiResid<false> E{RA, RC, RB, RC, MOD + 5 * D};
              pg8::gemm_phase<EpiResid<false>, pg8::StaticOrder, GEMM_ALIGN, GEMM_SP2>(c.lds, g, S, E); }
            { pg8::Gemm g{Pb + (size_t)ML * FF, W2, MC, D, FF / 4, FF}; pg8::SplitOrder4 S{c.wg, FF / 4}; EpiDeltaPart E{PD, MOD + 5 * D, FF / 4};
              pg8::gemm_phase<EpiDeltaPart, pg8::SplitOrder4, GEMM_ALIGN, GEMM_SP2>(c.lds, g, S, E); }
            __syncthreads();
            ada_phase(c, 1, 128, 96);
        } else {
            pg8::Gemm g{Pb, W2, MT, D, FF}; pg8::StaticOrder S; S.init(MT, D, c.G, c.wg); EpiResid<false> E{RA, RC, RB, RC, MOD + 5 * D};
            pg8::gemm_phase<EpiResid<false>, pg8::StaticOrder, GEMM_ALIGN, GEMM_SP2>(c.lds, g, S, E);
            __syncthreads(); const int nt3 = (MT / 256) * (D / 256) - 2 * c.G;
            if (nt3 > 0 && nt3 < c.G) { ada_phase(c, 1, nt3, c.G - nt3); __syncthreads(); convert_weights(c, 1, nt3, c.G - nt3, 31); } else { ada_phase(c, 1, 0, c.G); __syncthreads(); convert_weights(c, 1, 0, c.G, 31); } } }
    SEAM(11);
    if (IN(12)) norm_mod_phase<true>(c, RB, RC, c.in[IN_NORMW] + 2 * D, MOD + 5 * MODW, 0, D, MT, nullptr, RB, RC, split11 ? PD : nullptr);
    SEAM(12);
    if (IN(13)) { pg8::Gemm g{HY, (const bf16_t*)(c.ws + WS_WIN1), MT, NIN1, D}; pg8::StaticOrder S; S.init(MT, NIN1, c.G, c.wg); EpiInProj E{Pb, PW1, PW1 / 256, TL, TW1};
        pg8::gemm_phase<EpiInProj, pg8::StaticOrder, GEMM_ALIGN, GEMM_SP2>(c.lds, g, S, E);
        if (split11) { __syncthreads(); const int nlast = ((MT / 256) * (NIN1 / 256)) % c.G; convert_weights(c, 1, nlast, c.G - nlast, 4); } }
    SEAM(13);
    if (IN(15)) mlstm_chunk_phase(c);
    SEAM(15);
    if (IN(16)) ml_output_phase(c);
    SEAM(16);
    if (IN(17)) { pg8::Gemm g{HY, (const bf16_t*)(c.ws + WS_WOUT1), ML, D, D}; pg8::StaticOrder S; S.init(ML, D, c.G, c.wg); EpiResid<false> E{RB, RC, RB, RC, MOD + 5 * MODW + 2 * D};
        pg8::gemm_phase<EpiResid<false>, pg8::StaticOrder, GEMM_ALIGN, GEMM_SP2>(c.lds, g, S, E); }
    SEAM(17);
    if (IN(18)) norm_mod_phase<true, true>(c, RB, RC, c.in[IN_NORMW] + 3 * D, MOD + 5 * MODW, 3 * D, 4 * D, ML);
    SEAM(18);
    if (IN(19)) { pg8::Gemm g{HY, (const bf16_t*)(c.ws + WS_W131), ML, 2 * FF, D}; pg8::StaticOrder S; S.init(ML, 2 * FF, c.G, c.wg); EpiSwiGLU E{Pb, FF};
        pg8::gemm_phase<EpiSwiGLU, pg8::StaticOrder, GEMM_ALIGN, GEMM_SP2>(c.lds, g, S, E); }
    SEAM(19);
    if (IN(20)) { pg8::Gemm g{Pb, (const bf16_t*)(c.ws + WS_W21), ML, D, FF}; pg8::StaticOrder S; S.init(ML, D, c.G, c.wg); EpiResid<false> E{RB, RC, RB, RC, MOD + 5 * MODW + 5 * D};
        pg8::gemm_phase<EpiResid<false>, pg8::StaticOrder, GEMM_ALIGN, GEMM_SP2>(c.lds, g, S, E); }
    SEAM(20);
    if (IN(21)) final_norm_phase(c, RB);
#undef IN
#undef SEAM
}

#ifndef N_LAUNCH_MODE
#define N_LAUNCH_MODE 1
#endif
extern "C" void kernel_launch(void* const* d_in, const int* in_sizes, int n_in, void* d_out, int out_size, void* d_ws, size_t ws_size, hipStream_t stream) {
    static int grid = 0;
    if (grid == 0) {
        if (n_in != 32 || out_size != ML * D || ws_size < WS_END) { fprintf(stderr, "kernel_launch: unexpected problem (n_in %d out %d ws %zu)\n", n_in, out_size, ws_size); grid = -1; return; }
        int dev = 0, cus = 0;
        if (hipGetDevice(&dev) != hipSuccess || hipDeviceGetAttribute(&cus, hipDeviceAttributeMultiprocessorCount, dev) != hipSuccess) { grid = -1; return; }
        if (hipFuncSetAttribute((const void*)fwd_kernel, hipFuncAttributeMaxDynamicSharedMemorySize, LDS_BYTES) != hipSuccess) { grid = -1; return; }
        int per_cu = 0;
        if (hipOccupancyMaxActiveBlocksPerMultiprocessor(&per_cu, (const void*)fwd_kernel, NTHREADS, LDS_BYTES) != hipSuccess || per_cu < 1) { fprintf(stderr, "kernel_launch: occupancy query says %d\n", per_cu); }
        (void)hipGetLastError();
        grid = cus;
    }
    if (grid < 0) return;
    (void)hipMemsetAsync((char*)d_ws + WS_CTL, 0, CTL_BYTES, stream);
    Args a{};
    for (int i = 0; i < 32; ++i) a.in[i] = (const float*)d_in[i];
    a.out = (float*)d_out; a.ws = (unsigned char*)d_ws;
#if N_LAUNCH_MODE == 1
    a.ph_lo = 0; a.ph_hi = NPHASE;
    hipLaunchKernelGGL(fwd_kernel, dim3(grid), dim3(NTHREADS), LDS_BYTES, stream, a);
#else
    for (int p = 0; p < 22; ++p) { a.ph_lo = p; a.ph_hi = p + 1; hipLaunchKernelGGL(fwd_kernel, dim3(grid), dim3(NTHREADS), LDS_BYTES, stream, a); }
#endif
}
```
